# Optimizing an MI355X kernel written in HIP

```python
import math
import jax
import jax.numpy as jnp
from jax import lax
import numpy as np

D_MODEL = 1024
BATCH = 8
SEQ = 2048
DEPTH = 2

F32 = jnp.float32
GRID_W = 64
CTX_LEN = 256
NORM_EPS = 1e-6

S5_WIDTH = D_MODEL // 4
S5_GROUP_CH = 16
S5_GROUPS = S5_WIDTH // S5_GROUP_CH
S5_STATE = 64

MLA_HEADS = D_MODEL // 128
MLA_NOPE = 64
MLA_ROPE = 32
MLA_V = 64
MLA_Q_LORA = D_MODEL // 4
MLA_KV_LORA = D_MODEL // 8
MLA_Q_BLOCK = 128
MLA_SCALE = 1.0 / math.sqrt(MLA_NOPE + MLA_ROPE)
ROPE_PAIRS = MLA_ROPE // 4
ROPE_BASE = 10000.0

HG_HEADS = D_MODEL // 256
HG_K = 128
HG_V = 64
HG_CHUNK = 64

MOE_GROUPS = 4
MOE_EXPERTS_PER_GROUP = 8
MOE_EXPERTS = MOE_GROUPS * MOE_EXPERTS_PER_GROUP
MOE_TOP_K = 2
MOE_HIDDEN = D_MODEL // 2
MOE_BLOCK = 128

IN_SPLITS = (S5_WIDTH, MLA_Q_LORA, MLA_KV_LORA, MLA_ROPE,
             HG_HEADS * HG_K, HG_HEADS * HG_K, HG_HEADS * HG_K,
             HG_HEADS * HG_V, HG_HEADS * HG_V,
             D_MODEL, D_MODEL, D_MODEL)
IN_COLS = sum(IN_SPLITS)

kernel_name = 'hybrid_s5_mla_hgrn2_hmoe_dit'


def rms_norm(x, g):
    xf = x.astype(F32)
    y = xf * lax.rsqrt(jnp.mean(xf * xf, axis=-1, keepdims=True) + NORM_EPS)
    return (y * g.astype(F32)).astype(x.dtype)


def modulate(h, shift, scale):
    return h * (1 + scale) + shift


def split_columns(z):
    cuts = [int(v) for v in np.cumsum(IN_SPLITS)[:-1]]
    return jnp.split(z, cuts, axis=-1)


def rev(a, direction, axis):
    return jnp.flip(a, axis=axis) if direction == 1 else a


def axial_rope_angles(n_tokens):
    rows = n_tokens // GRID_W
    row = jnp.repeat(jnp.arange(rows, dtype=F32), GRID_W)
    col = jnp.tile(jnp.arange(GRID_W, dtype=F32), rows)
    inv = ROPE_BASE ** (-jnp.arange(ROPE_PAIRS, dtype=F32) / ROPE_PAIRS)
    ang = jnp.stack([row[:, None] * inv, col[:, None] * inv], axis=1)
    return jnp.cos(ang), jnp.sin(ang)


def apply_axial_rope(x, cos, sin):
    shp = x.shape
    xr = x.astype(F32).reshape(shp[:-1] + (2, 2, ROPE_PAIRS))
    x1, x2 = xr[..., 0, :], xr[..., 1, :]
    out = jnp.stack([x1 * cos - x2 * sin, x1 * sin + x2 * cos], axis=-2)
    return out.reshape(shp).astype(x.dtype)


def s5_discretise(lam_re, lam_im, b_re, b_im, log_step):
    lam_re, lam_im = lam_re.astype(F32), lam_im.astype(F32)
    b_re, b_im = b_re.astype(F32), b_im.astype(F32)
    dt = jnp.exp(log_step.astype(F32))[:, None]
    mag = jnp.exp(lam_re * dt)
    lb_re, lb_im = mag * jnp.cos(lam_im * dt), mag * jnp.sin(lam_im * dt)
    den = lam_re * lam_re + lam_im * lam_im
    fr = ((lb_re - 1) * lam_re + lb_im * lam_im) / den
    fi = (lb_im * lam_re - (lb_re - 1) * lam_im) / den
    bb_re = fr[..., None] * b_re - fi[..., None] * b_im
    bb_im = fr[..., None] * b_im + fi[..., None] * b_re
    return lb_re, lb_im, bb_re, bb_im


def s5_states(u, lb_re, lb_im, bb_re, bb_im, h0_re, h0_im):
    bu_re = jnp.einsum('blgh,gph->blgp', u, bb_re)
    bu_im = jnp.einsum('blgh,gph->blgp', u, bb_im)
    bu_re = bu_re.at[:, 0].add(lb_re * h0_re - lb_im * h0_im)
    bu_im = bu_im.at[:, 0].add(lb_re * h0_im + lb_im * h0_re)
    a_re = jnp.broadcast_to(lb_re, bu_re.shape)
    a_im = jnp.broadcast_to(lb_im, bu_im.shape)

    def combine(e1, e2):
        a1r, a1i, b1r, b1i = e1
        a2r, a2i, b2r, b2i = e2
        return (a2r * a1r - a2i * a1i, a2r * a1i + a2i * a1r,
                a2r * b1r - a2i * b1i + b2r, a2r * b1i + a2i * b1r + b2i)

    _, _, h_re, h_im = lax.associative_scan(combine, (a_re, a_im, bu_re, bu_im), axis=1)
    return h_re, h_im


def s5_readout(h_re, h_im, c_re, c_im):
    return jnp.einsum('blgp,ghp->blgh', h_re, c_re) - jnp.einsum('blgp,ghp->blgh', h_im, c_im)


def s5_mixer(u_lat, u_ctx, lam_re, lam_im, b_re, b_im, c_re, c_im, log_step, d_skip,
             glu_w, glu_b, need_ctx):
    def grouped(u):
        return u.astype(F32).reshape(u.shape[0], u.shape[1], S5_GROUPS, S5_GROUP_CH)

    ul, uc = grouped(u_lat), grouped(u_ctx)
    zero = jnp.zeros((ul.shape[0], S5_GROUPS, S5_STATE), F32)
    y_lat, y_ctx = 0.0, 0.0
    for d in range(2):
        lb_re, lb_im, bb_re, bb_im = s5_discretise(lam_re[d], lam_im[d], b_re[d], b_im[d], log_step[d])
        cr, ci = c_re[d].astype(F32), c_im[d].astype(F32)
        hc_re, hc_im = s5_states(rev(uc, d, 1), lb_re, lb_im, bb_re, bb_im, zero, zero)
        hl_re, hl_im = s5_states(rev(ul, d, 1), lb_re, lb_im, bb_re, bb_im, hc_re[:, -1], hc_im[:, -1])
        y_lat = y_lat + rev(s5_readout(hl_re, hl_im, cr, ci), d, 1)
        if need_ctx:
            y_ctx = y_ctx + rev(s5_readout(hc_re, hc_im, cr, ci), d, 1)

    def finish(y, u, like):
        y = jax.nn.gelu(y + d_skip.astype(F32).reshape(S5_GROUPS, S5_GROUP_CH) * u).reshape(like.shape)
        y = y * jax.nn.sigmoid(y @ glu_w.astype(F32) + glu_b.astype(F32))
        return y.astype(like.dtype)

    return finish(y_lat, ul, u_lat), (finish(y_ctx, uc, u_ctx) if need_ctx else None)


def mla_queries(cq, qa_g, w_uq, cos, sin):
    n_b, n_t, _ = cq.shape
    q = (rms_norm(cq, qa_g) @ w_uq).reshape(n_b, n_t, MLA_HEADS, MLA_NOPE + MLA_ROPE)
    q_nope, q_pe = q[..., :MLA_NOPE], q[..., MLA_NOPE:]
    if cos is not None:
        q_pe = apply_axial_rope(q_pe, cos[:, None], sin[:, None])
    return q_nope, q_pe


def mla_keys_values(ckv, k_pe, kva_g, w_uk, w_uv, cos, sin):
    n_b, n_t, _ = ckv.shape
    ckv = rms_norm(ckv, kva_g)
    k_nope = (ckv @ w_uk).reshape(n_b, n_t, MLA_HEADS, MLA_NOPE)
    v = (ckv @ w_uv).reshape(n_b, n_t, MLA_HEADS, MLA_V)
    if cos is not None:
        k_pe = apply_axial_rope(k_pe, cos, sin)
    return k_nope, k_pe, v


def mla_attend(q_nope, q_pe, k_nope, k_pe, v):
    s = (jnp.einsum('bqhd,bkhd->bhqk', q_nope, k_nope)
         + jnp.einsum('bqhr,bkr->bhqk', q_pe, k_pe)).astype(F32)
    p = jax.nn.softmax(s * MLA_SCALE, axis=-1).astype(v.dtype)
    return jnp.einsum('bhqk,bkhd->bqhd', p, v)


def mla_attend_blocked(q_nope, q_pe, k_nope, k_pe, v):
    n_b, n_t = q_nope.shape[:2]
    n_blk = n_t // MLA_Q_BLOCK

    def blocks(a):
        return jnp.moveaxis(a.reshape((n_b, n_blk, MLA_Q_BLOCK) + a.shape[2:]), 1, 0)

    out = lax.map(lambda qb: mla_attend(qb[0], qb[1], k_nope, k_pe, v), (blocks(q_nope), blocks(q_pe)))
    return jnp.moveaxis(out, 0, 1).reshape(n_b, n_t, MLA_HEADS * MLA_V)


def hgrn2_chunk_scan(q, k, v, log_f, s0):
    n_b, n_h, n_t, _ = q.shape
    d_v = v.shape[-1]
    n_c = n_t // HG_CHUNK

    def chunks(a):
        return jnp.moveaxis(a.reshape(n_b, n_h, n_c, HG_CHUNK, a.shape[-1]), 2, 0)

    lower = jnp.tril(jnp.ones((HG_CHUNK, HG_CHUNK), bool))[:, :, None]

    def step(state, inp):
        qc, kc, vc, gc = inp
        b = jnp.cumsum(gc, axis=2)
        o_inter = jnp.einsum('bhtk,bhkv->bhtv', qc * jnp.exp(b), state)
        decay = jnp.exp(jnp.where(lower, b[:, :, :, None, :] - b[:, :, None, :, :], -jnp.inf))
        scores = jnp.einsum('bhtk,bhsk,bhtsk->bhts', qc, kc, decay)
        o = o_inter + jnp.einsum('bhts,bhsv->bhtv', scores, vc)
        b_last = b[:, :, -1:, :]
        state = (jnp.exp(b_last[:, :, 0, :, None]) * state
                 + jnp.einsum('bhsk,bhsv->bhkv', kc * jnp.exp(b_last - b), vc))
        return state, o

    state, o = lax.scan(step, s0, (chunks(q), chunks(k), chunks(v), chunks(log_f)))
    return jnp.moveaxis(o, 0, 2).reshape(n_b, n_h, n_t, d_v), state


def hgrn2_mixer(parts_lat, parts_ctx, lb, norm_g, need_ctx):
    def heads(a, dh):
        return a.astype(F32).reshape(a.shape[0], a.shape[1], HG_HEADS, dh).transpose(0, 2, 1, 3)

    def forget(z):
        log_f = jnp.logaddexp(jnp.log(lb), jnp.log1p(-lb) + jax.nn.log_sigmoid(heads(z, HG_K)))
        return -jnp.expm1(log_f), log_f

    q_l, i_l = heads(parts_lat[0], HG_K), heads(parts_lat[3], HG_V)
    q_c, i_c = heads(parts_ctx[0], HG_K), heads(parts_ctx[3], HG_V)
    state0 = jnp.zeros((q_l.shape[0], HG_HEADS, HG_K, HG_V), F32)
    o_lat, o_ctx = 0.0, 0.0
    for d in range(2):
        k_c, lf_c = forget(parts_ctx[1 + d])
        k_l, lf_l = forget(parts_lat[1 + d])
        oc, s_ctx = hgrn2_chunk_scan(rev(q_c, d, 2), rev(k_c, d, 2), rev(i_c, d, 2), rev(lf_c, d, 2), state0)
        ol, _ = hgrn2_chunk_scan(rev(q_l, d, 2), rev(k_l, d, 2), rev(i_l, d, 2), rev(lf_l, d, 2), s_ctx)
        o_lat = o_lat + rev(ol, d, 2)
        if need_ctx:
            o_ctx = o_ctx + rev(oc, d, 2)

    def finish(o, g):
        o = o.transpose(0, 2, 1, 3)
        o = o * lax.rsqrt(jnp.mean(o * o, axis=-1, keepdims=True) + NORM_EPS)
        o = o * norm_g.astype(F32).reshape(HG_HEADS, HG_V) * jax.nn.silu(g.astype(F32)).reshape(o.shape)
        return o.reshape(g.shape).astype(g.dtype)

    return finish(o_lat, parts_lat[4]), (finish(o_ctx, parts_ctx[4]) if need_ctx else None)


def merge_branches(gates, y_s5, y_mla, y_hg, w_pa, w_pb, w_pc, w_out):
    g_a, g_b, g_c = gates
    merged = (jax.nn.sigmoid(g_a) * (y_s5 @ w_pa)
              + jax.nn.sigmoid(g_b) * (y_mla @ w_pb)
              + jax.nn.sigmoid(g_c) * (y_hg @ w_pc))
    return merged @ w_out


def hier_moe(h, w_group, b_group, w_expert, b_expert, w1, w3, w2):
    n_tok = h.shape[0]
    hf = h.astype(F32)
    g_prob = jax.nn.softmax(hf @ w_group.astype(F32) + b_group.astype(F32), axis=-1)
    g_w, g_idx = lax.top_k(g_prob, 1)
    e_logits = (hf @ w_expert.astype(F32) + b_expert.astype(F32)).reshape(
        n_tok, MOE_GROUPS, MOE_EXPERTS_PER_GROUP)
    e_logits = jnp.take_along_axis(e_logits, g_idx[:, :, None], axis=1)[:, 0]
    top_v, top_i = lax.top_k(e_logits, MOE_TOP_K)
    gate = jax.nn.softmax(top_v, axis=-1) * g_w
    expert = g_idx * MOE_EXPERTS_PER_GROUP + top_i

    n_assign = n_tok * MOE_TOP_K
    flat_e = expert.reshape(n_assign)
    order = jnp.argsort(flat_e)
    s_exp = flat_e[order]
    s_tok = order // MOE_TOP_K
    s_gate = gate.reshape(n_assign)[order]
    counts = jnp.bincount(flat_e, length=MOE_EXPERTS)
    starts = jnp.cumsum(counts) - counts
    padded = (counts + MOE_BLOCK - 1) // MOE_BLOCK * MOE_BLOCK
    p_ends = jnp.cumsum(padded)
    dest = (p_ends - padded)[s_exp] + jnp.arange(n_assign) - starts[s_exp]
    n_blocks = (n_assign + MOE_EXPERTS * (MOE_BLOCK - 1) + MOE_BLOCK - 1) // MOE_BLOCK
    buf = jnp.zeros((n_blocks * MOE_BLOCK, h.shape[1]), h.dtype).at[dest].set(h[s_tok])
    block_expert = jnp.minimum(
        jnp.searchsorted(p_ends, jnp.arange(n_blocks) * MOE_BLOCK, side='right'), MOE_EXPERTS - 1)

    def expert_block(args):
        xb, e = args
        return (jax.nn.silu(xb @ w1[e]) * (xb @ w3[e])) @ w2[e]

    y = lax.map(expert_block, (buf.reshape(n_blocks, MOE_BLOCK, -1), block_expert))
    y = y.reshape(n_blocks * MOE_BLOCK, -1)[dest].astype(F32) * s_gate[:, None]
    return jnp.zeros(h.shape, F32).at[s_tok].add(y).astype(h.dtype)


def setup_inputs(seed: int = 0) -> dict:
    key = jax.random.key(seed)
    ks = iter(jax.random.split(key, 48))

    def nrm(shape, scale):
        return jax.random.normal(next(ks), shape, F32) * scale

    L, G, P, H5, E = DEPTH, S5_GROUPS, S5_STATE, S5_GROUP_CH, MOE_EXPERTS
    n_idx = jnp.arange(S5_STATE, dtype=F32)
    return {
        'x': nrm((BATCH, SEQ, D_MODEL), 1.0),
        'c': nrm((BATCH, D_MODEL), 1.0),
        'ctx': nrm((BATCH, CTX_LEN, D_MODEL), 1.0),
        'c_ctx': nrm((D_MODEL,), 1.0),
        'mod_w': nrm((L, D_MODEL, 6 * D_MODEL), 0.5 * D_MODEL ** -0.5),
        'mod_b': nrm((L, 6 * D_MODEL), 0.01),
        'norm1_g': 1.0 + nrm((L, D_MODEL), 0.05),
        'norm2_g': 1.0 + nrm((L, D_MODEL), 0.05),
        'w_in': nrm((L, D_MODEL, IN_COLS), D_MODEL ** -0.5),
        's5_lam_re': -0.5 + nrm((L, 2, G, P), 0.01),
        's5_lam_im': math.pi * n_idx + nrm((L, 2, G, P), 0.01),
        's5_b_re': nrm((L, 2, G, P, H5), (2 * H5) ** -0.5),
        's5_b_im': nrm((L, 2, G, P, H5), (2 * H5) ** -0.5),
        's5_c_re': nrm((L, 2, G, H5, P), 0.5),
        's5_c_im': nrm((L, 2, G, H5, P), 0.5),
        's5_log_step': jax.random.uniform(next(ks), (L, 2, G), F32, math.log(1e-3), math.log(1e-1)),
        's5_d': nrm((L, S5_WIDTH), 1.0),
        's5_glu_w': nrm((L, S5_WIDTH, S5_WIDTH), S5_WIDTH ** -0.5),
        's5_glu_b': nrm((L, S5_WIDTH), 0.01),
        'mla_qa_g': 1.0 + nrm((L, MLA_Q_LORA), 0.05),
        'mla_kva_g': 1.0 + nrm((L, MLA_KV_LORA), 0.05),
        'mla_w_uq': nrm((L, MLA_Q_LORA, MLA_HEADS * (MLA_NOPE + MLA_ROPE)), MLA_Q_LORA ** -0.5),
        'mla_w_uk': nrm((L, MLA_KV_LORA, MLA_HEADS * MLA_NOPE), MLA_KV_LORA ** -0.5),
        'mla_w_uv': nrm((L, MLA_KV_LORA, MLA_HEADS * MLA_V), MLA_KV_LORA ** -0.5),
        'hg_lb_logits': nrm((L,), 1.0),
        'hg_norm_g': 1.0 + nrm((L, HG_HEADS * HG_V), 0.05),
        'w_pa': nrm((L, S5_WIDTH, D_MODEL), S5_WIDTH ** -0.5),
        'w_pb': nrm((L, MLA_HEADS * MLA_V, D_MODEL), (MLA_HEADS * MLA_V) ** -0.5),
        'w_pc': nrm((L, HG_HEADS * HG_V, D_MODEL), (HG_HEADS * HG_V) ** -0.5),
        'w_out': nrm((L, D_MODEL, D_MODEL), D_MODEL ** -0.5),
        'moe_w_group': nrm((L, D_MODEL, MOE_GROUPS), D_MODEL ** -0.5),
        'moe_b_group': nrm((L, MOE_GROUPS), 0.01),
        'moe_w_expert': nrm((L, D_MODEL, E), D_MODEL ** -0.5),
        'moe_b_expert': nrm((L, E), 0.01),
        'moe_w1': nrm((L, E, D_MODEL, MOE_HIDDEN), D_MODEL ** -0.5),
        'moe_w3': nrm((L, E, D_MODEL, MOE_HIDDEN), D_MODEL ** -0.5),
        'moe_w2': nrm((L, E, MOE_HIDDEN, D_MODEL), MOE_HIDDEN ** -0.5),
        'final_norm_g': 1.0 + nrm((D_MODEL,), 0.05),
    }


def reference(x, c, ctx, c_ctx, mod_w, mod_b, norm1_g, norm2_g, w_in,
              s5_lam_re, s5_lam_im, s5_b_re, s5_b_im, s5_c_re, s5_c_im, s5_log_step, s5_d,
              s5_glu_w, s5_glu_b,
              mla_qa_g, mla_kva_g, mla_w_uq, mla_w_uk, mla_w_uv,
              hg_lb_logits, hg_norm_g,
              w_pa, w_pb, w_pc, w_out,
              moe_w_group, moe_b_group, moe_w_expert, moe_b_expert, moe_w1, moe_w3, moe_w2,
              final_norm_g):
    n_b, n_lat, _ = x.shape
    cos, sin = axial_rope_angles(n_lat)
    lb_all = jnp.cumsum(jax.nn.softmax(hg_lb_logits.astype(F32)))
    lb_all = lb_all - lb_all[0]
    silu_c = jax.nn.silu(c)
    silu_cc = jax.nn.silu(c_ctx)
    x_lat, x_ctx = x, ctx
    for layer in range(DEPTH):
        need_ctx = layer < DEPTH - 1
        mod_l = jnp.split((silu_c @ mod_w[layer] + mod_b[layer])[:, None, :], 6, axis=-1)
        mod_c = jnp.split(silu_cc @ mod_w[layer] + mod_b[layer], 6, axis=-1)

        h_lat = modulate(rms_norm(x_lat, norm1_g[layer]), mod_l[0], mod_l[1])
        h_ctx = modulate(rms_norm(x_ctx, norm1_g[layer]), mod_c[0], mod_c[1])
        z_lat = split_columns(h_lat @ w_in[layer])
        z_ctx = split_columns(h_ctx @ w_in[layer])

        s5_lat, s5_ctx = s5_mixer(z_lat[0], z_ctx[0], s5_lam_re[layer], s5_lam_im[layer],
                                  s5_b_re[layer], s5_b_im[layer], s5_c_re[layer], s5_c_im[layer],
                                  s5_log_step[layer], s5_d[layer], s5_glu_w[layer], s5_glu_b[layer],
                                  need_ctx)

        kn_l, kp_l, v_l = mla_keys_values(z_lat[2], z_lat[3], mla_kva_g[layer], mla_w_uk[layer],
                                          mla_w_uv[layer], cos, sin)
        kn_c, kp_c, v_c = mla_keys_values(z_ctx[2], z_ctx[3], mla_kva_g[layer], mla_w_uk[layer],
                                          mla_w_uv[layer], None, None)
        qn_l, qp_l = mla_queries(z_lat[1], mla_qa_g[layer], mla_w_uq[layer], cos, sin)
        mla_lat = mla_attend_blocked(qn_l, qp_l,
                                     jnp.concatenate([kn_l, kn_c], axis=1),
                                     jnp.concatenate([kp_l, kp_c], axis=1),
                                     jnp.concatenate([v_l, v_c], axis=1))

        hg_lat, hg_ctx = hgrn2_mixer(tuple(z_lat[4:9]), tuple(z_ctx[4:9]), lb_all[layer],
                                     hg_norm_g[layer], need_ctx)

        y_lat = merge_branches(z_lat[9:12], s5_lat, mla_lat, hg_lat,
                               w_pa[layer], w_pb[layer], w_pc[layer], w_out[layer])
        x_lat = x_lat + mod_l[2] * y_lat
        if need_ctx:
            qn_c, qp_c = mla_queries(z_ctx[1], mla_qa_g[layer], mla_w_uq[layer], None, None)
            mla_ctx = mla_attend(qn_c, qp_c, kn_c, kp_c, v_c).reshape(n_b, -1, MLA_HEADS * MLA_V)
            y_ctx = merge_branches(z_ctx[9:12], s5_ctx, mla_ctx, hg_ctx,
                                   w_pa[layer], w_pb[layer], w_pc[layer], w_out[layer])
            x_ctx = x_ctx + mod_c[2] * y_ctx

        h2_lat = modulate(rms_norm(x_lat, norm2_g[layer]), mod_l[3], mod_l[4]).reshape(-1, D_MODEL)
        n_lat_tok = h2_lat.shape[0]
        if need_ctx:
            h2_ctx = modulate(rms_norm(x_ctx, norm2_g[layer]), mod_c[3], mod_c[4]).reshape(-1, D_MODEL)
            tokens = jnp.concatenate([h2_lat, h2_ctx], axis=0)
        else:
            tokens = h2_lat
        f = hier_moe(tokens, moe_w_group[layer], moe_b_group[layer], moe_w_expert[layer],
                     moe_b_expert[layer], moe_w1[layer], moe_w3[layer], moe_w2[layer])
        x_lat = x_lat + mod_l[5] * f[:n_lat_tok].reshape(x_lat.shape)
        if need_ctx:
            x_ctx = x_ctx + mod_c[5] * f[n_lat_tok:].reshape(x_ctx.shape)
    return rms_norm(x_lat, final_norm_g)
```

```cpp
#include <hip/hip_runtime.h>
#include <cstdio>
#include <cstdint>

#ifndef NAIVE_ATTN
#define NAIVE_ATTN 0
#endif
#ifndef NAIVE_S5
#define NAIVE_S5 0
#endif
#ifndef NAIVE_HG
#define NAIVE_HG 0
#endif
#ifndef PROBE_PH
#define PROBE_PH 0
#endif
#ifndef PROBE_N
#define PROBE_N 1
#endif
#define REP(id) for (int rep_ = 0; rep_ < ((PROBE_PH == (id)) ? PROBE_N : 1); ++rep_)
#ifndef MK_PER_PHASE
#define MK_PER_PHASE 0
#endif

#define GAS __attribute__((address_space(1)))
#define LAS __attribute__((address_space(3)))
typedef unsigned short bf16_t;
typedef short bf16x8 __attribute__((ext_vector_type(8)));
typedef float f32x4 __attribute__((ext_vector_type(4)));
typedef float f32x2 __attribute__((ext_vector_type(2)));
typedef float f32x16 __attribute__((ext_vector_type(16)));
typedef unsigned u32x4 __attribute__((ext_vector_type(4)));
typedef unsigned u32x2 __attribute__((ext_vector_type(2)));
typedef GAS unsigned gu32;

constexpr int D = 1024, NB = 8, SEQ = 2048, CTXL = 256, NLAT = NB * SEQ, NCTX = NB * CTXL, MTOK = NLAT + NCTX;
constexpr int ZC = 5888, INC = 5792;
constexpr int ZU = 0, ZCQ = 256, ZCKV = 512, ZKPE = 640, ZHQ = 672, ZF0 = 1184, ZF1 = 1696, ZI = 2208, ZG = 2464, ZGA = 2720, ZGB = 3744, ZGC = 4768;
constexpr float EPS = 1e-6f;
constexpr float QSCALE = 0.10206207261596577f * 1.4426950408889634f;
constexpr int NEXP = 32, HID = 512;
constexpr int XS_ROWS = 45056;

constexpr size_t MiB = 1u << 20;
constexpr size_t WS_CTL = 0, CTL_ZERO_BYTES = 96 * 1024;
constexpr size_t WS_MODV = 1 * MiB;
constexpr size_t WS_ROPE = 2 * MiB;
constexpr size_t WS_SSQ = 2 * MiB + 65536;
constexpr size_t WS_ROUTE = 3 * MiB;
constexpr size_t WS_S5P = 4 * MiB;
constexpr size_t WS_LISTS = 5 * MiB;
constexpr size_t WS_WB = 8 * MiB;
constexpr size_t WL_WIN = 0, WL_UQ = WL_WIN + (size_t)ZC * D * 2, WL_UKV = WL_UQ + 768 * 256 * 2, WL_GLU = WL_UKV + 1024 * 128 * 2,
                 WL_PA = WL_GLU + 256 * 256 * 2, WL_PB = WL_PA + 1024 * 256 * 2, WL_PC = WL_PB + 1024 * 512 * 2, WL_OUT = WL_PC + 1024 * 256 * 2,
                 WL_BS = WL_OUT + 1024 * 1024 * 2, WL_B2 = WL_BS + 32 * 128 * 256 * 2, WL_END = WL_B2 + 16 * 256 * 512 * 2;
constexpr size_t WL_STRIDE = 24 * MiB;
static_assert(WL_END <= WL_STRIDE, "weights per layer");
constexpr size_t WS_X = 56 * MiB;
constexpr size_t WS_H = 128 * MiB;
constexpr size_t WS_MIX = 164 * MiB;
constexpr size_t MX_Q = 0, MX_KN = MX_Q + (size_t)MTOK * 768 * 2, MX_V = MX_KN + (size_t)MTOK * 512 * 2, MX_KPE = MX_V + (size_t)MTOK * 512 * 2,
                 MX_YS5P = MX_KPE + (size_t)MTOK * 32 * 2, MX_YS5 = MX_YS5P + (size_t)MTOK * 256 * 2, MX_YHG = MX_YS5 + (size_t)MTOK * 256 * 2,
                 MX_YMLA = MX_YHG + (size_t)MTOK * 256 * 2, MX_S5A = MX_YMLA + (size_t)MTOK * 512 * 2, MX_HGD = MX_S5A + (size_t)16 * 1280 * 512 * 2,
                 MX_END = MX_HGD + (size_t)2304 * 128 * 4;
static_assert(MX_END <= 132 * MiB, "mixer region");
constexpr size_t MW_W13 = 0, MW_W2 = (size_t)NEXP * 1024 * 1024 * 2;
static_assert(MW_W2 + (size_t)NEXP * 1024 * 512 * 2 <= 132 * MiB, "moe weights");
constexpr size_t WS_Z = 296 * MiB;
constexpr size_t MZ_XS = 0, MZ_HID = (size_t)XS_ROWS * 1024 * 2;
constexpr size_t WS_END = WS_Z + (size_t)MTOK * ZC * 2;
static_assert(MZ_HID + (size_t)XS_ROWS * 512 * 2 <= (size_t)MTOK * ZC * 2, "moe buffers");
constexpr int CW_BAR = 4096;
constexpr int CW_CNT = 16384;

__device__ __forceinline__ unsigned f2bf(float f) { unsigned u = __builtin_bit_cast(unsigned, f); return (u + 0x7fffu + ((u >> 16) & 1u)) >> 16; }
typedef __bf16 bf16x2_t __attribute__((ext_vector_type(2)));
__device__ __forceinline__ unsigned pk2(float lo, float hi) { const f32x2 v = {lo, hi}; return __builtin_bit_cast(unsigned, __builtin_convertvector(v, bf16x2_t)); }
__device__ __forceinline__ float bf2f(unsigned short b) { return __builtin_bit_cast(float, (unsigned)b << 16); }
__device__ __forceinline__ float bflo(unsigned w) { return __builtin_bit_cast(float, w << 16); }
__device__ __forceinline__ float bfhi(unsigned w) { return __builtin_bit_cast(float, w & 0xffff0000u); }
template <int CTRL> __device__ __forceinline__ float dppf(float v) { return __builtin_bit_cast(float, __builtin_amdgcn_update_dpp(0, __builtin_bit_cast(int, v), CTRL, 0xf, 0xf, true)); }
__device__ __forceinline__ float rlanef(float v, int l) { return __builtin_bit_cast(float, __builtin_amdgcn_readlane(__builtin_bit_cast(int, v), l)); }
__device__ __forceinline__ float wave_sum(float v) {
    v += dppf<0xB1>(v); v += dppf<0x4E>(v); v += dppf<0x141>(v); v += dppf<0x140>(v);
    return (rlanef(v, 0) + rlanef(v, 16)) + (rlanef(v, 32) + rlanef(v, 48));
}
__device__ __forceinline__ int shfl_i(int v, int src_lane) { return __builtin_amdgcn_ds_bpermute(src_lane << 2, v); }
__device__ __forceinline__ float shfl_f(float v, int src_lane) { return __builtin_bit_cast(float, __builtin_amdgcn_ds_bpermute(src_lane << 2, __builtin_bit_cast(int, v))); }
__device__ __forceinline__ float sigmoidf_(float x) { return __builtin_amdgcn_rcpf(1.f + __expf(-x)); }
__device__ __forceinline__ float siluf_(float x) { return x * __builtin_amdgcn_rcpf(1.f + __expf(-x)); }
__device__ __forceinline__ float gelu_tanh(float x) { const float t = 0.7978845608028654f * (x + 0.044715f * x * x * x); return x * __builtin_amdgcn_rcpf(1.f + __expf(-2.f * t)); }
__device__ __forceinline__ int tok_modrow(int row) { return row < NLAT ? (row >> 11) : 8; }

namespace pg8 {
constexpr int BM = 256, BK = 64, HALF = 128, HTB = HALF * BK * 2, STAGE_BYTES = 8 * HTB, NXCD = 8, WGM = 8;
__host__ __device__ __forceinline__ int lds_byte(int r, int c) { const int st = (r >> 4) * 2 + (c >> 5), rr = r & 15, cc = c & 31, ob = rr * 64 + cc * 2; return st * 1024 + (ob ^ (((ob >> 9) & 1) << 5)); }
__host__ __device__ __forceinline__ void stage_rc(int b, int& R, int& C) { const int st = b / 1024, sb = b % 1024, swz = sb ^ (((sb >> 9) & 1) << 5); R = (st >> 1) * 16 + swz / 64; C = (st & 1) * 32 + (swz % 64) / 2; }
__host__ __device__ __forceinline__ int perm32(int rho) { const int n = rho >> 4, i = rho & 15; return 8 * (i >> 2) + 4 * n + (i & 3); }
struct Unit { int pm, pn; };
struct Gemm { const bf16_t* A; const bf16_t* Bt; int K, lda, ldb; };
struct StaticOrder {
    int nM, nN, nwg, G, c;
    __device__ void init(int M, int N, int G_, int c_) { nM = M / BM; nN = N / BM; nwg = nM * nN; G = G_; c = c_; }
    __device__ bool next(int i, Unit& u) const {
        const long L = (long)i * G + c; if (L >= nwg) return false;
        int wgid = (int)L; { const int q = nwg / NXCD, r = nwg % NXCD, xcd = wgid % NXCD, off = wgid / NXCD; wgid = (xcd < r ? xcd * (q + 1) : r * (q + 1) + (xcd - r) * q) + off; }
        const int nig = WGM * nN, gid = wgid / nig, fm = gid * WGM, gsz = (nM - fm) < WGM ? (nM - fm) : WGM;
        u.pm = fm + ((wgid % nig) % gsz); u.pn = (wgid % nig) / gsz; return true;
    }
};
template <class Epi, class Sched, bool GATHER = false>
__device__ __forceinline__ void gemm_phase(LAS unsigned char* lds, int tid_in, const Gemm g, const Sched& S, const Epi& E) {
    int tid_ = tid_in; asm volatile("" : "+v"(tid_));
    const int tid = tid_, wid = __builtin_amdgcn_readfirstlane(tid >> 6), lane = tid & 63, wr = wid >> 2, wc = wid & 3, fr = lane & 15, fq = lane >> 4;
    const int K = g.K, nt = K / BK;
    unsigned voffB[2], vAc[2][2], vAx[2][2];
#pragma unroll
    for (int i = 0; i < 2; ++i) { int R, C; stage_rc(tid * 16 + i * 8192, R, C); const int Rb = (R & ~31) + perm32(R & 31);
        voffB[i] = (unsigned)(Rb * g.ldb + C) * 2u;
#pragma unroll
        for (int h = 0; h < 2; ++h) vAc[h][i] = vAx[h][i] = (unsigned)((R + 128 * h) * g.lda + C) * 2u; }
#define PG8_GROWS(dst, uidx) do { if constexpr (GATHER) { _Pragma("unroll") for (int i_ = 0; i_ < 2; ++i_) { int R_, C_; stage_rc(tid * 16 + i_ * 8192, R_, C_); \
        _Pragma("unroll") for (int h_ = 0; h_ < 2; ++h_) dst[h_][i_] = (unsigned)(S.a_row((uidx), R_ + 128 * h_) * g.lda + C_) * 2u; } } } while (0)
    const size_t kstep = (size_t)(BK * 2);
    const size_t hstepA = (size_t)HALF * g.lda * 2, hstepB = (size_t)HALF * g.ldb * 2;
    const size_t tstepA = 2 * hstepA, tstepB = 2 * hstepB;
    const unsigned ldsw = (unsigned)wid * 1024u;
    const int aoff = lds_byte(wr * 64 + fr, fq * 8), boff = lds_byte(wc * 32 + fr, fq * 8);
#define PG8_SA(b, h) (((b) * 2 + (h)) * HTB)
#define PG8_SB(b, h) ((4 + (b) * 2 + (h)) * HTB)
#define PG8_STAGE(bufoff, gbase, voff) do { _Pragma("unroll") for (int _i = 0; _i < 2; ++_i) \
        __builtin_amdgcn_global_load_lds((const unsigned*)((const char*)(gbase) + (voff)[_i]), (LAS unsigned*)(lds + (bufoff) + ldsw + _i * 8192), 16, 0, 0); } while (0)
#define PG8_LDA(dst, b, h) do { _Pragma("unroll") for (int m = 0; m < 4; ++m) _Pragma("unroll") for (int k = 0; k < 2; ++k) dst[m][k] = *(const LAS bf16x8*)(lds + PG8_SA(b, h) + aoff + m * 2048 + k * 1024); } while (0)
#define PG8_LDB(dst, b, h) do { _Pragma("unroll") for (int n = 0; n < 2; ++n) _Pragma("unroll") for (int k = 0; k < 2; ++k) dst[n][k] = *(const LAS bf16x8*)(lds + PG8_SB(b, h) + boff + n * 2048 + k * 1024); } while (0)
#define PG8_MMA(ai, bj, At, Bt) do { __builtin_amdgcn_s_setprio(1); _Pragma("unroll") for (int m = 0; m < 4; ++m) _Pragma("unroll") for (int n = 0; n < 2; ++n) _Pragma("unroll") for (int k = 0; k < 2; ++k) \
        acc[ai][bj][m][n] = __builtin_amdgcn_mfma_f32_16x16x32_bf16(Bt[n][k], At[m][k], acc[ai][bj][m][n], 0, 0, 0); __builtin_amdgcn_s_setprio(0); } while (0)
#define PG8_WAIT_V(n) asm volatile("s_waitcnt vmcnt(" #n ")" ::: "memory")
#define PG8_WAIT_L(n) asm volatile("s_waitcnt lgkmcnt(" #n ")" ::: "memory")
#define PG8_BAR __builtin_amdgcn_s_barrier()
#define PG8_SCHED __builtin_amdgcn_sched_barrier(0)
    Unit cur, nxt; int ui = 0;
    if (!S.next(0, cur)) return;
    f32x4 acc[2][2][4][2];
#pragma unroll
    for (int a = 0; a < 2; ++a)
#pragma unroll
        for (int b = 0; b < 2; ++b)
#pragma unroll
            for (int m = 0; m < 4; ++m)
#pragma unroll
                for (int n = 0; n < 2; ++n) acc[a][b][m][n] = (f32x4){0.f, 0.f, 0.f, 0.f};
    bf16x8 At[4][2], B0[2][2], B1[2][2];
    const char* cA = (const char*)g.A + (GATHER ? (size_t)0 : (size_t)cur.pm * tstepA); const char* cB = (const char*)g.Bt + (size_t)cur.pn * tstepB;
    PG8_GROWS(vAc, 0);
    PG8_STAGE(PG8_SB(0, 0), cB, voffB); PG8_STAGE(PG8_SB(0, 1), cB + hstepB, voffB); PG8_STAGE(PG8_SA(0, 0), cA, vAc[0]); PG8_STAGE(PG8_SA(0, 1), cA, vAc[1]);
    if (wr == 1) PG8_BAR;
    PG8_WAIT_V(2); PG8_BAR;
    PG8_STAGE(PG8_SB(1, 0), cB + kstep, voffB); PG8_STAGE(PG8_SA(1, 0), cA + kstep, vAc[0]); PG8_STAGE(PG8_SB(1, 1), cB + hstepB + kstep, voffB);
    PG8_WAIT_V(6); PG8_BAR;
    for (;;) {
        const bool has_next = S.next(ui + 1, nxt);
        const char* nA = (has_next && !GATHER) ? (const char*)g.A + (size_t)nxt.pm * tstepA : cA;
        if constexpr (GATHER) { if (has_next) PG8_GROWS(vAx, ui + 1); else {
#pragma unroll
            for (int h = 0; h < 2; ++h) { vAx[h][0] = vAc[h][0]; vAx[h][1] = vAc[h][1]; } } }
        const char* nB = has_next ? (const char*)g.Bt + (size_t)nxt.pn * tstepB : cB;
        for (int t = 0; t < nt; t += 2) {
            const bool last = (t == nt - 2);
            const char* a1 = cA + (size_t)(t + 1) * kstep;
            const char* a2 = last ? nA : cA + (size_t)(t + 2) * kstep; const char* b2 = last ? nB : cB + (size_t)(t + 2) * kstep;
            const char* a3 = a2 + kstep; const char* b3 = b2 + kstep;
            unsigned vS0[2], vS1[2];
            if constexpr (GATHER) { vS0[0] = last ? vAx[0][0] : vAc[0][0]; vS0[1] = last ? vAx[0][1] : vAc[0][1]; vS1[0] = last ? vAx[1][0] : vAc[1][0]; vS1[1] = last ? vAx[1][1] : vAc[1][1]; }
            else { vS0[0] = vAc[0][0]; vS0[1] = vAc[0][1]; vS1[0] = vAc[1][0]; vS1[1] = vAc[1][1]; }
            PG8_LDB(B0, 0, 0); PG8_LDB(B1, 0, 1); PG8_SCHED; PG8_LDA(At, 0, 0); PG8_STAGE(PG8_SA(1, 1), a1, vAc[1]);
            PG8_WAIT_V(8); PG8_WAIT_L(0); PG8_BAR; PG8_MMA(0, 0, At, B0); PG8_MMA(0, 1, At, B1); PG8_BAR; PG8_SCHED;
            PG8_LDA(At, 0, 1); PG8_STAGE(PG8_SB(0, 0), b2, voffB); PG8_STAGE(PG8_SB(0, 1), b2 + hstepB, voffB); PG8_STAGE(PG8_SA(0, 0), a2, vS0);
            PG8_WAIT_V(8); PG8_WAIT_L(0); PG8_BAR; PG8_MMA(1, 0, At, B0); PG8_MMA(1, 1, At, B1); PG8_BAR; PG8_SCHED;
            PG8_LDB(B0, 1, 0); PG8_LDB(B1, 1, 1); PG8_SCHED; PG8_LDA(At, 1, 0); PG8_STAGE(PG8_SA(0, 1), a2, vS1);
            PG8_WAIT_V(8); PG8_WAIT_L(0); PG8_BAR; PG8_MMA(0, 0, At, B0); PG8_MMA(0, 1, At, B1); PG8_BAR; PG8_SCHED;
            PG8_LDA(At, 1, 1); PG8_STAGE(PG8_SB(1, 0), b3, voffB); PG8_STAGE(PG8_SB(1, 1), b3 + hstepB, voffB); PG8_STAGE(PG8_SA(1, 0), a3, vS0);
            PG8_WAIT_V(8); PG8_WAIT_L(0); PG8_BAR; PG8_MMA(1, 0, At, B0); PG8_MMA(1, 1, At, B1); PG8_BAR; PG8_SCHED;
        }
        if (wr == 0) PG8_BAR;
        E(acc, cur, wr, wc, fr, fq);
        if (!has_next) break;
#pragma unroll
        for (int a = 0; a < 2; ++a)
#pragma unroll
            for (int b = 0; b < 2; ++b)
#pragma unroll
                for (int m = 0; m < 4; ++m)
#pragma unroll
                    for (int n = 0; n < 2; ++n) acc[a][b][m][n] = (f32x4){0.f, 0.f, 0.f, 0.f};
        cur = nxt; cA = nA; cB = nB; ++ui;
        if constexpr (GATHER) {
#pragma unroll
            for (int h = 0; h < 2; ++h) { vAc[h][0] = vAx[h][0]; vAc[h][1] = vAx[h][1]; } }
        if (wr == 1) PG8_BAR;
    }
    PG8_WAIT_V(0);
    PG8_BAR;
#undef PG8_SA
#undef PG8_SB
#undef PG8_STAGE
#undef PG8_GROWS
#undef PG8_LDA
#undef PG8_LDB
#undef PG8_MMA
#undef PG8_WAIT_V
#undef PG8_WAIT_L
#undef PG8_BAR
#undef PG8_SCHED
}
}

enum EpiMode { EM_Z = 0, EM_Q = 1, EM_KV = 2, EM_GLU = 3, EM_MERGE0 = 4, EM_MERGE1 = 5, EM_WOUT = 6, EM_MOEUP = 7, EM_MOEDN = 8, EM_S5 = 9 };
template <int mode> struct Epi {
    bf16_t* o0; bf16_t* o1; bf16_t* o2;
    const bf16_t* i0;
    const float* f0; const float* f1; const float* f2;
    float* fo;
    float* ssq;
    const float* rope;
    int layer;
    struct Side { u32x4 s[4]; };
    __device__ __forceinline__ Side load_side(const pg8::Unit& u, int ai, int m, int wr, int fr, int cl) const {
        Side S; const int row = u.pm * 256 + ai * 128 + wr * 64 + m * 16 + fr;
        if constexpr (mode == EM_Q) S.s[0] = *(const u32x4*)(ssq + (size_t)row * 4);
        else if constexpr (mode == EM_KV) S.s[0] = *(const u32x4*)(ssq + (size_t)MTOK * 4 + (size_t)row * 4);
        else if constexpr (mode == EM_GLU) { S.s[0] = *(const u32x4*)(i0 + (size_t)row * 256 + cl); S.s[1] = *(const u32x4*)(i0 + (size_t)row * 256 + 128 + cl); }
        else if constexpr (mode == EM_MERGE0 || mode == EM_MERGE1) { const int col = u.pn * 256 + cl;
            S.s[0] = *(const u32x4*)(i0 + (size_t)row * ZC + col); S.s[1] = *(const u32x4*)(i0 + (size_t)row * ZC + col + 128);
            if constexpr (mode == EM_MERGE1) { S.s[2] = __builtin_nontemporal_load((const u32x4*)(o0 + (size_t)row * 1024 + col)); S.s[3] = __builtin_nontemporal_load((const u32x4*)(o0 + (size_t)row * 1024 + col + 128)); } }
        else if constexpr (mode == EM_WOUT) { const float* xin = (layer == 0) ? (row < NLAT ? f1 + (size_t)row * D : f2 + (size_t)(row - NLAT) * D) : fo + (size_t)row * D; const int col = u.pn * 256 + cl;
            S.s[0] = *(const u32x4*)(xin + col); S.s[1] = *(const u32x4*)(xin + col + 4); S.s[2] = *(const u32x4*)(xin + col + 128); S.s[3] = *(const u32x4*)(xin + col + 132); }
        else if constexpr (mode == EM_S5) { S.s[0] = *(const u32x4*)(i0 + (size_t)row * 512 + cl); S.s[1] = *(const u32x4*)(i0 + (size_t)row * 512 + 128 + cl); }
        return S;
    }
    __device__ __forceinline__ void operator()(const f32x4 (&acc)[2][2][4][2], const pg8::Unit& u, int wr, int wc, int fr_in, int fq_in) const {
        int fr = fr_in, fq = fq_in; asm volatile("" : "+v"(fr), "+v"(fq));
        const int cl = wc * 32 + 8 * fq;
        f32x4 hc[4] = {};
        if constexpr (mode == EM_GLU) { hc[0] = *(const f32x4*)(f0 + cl); hc[1] = *(const f32x4*)(f0 + cl + 4); hc[2] = *(const f32x4*)(f0 + 128 + cl); hc[3] = *(const f32x4*)(f0 + 128 + cl + 4); }
        if constexpr (mode == EM_WOUT) { const float* gt = f0 + (size_t)tok_modrow(u.pm * 256) * 6144 + 2 * 1024 + u.pn * 256 + cl;
            hc[0] = *(const f32x4*)(gt); hc[1] = *(const f32x4*)(gt + 4); hc[2] = *(const f32x4*)(gt + 128); hc[3] = *(const f32x4*)(gt + 132); }
        if constexpr (mode == EM_S5) { const float* dk = f0 + u.pn * 16 + (cl & 15); hc[0] = *(const f32x4*)(dk); hc[1] = *(const f32x4*)(dk + 4); }
        Side cur = load_side(u, 0, 0, wr, fr, cl);
#pragma unroll
        for (int it = 0; it < 8; ++it) {
                const int ai = it >> 2, m = it & 3;
                Side nxt = cur; if (it < 7) nxt = load_side(u, (it + 1) >> 2, (it + 1) & 3, wr, fr, cl);
                asm volatile("" ::: "memory");
                const int row = u.pm * 256 + ai * 128 + wr * 64 + m * 16 + fr;
                if constexpr (mode == EM_Z) {
                    float s0 = 0.f;
#pragma unroll
                    for (int bj = 0; bj < 2; ++bj) {
                        f32x4 v0 = acc[ai][bj][m][0], v1 = acc[ai][bj][m][1];
                        const int col = u.pn * 256 + bj * 128 + cl;
                        if (u.pn == 1 || (u.pn == 2 && bj == 0)) s0 += (v0[0] * v0[0] + v0[1] * v0[1]) + (v0[2] * v0[2] + v0[3] * v0[3]) + (v1[0] * v1[0] + v1[1] * v1[1]) + (v1[2] * v1[2] + v1[3] * v1[3]);
                        if (u.pn == 2 && bj == 1 && wc == 0) {
                            if (row < NLAT) {
                                const int t = row & 2047, pb = 4 * fq, axis = pb >> 3, pos = axis ? (t & 63) : (t >> 6);
                                const float* cs = rope + pos * 8 + (pb & 7); const float* sn = cs + 512;
                                float x1, x2;
                                x1 = v0[0]; x2 = v0[1]; v0[0] = x1 * cs[0] - x2 * sn[0]; v0[1] = x1 * sn[0] + x2 * cs[0];
                                x1 = v0[2]; x2 = v0[3]; v0[2] = x1 * cs[1] - x2 * sn[1]; v0[3] = x1 * sn[1] + x2 * cs[1];
                                x1 = v1[0]; x2 = v1[1]; v1[0] = x1 * cs[2] - x2 * sn[2]; v1[1] = x1 * sn[2] + x2 * cs[2];
                                x1 = v1[2]; x2 = v1[3]; v1[2] = x1 * cs[3] - x2 * sn[3]; v1[3] = x1 * sn[3] + x2 * cs[3];
                            }
                            u32x4 w; w.x = pk2(v0[0], v0[1]); w.y = pk2(v0[2], v0[3]); w.z = pk2(v1[0], v1[1]); w.w = pk2(v1[2], v1[3]);
                            *(u32x4*)(o1 + (size_t)row * 32 + 8 * fq) = w;
                        }
                        u32x4 w; w.x = pk2(v0[0], v0[1]); w.y = pk2(v0[2], v0[3]); w.z = pk2(v1[0], v1[1]); w.w = pk2(v1[2], v1[3]);
                        *(u32x4*)(o0 + (size_t)row * ZC + col) = w;
                        if (u.pn == 0) {
                            int b, s; if (row < NLAT) { b = row >> 11; s = 256 + (row & 2047); } else { b = (row - NLAT) >> 8; s = (row - NLAT) & 255; }
                            const int colu = bj * 128 + cl, g = colu >> 4, h0 = colu & 15;
                            *(u32x4*)(o2 + ((size_t)g * 1280 + b * 160 + (s >> 4)) * 512 + (s & 15) * 16 + h0) = w;
                        }
                    }
                    if (u.pn == 1 || u.pn == 2) {
                        { const int ln = fr + 16 * fq; s0 += shfl_f(s0, ln ^ 16); s0 += shfl_f(s0, ln ^ 32); }
                        if (fq == 0) ssq[(size_t)(u.pn - 1) * MTOK * 4 + (size_t)row * 4 + wc] = s0;
                    }
                } else if constexpr (mode == EM_Q || mode == EM_KV) {
                    const f32x4 sp = __builtin_bit_cast(f32x4, cur.s[0]);
                    const float rs = mode == EM_Q ? rsqrtf(((sp[0] + sp[1]) + (sp[2] + sp[3])) * (1.f / 256.f) + EPS) * QSCALE : rsqrtf(((sp[0] + sp[1]) + (sp[2] + sp[3])) * (1.f / 128.f) + EPS);
#pragma unroll
                    for (int bj = 0; bj < 2; ++bj) {
                        f32x4 v0 = acc[ai][bj][m][0] * rs, v1 = acc[ai][bj][m][1] * rs;
                        const int col = u.pn * 256 + bj * 128 + cl;
                        if constexpr (mode == EM_Q) { const int cc = col % 96;
                            if (cc >= 64 && row < NLAT) {
                                const int t = row & 2047, pb = (cc - 64) >> 1, axis = pb >> 3, pos = axis ? (t & 63) : (t >> 6);
                                const float* cs = rope + pos * 8 + (pb & 7); const float* sn = cs + 512;
                                float x1, x2;
                                x1 = v0[0]; x2 = v0[1]; v0[0] = x1 * cs[0] - x2 * sn[0]; v0[1] = x1 * sn[0] + x2 * cs[0];
                                x1 = v0[2]; x2 = v0[3]; v0[2] = x1 * cs[1] - x2 * sn[1]; v0[3] = x1 * sn[1] + x2 * cs[1];
                                x1 = v1[0]; x2 = v1[1]; v1[0] = x1 * cs[2] - x2 * sn[2]; v1[1] = x1 * sn[2] + x2 * cs[2];
                                x1 = v1[2]; x2 = v1[3]; v1[2] = x1 * cs[3] - x2 * sn[3]; v1[3] = x1 * sn[3] + x2 * cs[3];
                            } }
                        u32x4 w; w.x = pk2(v0[0], v0[1]); w.y = pk2(v0[2], v0[3]); w.z = pk2(v1[0], v1[1]); w.w = pk2(v1[2], v1[3]);
                        if constexpr (mode == EM_Q) *(u32x4*)(o0 + (size_t)row * 768 + col) = w;
                        else { bf16_t* dst = col < 512 ? o0 + (size_t)row * 512 + col : o1 + (size_t)row * 512 + (col - 512); *(u32x4*)dst = w; }
                    }
                } else if constexpr (mode == EM_GLU) {
#pragma unroll
                    for (int bj = 0; bj < 2; ++bj) {
                        const int col = bj * 128 + cl;
                        const f32x4 a0 = acc[ai][bj][m][0] + hc[2 * bj], a1 = acc[ai][bj][m][1] + hc[2 * bj + 1];
                        const u32x4 y = cur.s[bj];
                        u32x4 w;
                        w.x = pk2(bflo(y.x) * sigmoidf_(a0[0]), bfhi(y.x) * sigmoidf_(a0[1])); w.y = pk2(bflo(y.y) * sigmoidf_(a0[2]), bfhi(y.y) * sigmoidf_(a0[3]));
                        w.z = pk2(bflo(y.z) * sigmoidf_(a1[0]), bfhi(y.z) * sigmoidf_(a1[1])); w.w = pk2(bflo(y.w) * sigmoidf_(a1[2]), bfhi(y.w) * sigmoidf_(a1[3]));
                        *(u32x4*)(o0 + (size_t)row * 256 + col) = w;
                    }
                } else if constexpr (mode == EM_MERGE0 || mode == EM_MERGE1) {
#pragma unroll
                    for (int bj = 0; bj < 2; ++bj) {
                        const int col = u.pn * 256 + bj * 128 + cl;
                        const u32x4 gt = cur.s[bj];
                        const f32x4 a0 = acc[ai][bj][m][0], a1 = acc[ai][bj][m][1];
                        float r[8] = { a0[0] * sigmoidf_(bflo(gt.x)), a0[1] * sigmoidf_(bfhi(gt.x)), a0[2] * sigmoidf_(bflo(gt.y)), a0[3] * sigmoidf_(bfhi(gt.y)),
                                       a1[0] * sigmoidf_(bflo(gt.z)), a1[1] * sigmoidf_(bfhi(gt.z)), a1[2] * sigmoidf_(bflo(gt.w)), a1[3] * sigmoidf_(bfhi(gt.w)) };
                        if constexpr (mode == EM_MERGE1) { const u32x4 pv = cur.s[2 + bj];
                            r[0] += bflo(pv.x); r[1] += bfhi(pv.x); r[2] += bflo(pv.y); r[3] += bfhi(pv.y); r[4] += bflo(pv.z); r[5] += bfhi(pv.z); r[6] += bflo(pv.w); r[7] += bfhi(pv.w); }
                        u32x4 w; w.x = pk2(r[0], r[1]); w.y = pk2(r[2], r[3]); w.z = pk2(r[4], r[5]); w.w = pk2(r[6], r[7]);
                        *(u32x4*)(o0 + (size_t)row * 1024 + col) = w;
                    }
                } else if constexpr (mode == EM_WOUT) {
#pragma unroll
                    for (int bj = 0; bj < 2; ++bj) {
                        const int col = u.pn * 256 + bj * 128 + cl;
#pragma unroll
                        for (int n = 0; n < 2; ++n) *(f32x4*)(fo + (size_t)row * D + col + 4 * n) = __builtin_bit_cast(f32x4, cur.s[2 * bj + n]) + hc[2 * bj + n] * acc[ai][bj][m][n];
                    }
                } else if constexpr (mode == EM_MOEUP) {
                    const f32x4 a0 = acc[ai][0][m][0], a1 = acc[ai][0][m][1], b0 = acc[ai][1][m][0], b1 = acc[ai][1][m][1];
                    u32x4 w; w.x = pk2(siluf_(a0[0]) * b0[0], siluf_(a0[1]) * b0[1]); w.y = pk2(siluf_(a0[2]) * b0[2], siluf_(a0[3]) * b0[3]);
                    w.z = pk2(siluf_(a1[0]) * b1[0], siluf_(a1[1]) * b1[1]); w.w = pk2(siluf_(a1[2]) * b1[2], siluf_(a1[3]) * b1[3]);
                    *(u32x4*)(o0 + (size_t)row * HID + (u.pn & 3) * 128 + cl) = w;
                } else if constexpr (mode == EM_MOEDN) {
#pragma unroll
                    for (int bj = 0; bj < 2; ++bj) {
                        const f32x4 v0 = acc[ai][bj][m][0], v1 = acc[ai][bj][m][1];
                        u32x4 w; w.x = pk2(v0[0], v0[1]); w.y = pk2(v0[2], v0[3]); w.z = pk2(v1[0], v1[1]); w.w = pk2(v1[2], v1[3]);
                        *(u32x4*)(o0 + (size_t)row * 1024 + (u.pn & 3) * 256 + bj * 128 + cl) = w;
                    }
                } else if constexpr (mode == EM_S5) {
                    const int g = u.pn, rr = row - g * 1280, b = rr / 160, c = rr - b * 160;
                    if (c < 144) {
#pragma unroll
                        for (int bj = 0; bj < 2; ++bj) {
                            const int n = bj * 128 + cl, i = n >> 4, h0 = n & 15, s = 16 * c + i;
                            const int trow = s < 256 ? NLAT + b * 256 + s : b * 2048 + (s - 256);
                            const u32x4 uv = cur.s[bj];
                            const f32x4 a0 = acc[ai][bj][m][0], a1 = acc[ai][bj][m][1];
                            u32x4 w;
                            w.x = pk2(gelu_tanh(a0[0] + hc[0][0] * bflo(uv.x)), gelu_tanh(a0[1] + hc[0][1] * bfhi(uv.x))); w.y = pk2(gelu_tanh(a0[2] + hc[0][2] * bflo(uv.y)), gelu_tanh(a0[3] + hc[0][3] * bfhi(uv.y)));
                            w.z = pk2(gelu_tanh(a1[0] + hc[1][0] * bflo(uv.z)), gelu_tanh(a1[1] + hc[1][1] * bfhi(uv.z))); w.w = pk2(gelu_tanh(a1[2] + hc[1][2] * bflo(uv.w)), gelu_tanh(a1[3] + hc[1][3] * bfhi(uv.w)));
                            *(u32x4*)(o0 + (size_t)trow * 256 + g * 16 + h0) = w;
                        }
                    }
                }
                cur = nxt;
        }
    }
};

#define XB_TMO      128
#define XB_XCNT(j)  (256  + 64 * (j))
#define XB_XSUB(j)  (1280 + 64 * (j))
#define XB_XGEN(j)  (2304 + 64 * (j))
#define XB_TOP      3328
#define XB_TOPGEN   3392
#define XCD_BAR_WORDS 3456
#define XB_SPIN_CAP (1u << 22)
__device__ __forceinline__ unsigned xb_ld(unsigned* p)              { return __hip_atomic_load(p, __ATOMIC_RELAXED, __HIP_MEMORY_SCOPE_AGENT); }
__device__ __forceinline__ unsigned xb_add(unsigned* p, unsigned v) { return __hip_atomic_fetch_add(p, v, __ATOMIC_RELAXED, __HIP_MEMORY_SCOPE_AGENT); }
__device__ __forceinline__ unsigned xb_xcc_id() { return (unsigned)__builtin_amdgcn_s_getreg((3 << 11) | 20) & 0xFu; }
#define XB_SPIN(cond, bar) do { unsigned _sp = 0; while (cond) { __builtin_amdgcn_s_sleep(1); \
    if ((++_sp & 255u) == 0u) { if (xb_ld(&(bar)[XB_TMO])) break; if (_sp > XB_SPIN_CAP) { atomicAdd(&(bar)[XB_TMO], 1u); break; } } } } while (0)
struct XcdBarrier { unsigned* bar; unsigned x; volatile LAS unsigned* st; };
__device__ __forceinline__ XcdBarrier xcd_barrier_post(unsigned* bar, volatile LAS unsigned* st) {
    XcdBarrier b; b.bar = bar; b.x = xb_xcc_id(); b.st = st;
    if (threadIdx.x == 0) (void)xb_add(&bar[XB_XCNT(b.x)], 1u);
    return b;
}
__device__ __forceinline__ void xcd_barrier_complete(unsigned* bar, unsigned x, unsigned& nloc, unsigned& nx) {
    const unsigned G = gridDim.x * gridDim.y * gridDim.z;
    unsigned sum, cnt, mine, sp = 0u;
    for (;;) {
        sum = 0u; cnt = 0u; mine = 0u;
#pragma unroll
        for (unsigned j = 0; j < 16; ++j) { const unsigned c = xb_ld(&bar[XB_XCNT(j)]); sum += c; cnt += (c > 0u) ? 1u : 0u; mine = (j == x) ? c : mine; }
        if (sum == G) break;
        __builtin_amdgcn_s_sleep(1);
        if ((++sp & 255u) == 0u) { if (xb_ld(&bar[XB_TMO])) break; if (sp > XB_SPIN_CAP) { atomicAdd(&bar[XB_TMO], 1u); break; } }
    }
    nloc = mine > 0u ? mine : 1u; nx = cnt > 0u ? cnt : 1u;
}
__device__ __noinline__ void xcd_barrier_fn(unsigned* bar_in, unsigned bx, unsigned st_off, int tid) {
    XcdBarrier b; b.bar = bar_in; b.x = bx; b.st = (volatile LAS unsigned*)(uintptr_t)st_off;
    asm volatile("s_waitcnt vmcnt(0)" ::: "memory");
    __syncthreads();
    if (tid == 0) {
        unsigned* bar = b.bar;
        __builtin_amdgcn_s_waitcnt(0);
        unsigned nloc = b.st[0], nx = b.st[1];
        if (nloc == 0u) { xcd_barrier_complete(bar, b.x, nloc, nx); b.st[0] = nloc; b.st[1] = nx; }
        const unsigned old = xb_add(&bar[XB_XSUB(b.x)], 1u);
        const unsigned gen = old / nloc;
        if (old + 1u == (gen + 1u) * nloc) {
            __builtin_amdgcn_fence(__ATOMIC_RELEASE, "agent");
            asm volatile("s_waitcnt vmcnt(0)" ::: "memory");
            const unsigned og = xb_add(&bar[XB_TOP], 1u);
            const unsigned tg = og / nx;
            if (og + 1u == (tg + 1u) * nx) xb_add(&bar[XB_TOPGEN], 1u);
            else XB_SPIN(xb_ld(&bar[XB_TOPGEN]) == tg, bar);
            __builtin_amdgcn_fence(__ATOMIC_ACQUIRE, "agent");
            xb_add(&bar[XB_XGEN(b.x)], 1u);
            asm volatile("s_waitcnt vmcnt(0)" ::: "memory");
        } else {
            XB_SPIN(xb_ld(&bar[XB_XGEN(b.x)]) == gen, bar);
            __builtin_amdgcn_fence(__ATOMIC_ACQUIRE, "agent");
            asm volatile("s_waitcnt vmcnt(0)" ::: "memory");
        }
    }
    __syncthreads();
}

constexpr int NWAVES = 8;
constexpr int RING_BYTES = 131072, MISC_OFF = RING_BYTES + 320, TBL_OFF = RING_BYTES + 1024, LDS_BYTES = 147456;
struct Args { const float* in[38]; float* out; unsigned char* ws; int ph_lo, ph_hi; };
typedef const __attribute__((address_space(4))) Args* ArgsP;
struct Frame {
    LAS unsigned char* lds;
    int tid, lane, wave, vcu, G, gw, NGW;
    unsigned char* ws;
};

enum RowMap { RM_ID = 0, RM_WIN = 1, RM_UQ = 2, RM_W13 = 3 };
__device__ __forceinline__ int rope_perm(int o) { const int axis = o >> 4, half = (o >> 3) & 1, i = o & 7; return 2 * (axis * 8 + i) + half; }
__device__ __forceinline__ int map_row(int rm, int n, int row_off) {
    if (rm == RM_WIN) return (n >= ZKPE && n < ZKPE + 32) ? ZKPE + rope_perm(n - ZKPE) : n;
    if (rm == RM_UQ) { const int hd = n / 96, cc = n - hd * 96; return cc >= 64 ? hd * 96 + 64 + rope_perm(cc - 64) : n; }
    if (rm == RM_W13) return row_off + (n >> 7) * 256 + (n & 127);
    return row_off + n;
}
__device__ __forceinline__ void transpose_item(const float* W, int K, int N, bf16_t* WT, int rm, int row_off, const float* kscale, LAS float* scr, int item, int lane) {
    const int nblk = N / 32, kb = item / nblk, nb = item % nblk, k0 = 64 * kb, n0 = 32 * nb;
    float tv[32];
#pragma unroll
    for (int i = 0; i < 32; ++i) tv[i] = W[(size_t)(k0 + 2 * i + (lane >> 5)) * N + n0 + (lane & 31)];
#pragma unroll
    for (int i = 0; i < 32; ++i) { const int kk = 2 * i + (lane >> 5); float v = tv[i]; if (kscale) v *= kscale[k0 + kk]; scr[kk * 33 + (lane & 31)] = v; }
    asm volatile("s_waitcnt lgkmcnt(0)" ::: "memory");
    const int c = lane & 7;
#pragma unroll
    for (int j = 0; j < 4; ++j) { const int n = (lane >> 3) + 8 * j; const LAS float* s = scr + (8 * c) * 33 + n;
        u32x4 o; o.x = pk2(s[0 * 33], s[1 * 33]); o.y = pk2(s[2 * 33], s[3 * 33]); o.z = pk2(s[4 * 33], s[5 * 33]); o.w = pk2(s[6 * 33], s[7 * 33]);
        *(u32x4*)(WT + (size_t)map_row(rm, n0 + n, row_off) * K + k0 + 8 * c) = o; }
    asm volatile("s_waitcnt lgkmcnt(0)" ::: "memory");
}

#if !NAIVE_S5
__device__ __forceinline__ void s5_build(Frame& F, ArgsP a);
#endif
__device__ __forceinline__ void prologue_phase(Frame& F, ArgsP a) {
    LAS float* scr = (LAS float*)(F.lds + F.wave * 16384);
    REP(21) for (int l = 0; l < 2; ++l) {
        unsigned char* wl = F.ws + WS_WB + (size_t)l * WL_STRIDE;
#define CONV(Wp, K_, N_, WTp, rm_, ro_, ks_) do { const int items_ = ((K_) / 64) * ((N_) / 32); \
            for (int it = F.gw; it < items_; it += F.NGW) transpose_item((Wp), (K_), (N_), (bf16_t*)(WTp), (rm_), (ro_), (ks_), scr, it, F.lane); } while (0)
        CONV(a->in[8] + (size_t)l * D * INC, D, INC, wl + WL_WIN, RM_WIN, 0, nullptr);
        CONV(a->in[21] + (size_t)l * 256 * 768, 256, 768, wl + WL_UQ, RM_UQ, 0, a->in[19] + l * 256);
        CONV(a->in[22] + (size_t)l * 128 * 512, 128, 512, wl + WL_UKV, RM_ID, 0, a->in[20] + l * 128);
        CONV(a->in[23] + (size_t)l * 128 * 512, 128, 512, wl + WL_UKV, RM_ID, 512, a->in[20] + l * 128);
        CONV(a->in[17] + (size_t)l * 256 * 256, 256, 256, wl + WL_GLU, RM_ID, 0, nullptr);
        CONV(a->in[26] + (size_t)l * 256 * 1024, 256, 1024, wl + WL_PA, RM_ID, 0, nullptr);
        CONV(a->in[27] + (size_t)l * 512 * 1024, 512, 1024, wl + WL_PB, RM_ID, 0, nullptr);
        CONV(a->in[28] + (size_t)l * 256 * 1024, 256, 1024, wl + WL_PC, RM_ID, 0, nullptr);
        CONV(a->in[29] + (size_t)l * 1024 * 1024, 1024, 1024, wl + WL_OUT, RM_ID, 0, nullptr);
#undef CONV
        u32x4* padp = (u32x4*)(wl + WL_WIN + (size_t)INC * D * 2);
        for (int i = F.gw * 64 + F.lane; i < (ZC - INC) * D * 2 / 16; i += F.NGW * 64) padp[i] = (u32x4){0u, 0u, 0u, 0u};
    }
    if (blockIdx.x == 0) {
        float* rp = (float*)(F.ws + WS_ROPE);
        const int pos = F.tid >> 3, i = F.tid & 7;
        const float ang = (float)pos * exp2f(-(float)i * (13.287712379549449f / 8.f));
        rp[F.tid] = cosf(ang); rp[512 + F.tid] = sinf(ang);
    }
    __syncthreads();
    REP(22)
    {
        LAS float* sil = (LAS float*)F.lds;
        LAS float* red = (LAS float*)(F.lds + 40960);
        bool have = false;
        for (int it = blockIdx.x; it < 192; it += F.G) {
            if (!have) {
                for (int i = F.tid; i < 9 * 1024; i += 512) { const int r = i >> 10, k = i & 1023; const float cv = r < 8 ? a->in[1][r * 1024 + k] : a->in[3][k]; sil[i] = siluf_(cv); }
                have = true; __syncthreads();
            }
            const int l = it / 96, n = (it % 96) * 64 + F.lane;
            const float* wp = a->in[4] + (size_t)l * D * 6144 + (size_t)(F.wave * 128) * 6144 + n;
            float acc[9];
#pragma unroll
            for (int r = 0; r < 9; ++r) acc[r] = 0.f;
#pragma unroll 8
            for (int k = 0; k < 128; ++k) { const float wv = wp[(size_t)k * 6144];
#pragma unroll
                for (int r = 0; r < 9; ++r) acc[r] += sil[r * 1024 + F.wave * 128 + k] * wv; }
#pragma unroll
            for (int r = 0; r < 9; ++r) red[(F.wave * 9 + r) * 64 + F.lane] = acc[r];
            __syncthreads();
            for (int i = F.tid; i < 9 * 64; i += 512) { const int r = i >> 6, ln = i & 63; float s = 0.f;
#pragma unroll
                for (int w = 0; w < 8; ++w) s += red[(w * 9 + r) * 64 + ln];
                const int nn = (it % 96) * 64 + ln;
                ((float*)(F.ws + WS_MODV))[((size_t)l * 9 + r) * 6144 + nn] = s + a->in[5][l * 6144 + nn]; }
            __syncthreads();
        }
    }
#if !NAIVE_S5
    REP(23) s5_build(F, a);
#endif
}

__device__ __forceinline__ void moe_convert(Frame& F, ArgsP a, int l) {
    LAS float* scr = (LAS float*)(F.lds + F.wave * 16384);
    bf16_t* w13 = (bf16_t*)(F.ws + WS_MIX + MW_W13); bf16_t* w2 = (bf16_t*)(F.ws + WS_MIX + MW_W2);
    for (int it = F.gw; it < NEXP * 768; it += F.NGW) {
        const int e = it / 768, r = it % 768, which = r >> 8, sub = r & 255;
        const size_t eoff = ((size_t)l * NEXP + e) * 1024 * 512;
        if (which == 0) transpose_item(a->in[34] + eoff, 1024, 512, w13, RM_W13, e * 1024, nullptr, scr, sub, F.lane);
        else if (which == 1) transpose_item(a->in[35] + eoff, 1024, 512, w13, RM_W13, e * 1024 + 128, nullptr, scr, sub, F.lane);
        else transpose_item(a->in[36] + eoff, 512, 1024, w2, RM_ID, e * 1024, nullptr, scr, sub, F.lane);
    }
}

__device__ __forceinline__ const float* x_row_ptr(ArgsP a, const float* X, int layer, int row) {
    return layer == 0 ? (row < NLAT ? a->in[0] + (size_t)row * D : a->in[2] + (size_t)(row - NLAT) * D) : X + (size_t)row * D;
}
__device__ __forceinline__ void norm_mod_row(const f32x4 (&v)[4], f32x4 (&h)[4], const float* g, const float* shift, const float* scale, int lane) {
    float ss = 0.f;
#pragma unroll
    for (int j = 0; j < 4; ++j) ss += (v[j][0] * v[j][0] + v[j][1] * v[j][1]) + (v[j][2] * v[j][2] + v[j][3] * v[j][3]);
    const float rstd = rsqrtf(wave_sum(ss) * (1.f / D) + EPS);
#pragma unroll
    for (int j = 0; j < 4; ++j) { const int c = 4 * lane + 256 * j; const f32x4 gv = *(const f32x4*)(g + c), sh = *(const f32x4*)(shift + c), sc = *(const f32x4*)(scale + c);
        h[j] = v[j] * rstd * gv * (sc + 1.f) + sh; }
}
__device__ __forceinline__ void store_row_bf16(bf16_t* orow, const f32x4 (&h)[4], int lane) {
#pragma unroll
    for (int j = 0; j < 4; ++j) { u32x2 w; w.x = pk2(h[j][0], h[j][1]); w.y = pk2(h[j][2], h[j][3]); *(u32x2*)(orow + 4 * lane + 256 * j) = w; }
}
__device__ __forceinline__ void norm1_phase(Frame& F, ArgsP a, int layer, int nrows) {
    const float* X = (const float*)(F.ws + WS_X); bf16_t* H = (bf16_t*)(F.ws + WS_H);
    const float* modv = (const float*)(F.ws + WS_MODV) + (size_t)layer * 9 * 6144;
    for (int row = F.gw; row < nrows; row += F.NGW) {
        const float* xr = x_row_ptr(a, X, layer, row); f32x4 v[4], h[4];
#pragma unroll
        for (int j = 0; j < 4; ++j) v[j] = *(const f32x4*)(xr + 4 * F.lane + 256 * j);
        const float* mv = modv + (size_t)tok_modrow(row) * 6144;
        norm_mod_row(v, h, a->in[6] + layer * D, mv, mv + 1024, F.lane);
        store_row_bf16(H + (size_t)row * D, h, F.lane);
    }
}

__device__ __forceinline__ int seq_row(int b, int s, int d) {
    if (d == 0) return s < 256 ? NLAT + b * 256 + s : b * 2048 + (s - 256);
    return s < 256 ? NLAT + b * 256 + (255 - s) : b * 2048 + (2047 - (s - 256));
}
__device__ __forceinline__ float hg_lb(ArgsP a, int l) { return l == 0 ? 0.f : 1.f / (1.f + __expf(a->in[24][0] - a->in[24][1])); }

#if NAIVE_S5
__device__ __forceinline__ void s5_naive(Frame& F, ArgsP a, int l) {
    const bf16_t* Z = (const bf16_t*)(F.ws + WS_Z); float* Yacc = (float*)(F.ws + WS_MIX + MX_S5A);
    for (int unit = F.gw; unit < 128; unit += F.NGW) {
        const int b = unit >> 4, g = unit & 15, p = F.lane;
        for (int d = 0; d < 2; ++d) {
            const int idx = (l * 2 + d) * 16 + g;
            const float lre = a->in[9][idx * 64 + p], lim = a->in[10][idx * 64 + p], dt = expf(a->in[15][idx]);
            const float mag = expf(lre * dt), lbr = mag * cosf(lim * dt), lbi = mag * sinf(lim * dt), den = lre * lre + lim * lim;
            const float fr = ((lbr - 1.f) * lre + lbi * lim) / den, fi = (lbi * lre - (lbr - 1.f) * lim) / den;
            float bbr[16], bbi[16], cre[16], cim[16];
#pragma unroll
            for (int h = 0; h < 16; ++h) { const float br = a->in[11][(size_t)(idx * 64 + p) * 16 + h], bi = a->in[12][(size_t)(idx * 64 + p) * 16 + h];
                bbr[h] = fr * br - fi * bi; bbi[h] = fr * bi + fi * br;
                cre[h] = a->in[13][(size_t)(idx * 16 + h) * 64 + p]; cim[h] = a->in[14][(size_t)(idx * 16 + h) * 64 + p]; }
            float hr = 0.f, hi = 0.f;
            for (int s = 0; s < 2304; ++s) {
                const int row = seq_row(b, s, d);
                const u32x4 u0 = *(const u32x4*)(Z + (size_t)row * ZC + g * 16), u1 = *(const u32x4*)(Z + (size_t)row * ZC + g * 16 + 8);
                const float uu[16] = { bflo(u0.x), bfhi(u0.x), bflo(u0.y), bfhi(u0.y), bflo(u0.z), bfhi(u0.z), bflo(u0.w), bfhi(u0.w),
                                       bflo(u1.x), bfhi(u1.x), bflo(u1.y), bfhi(u1.y), bflo(u1.z), bfhi(u1.z), bflo(u1.w), bfhi(u1.w) };
                float bur = 0.f, bui = 0.f;
#pragma unroll
                for (int h = 0; h < 16; ++h) { bur += bbr[h] * uu[h]; bui += bbi[h] * uu[h]; }
                const float nhr = lbr * hr - lbi * hi + bur, nhi = lbr * hi + lbi * hr + bui; hr = nhr; hi = nhi;
                float mine = 0.f;
#pragma unroll
                for (int h = 0; h < 16; ++h) { const float y = wave_sum(cre[h] * hr - cim[h] * hi); if (F.lane == h) mine = y; }
                if (F.lane < 16) { float* ptr = Yacc + (size_t)row * 256 + g * 16 + F.lane; if (d == 0) *ptr = mine; else *ptr += mine; }
            }
        }
    }
}
__device__ __forceinline__ void s5_naive_finish(Frame& F, ArgsP a, int l, int nrows) {
    const bf16_t* Z = (const bf16_t*)(F.ws + WS_Z); const float* Yacc = (const float*)(F.ws + WS_MIX + MX_S5A); bf16_t* ysp = (bf16_t*)(F.ws + WS_MIX + MX_YS5P);
    for (int i = F.gw * 64 + F.lane; i < nrows * 256; i += F.NGW * 64) { const int row = i >> 8, n = i & 255;
        ysp[i] = (bf16_t)f2bf(gelu_tanh(Yacc[i] + a->in[16][l * 256 + n] * bf2f(Z[(size_t)row * ZC + n]))); }
}
#endif

#if NAIVE_HG
__device__ __forceinline__ void hg_naive(Frame& F, ArgsP a, int l) {
    const bf16_t* Z = (const bf16_t*)(F.ws + WS_Z); float* Ohg = (float*)(F.ws + WS_H);
    LAS float* red = (LAS float*)F.lds;
    const float lb = hg_lb(a, l);
    for (int unit = blockIdx.x; unit < 32; unit += F.G) {
        const int b = unit >> 2, hd = unit & 3, v = F.tid & 63, kg = F.wave;
        for (int d = 0; d < 2; ++d) {
            float S[16];
#pragma unroll
            for (int k = 0; k < 16; ++k) S[k] = 0.f;
            for (int s = 0; s < 2304; ++s) {
                const int row = seq_row(b, s, d);
                const bf16_t* zr = Z + (size_t)row * ZC;
                const u32x4 q0 = *(const u32x4*)(zr + ZHQ + hd * 128 + kg * 16), q1 = *(const u32x4*)(zr + ZHQ + hd * 128 + kg * 16 + 8);
                const int zf = d ? ZF1 : ZF0;
                const u32x4 z0 = *(const u32x4*)(zr + zf + hd * 128 + kg * 16), z1 = *(const u32x4*)(zr + zf + hd * 128 + kg * 16 + 8);
                const float vt = bf2f(zr[ZI + hd * 64 + v]);
                const float qq[16] = { bflo(q0.x), bfhi(q0.x), bflo(q0.y), bfhi(q0.y), bflo(q0.z), bfhi(q0.z), bflo(q0.w), bfhi(q0.w),
                                       bflo(q1.x), bfhi(q1.x), bflo(q1.y), bfhi(q1.y), bflo(q1.z), bfhi(q1.z), bflo(q1.w), bfhi(q1.w) };
                const float zz[16] = { bflo(z0.x), bfhi(z0.x), bflo(z0.y), bfhi(z0.y), bflo(z0.z), bfhi(z0.z), bflo(z0.w), bfhi(z0.w),
                                       bflo(z1.x), bfhi(z1.x), bflo(z1.y), bfhi(z1.y), bflo(z1.z), bfhi(z1.z), bflo(z1.w), bfhi(z1.w) };
                float part = 0.f;
#pragma unroll
                for (int k = 0; k < 16; ++k) { const float kin = (1.f - lb) / (1.f + __expf(zz[k])), f = 1.f - kin; S[k] = f * S[k] + kin * vt; part += qq[k] * S[k]; }
                red[((s & 1) * 8 + kg) * 64 + v] = part;
                __syncthreads();
                if (F.tid < 64) { float o = 0.f;
#pragma unroll
                    for (int w = 0; w < 8; ++w) o += red[((s & 1) * 8 + w) * 64 + F.tid];
                    float* ptr = Ohg + (size_t)row * 256 + hd * 64 + F.tid; if (d == 0) *ptr = o; else *ptr += o; }
            }
            __syncthreads();
        }
    }
}
__device__ __forceinline__ void hg_naive_finish(Frame& F, ArgsP a, int l, int nrows) {
    const bf16_t* Z = (const bf16_t*)(F.ws + WS_Z); const float* Ohg = (const float*)(F.ws + WS_H); bf16_t* yhg = (bf16_t*)(F.ws + WS_MIX + MX_YHG);
    for (int it = F.gw; it < nrows * 4; it += F.NGW) { const int row = it >> 2, hd = it & 3, c = hd * 64 + F.lane;
        float o = Ohg[(size_t)row * 256 + c]; const float ms = wave_sum(o * o) * (1.f / 64.f);
        o = o * rsqrtf(ms + EPS) * a->in[25][l * 256 + c] * siluf_(bf2f(Z[(size_t)row * ZC + ZG + c]));
        yhg[(size_t)row * 256 + c] = (bf16_t)f2bf(o); }
}
#endif

#if NAIVE_ATTN
__device__ __forceinline__ void attn_naive(Frame& F, bool need_ctx) {
    const bf16_t* Q = (const bf16_t*)(F.ws + WS_MIX + MX_Q); const bf16_t* KN = (const bf16_t*)(F.ws + WS_MIX + MX_KN); const bf16_t* V = (const bf16_t*)(F.ws + WS_MIX + MX_V);
    const bf16_t* KPE = (const bf16_t*)(F.ws + WS_MIX + MX_KPE); bf16_t* YM = (bf16_t*)(F.ws + WS_MIX + MX_YMLA);
    const int nunits = need_ctx ? 320 : 256;
    for (int unit = blockIdx.x; unit < nunits; unit += F.G) {
        int b, h, qrow, nk; bool active = true; const bool lat = unit < 256;
        if (lat) { b = unit >> 5; h = (unit >> 2) & 7; qrow = b * 2048 + (unit & 3) * 512 + F.tid; nk = 2304; }
        else { const int u2 = unit - 256; b = u2 >> 3; h = u2 & 7; active = F.tid < 256; qrow = NLAT + b * 256 + (F.tid & 255); nk = 256; }
        float q[96];
#pragma unroll
        for (int c = 0; c < 12; ++c) { const u32x4 w = *(const u32x4*)(Q + (size_t)qrow * 768 + h * 96 + c * 8);
            q[c * 8 + 0] = bflo(w.x); q[c * 8 + 1] = bfhi(w.x); q[c * 8 + 2] = bflo(w.y); q[c * 8 + 3] = bfhi(w.y); q[c * 8 + 4] = bflo(w.z); q[c * 8 + 5] = bfhi(w.z); q[c * 8 + 6] = bflo(w.w); q[c * 8 + 7] = bfhi(w.w); }
        float o[64], m = -1e30f, lsum = 0.f;
#pragma unroll
        for (int dd = 0; dd < 64; ++dd) o[dd] = 0.f;
        for (int j = 0; j < nk; ++j) {
            const int krow = lat ? (j < 2048 ? b * 2048 + j : NLAT + b * 256 + (j - 2048)) : NLAT + b * 256 + j;
            const bf16_t* kn = KN + (size_t)krow * 512 + h * 64; const bf16_t* kp = KPE + (size_t)krow * 32; const bf16_t* vv = V + (size_t)krow * 512 + h * 64;
            float s = 0.f;
#pragma unroll
            for (int c = 0; c < 12; ++c) { const u32x4 w = c < 8 ? *(const u32x4*)(kn + c * 8) : *(const u32x4*)(kp + (c - 8) * 8);
                s += q[c * 8 + 0] * bflo(w.x) + q[c * 8 + 1] * bfhi(w.x) + q[c * 8 + 2] * bflo(w.y) + q[c * 8 + 3] * bfhi(w.y) + q[c * 8 + 4] * bflo(w.z) + q[c * 8 + 5] * bfhi(w.z) + q[c * 8 + 6] * bflo(w.w) + q[c * 8 + 7] * bfhi(w.w); }
            const float mn = fmaxf(m, s), al = __builtin_amdgcn_exp2f(m - mn), pp = __builtin_amdgcn_exp2f(s - mn);
            lsum = lsum * al + pp; m = mn;
#pragma unroll
            for (int c = 0; c < 8; ++c) { const u32x4 w = *(const u32x4*)(vv + c * 8);
                o[c * 8 + 0] = o[c * 8 + 0] * al + pp * bflo(w.x); o[c * 8 + 1] = o[c * 8 + 1] * al + pp * bfhi(w.x); o[c * 8 + 2] = o[c * 8 + 2] * al + pp * bflo(w.y); o[c * 8 + 3] = o[c * 8 + 3] * al + pp * bfhi(w.y);
                o[c * 8 + 4] = o[c * 8 + 4] * al + pp * bflo(w.z); o[c * 8 + 5] = o[c * 8 + 5] * al + pp * bfhi(w.z); o[c * 8 + 6] = o[c * 8 + 6] * al + pp * bflo(w.w); o[c * 8 + 7] = o[c * 8 + 7] * al + pp * bfhi(w.w); }
        }
        if (active) { const float inv = 1.f / lsum;
#pragma unroll
            for (int c = 0; c < 8; ++c) { u32x4 w; w.x = pk2(o[c * 8] * inv, o[c * 8 + 1] * inv); w.y = pk2(o[c * 8 + 2] * inv, o[c * 8 + 3] * inv); w.z = pk2(o[c * 8 + 4] * inv, o[c * 8 + 5] * inv); w.w = pk2(o[c * 8 + 6] * inv, o[c * 8 + 7] * inv);
                *(u32x4*)(YM + (size_t)qrow * 512 + h * 64 + c * 8) = w; } }
    }
}
#endif

typedef short s16x4 __attribute__((ext_vector_type(4)));
__device__ __forceinline__ f32x4 mfma16(bf16x8 a, bf16x8 b, f32x4 c) { return __builtin_amdgcn_mfma_f32_16x16x32_bf16(a, b, c, 0, 0, 0); }
__device__ __forceinline__ s16x4 vtr16(const LAS unsigned char* p) { return __builtin_bit_cast(s16x4, __builtin_amdgcn_ds_read_tr16_b64_v4i16((LAS s16x4*)p)); }
__device__ __forceinline__ float max3f_(float a, float b, float c) { float r; asm("v_max3_f32 %0, %1, %2, %3" : "=v"(r) : "v"(a), "v"(b), "v"(c)); return r; }
__device__ __forceinline__ void glds16(const void* gsrc, unsigned lds_dst) { unsigned keep;
    asm volatile("s_mov_b32 %0, m0\n\ts_mov_b32 m0, %2\n\ts_nop 0\n\tglobal_load_lds_dwordx4 %1, off\n\ts_mov_b32 m0, %0" : "=&s"(keep) : "v"(gsrc), "s"(lds_dst) : "memory"); }
#if !NAIVE_ATTN
template <int VAR> __device__ __forceinline__ void attn_fast(Frame& F, bool need_ctx, bf16_t* YM) {
    const bf16_t* Q = (const bf16_t*)(F.ws + WS_MIX + MX_Q); const bf16_t* KN = (const bf16_t*)(F.ws + WS_MIX + MX_KN); const bf16_t* V = (const bf16_t*)(F.ws + WS_MIX + MX_V);
    const bf16_t* KPE = (const bf16_t*)(F.ws + WS_MIX + MX_KPE);
    const int lane = F.lane, wid = F.wave, r32 = lane & 31, hi = lane >> 5;
    constexpr int SLOT = 20480, VOFF = 12288, NSLOT = 5;
    const unsigned lds0 = (unsigned)(uintptr_t)F.lds;
    const int nunits = need_ctx ? 576 : 512;
    const unsigned kA = (unsigned)(hi * 1024 + r32 * 16);
    const unsigned vB = (unsigned)(VOFF + ((lane >> 4) & 1) * 32 + (lane & 3) * 8 + (4 * hi + ((lane & 15) >> 2)) * 64);
    for (int unit = F.vcu; unit < nunits; unit += F.G) {
        int b, h, qrow0, NT; const bool lat = unit < 512;
        if (lat) { b = unit >> 6; h = (unit >> 3) & 7; qrow0 = b * 2048 + (unit & 7) * 256; NT = 36; }
        else { const int u2 = unit - 512; b = u2 >> 3; h = u2 & 7; qrow0 = NLAT + b * 256; NT = 4; }
#define ATT_KROW(t) (lat ? ((t) < 32 ? b * 2048 + 64 * (t) : NLAT + b * 256 + 64 * ((t) - 32)) : NLAT + b * 256 + 64 * (t))
#define ATT_ISSUE(tt, sl) do { const int tc_ = (tt) < NT ? (tt) : NT - 1; const int kr_ = ATT_KROW(tc_); const unsigned sd_ = (unsigned)__builtin_amdgcn_readfirstlane((int)(lds0 + (sl) * SLOT + wid * 1024)); \
            glds16(KN + (size_t)(kr_ + lane) * 512 + h * 64 + wid * 8, sd_); \
            if (wid < 4) glds16(KPE + (size_t)(kr_ + lane) * 32 + wid * 8, sd_ + 8 * 1024); \
            glds16(V + (size_t)(kr_ + 16 * (wid & 3) + (lane >> 2)) * 512 + h * 64 + (wid >> 2) * 32 + (lane & 3) * 8, sd_ + VOFF); } while (0)
#define ATT_QK(P0, P1, slot) do { const LAS unsigned char* sq_ = F.lds + (slot) * SLOT; _Pragma("unroll") for (int d0 = 0; d0 < 6; ++d0) { \
            const bf16x8 k0_ = *(const LAS bf16x8*)(sq_ + kA + d0 * 2048), k1_ = *(const LAS bf16x8*)(sq_ + kA + d0 * 2048 + 512); \
            if (d0 == 0) { P0 = __builtin_amdgcn_mfma_f32_32x32x16_bf16(k0_, qf[0], negm, 0, 0, 0); P1 = __builtin_amdgcn_mfma_f32_32x32x16_bf16(k1_, qf[0], negm, 0, 0, 0); } \
            else { P0 = __builtin_amdgcn_mfma_f32_32x32x16_bf16(k0_, qf[d0], P0, 0, 0, 0); P1 = __builtin_amdgcn_mfma_f32_32x32x16_bf16(k1_, qf[d0], P1, 0, 0, 0); } } } while (0)
        asm volatile("s_waitcnt vmcnt(0)" ::: "memory");
        __syncthreads();
        ATT_ISSUE(0, 0); ATT_ISSUE(1, 1); ATT_ISSUE(2, 2); ATT_ISSUE(3, 3);
        bf16x8 qf[6];
        { const bf16_t* qp = Q + (size_t)(qrow0 + wid * 32 + r32) * 768 + h * 96 + hi * 8;
#pragma unroll
          for (int d0 = 0; d0 < 6; ++d0) qf[d0] = *(const bf16x8*)(qp + d0 * 16); }
        float mref = 0.f, lsum = 0.f, dpend = 0.f; f32x16 o0 = {}, o1 = {}, negm = {};
        asm volatile("s_waitcnt vmcnt(0)" ::: "memory");
        __syncthreads();
        f32x16 p0, p1;
        ATT_QK(p0, p1, 0);
        int s_cur = 0, s_nxt = 1, s_new = 4;
        for (int t = 0; t < NT; ++t) {
            ATT_ISSUE(t + 4, s_new);
            const LAS unsigned char* sb = F.lds + s_cur * SLOT;
            f32x16 n0, n1;
            if (t + 1 < NT) ATT_QK(n0, n1, s_nxt); else { n0 = p0; n1 = p1; }
            if (__builtin_expect(__any(dpend != 0.f), 0)) {
#pragma unroll
                for (int r = 0; r < 16; ++r) { p0[r] -= dpend; p1[r] -= dpend; } }
            float mxa = max3f_(p0[0], p0[1], p1[0]), mxb = max3f_(p0[2], p0[3], p1[1]); mxa = max3f_(mxa, p1[2], p1[3]);
#pragma unroll
            for (int r = 4; r < 16; r += 4) { mxa = max3f_(mxa, p0[r], p0[r + 1]); mxb = max3f_(mxb, p0[r + 2], p0[r + 3]); mxa = max3f_(mxa, p1[r], p1[r + 1]); mxb = max3f_(mxb, p1[r + 2], p1[r + 3]); }
            float mx = fmaxf(mxa, mxb);
            { auto rr = __builtin_amdgcn_permlane32_swap(__float_as_uint(mx), __float_as_uint(mx), false, false); mx = fmaxf(__uint_as_float(rr[0]), __uint_as_float(rr[1])); }
            dpend = 0.f;
            if (__builtin_expect(t == 0 || __any(mx > 8.f), 0)) {
                const float dl = t == 0 ? mx : fmaxf(mx, 0.f); mref += dl; dpend = dl;
#pragma unroll
                for (int r = 0; r < 16; ++r) { p0[r] -= dl; p1[r] -= dl; negm[r] = -mref; }
                const float fs = __builtin_amdgcn_exp2f(-dl); lsum *= fs;
#pragma unroll
                for (int r = 0; r < 16; ++r) { o0[r] *= fs; o1[r] *= fs; } }
            f32x2 ps2 = {0.f, 0.f};
#pragma unroll
            for (int r = 0; r < 16; r += 2) { p0[r] = __builtin_amdgcn_exp2f(p0[r]); p0[r + 1] = __builtin_amdgcn_exp2f(p0[r + 1]); p1[r] = __builtin_amdgcn_exp2f(p1[r]); p1[r + 1] = __builtin_amdgcn_exp2f(p1[r + 1]);
                ps2 += (f32x2){p0[r], p0[r + 1]}; ps2 += (f32x2){p1[r], p1[r + 1]}; }
            lsum += ps2.x + ps2.y;
            bf16x8 pb[4];
#pragma unroll
            for (int s = 0; s < 4; ++s) { u32x4 w;
                if (s < 2) { w.x = pk2(p0[8 * s], p0[8 * s + 1]); w.y = pk2(p0[8 * s + 2], p0[8 * s + 3]); w.z = pk2(p0[8 * s + 4], p0[8 * s + 5]); w.w = pk2(p0[8 * s + 6], p0[8 * s + 7]); }
                else { const int q = s - 2; w.x = pk2(p1[8 * q], p1[8 * q + 1]); w.y = pk2(p1[8 * q + 2], p1[8 * q + 3]); w.z = pk2(p1[8 * q + 4], p1[8 * q + 5]); w.w = pk2(p1[8 * q + 6], p1[8 * q + 7]); }
                pb[s] = __builtin_bit_cast(bf16x8, w); }
#pragma unroll
            for (int s = 0; s < 4; ++s) {
                const s16x4 a0l = vtr16(sb + vB + s * 1024), a0h = vtr16(sb + vB + s * 1024 + 512), a1l = vtr16(sb + vB + 4096 + s * 1024), a1h = vtr16(sb + vB + 4096 + s * 1024 + 512);
                const bf16x8 va0 = {a0l[0], a0l[1], a0l[2], a0l[3], a0h[0], a0h[1], a0h[2], a0h[3]}, va1 = {a1l[0], a1l[1], a1l[2], a1l[3], a1h[0], a1h[1], a1h[2], a1h[3]};
                o0 = __builtin_amdgcn_mfma_f32_32x32x16_bf16(va0, pb[s], o0, 0, 0, 0);
                o1 = __builtin_amdgcn_mfma_f32_32x32x16_bf16(va1, pb[s], o1, 0, 0, 0);
            }
            if (wid < 4) asm volatile("s_waitcnt vmcnt(6) lgkmcnt(0)" ::: "memory"); else asm volatile("s_waitcnt vmcnt(4) lgkmcnt(0)" ::: "memory");
            __builtin_amdgcn_s_barrier();
            p0 = n0; p1 = n1;
            s_cur = s_nxt; s_nxt = s_nxt + 1 == NSLOT ? 0 : s_nxt + 1; s_new = s_new + 1 == NSLOT ? 0 : s_new + 1;
        }
#undef ATT_QK
#undef ATT_ISSUE
#undef ATT_KROW
        lsum += shfl_f(lsum, lane ^ 32);
        const float inv = 1.f / lsum;
        bf16_t* op = YM + (size_t)(qrow0 + wid * 32 + r32) * 512 + h * 64 + 4 * hi;
#pragma unroll
        for (int g = 0; g < 4; ++g) {
            u32x2 w0, w1; w0.x = pk2(o0[4 * g] * inv, o0[4 * g + 1] * inv); w0.y = pk2(o0[4 * g + 2] * inv, o0[4 * g + 3] * inv);
            w1.x = pk2(o1[4 * g] * inv, o1[4 * g + 1] * inv); w1.y = pk2(o1[4 * g + 2] * inv, o1[4 * g + 3] * inv);
            *(u32x2*)(op + 8 * g) = w0; *(u32x2*)(op + 32 + 8 * g) = w1;
        }
    }
}
#endif

#if !NAIVE_HG
__device__ __forceinline__ bf16x8 trfrag(const LAS unsigned char* p, int rowstep4) {
    const s16x4 lo = vtr16(p), hi = vtr16(p + rowstep4); return (bf16x8){lo[0], lo[1], lo[2], lo[3], hi[0], hi[1], hi[2], hi[3]}; }
__device__ __forceinline__ void hg_gate16(const bf16_t* Z, int b, int s0, int d, int zcol, float lb, float (&kin)[16], float (&gl)[16]) {
#pragma unroll
    for (int i = 0; i < 16; ++i) { const int row = seq_row(b, s0 + i, d); const float z = bf2f(Z[(size_t)row * ZC + zcol]);
        const float e = __expf(-z), sg = 1.f / (1.f + e), f = lb + (1.f - lb) * sg; kin[i] = (1.f - lb) * e * sg; gl[i] = __logf(f); }
}
__device__ __forceinline__ void hg_local_load(u32x4 (&tz)[2], u32x4& tv, const bf16_t* Z, int unit, int tid) {
    const int c = unit % 36, r = unit / 36, d = r & 1, hd = (r >> 1) & 3, b = r >> 3;
#pragma unroll
    for (int j = 0; j < 2; ++j) { const int pc = tid + 512 * j, t = pc >> 4, c16 = pc & 15, row = seq_row(b, 64 * c + t, d);
        tz[j] = *(const u32x4*)(Z + (size_t)row * ZC + (d ? ZF1 : ZF0) + hd * 128 + c16 * 8); }
    { const int t = tid >> 3, cc = tid & 7, row = seq_row(b, 64 * c + t, d); tv = *(const u32x4*)(Z + (size_t)row * ZC + ZI + hd * 64 + cc * 8); }
}
__device__ __forceinline__ void hg_local_phase(Frame& F, ArgsP a, int l) {
    const bf16_t* Z = (const bf16_t*)(F.ws + WS_Z); bf16_t* HGS = (bf16_t*)(F.ws + WS_H); float* HGD = (float*)(F.ws + WS_MIX + MX_HGD);
    const float lb = hg_lb(a, l);
    LAS unsigned char* Vl = F.lds; LAS unsigned char* KdT = F.lds + 9216; LAS float* seg = (LAS float*)(F.lds + 27648); LAS unsigned char* Zr = F.lds + 32768;
    const int tid = F.tid, lane = F.lane, w = F.wave, k = tid & 127, tq = tid >> 7;
    u32x4 tz[2], tv;
    if (F.vcu < 2304) hg_local_load(tz, tv, Z, F.vcu, tid);
    for (int unit = F.vcu; unit < 2304; unit += F.G) {
        __syncthreads();
#pragma unroll
        for (int j = 0; j < 2; ++j) { const int pc = tid + 512 * j; *(LAS u32x4*)(Zr + (pc >> 4) * 272 + (pc & 15) * 16) = tz[j]; }
        *(LAS u32x4*)(Vl + (tid >> 3) * 144 + (tid & 7) * 16) = tv;
        if (unit + F.G < 2304) hg_local_load(tz, tv, Z, unit + F.G, tid);
        __syncthreads();
        float kin0[8], kin1[8], g0[8], g1[8];
#pragma unroll
        for (int i = 0; i < 8; ++i) { const unsigned zz = *(const LAS unsigned*)(Zr + ((8 * w + i) * 136 + 2 * lane) * 2);
            { const float e = __expf(-bflo(zz)), sg = __builtin_amdgcn_rcpf(1.f + e); kin0[i] = (1.f - lb) * e * sg; g0[i] = __logf(lb + (1.f - lb) * sg); }
            { const float e = __expf(-bfhi(zz)), sg = __builtin_amdgcn_rcpf(1.f + e); kin1[i] = (1.f - lb) * e * sg; g1[i] = __logf(lb + (1.f - lb) * sg); } }
        float run0 = 0.f, run1 = 0.f;
#pragma unroll
        for (int i = 7; i >= 0; --i) { const float a0 = g0[i], a1 = g1[i]; g0[i] = run0; g1[i] = run1; run0 += a0; run1 += a1; }
        *(LAS f32x2*)(seg + w * 128 + 2 * lane) = (f32x2){run0, run1};
        __syncthreads();
        float lat0 = 0.f, lat1 = 0.f, tot0 = 0.f, tot1 = 0.f;
#pragma unroll
        for (int q = 0; q < 8; ++q) { const f32x2 sv = *(const LAS f32x2*)(seg + q * 128 + 2 * lane); tot0 += sv.x; tot1 += sv.y; if (q > w) { lat0 += sv.x; lat1 += sv.y; } }
        { u32x4 w0, w1;
          w0.x = pk2(kin0[0] * __expf(g0[0] + lat0), kin0[1] * __expf(g0[1] + lat0)); w0.y = pk2(kin0[2] * __expf(g0[2] + lat0), kin0[3] * __expf(g0[3] + lat0));
          w0.z = pk2(kin0[4] * __expf(g0[4] + lat0), kin0[5] * __expf(g0[5] + lat0)); w0.w = pk2(kin0[6] * __expf(g0[6] + lat0), kin0[7] * __expf(g0[7] + lat0));
          w1.x = pk2(kin1[0] * __expf(g1[0] + lat1), kin1[1] * __expf(g1[1] + lat1)); w1.y = pk2(kin1[2] * __expf(g1[2] + lat1), kin1[3] * __expf(g1[3] + lat1));
          w1.z = pk2(kin1[4] * __expf(g1[4] + lat1), kin1[5] * __expf(g1[5] + lat1)); w1.w = pk2(kin1[6] * __expf(g1[6] + lat1), kin1[7] * __expf(g1[7] + lat1));
          *(LAS u32x4*)(KdT + (2 * lane) * 144 + w * 16) = w0; *(LAS u32x4*)(KdT + (2 * lane + 1) * 144 + w * 16) = w1; }
        if (w == 0) *(f32x2*)(HGD + (size_t)unit * 128 + 2 * lane) = (f32x2){__expf(tot0), __expf(tot1)};
        __syncthreads();
        f32x4 acc[4] = {};
#pragma unroll
        for (int ks = 0; ks < 2; ++ks) {
            const bf16x8 bf = *(const LAS bf16x8*)(KdT + (16 * w + (lane & 15)) * 144 + (32 * ks + 8 * (lane >> 4)) * 2);
#pragma unroll
            for (int mt = 0; mt < 4; ++mt) { const bf16x8 af = trfrag(Vl + (32 * ks + 8 * (lane >> 4) + ((lane & 15) >> 2)) * 144 + (mt * 16 + 4 * (lane & 3)) * 2, 4 * 144);
                acc[mt] = mfma16(af, bf, acc[mt]); }
        }
        bf16_t* dst = HGS + (size_t)unit * 8192 + 16 * w + (lane & 15);
#pragma unroll
        for (int mt = 0; mt < 4; ++mt)
#pragma unroll
            for (int rr = 0; rr < 4; ++rr) dst[(size_t)(16 * mt + 4 * (lane >> 4) + rr) * 128] = (bf16_t)f2bf(acc[mt][rr]);
    }
}
__device__ __forceinline__ void hg_scan_phase(Frame& F) {
    bf16_t* HGS = (bf16_t*)(F.ws + WS_H); const float* HGD = (const float*)(F.ws + WS_MIX + MX_HGD);
    for (int it = F.gw * 64 + F.lane; it < 64 * 1024; it += F.NGW * 64) {
        const int r = it >> 10, e8 = (it & 1023) * 8, k0 = e8 & 127;
        float S[8];
#pragma unroll
        for (int j = 0; j < 8; ++j) S[j] = 0.f;
#pragma unroll 4
        for (int c = 0; c < 36; ++c) {
            u32x4* p = (u32x4*)(HGS + (size_t)(r * 36 + c) * 8192 + e8); const u32x4 ds = *p;
            const f32x4 d0 = *(const f32x4*)(HGD + (size_t)(r * 36 + c) * 128 + k0), d1 = *(const f32x4*)(HGD + (size_t)(r * 36 + c) * 128 + k0 + 4);
            u32x4 o; o.x = pk2(S[0], S[1]); o.y = pk2(S[2], S[3]); o.z = pk2(S[4], S[5]); o.w = pk2(S[6], S[7]); *p = o;
            S[0] = d0[0] * S[0] + bflo(ds.x); S[1] = d0[1] * S[1] + bfhi(ds.x); S[2] = d0[2] * S[2] + bflo(ds.y); S[3] = d0[3] * S[3] + bfhi(ds.y);
            S[4] = d1[0] * S[4] + bflo(ds.z); S[5] = d1[1] * S[5] + bfhi(ds.z); S[6] = d1[2] * S[6] + bflo(ds.w); S[7] = d1[3] * S[7] + bfhi(ds.w);
        }
    }
}
struct HgTile { u32x4 z[2], q[2], s[2], v; };
__device__ __forceinline__ void hg_out_decode(int unit, bool need_ctx, int& b, int& hd, int& ct) {
    if (need_ctx) { ct = unit % 36; hd = (unit / 36) & 3; b = unit / 144; } else { ct = 4 + (unit & 31); hd = (unit >> 5) & 3; b = unit >> 7; }
}
__device__ __forceinline__ void hg_out_load(HgTile& T, const bf16_t* Z, const bf16_t* HGS, int b, int hd, int ct, int d, int tid) {
    const int cs = d == 0 ? ct : (ct < 4 ? 3 - ct : 39 - ct); const size_t su = (size_t)(((b * 4 + hd) * 2 + d) * 36 + cs);
#pragma unroll
    for (int j = 0; j < 2; ++j) { const int pc = tid + 512 * j, t = pc >> 4, c16 = pc & 15, row = seq_row(b, 64 * cs + t, d);
        T.z[j] = *(const u32x4*)(Z + (size_t)row * ZC + (d ? ZF1 : ZF0) + hd * 128 + c16 * 8); T.q[j] = *(const u32x4*)(Z + (size_t)row * ZC + ZHQ + hd * 128 + c16 * 8);
        T.s[j] = *(const u32x4*)(HGS + su * 8192 + (size_t)t * 128 + c16 * 8); }
    { const int t = tid >> 3, cc = tid & 7, row = seq_row(b, 64 * cs + t, d); T.v = *(const u32x4*)(Z + (size_t)row * ZC + ZI + hd * 64 + cc * 8); }
}
__device__ __forceinline__ void hg_out_phase(Frame& F, ArgsP a, int l, bool need_ctx) {
    const bf16_t* Z = (const bf16_t*)(F.ws + WS_Z); const bf16_t* HGS = (const bf16_t*)(F.ws + WS_H); bf16_t* YHG = (bf16_t*)(F.ws + WS_MIX + MX_YHG);
    const float lb = hg_lb(a, l);
    LAS unsigned char* HQD = F.lds; LAS unsigned char* HQ1 = F.lds + 17408; LAS unsigned char* HK1 = F.lds + 34816; LAS unsigned char* HST = F.lds + 52224;
    LAS unsigned char* HV = F.lds + 69632; LAS unsigned char* HP = F.lds + 78848; LAS float* HO = (LAS float*)(F.lds + 88064); LAS float* seg = (LAS float*)(F.lds + 105472);
    const int tid = F.tid, lane = F.lane, w = F.wave, k = tid & 127, tq = tid >> 7, mt = w >> 1, nh = w & 1;
    const int nunits = need_ctx ? 1152 : 1024;
    const int nmine = F.vcu < nunits ? (nunits - 1 - F.vcu) / F.G + 1 : 0, nit = 2 * nmine;
    HgTile T;
    if (nit > 0) { int b, hd, ct; hg_out_decode(F.vcu, need_ctx, b, hd, ct); hg_out_load(T, Z, HGS, b, hd, ct, 0, tid); }
    for (int it = 0; it < nit; ++it) {
        const int unit = F.vcu + (it >> 1) * F.G, d = it & 1; int b, hd, ct; hg_out_decode(unit, need_ctx, b, hd, ct);
        __syncthreads();
#pragma unroll
        for (int j = 0; j < 2; ++j) { const int pc = tid + 512 * j, t = pc >> 4, c16 = pc & 15;
            *(LAS u32x4*)(HQD + t * 272 + c16 * 16) = T.q[j]; *(LAS u32x4*)(HK1 + t * 272 + c16 * 16) = T.z[j]; *(LAS u32x4*)(HST + t * 272 + c16 * 16) = T.s[j]; }
        *(LAS u32x4*)(HV + (tid >> 3) * 144 + (tid & 7) * 16) = T.v;
        if (it + 1 < nit) { const int un = F.vcu + ((it + 1) >> 1) * F.G; int b2, hd2, ct2; hg_out_decode(un, need_ctx, b2, hd2, ct2); hg_out_load(T, Z, HGS, b2, hd2, ct2, (it + 1) & 1, tid); }
        __syncthreads();
        float kin0[8], kin1[8], g0[8], g1[8];
#pragma unroll
        for (int i = 0; i < 8; ++i) { const unsigned zz = *(const LAS unsigned*)(HK1 + ((8 * w + i) * 136 + 2 * lane) * 2);
            { const float e = __expf(-bflo(zz)), sg = __builtin_amdgcn_rcpf(1.f + e); kin0[i] = (1.f - lb) * e * sg; g0[i] = __logf(lb + (1.f - lb) * sg); }
            { const float e = __expf(-bfhi(zz)), sg = __builtin_amdgcn_rcpf(1.f + e); kin1[i] = (1.f - lb) * e * sg; g1[i] = __logf(lb + (1.f - lb) * sg); } }
        float run0 = 0.f, run1 = 0.f;
#pragma unroll
        for (int i = 0; i < 8; ++i) { run0 += g0[i]; g0[i] = run0; run1 += g1[i]; g1[i] = run1; }
        *(LAS f32x2*)(seg + w * 128 + 2 * lane) = (f32x2){run0, run1};
        __syncthreads();
        float bef0 = 0.f, bef1 = 0.f, br0 = 0.f, br1 = 0.f;
#pragma unroll
        for (int q = 0; q < 7; ++q) { const f32x2 sv = *(const LAS f32x2*)(seg + q * 128 + 2 * lane); if (q < w) { bef0 += sv.x; bef1 += sv.y; } if (q < 4) { br0 += sv.x; br1 += sv.y; } }
        const float er0 = __expf(br0), er1 = __expf(br1);
#pragma unroll
        for (int i = 0; i < 8; ++i) { const int t = 8 * w + i, off = (t * 136 + 2 * lane) * 2;
            const unsigned qq = *(const LAS unsigned*)(HQD + off);
            const float e0 = __expf(fminf(fmaxf(bef0 + g0[i] - br0, -80.f), 80.f)), e1 = __expf(fminf(fmaxf(bef1 + g1[i] - br1, -80.f), 80.f));
            const float q10 = bflo(qq) * e0, q11 = bfhi(qq) * e1;
            *(LAS unsigned*)(HQ1 + off) = pk2(q10, q11);
            *(LAS unsigned*)(HQD + off) = pk2(q10 * er0, q11 * er1);
            *(LAS unsigned*)(HK1 + off) = pk2(kin0[i] * __builtin_amdgcn_rcpf(e0), kin1[i] * __builtin_amdgcn_rcpf(e1)); }
        __syncthreads();
        f32x4 ao[2] = {}, as[2] = {};
#pragma unroll
        for (int ks = 0; ks < 4; ++ks) {
            const int ko = (32 * ks + 8 * (lane >> 4)) * 2;
            const bf16x8 aqd = *(const LAS bf16x8*)(HQD + (16 * mt + (lane & 15)) * 272 + ko), aq1 = *(const LAS bf16x8*)(HQ1 + (16 * mt + (lane & 15)) * 272 + ko);
#pragma unroll
            for (int j = 0; j < 2; ++j) { const int nt = 2 * nh + j;
                ao[j] = mfma16(aqd, *(const LAS bf16x8*)(HST + (16 * nt + (lane & 15)) * 272 + ko), ao[j]);
                as[j] = mfma16(aq1, *(const LAS bf16x8*)(HK1 + (16 * nt + (lane & 15)) * 272 + ko), as[j]); }
        }
#pragma unroll
        for (int j = 0; j < 2; ++j) { const int sc = 16 * (2 * nh + j) + (lane & 15);
#pragma unroll
            for (int rr = 0; rr < 4; ++rr) { const int t = 16 * mt + 4 * (lane >> 4) + rr; *(LAS bf16_t*)(HP + (t * 72 + sc) * 2) = (bf16_t)f2bf(sc <= t ? as[j][rr] : 0.f); } }
        __syncthreads();
#pragma unroll
        for (int ks = 0; ks < 2; ++ks) {
            const bf16x8 ap = *(const LAS bf16x8*)(HP + (16 * mt + (lane & 15)) * 144 + (32 * ks + 8 * (lane >> 4)) * 2);
#pragma unroll
            for (int j = 0; j < 2; ++j) { const int nt = 2 * nh + j;
                const bf16x8 bv = trfrag(HV + (32 * ks + 8 * (lane >> 4) + ((lane & 15) >> 2)) * 144 + (16 * nt + 4 * (lane & 3)) * 2, 4 * 144);
                ao[j] = mfma16(ap, bv, ao[j]); }
        }
#pragma unroll
        for (int j = 0; j < 2; ++j) { const int v = 16 * (2 * nh + j) + (lane & 15);
#pragma unroll
            for (int rr = 0; rr < 4; ++rr) { const int t = 16 * mt + 4 * (lane >> 4) + rr, tt = d == 0 ? t : 63 - t;
                if (d == 0) HO[tt * 68 + v] = ao[j][rr]; else HO[tt * 68 + v] += ao[j][rr]; } }
        if (d == 1) {
            __syncthreads();
#pragma unroll
            for (int i = 0; i < 8; ++i) { const int tt = 8 * w + i, row = ct < 4 ? NLAT + b * 256 + 64 * ct + tt : b * 2048 + 64 * (ct - 4) + tt, cidx = hd * 64 + lane;
                float o = HO[tt * 68 + lane]; const float ms = wave_sum(o * o) * (1.f / 64.f);
                o = o * rsqrtf(ms + EPS) * a->in[25][l * 256 + cidx] * siluf_(bf2f(Z[(size_t)row * ZC + ZG + cidx]));
                YHG[(size_t)row * 256 + cidx] = (bf16_t)f2bf(o); }
        }
    }
}
#endif

#if !NAIVE_S5
typedef f32x2 cf32;
__device__ __forceinline__ cf32 cmul(cf32 a, cf32 b) { return (cf32){a.x * b.x - a.y * b.y, a.x * b.y + a.y * b.x}; }
__device__ __forceinline__ void s5_build(Frame& F, ArgsP a) {
    LAS cf32* lamp = (LAS cf32*)F.lds;
    LAS cf32* Bb = lamp + 2 * 17 * 64;
    LAS cf32* Cc = Bb + 2 * 64 * 16;
    LAS float* Kd = (LAS float*)(Cc + 2 * 16 * 64);
    const int tid = F.tid;
    for (int unit = blockIdx.x; unit < 128; unit += F.G) {
        const int l = unit >> 6, g = (unit >> 2) & 15, q = unit & 3;
        bf16_t* Bs_t = (bf16_t*)(F.ws + WS_WB + (size_t)l * WL_STRIDE + WL_BS); bf16_t* B2_t = (bf16_t*)(F.ws + WS_WB + (size_t)l * WL_STRIDE + WL_B2);
        __syncthreads();
        if (tid < 128) { const int d = tid >> 6, p = tid & 63, idx = (l * 2 + d) * 16 + g;
            const float lre = a->in[9][idx * 64 + p], lim = a->in[10][idx * 64 + p], dt = expf(a->in[15][idx]);
            const float ar = lre * dt, ai = lim * dt;
            for (int tau = 0; tau <= 16; ++tau) { const float mag = expf(ar * (float)tau); float sn, cs; sincosf(ai * (float)tau, &sn, &cs); lamp[(d * 17 + tau) * 64 + p] = (cf32){mag * cs, mag * sn}; }
            const cf32 lb = lamp[(d * 17 + 1) * 64 + p]; const float den = lre * lre + lim * lim;
            const cf32 f = (cf32){((lb.x - 1.f) * lre + lb.y * lim) / den, (lb.y * lre - (lb.x - 1.f) * lim) / den};
            { const f32x4* br4 = (const f32x4*)(a->in[11] + (size_t)(idx * 64 + p) * 16); const f32x4* bi4 = (const f32x4*)(a->in[12] + (size_t)(idx * 64 + p) * 16);
              f32x4 br[4], bi[4];
#pragma unroll
              for (int q4 = 0; q4 < 4; ++q4) { br[q4] = br4[q4]; bi[q4] = bi4[q4]; }
#pragma unroll
              for (int h = 0; h < 16; ++h) Bb[(d * 64 + p) * 16 + h] = cmul(f, (cf32){br[h >> 2][h & 3], bi[h >> 2][h & 3]}); }
            if (q == 0) ((cf32*)(F.ws + WS_S5P))[idx * 64 + p] = lamp[(d * 17 + 16) * 64 + p];
        }
        for (int e = tid; e < 2048; e += 512) { const int d = e >> 10, h = (e >> 6) & 15, p = e & 63, idx = (l * 2 + d) * 16 + g;
            Cc[e] = (cf32){a->in[13][(size_t)(idx * 16 + h) * 64 + p], a->in[14][(size_t)(idx * 16 + h) * 64 + p]}; }
        __syncthreads();
        { const int d = tid >> 8, tau = (tid >> 4) & 15, h = tid & 15; float kacc[16];
#pragma unroll
          for (int hp = 0; hp < 16; ++hp) kacc[hp] = 0.f;
          for (int p = 0; p < 64; ++p) { const cf32 t1 = cmul(Cc[(d * 16 + h) * 64 + p], lamp[(d * 17 + tau) * 64 + p]);
#pragma unroll
              for (int hp = 0; hp < 16; ++hp) { const cf32 bb = Bb[(d * 64 + p) * 16 + hp]; kacc[hp] += t1.x * bb.x - t1.y * bb.y; } }
#pragma unroll
          for (int hp = 0; hp < 16; ++hp) Kd[tid * 16 + hp] = kacc[hp]; }
        __syncthreads();
        for (int e = tid; e < 64 * 512; e += 512) { const int n = 64 * q + (e >> 9), kk = e & 511, i = n >> 4, h = n & 15; float val;
            if (kk < 256) { const int j = kk >> 4, hp = kk & 15; val = 0.f;
                if (j <= i) val += Kd[((i - j) * 16 + h) * 16 + hp];
                if (j >= i) val += Kd[4096 + ((j - i) * 16 + h) * 16 + hp]; }
            else { const int dd = (kk - 256) >> 7, pp = (kk - 256) & 127, p = pp & 63, pw = dd == 0 ? i + 1 : 16 - i;
                const cf32 cl = cmul(Cc[(dd * 16 + h) * 64 + p], lamp[(dd * 17 + pw) * 64 + p]); val = pp < 64 ? cl.x : -cl.y; }
            B2_t[((size_t)g * 256 + n) * 512 + kk] = (bf16_t)f2bf(val); }
        { const int d = q & 1, half = q >> 1;
          for (int e = tid; e < 64 * 256; e += 512) { const int p = e >> 8, kk = e & 255, j = kk >> 4, hp = kk & 15, pw = d == 0 ? 15 - j : j;
              const cf32 v = cmul(lamp[(d * 17 + pw) * 64 + p], Bb[(d * 64 + p) * 16 + hp]);
              Bs_t[((size_t)(g * 2 + d) * 128 + half * 64 + p) * 256 + kk] = (bf16_t)f2bf(half ? v.y : v.x); } }
    }
    __syncthreads();
}
__device__ __forceinline__ void s5_state_phase(Frame& F, int l) {
    bf16_t* S5A = (bf16_t*)(F.ws + WS_MIX + MX_S5A); const bf16_t* Bs_t = (const bf16_t*)(F.ws + WS_WB + (size_t)l * WL_STRIDE + WL_BS);
    const cf32* lam16 = (const cf32*)(F.ws + WS_S5P);
    LAS float* hl = (LAS float*)F.lds;
    const int lane = F.lane, w = F.wave;
    for (int unit = F.vcu; unit < 256; unit += F.G) {
        const int b = unit & 7, d = (unit >> 3) & 1, g = unit >> 4;
        __syncthreads();
        f32x4 acc[10] = {};
        { u32x4 ta[10]; const bf16_t* Asrc = S5A + ((size_t)g * 1280 + b * 160) * 512;
#pragma unroll
          for (int j = 0; j < 10; ++j) { const int pc = F.tid + 512 * j; ta[j] = *(const u32x4*)(Asrc + (size_t)(pc >> 5) * 512 + (pc & 31) * 8); }
          const bf16_t* Bb = Bs_t + ((size_t)(g * 2 + d) * 128 + 16 * w + (lane & 15)) * 256 + 8 * (lane >> 4);
          bf16x8 bfr[8];
#pragma unroll
          for (int ks = 0; ks < 8; ++ks) bfr[ks] = *(const bf16x8*)(Bb + 32 * ks);
#pragma unroll
          for (int j = 0; j < 10; ++j) { const int pc = F.tid + 512 * j; *(LAS u32x4*)(F.lds + (pc >> 5) * 528 + (pc & 31) * 16) = ta[j]; }
          __syncthreads();
#pragma unroll
          for (int ks = 0; ks < 8; ++ks)
#pragma unroll
              for (int mt = 0; mt < 10; ++mt) acc[mt] = mfma16(*(const LAS bf16x8*)(F.lds + (16 * mt + (lane & 15)) * 528 + (32 * ks + 8 * (lane >> 4)) * 2), bfr[ks], acc[mt]);
          __syncthreads(); }
#pragma unroll
        for (int mt = 0; mt < 10; ++mt)
#pragma unroll
            for (int rr = 0; rr < 4; ++rr) hl[(16 * mt + 4 * (lane >> 4) + rr) * 132 + 16 * w + (lane & 15)] = acc[mt][rr];
        __syncthreads();
        if (w == 0) { const cf32 lm = lam16[((l * 2 + d) * 16 + g) * 64 + lane]; float hr = 0.f, hi = 0.f;
            bf16_t* dst = S5A + ((size_t)g * 1280 + b * 160) * 512 + 256 + d * 128 + lane;
            for (int s = 0; s < 144; ++s) { const int c = d == 0 ? s : (s < 16 ? 15 - s : 159 - s);
                dst[(size_t)c * 512] = (bf16_t)f2bf(hr); dst[(size_t)c * 512 + 64] = (bf16_t)f2bf(hi);
                const float lr = hl[c * 132 + lane], li = hl[c * 132 + 64 + lane];
                const float nr = lm.x * hr - lm.y * hi + lr, ni = lm.x * hi + lm.y * hr + li; hr = nr; hi = ni; }
        }
    }
}
struct WinOrderLast { pg8::StaticOrder S0; int G, c;
    __device__ bool next(int i, pg8::Unit& u) const { const int L = i * G + c; if (L < S0.nwg) return S0.next(i, u); const int e = L - S0.nwg; if (e >= 64) return false;
        const int t = e >> 3; u.pm = 64 + (e & 7); u.pn = t == 0 ? 0 : (t == 1 ? 2 : t + 2); return true; } };
struct S5Order { int G, c; __device__ bool next(int i, pg8::Unit& u) const { const int L = i * G + c; if (L >= 80) return false; u.pm = L; u.pn = L / 5; return true; } };
#endif

__device__ __forceinline__ bf16x8 pack8(const float (&v)[8]) { u32x4 w; w.x = pk2(v[0], v[1]); w.y = pk2(v[2], v[3]); w.z = pk2(v[4], v[5]); w.w = pk2(v[6], v[7]); return __builtin_bit_cast(bf16x8, w); }
__device__ __forceinline__ void norm2_router_phase(Frame& F, ArgsP a, int l, int nrows) {
    const float* X = (const float*)(F.ws + WS_X); bf16_t* H = (bf16_t*)(F.ws + WS_H);
    const float* modv = (const float*)(F.ws + WS_MODV) + (size_t)l * 9 * 6144;
    const float* Wg = a->in[30] + (size_t)l * D * 4; const float* bg = a->in[31] + l * 4; const float* We = a->in[32] + (size_t)l * D * 32; const float* be = a->in[33] + l * 32;
    int* ri = (int*)(F.ws + WS_ROUTE); float* rg = (float*)(F.ws + WS_ROUTE + (size_t)MTOK * 16);
    unsigned* cnt = (unsigned*)(F.ws + WS_CTL) + CW_CNT + l * 32 * 64;
    LAS unsigned char* hhi = F.lds; LAS unsigned char* hlo = F.lds + 33024; LAS float* part = (LAS float*)(F.lds + 66048); LAS float* lg = (LAS float*)(F.lds + 90624);
    const int w = F.wave, lane = F.lane, tid = F.tid;
    bf16x8 whi[4][3], wlo[4][3];
#pragma unroll
    for (int ks = 0; ks < 4; ++ks)
#pragma unroll
        for (int nt = 0; nt < 3; ++nt) { float hv[8], lv[8]; const int col = 16 * nt + (lane & 15);
#pragma unroll
            for (int i = 0; i < 8; ++i) { const int k = 128 * w + 32 * ks + 8 * (lane >> 4) + i;
                const float wv = col < 32 ? We[(size_t)k * 32 + col] : (col < 36 ? Wg[(size_t)k * 4 + (col - 32)] : 0.f);
                const float hi = bflo(pk2(wv, 0.f)); hv[i] = hi; lv[i] = wv - hi; }
            whi[ks][nt] = pack8(hv); wlo[ks][nt] = pack8(lv); }
    const int niter = nrows >> 4;
    for (int it = F.vcu; it < niter; it += F.G) {
        const int base = it * 16;
        __syncthreads();
#pragma unroll
        for (int rr = 0; rr < 2; ++rr) { const int lr = 2 * w + rr, row = base + lr; f32x4 v[4], h[4];
#pragma unroll
            for (int j = 0; j < 4; ++j) v[j] = *(const f32x4*)(X + (size_t)row * D + 4 * lane + 256 * j);
            const float* mv = modv + (size_t)tok_modrow(row) * 6144;
            norm_mod_row(v, h, a->in[7] + l * D, mv + 3 * 1024, mv + 4 * 1024, lane);
            store_row_bf16(H + (size_t)row * D, h, lane);
#pragma unroll
            for (int j = 0; j < 4; ++j) { u32x2 ph, pl; ph.x = pk2(h[j][0], h[j][1]); ph.y = pk2(h[j][2], h[j][3]);
                pl.x = pk2(h[j][0] - bflo(ph.x), h[j][1] - bfhi(ph.x)); pl.y = pk2(h[j][2] - bflo(ph.y), h[j][3] - bfhi(ph.y));
                *(LAS u32x2*)(hhi + (lr * 1032 + 4 * lane + 256 * j) * 2) = ph; *(LAS u32x2*)(hlo + (lr * 1032 + 4 * lane + 256 * j) * 2) = pl; } }
        __syncthreads();
        f32x4 acc[3] = {};
#pragma unroll
        for (int ks = 0; ks < 4; ++ks) { const int ao = ((lane & 15) * 1032 + 128 * w + 32 * ks + 8 * (lane >> 4)) * 2;
            const bf16x8 ahi = *(const LAS bf16x8*)(hhi + ao), alo = *(const LAS bf16x8*)(hlo + ao);
#pragma unroll
            for (int nt = 0; nt < 3; ++nt) { acc[nt] = mfma16(ahi, whi[ks][nt], acc[nt]); acc[nt] = mfma16(ahi, wlo[ks][nt], acc[nt]); acc[nt] = mfma16(alo, whi[ks][nt], acc[nt]); } }
#pragma unroll
        for (int nt = 0; nt < 3; ++nt)
#pragma unroll
            for (int r = 0; r < 4; ++r) part[(w * 16 + 4 * (lane >> 4) + r) * 48 + 16 * nt + (lane & 15)] = acc[nt][r];
        __syncthreads();
        for (int t = tid; t < 576; t += 512) { const int r = t / 36, c = t - r * 36; float sacc = 0.f;
#pragma unroll
            for (int q = 0; q < 8; ++q) sacc += part[(q * 16 + r) * 48 + c];
            lg[r * 40 + c] = sacc + (c < 32 ? be[c] : bg[c - 32]); }
        __syncthreads();
        if (tid < 16) { const int row = base + tid; const LAS float* lr = lg + tid * 40;
            int gi = 0; float gm = lr[32];
#pragma unroll
            for (int i = 1; i < 4; ++i) if (lr[32 + i] > gm) { gm = lr[32 + i]; gi = i; }
            float gs = 0.f;
#pragma unroll
            for (int i = 0; i < 4; ++i) gs += __expf(lr[32 + i] - gm);
            const float gw_ = 1.f / gs;
            const LAS float* el = lr + gi * 8;
            int i1 = 0; float v1 = el[0];
#pragma unroll
            for (int j = 1; j < 8; ++j) if (el[j] > v1) { v1 = el[j]; i1 = j; }
            int i2 = -1; float v2 = -3.0e38f;
#pragma unroll
            for (int j = 0; j < 8; ++j) if (j != i1 && el[j] > v2) { v2 = el[j]; i2 = j; }
            const float e2 = __expf(v2 - v1), g1 = gw_ / (1.f + e2), g2 = gw_ * e2 / (1.f + e2);
            const int e0 = gi * 8 + i1, e1 = gi * 8 + i2;
            const unsigned r0 = __hip_atomic_fetch_add(cnt + e0 * 64, 1u, __ATOMIC_RELAXED, __HIP_MEMORY_SCOPE_AGENT), r1 = __hip_atomic_fetch_add(cnt + e1 * 64, 1u, __ATOMIC_RELAXED, __HIP_MEMORY_SCOPE_AGENT);
            *(int4*)(ri + (size_t)row * 4) = make_int4(e0, e1, (int)r0, (int)r1);
            { int* lists = (int*)(F.ws + WS_LISTS); lists[(size_t)e0 * MTOK + r0] = row; lists[(size_t)e1 * MTOK + r1] = row; }
            rg[(size_t)row * 2 + 0] = g1; rg[(size_t)row * 2 + 1] = g2; }
    }
}
__device__ __forceinline__ int moe_starts(Frame& F, int l, int& total) {
    unsigned* cnt = (unsigned*)(F.ws + WS_CTL) + CW_CNT + l * 32 * 64;
    const int c = F.lane < 32 ? (int)__hip_atomic_load(cnt + (F.lane & 31) * 64, __ATOMIC_RELAXED, __HIP_MEMORY_SCOPE_AGENT) : 0;
    const int padded = (c + 255) & ~255; int incl = padded;
#pragma unroll
    for (int o = 1; o < 32; o <<= 1) { const int t = shfl_i(incl, F.lane - o); if (F.lane >= o) incl += t; }
    total = shfl_i(incl, 31);
    return incl - padded;
}
__device__ __forceinline__ void moe_gather_phase(Frame& F, int l, int nrows) {
    const bf16_t* H = (const bf16_t*)(F.ws + WS_H); bf16_t* XS = (bf16_t*)(F.ws + WS_Z + MZ_XS); const int* ri = (const int*)(F.ws + WS_ROUTE);
    int total; const int st = moe_starts(F, l, total);
    for (int row = F.gw; row < nrows; row += F.NGW) {
        const int e0 = ri[(size_t)row * 4], e1 = ri[(size_t)row * 4 + 1], r0 = ri[(size_t)row * 4 + 2], r1 = ri[(size_t)row * 4 + 3];
        const int d0 = shfl_i(st, e0) + r0, d1 = shfl_i(st, e1) + r1;
#pragma unroll
        for (int j = 0; j < 2; ++j) { const u32x4 w = *(const u32x4*)(H + (size_t)row * D + j * 512 + F.lane * 8);
            *(u32x4*)(XS + (size_t)d0 * D + j * 512 + F.lane * 8) = w; *(u32x4*)(XS + (size_t)d1 * D + j * 512 + F.lane * 8) = w; }
    }
}
__device__ __forceinline__ int moe_unit_wgid(int L, int nunits) { const int q = nunits / 8, r = nunits % 8, xcd = L % 8, off = L / 8; return (xcd < r ? xcd * (q + 1) : r * (q + 1) + (xcd - r) * q) + off; }
struct MoeOrder {
    int nunits, G, c; const LAS int* tile_e; const LAS int* rows;
    __device__ bool next(int i, pg8::Unit& u) const {
        const long L = (long)i * G + c; if (L >= nunits) return false;
        const int wgid = moe_unit_wgid((int)L, nunits), tile = wgid >> 2; u.pm = tile; u.pn = tile_e[tile] * 4 + (wgid & 3); return true;
    }
    __device__ unsigned a_row(int ui, int r) const { return (unsigned)rows[ui * 256 + r]; }
};
__device__ __forceinline__ int moe_build_tiles(Frame& F, int l, bool fill_rows) {
    LAS int* tbl = (LAS int*)(F.lds + TBL_OFF);
    __syncthreads();
    if (F.wave == 0) { int total; const int st = moe_starts(F, l, total); if (F.lane < 32) { tbl[F.lane] = st;
            tbl[256 + F.lane] = (int)__hip_atomic_load((unsigned*)(F.ws + WS_CTL) + CW_CNT + (l * 32 + F.lane) * 64, __ATOMIC_RELAXED, __HIP_MEMORY_SCOPE_AGENT); }
        if (F.lane == 0) tbl[32] = total; }
    __syncthreads();
    const int total = tbl[32], ntiles = total >> 8;
    for (int t = F.tid; t < ntiles; t += 512) { int e = 0;
#pragma unroll
        for (int j = 1; j < 32; ++j) if (tbl[j] <= t * 256) e = j;
        tbl[64 + t] = e; }
    __syncthreads();
    if (fill_rows) { const int* lists = (const int*)(F.ws + WS_LISTS); const int nunits = ntiles * 4;
        for (int x = F.tid; x < 768; x += 512) { const int ui = x >> 8, r = x & 255, L = ui * F.G + (int)blockIdx.x; int src = 0;
            if (L < nunits) { const int tile = moe_unit_wgid(L, nunits) >> 2, e = tbl[64 + tile], rank = tile * 256 - tbl[e] + r; if (rank < tbl[256 + e]) src = lists[(size_t)e * MTOK + rank]; }
            tbl[512 + x] = src; }
        __syncthreads(); }
    return ntiles;
}
__device__ __forceinline__ void moe_combine_phase(Frame& F, ArgsP a, int l, int nrows, bool dry = false) {
    float* X = (float*)(F.ws + WS_X); float* Xo = dry ? (float*)(F.ws + WS_Z + 132 * MiB) : X; float* outp = dry ? Xo : a->out; bf16_t* H = (bf16_t*)(F.ws + WS_H); const bf16_t* Y = (const bf16_t*)(F.ws + WS_Z + MZ_XS);
    const int* ri = (const int*)(F.ws + WS_ROUTE); const float* rg = (const float*)(F.ws + WS_ROUTE + (size_t)MTOK * 16);
    const float* modv = (const float*)(F.ws + WS_MODV);
    int total; const int st = moe_starts(F, l, total);
    for (int row = F.gw; row < nrows; row += F.NGW) {
        const int e0 = ri[(size_t)row * 4], e1 = ri[(size_t)row * 4 + 1], r0 = ri[(size_t)row * 4 + 2], r1 = ri[(size_t)row * 4 + 3];
        const int p0 = shfl_i(st, e0) + r0, p1 = shfl_i(st, e1) + r1; const float g0 = rg[(size_t)row * 2], g1 = rg[(size_t)row * 2 + 1];
        const float* mv = modv + ((size_t)l * 9 + tok_modrow(row)) * 6144;
        f32x4 v[4];
#pragma unroll
        for (int j = 0; j < 4; ++j) { const int c = 4 * F.lane + 256 * j;
            const u32x2 y0 = *(const u32x2*)(Y + (size_t)p0 * D + c), y1 = *(const u32x2*)(Y + (size_t)p1 * D + c);
            const f32x4 f = { g0 * bflo(y0.x) + g1 * bflo(y1.x), g0 * bfhi(y0.x) + g1 * bfhi(y1.x), g0 * bflo(y0.y) + g1 * bflo(y1.y), g0 * bfhi(y0.y) + g1 * bfhi(y1.y) };
            v[j] = *(const f32x4*)(X + (size_t)row * D + c) + *(const f32x4*)(mv + 5 * 1024 + c) * f; }
        if (l == 0) {
#pragma unroll
            for (int j = 0; j < 4; ++j) *(f32x4*)(Xo + (size_t)row * D + 4 * F.lane + 256 * j) = v[j];
            f32x4 h[4]; const float* mv1 = modv + ((size_t)9 + tok_modrow(row)) * 6144;
            norm_mod_row(v, h, a->in[6] + D, mv1, mv1 + 1024, F.lane);
            store_row_bf16(H + (size_t)row * D, h, F.lane);
        } else {
            float ss = 0.f;
#pragma unroll
            for (int j = 0; j < 4; ++j) ss += (v[j][0] * v[j][0] + v[j][1] * v[j][1]) + (v[j][2] * v[j][2] + v[j][3] * v[j][3]);
            const float rstd = rsqrtf(wave_sum(ss) * (1.f / D) + EPS);
#pragma unroll
            for (int j = 0; j < 4; ++j) { const int c = 4 * F.lane + 256 * j; *(f32x4*)(outp + (size_t)row * D + c) = v[j] * rstd * *(const f32x4*)(a->in[37] + c); }
        }
    }
}

#define REOPAQUE() { unsigned m1_ = ~0u; asm volatile("" : "+s"(m1_)); int ln_ = __builtin_amdgcn_mbcnt_hi(m1_, __builtin_amdgcn_mbcnt_lo(m1_, 0u)); asm volatile("" : "+v"(ln_)); F.lane = ln_; F.wave = wave_s; F.tid = wave_s * 64 + ln_; F.gw = F.vcu * NWAVES + F.wave; int z_ = 0; asm volatile("" : "+s"(z_)); args = (ArgsP)__builtin_amdgcn_kernarg_segment_ptr() + z_; F.ws = args->ws; }
#define PH_BEGIN if (ph >= lo && ph < hi) { REOPAQUE()
#define PH_END } if (ph >= lo && ph + 1 < hi) { if (!MK_PER_PHASE) REP(15) xcd_barrier_fn(bar.bar, bar.x, (unsigned)(uintptr_t)bar.st, F.tid); } ++ph;

#define pH ((bf16_t*)(F.ws + WS_H))
#define pZ ((bf16_t*)(F.ws + WS_Z))
#define pX ((float*)(F.ws + WS_X))
#define pMix (F.ws + WS_MIX)
#define pSsq ((float*)(F.ws + WS_SSQ))
#define pRope ((const float*)(F.ws + WS_ROPE))
#define pWl (F.ws + WS_WB + (size_t)l * WL_STRIDE)
#define pModv ((const float*)(F.ws + WS_MODV) + (size_t)l * 9 * 6144)


template <int l> __device__ __forceinline__ void layer_prog(Frame& F, ArgsP& args, int& ph, const int lo, const int hi, const XcdBarrier& bar, const int wave_s) {
        const bool need_ctx = (l == 0); const int nrows = need_ctx ? MTOK : NLAT;

        PH_BEGIN REP(1) { pg8::Gemm g{pH, (const bf16_t*)(pWl + WL_WIN), D, D, D};
            Epi<EM_Z> E{}; E.ssq = pSsq; E.rope = pRope; E.o0 = pZ; E.o1 = (bf16_t*)(pMix + MX_KPE); E.o2 = (bf16_t*)(pMix + MX_S5A);
            if constexpr (l == 0) { pg8::StaticOrder S; S.init(MTOK, ZC, F.G, (int)blockIdx.x); pg8::gemm_phase(F.lds, F.tid, g, S, E); }
            else { WinOrderLast S; S.S0.init(NLAT, ZC, F.G, (int)blockIdx.x); S.G = F.G; S.c = (int)blockIdx.x; pg8::gemm_phase(F.lds, F.tid, g, S, E); } } PH_END

        PH_BEGIN {
            REP(2) { pg8::Gemm g{pZ + ZCQ, (const bf16_t*)(pWl + WL_UQ), 256, ZC, 256}; pg8::StaticOrder S; S.init(nrows, 768, F.G, ((int)blockIdx.x + F.G - 32) % F.G);
              Epi<EM_Q> E{}; E.ssq = pSsq; E.rope = pRope; E.o0 = (bf16_t*)(pMix + MX_Q); pg8::gemm_phase(F.lds, F.tid, g, S, E); }
            REOPAQUE()
            REP(2) { pg8::Gemm g{pZ + ZCKV, (const bf16_t*)(pWl + WL_UKV), 128, ZC, 128}; pg8::StaticOrder S; S.init(MTOK, 1024, F.G, (int)blockIdx.x);
              Epi<EM_KV> E{}; E.ssq = pSsq; E.o0 = (bf16_t*)(pMix + MX_KN); E.o1 = (bf16_t*)(pMix + MX_V); pg8::gemm_phase(F.lds, F.tid, g, S, E); }
            REOPAQUE()
#if NAIVE_S5
            s5_naive(F, args, l);
#else
            REP(3) s5_state_phase(F, l);
#endif
            REOPAQUE()
#if NAIVE_HG
            hg_naive(F, args, l);
#else
            REP(4) hg_local_phase(F, args, l);
#endif
        } PH_END

        PH_BEGIN {
#if NAIVE_ATTN
            attn_naive(F, need_ctx);
#else
#if PROBE_PH >= 50 && PROBE_PH < 60
            attn_fast<PROBE_PH - 49>(F, need_ctx, (bf16_t*)args->out); REOPAQUE()
#endif
            attn_fast<0>(F, need_ctx, (bf16_t*)(pMix + MX_YMLA));
#endif
            REOPAQUE()
#if NAIVE_S5
            s5_naive_finish(F, args, l, nrows);
#else
            REP(6) { pg8::Gemm g{(const bf16_t*)(pMix + MX_S5A), (const bf16_t*)(pWl + WL_B2), 512, 512, 512}; S5Order S{F.G, (F.vcu + F.G - 64) % F.G};
              Epi<EM_S5> E{}; E.o0 = (bf16_t*)(pMix + MX_YS5P); E.i0 = (const bf16_t*)(pMix + MX_S5A); E.f0 = args->in[16] + l * 256; pg8::gemm_phase(F.lds, F.tid, g, S, E); }
#endif
            REOPAQUE()
#if NAIVE_HG
            hg_naive_finish(F, args, l, nrows);
#else
            hg_scan_phase(F);
#endif
        } PH_END

        PH_BEGIN {
#if !NAIVE_HG
            REP(7) hg_out_phase(F, args, l, need_ctx);
            REOPAQUE()
#endif
            REP(8) { pg8::Gemm g{(const bf16_t*)(pMix + MX_YS5P), (const bf16_t*)(pWl + WL_GLU), 256, 256, 256}; pg8::StaticOrder S; S.init(nrows, 256, F.G, (F.vcu + F.G - 128) % F.G);
            Epi<EM_GLU> E{}; E.o0 = (bf16_t*)(pMix + MX_YS5); E.i0 = (const bf16_t*)(pMix + MX_YS5P); E.f0 = args->in[18] + l * 256;
            pg8::gemm_phase(F.lds, F.tid, g, S, E); } } PH_END

        PH_BEGIN { pg8::StaticOrder S; S.init(nrows, 1024, F.G, (int)blockIdx.x);
            for (int mrep = (PROBE_PH == 60 ? 0 : 1); mrep < 2; ++mrep) { bf16_t* mout = mrep == 0 ? (bf16_t*)args->out : pH;
            { pg8::Gemm g{(const bf16_t*)(pMix + MX_YS5), (const bf16_t*)(pWl + WL_PA), 256, 256, 256}; Epi<EM_MERGE0> E{}; E.o0 = mout; E.i0 = pZ + ZGA; pg8::gemm_phase(F.lds, F.tid, g, S, E); }
            { pg8::Gemm g{(const bf16_t*)(pMix + MX_YMLA), (const bf16_t*)(pWl + WL_PB), 512, 512, 512}; Epi<EM_MERGE1> E{}; E.o0 = mout; E.i0 = pZ + ZGB; pg8::gemm_phase(F.lds, F.tid, g, S, E); }
            { pg8::Gemm g{(const bf16_t*)(pMix + MX_YHG), (const bf16_t*)(pWl + WL_PC), 256, 256, 256}; Epi<EM_MERGE1> E{}; E.o0 = mout; E.i0 = pZ + ZGC; pg8::gemm_phase(F.lds, F.tid, g, S, E); } }
        } PH_END

        PH_BEGIN REP(l == 0 ? 10 : -1) { pg8::Gemm g{pH, (const bf16_t*)(pWl + WL_OUT), D, D, D}; pg8::StaticOrder S; S.init(nrows, 1024, F.G, (int)blockIdx.x);
            Epi<EM_WOUT> E{}; E.layer = l; E.f0 = pModv; E.f1 = args->in[0]; E.f2 = args->in[2]; E.fo = pX;
            pg8::gemm_phase(F.lds, F.tid, g, S, E); } PH_END

        PH_BEGIN { norm2_router_phase(F, args, l, nrows); REOPAQUE() REP(11) moe_convert(F, args, l); } PH_END
        PH_BEGIN REP(13) { const int nt = moe_build_tiles(F, l, true); MoeOrder S{nt * 4, F.G, (int)blockIdx.x, (const LAS int*)(F.lds + TBL_OFF) + 64, (const LAS int*)(F.lds + TBL_OFF) + 512};
            pg8::Gemm g{pH, (const bf16_t*)(pMix + MW_W13), D, D, D};
            Epi<EM_MOEUP> E{}; E.o0 = (bf16_t*)(F.ws + WS_Z + MZ_HID); pg8::gemm_phase<Epi<EM_MOEUP>, MoeOrder, true>(F.lds, F.tid, g, S, E); } PH_END
        PH_BEGIN REP(14) { const int nt = moe_build_tiles(F, l, false); MoeOrder S{nt * 4, F.G, (int)blockIdx.x, (const LAS int*)(F.lds + TBL_OFF) + 64, (const LAS int*)(F.lds + TBL_OFF) + 512};
            pg8::Gemm g{(const bf16_t*)(F.ws + WS_Z + MZ_HID), (const bf16_t*)(pMix + MW_W2), HID, HID, HID};
            Epi<EM_MOEDN> E{}; E.o0 = (bf16_t*)(F.ws + WS_Z + MZ_XS); pg8::gemm_phase(F.lds, F.tid, g, S, E); } PH_END
        PH_BEGIN { if (PROBE_PH == 19) { moe_combine_phase(F, args, l, nrows, true); REOPAQUE() } moe_combine_phase(F, args, l, nrows); } PH_END
    }

__global__ void __launch_bounds__(NWAVES * 64, 2) mega_fwd(Args args_by_value) {
    ArgsP args = (ArgsP)__builtin_amdgcn_kernarg_segment_ptr();
    extern __shared__ __attribute__((aligned(16))) unsigned char lds_raw[];
    Frame F;
    F.lds = (LAS unsigned char*)lds_raw;
    F.tid = threadIdx.x; F.lane = F.tid & 63; F.wave = __builtin_amdgcn_readfirstlane(F.tid >> 6);
    const int wave_s = F.wave;
    F.G = gridDim.x; { const int bx = blockIdx.x; F.vcu = (F.G % 8 == 0) ? (bx % 8) * (F.G / 8) + bx / 8 : bx; }
    F.gw = F.vcu * NWAVES + F.wave; F.NGW = F.G * NWAVES; F.ws = args->ws;
    volatile LAS unsigned* MISC = (volatile LAS unsigned*)(F.lds + MISC_OFF);
    for (int u = F.tid; u < (LDS_BYTES - RING_BYTES) / 4; u += NWAVES * 64) ((LAS unsigned*)(F.lds + RING_BYTES))[u] = 0u;
    __syncthreads();
    unsigned* ctl = (unsigned*)(F.ws + WS_CTL);
    XcdBarrier bar; bar.bar = ctl + CW_BAR; bar.x = 0; bar.st = nullptr;
    if (!MK_PER_PHASE) bar = xcd_barrier_post(ctl + CW_BAR, MISC + 8);
    const int lo = args->ph_lo, hi = args->ph_hi;
    int ph = 0;
    PH_BEGIN REP(17) prologue_phase(F, args); PH_END
    PH_BEGIN REP(16) norm1_phase(F, args, 0, MTOK); PH_END

    layer_prog<0>(F, args, ph, lo, hi, bar, wave_s);
    layer_prog<1>(F, args, ph, lo, hi, bar, wave_s);
#undef PH_BEGIN
#undef REOPAQUE
#undef PH_END
#undef pH
#undef pZ
#undef pX
#undef pMix
#undef pSsq
#undef pRope
#undef pWl
#undef pModv
}
constexpr int N_PHASES = 2 + 2 * 10;

extern "C" void kernel_launch(void* const* d_in, const int* in_sizes, int n_in, void* d_out, int out_size, void* d_ws, size_t ws_size, hipStream_t stream) {
    static int grid = 0;
    if (grid == 0) {
        if (n_in != 38 || out_size != NLAT * D || ws_size < WS_END) { fprintf(stderr, "kernel_launch: unexpected shapes (n_in %d out %d ws %zu need %zu)\n", n_in, out_size, ws_size, (size_t)WS_END); grid = -1; return; }
        int dev = 0, cus = 0, per_cu = 0;
        if (hipGetDevice(&dev) != hipSuccess || hipDeviceGetAttribute(&cus, hipDeviceAttributeMultiprocessorCount, dev) != hipSuccess) { grid = -1; return; }
        if (hipFuncSetAttribute((const void*)mega_fwd, hipFuncAttributeMaxDynamicSharedMemorySize, LDS_BYTES) != hipSuccess) { fprintf(stderr, "kernel_launch: hipFuncSetAttribute failed\n"); grid = -1; return; }
        if (hipOccupancyMaxActiveBlocksPerMultiprocessor(&per_cu, (const void*)mega_fwd, NWAVES * 64, LDS_BYTES) != hipSuccess || per_cu < 1) { fprintf(stderr, "kernel_launch: occupancy query says %d\n", per_cu); }
        (void)hipGetLastError();
        grid = cus;
    }
    if (grid < 0) return;
    (void)hipMemsetAsync((char*)d_ws + WS_CTL, 0, CTL_ZERO_BYTES, stream);
    Args a{};
    for (int i = 0; i < 38; ++i) a.in[i] = (const float*)d_in[i];
    a.out = (float*)d_out; a.ws = (unsigned char*)d_ws;
#if MK_PER_PHASE
    for (int p = 0; p < N_PHASES; ++p) { a.ph_lo = p; a.ph_hi = p + 1; hipLaunchKernelGGL(mega_fwd, dim3(grid), dim3(NWAVES * 64), LDS_BYTES, stream, a); }
#else
    a.ph_lo = 0; a.ph_hi = N_PHASES;
    hipLaunchKernelGGL(mega_fwd, dim3(grid), dim3(NWAVES * 64), LDS_BYTES, stream, a);
#endif
}
```

```cpp
#include <hip/hip_runtime.h>
#include <cstdio>
#include <cstdint>

#ifndef NAIVE_ATTN
#define NAIVE_ATTN 0
#endif
#ifndef NAIVE_S5
#define NAIVE_S5 0
#endif
#ifndef NAIVE_HG
#define NAIVE_HG 0
#endif
#ifndef PROBE_PH
#define PROBE_PH 0
#endif
#ifndef PROBE_N
#define PROBE_N 1
#endif
#define REP(id) for (int rep_ = 0; rep_ < ((PROBE_PH == (id)) ? PROBE_N : 1); ++rep_)
#ifndef MK_PER_PHASE
#define MK_PER_PHASE 0
#endif

#define GAS __attribute__((address_space(1)))
#define LAS __attribute__((address_space(3)))
typedef unsigned short bf16_t;
typedef short bf16x8 __attribute__((ext_vector_type(8)));
typedef float f32x4 __attribute__((ext_vector_type(4)));
typedef float f32x2 __attribute__((ext_vector_type(2)));
typedef float f32x16 __attribute__((ext_vector_type(16)));
typedef unsigned u32x4 __attribute__((ext_vector_type(4)));
typedef unsigned u32x2 __attribute__((ext_vector_type(2)));
typedef GAS unsigned gu32;

constexpr int D = 1024, NB = 8, SEQ = 2048, CTXL = 256, NLAT = NB * SEQ, NCTX = NB * CTXL, MTOK = NLAT + NCTX;
constexpr int ZC = 5888, INC = 5792;
constexpr int ZU = 0, ZCQ = 256, ZCKV = 512, ZKPE = 640, ZHQ = 672, ZF0 = 1184, ZF1 = 1696, ZI = 2208, ZG = 2464, ZGA = 2720, ZGB = 3744, ZGC = 4768;
constexpr float EPS = 1e-6f;
constexpr float QSCALE = 0.10206207261596577f * 1.4426950408889634f;
constexpr int NEXP = 32, HID = 512;
constexpr int XS_ROWS = 45056;

constexpr size_t MiB = 1u << 20;
constexpr size_t WS_CTL = 0, CTL_ZERO_BYTES = 96 * 1024;
constexpr size_t WS_MODV = 1 * MiB;
constexpr size_t WS_ROPE = 2 * MiB;
constexpr size_t WS_SSQ = 2 * MiB + 65536;
constexpr size_t WS_ROUTE = 3 * MiB;
constexpr size_t WS_S5P = 4 * MiB;
constexpr size_t WS_LISTS = 5 * MiB;
constexpr size_t WS_WB = 8 * MiB;
constexpr size_t WL_WIN = 0, WL_UQ = WL_WIN + (size_t)ZC * D * 2, WL_UKV = WL_UQ + 768 * 256 * 2, WL_GLU = WL_UKV + 1024 * 128 * 2,
                 WL_PA = WL_GLU + 256 * 256 * 2, WL_PB = WL_PA + 1024 * 256 * 2, WL_PC = WL_PB + 1024 * 512 * 2, WL_OUT = WL_PC + 1024 * 256 * 2,
                 WL_BS = WL_OUT + 1024 * 1024 * 2, WL_B2 = WL_BS + 32 * 128 * 256 * 2, WL_END = WL_B2 + 16 * 256 * 512 * 2;
constexpr size_t WL_STRIDE = 24 * MiB;
static_assert(WL_END <= WL_STRIDE, "weights per layer");
constexpr size_t WS_X = 56 * MiB;
constexpr size_t WS_H = 128 * MiB;
constexpr size_t WS_MIX = 164 * MiB;
constexpr size_t MX_Q = 0, MX_KN = MX_Q + (size_t)MTOK * 768 * 2, MX_V = MX_KN + (size_t)MTOK * 512 * 2, MX_KPE = MX_V + (size_t)MTOK * 512 * 2,
                 MX_YS5P = MX_KPE + (size_t)MTOK * 32 * 2, MX_YS5 = MX_YS5P + (size_t)MTOK * 256 * 2, MX_YHG = MX_YS5 + (size_t)MTOK * 256 * 2,
                 MX_YMLA = MX_YHG + (size_t)MTOK * 256 * 2, MX_S5A = MX_YMLA + (size_t)MTOK * 512 * 2, MX_HGD = MX_S5A + (size_t)16 * 1280 * 512 * 2,
                 MX_END = MX_HGD + (size_t)2304 * 128 * 4;
static_assert(MX_END <= 132 * MiB, "mixer region");
constexpr size_t MW_W13 = 0, MW_W2 = (size_t)NEXP * 1024 * 1024 * 2;
static_assert(MW_W2 + (size_t)NEXP * 1024 * 512 * 2 <= 132 * MiB, "moe weights");
constexpr size_t WS_Z = 296 * MiB;
constexpr size_t MZ_XS = 0, MZ_HID = (size_t)XS_ROWS * 1024 * 2;
constexpr size_t WS_END = WS_Z + (size_t)MTOK * ZC * 2;
static_assert(MZ_HID + (size_t)XS_ROWS * 512 * 2 <= (size_t)MTOK * ZC * 2, "moe buffers");
constexpr int CW_BAR = 4096;
constexpr int CW_CNT = 16384;

__device__ __forceinline__ unsigned f2bf(float f) { unsigned u = __builtin_bit_cast(unsigned, f); return (u + 0x7fffu + ((u >> 16) & 1u)) >> 16; }
typedef __bf16 bf16x2_t __attribute__((ext_vector_type(2)));
__device__ __forceinline__ unsigned pk2(float lo, float hi) { const f32x2 v = {lo, hi}; return __builtin_bit_cast(unsigned, __builtin_convertvector(v, bf16x2_t)); }
__device__ __forceinline__ float bf2f(unsigned short b) { return __builtin_bit_cast(float, (unsigned)b << 16); }
__device__ __forceinline__ float bflo(unsigned w) { return __builtin_bit_cast(float, w << 16); }
__device__ __forceinline__ float bfhi(unsigned w) { return __builtin_bit_cast(float, w & 0xffff0000u); }
template <int CTRL> __device__ __forceinline__ float dppf(float v) { return __builtin_bit_cast(float, __builtin_amdgcn_update_dpp(0, __builtin_bit_cast(int, v), CTRL, 0xf, 0xf, true)); }
__device__ __forceinline__ float rlanef(float v, int l) { return __builtin_bit_cast(float, __builtin_amdgcn_readlane(__builtin_bit_cast(int, v), l)); }
__device__ __forceinline__ float wave_sum(float v) {
    v += dppf<0xB1>(v); v += dppf<0x4E>(v); v += dppf<0x141>(v); v += dppf<0x140>(v);
    return (rlanef(v, 0) + rlanef(v, 16)) + (rlanef(v, 32) + rlanef(v, 48));
}
__device__ __forceinline__ int shfl_i(int v, int src_lane) { return __builtin_amdgcn_ds_bpermute(src_lane << 2, v); }
__device__ __forceinline__ float shfl_f(float v, int src_lane) { return __builtin_bit_cast(float, __builtin_amdgcn_ds_bpermute(src_lane << 2, __builtin_bit_cast(int, v))); }
__device__ __forceinline__ float sigmoidf_(float x) { return __builtin_amdgcn_rcpf(1.f + __expf(-x)); }
__device__ __forceinline__ float siluf_(float x) { return x * __builtin_amdgcn_rcpf(1.f + __expf(-x)); }
__device__ __forceinline__ float gelu_tanh(float x) { const float t = 0.7978845608028654f * (x + 0.044715f * x * x * x); return x * __builtin_amdgcn_rcpf(1.f + __expf(-2.f * t)); }
__device__ __forceinline__ int tok_modrow(int row) { return row < NLAT ? (row >> 11) : 8; }

namespace pg8 {
constexpr int BM = 256, BK = 64, HALF = 128, HTB = HALF * BK * 2, STAGE_BYTES = 8 * HTB, NXCD = 8, WGM = 8;
__host__ __device__ __forceinline__ int lds_byte(int r, int c) { const int st = (r >> 4) * 2 + (c >> 5), rr = r & 15, cc = c & 31, ob = rr * 64 + cc * 2; return st * 1024 + (ob ^ (((ob >> 9) & 1) << 5)); }
__host__ __device__ __forceinline__ void stage_rc(int b, int& R, int& C) { const int st = b / 1024, sb = b % 1024, swz = sb ^ (((sb >> 9) & 1) << 5); R = (st >> 1) * 16 + swz / 64; C = (st & 1) * 32 + (swz % 64) / 2; }
__host__ __device__ __forceinline__ int perm32(int rho) { const int n = rho >> 4, i = rho & 15; return 8 * (i >> 2) + 4 * n + (i & 3); }
struct Unit { int pm, pn, h; };
struct Gemm { const bf16_t* A; const bf16_t* Bt; int K, lda, ldb; };
struct StaticOrder {
    int nM, nN, nwg, G, c;
    __device__ void init(int M, int N, int G_, int c_) { nM = M / BM; nN = N / BM; nwg = nM * nN; G = G_; c = c_; }
    __device__ bool next(int i, Unit& u) const {
        const long L = (long)i * G + c; if (L >= nwg) return false;
        int wgid = (int)L; { const int q = nwg / NXCD, r = nwg % NXCD, xcd = wgid % NXCD, off = wgid / NXCD; wgid = (xcd < r ? xcd * (q + 1) : r * (q + 1) + (xcd - r) * q) + off; }
        const int nig = WGM * nN, gid = wgid / nig, fm = gid * WGM, gsz = (nM - fm) < WGM ? (nM - fm) : WGM;
        u.pm = fm + ((wgid % nig) % gsz); u.pn = (wgid % nig) / gsz; u.h = -1; return true;
    }
};
template <class Epi, class Sched, bool GATHER = false>
__device__ __forceinline__ void gemm_phase(LAS unsigned char* lds, int tid_in, const Gemm g, const Sched& S, const Epi& E) {
    int tid_ = tid_in; asm volatile("" : "+v"(tid_));
    const int tid = tid_, wid = __builtin_amdgcn_readfirstlane(tid >> 6), lane = tid & 63, wr = wid >> 2, wc = wid & 3, fr = lane & 15, fq = lane >> 4;
    const int K = g.K, nt = K / BK;
    unsigned voffB[2], vAc[2][2], vAx[2][2];
#pragma unroll
    for (int i = 0; i < 2; ++i) { int R, C; stage_rc(tid * 16 + i * 8192, R, C); const int Rb = (R & ~31) + perm32(R & 31);
        voffB[i] = (unsigned)(Rb * g.ldb + C) * 2u;
#pragma unroll
        for (int h = 0; h < 2; ++h) vAc[h][i] = vAx[h][i] = (unsigned)((R + 128 * h) * g.lda + C) * 2u; }
#define PG8_GROWS(dst, uidx) do { if constexpr (GATHER) { _Pragma("unroll") for (int i_ = 0; i_ < 2; ++i_) { int R_, C_; stage_rc(tid * 16 + i_ * 8192, R_, C_); \
        _Pragma("unroll") for (int h_ = 0; h_ < 2; ++h_) dst[h_][i_] = (unsigned)(S.a_row((uidx), R_ + 128 * h_) * g.lda + C_) * 2u; } } } while (0)
    const size_t kstep = (size_t)(BK * 2);
    const size_t hstepA = (size_t)HALF * g.lda * 2, hstepB = (size_t)HALF * g.ldb * 2;
    const size_t tstepA = 2 * hstepA, tstepB = 2 * hstepB;
    const unsigned ldsw = (unsigned)wid * 1024u;
    const int aoff = lds_byte(wr * 64 + fr, fq * 8), boff = lds_byte(wc * 32 + fr, fq * 8);
#define PG8_SA(b, h) (((b) * 2 + (h)) * HTB)
#define PG8_SB(b, h) ((4 + (b) * 2 + (h)) * HTB)
#define PG8_STAGE(bufoff, gbase, voff) do { _Pragma("unroll") for (int _i = 0; _i < 2; ++_i) \
        __builtin_amdgcn_global_load_lds((const unsigned*)((const char*)(gbase) + (voff)[_i]), (LAS unsigned*)(lds + (bufoff) + ldsw + _i * 8192), 16, 0, 0); } while (0)
#define PG8_LDA(dst, b, h) do { _Pragma("unroll") for (int m = 0; m < 4; ++m) _Pragma("unroll") for (int k = 0; k < 2; ++k) dst[m][k] = *(const LAS bf16x8*)(lds + PG8_SA(b, h) + aoff + m * 2048 + k * 1024); } while (0)
#define PG8_LDB(dst, b, h) do { _Pragma("unroll") for (int n = 0; n < 2; ++n) _Pragma("unroll") for (int k = 0; k < 2; ++k) dst[n][k] = *(const LAS bf16x8*)(lds + PG8_SB(b, h) + boff + n * 2048 + k * 1024); } while (0)
#define PG8_MMA(ai, bj, At, Bt) do { __builtin_amdgcn_s_setprio(1); _Pragma("unroll") for (int m = 0; m < 4; ++m) _Pragma("unroll") for (int n = 0; n < 2; ++n) _Pragma("unroll") for (int k = 0; k < 2; ++k) \
        acc[ai][bj][m][n] = __builtin_amdgcn_mfma_f32_16x16x32_bf16(Bt[n][k], At[m][k], acc[ai][bj][m][n], 0, 0, 0); __builtin_amdgcn_s_setprio(0); } while (0)
#define PG8_WAIT_V(n) asm volatile("s_waitcnt vmcnt(" #n ")" ::: "memory")
#define PG8_WAIT_L(n) asm volatile("s_waitcnt lgkmcnt(" #n ")" ::: "memory")
#define PG8_BAR __builtin_amdgcn_s_barrier()
#define PG8_SCHED __builtin_amdgcn_sched_barrier(0)
    Unit cur, nxt; int ui = 0;
    if (!S.next(0, cur)) return;
    f32x4 acc[2][2][4][2];
#pragma unroll
    for (int a = 0; a < 2; ++a)
#pragma unroll
        for (int b = 0; b < 2; ++b)
#pragma unroll
            for (int m = 0; m < 4; ++m)
#pragma unroll
                for (int n = 0; n < 2; ++n) acc[a][b][m][n] = (f32x4){0.f, 0.f, 0.f, 0.f};
    bf16x8 At[4][2], B0[2][2], B1[2][2];
    const char* cA = (const char*)g.A + (GATHER ? (size_t)0 : (size_t)cur.pm * tstepA); const char* cB = (const char*)g.Bt + (size_t)cur.pn * tstepB;
    PG8_GROWS(vAc, 0);
    PG8_STAGE(PG8_SB(0, 0), cB, voffB); PG8_STAGE(PG8_SB(0, 1), cB + hstepB, voffB); PG8_STAGE(PG8_SA(0, 0), cA, vAc[0]); PG8_STAGE(PG8_SA(0, 1), cA, vAc[1]);
    if (wr == 1) PG8_BAR;
    PG8_WAIT_V(2); PG8_BAR;
    PG8_STAGE(PG8_SB(1, 0), cB + kstep, voffB); PG8_STAGE(PG8_SA(1, 0), cA + kstep, vAc[0]); PG8_STAGE(PG8_SB(1, 1), cB + hstepB + kstep, voffB);
    PG8_WAIT_V(6); PG8_BAR;
    for (;;) {
        const bool has_next = S.next(ui + 1, nxt);
        const char* nA = (has_next && !GATHER) ? (const char*)g.A + (size_t)nxt.pm * tstepA : cA;
        if constexpr (GATHER) { if (has_next) PG8_GROWS(vAx, ui + 1); else {
#pragma unroll
            for (int h = 0; h < 2; ++h) { vAx[h][0] = vAc[h][0]; vAx[h][1] = vAc[h][1]; } } }
        const char* nB = has_next ? (const char*)g.Bt + (size_t)nxt.pn * tstepB : cB;
        for (int t = 0; t < nt; t += 2) {
            const bool last = (t == nt - 2);
            const char* a1 = cA + (size_t)(t + 1) * kstep;
            const char* a2 = last ? nA : cA + (size_t)(t + 2) * kstep; const char* b2 = last ? nB : cB + (size_t)(t + 2) * kstep;
            const char* a3 = a2 + kstep; const char* b3 = b2 + kstep;
            unsigned vS0[2], vS1[2];
            if constexpr (GATHER) { vS0[0] = last ? vAx[0][0] : vAc[0][0]; vS0[1] = last ? vAx[0][1] : vAc[0][1]; vS1[0] = last ? vAx[1][0] : vAc[1][0]; vS1[1] = last ? vAx[1][1] : vAc[1][1]; }
            else { vS0[0] = vAc[0][0]; vS0[1] = vAc[0][1]; vS1[0] = vAc[1][0]; vS1[1] = vAc[1][1]; }
            PG8_LDB(B0, 0, 0); PG8_LDB(B1, 0, 1); PG8_SCHED; PG8_LDA(At, 0, 0); PG8_STAGE(PG8_SA(1, 1), a1, vAc[1]);
            PG8_WAIT_V(8); PG8_WAIT_L(0); PG8_BAR; if (cur.h != 1) { PG8_MMA(0, 0, At, B0); PG8_MMA(0, 1, At, B1); } PG8_BAR; PG8_SCHED;
            PG8_LDA(At, 0, 1); PG8_STAGE(PG8_SB(0, 0), b2, voffB); PG8_STAGE(PG8_SB(0, 1), b2 + hstepB, voffB); PG8_STAGE(PG8_SA(0, 0), a2, vS0);
            PG8_WAIT_V(8); PG8_WAIT_L(0); PG8_BAR; if (cur.h != 0) { PG8_MMA(1, 0, At, B0); PG8_MMA(1, 1, At, B1); } PG8_BAR; PG8_SCHED;
            PG8_LDB(B0, 1, 0); PG8_LDB(B1, 1, 1); PG8_SCHED; PG8_LDA(At, 1, 0); PG8_STAGE(PG8_SA(0, 1), a2, vS1);
            PG8_WAIT_V(8); PG8_WAIT_L(0); PG8_BAR; if (cur.h != 1) { PG8_MMA(0, 0, At, B0); PG8_MMA(0, 1, At, B1); } PG8_BAR; PG8_SCHED;
            PG8_LDA(At, 1, 1); PG8_STAGE(PG8_SB(1, 0), b3, voffB); PG8_STAGE(PG8_SB(1, 1), b3 + hstepB, voffB); PG8_STAGE(PG8_SA(1, 0), a3, vS0);
            PG8_WAIT_V(8); PG8_WAIT_L(0); PG8_BAR; if (cur.h != 0) { PG8_MMA(1, 0, At, B0); PG8_MMA(1, 1, At, B1); } PG8_BAR; PG8_SCHED;
        }
        if (wr == 0) PG8_BAR;
        E(acc, cur, wr, wc, fr, fq);
        if (!has_next) break;
#pragma unroll
        for (int a = 0; a < 2; ++a)
#pragma unroll
            for (int b = 0; b < 2; ++b)
#pragma unroll
                for (int m = 0; m < 4; ++m)
#pragma unroll
                    for (int n = 0; n < 2; ++n) acc[a][b][m][n] = (f32x4){0.f, 0.f, 0.f, 0.f};
        cur = nxt; cA = nA; cB = nB; ++ui;
        if constexpr (GATHER) {
#pragma unroll
            for (int h = 0; h < 2; ++h) { vAc[h][0] = vAx[h][0]; vAc[h][1] = vAx[h][1]; } }
        if (wr == 1) PG8_BAR;
    }
    PG8_WAIT_V(0);
    PG8_BAR;
#undef PG8_SA
#undef PG8_SB
#undef PG8_STAGE
#undef PG8_GROWS
#undef PG8_LDA
#undef PG8_LDB
#undef PG8_MMA
#undef PG8_WAIT_V
#undef PG8_WAIT_L
#undef PG8_BAR
#undef PG8_SCHED
}
}

enum EpiMode { EM_Z = 0, EM_Q = 1, EM_KV = 2, EM_GLU = 3, EM_MERGE0 = 4, EM_MERGE1 = 5, EM_WOUT = 6, EM_MOEUP = 7, EM_MOEDN = 8, EM_S5 = 9 };
template <int mode> struct Epi {
    bf16_t* o0; bf16_t* o1; bf16_t* o2;
    const bf16_t* i0;
    const float* f0; const float* f1; const float* f2;
    float* fo;
    float* ssq;
    const float* rope;
    int layer;
    struct Side { u32x4 s[4]; };
    __device__ __forceinline__ Side load_side(const pg8::Unit& u, int ai, int m, int wr, int fr, int cl) const {
        Side S; const int row = u.pm * 256 + ai * 128 + wr * 64 + m * 16 + fr;
        if constexpr (mode == EM_Q) S.s[0] = *(const u32x4*)(ssq + (size_t)row * 4);
        else if constexpr (mode == EM_KV) S.s[0] = *(const u32x4*)(ssq + (size_t)MTOK * 4 + (size_t)row * 4);
        else if constexpr (mode == EM_GLU) { S.s[0] = *(const u32x4*)(i0 + (size_t)row * 256 + cl); S.s[1] = *(const u32x4*)(i0 + (size_t)row * 256 + 128 + cl); }
        else if constexpr (mode == EM_MERGE0 || mode == EM_MERGE1) { const int col = u.pn * 256 + cl;
            S.s[0] = *(const u32x4*)(i0 + (size_t)row * ZC + col); S.s[1] = *(const u32x4*)(i0 + (size_t)row * ZC + col + 128);
            if constexpr (mode == EM_MERGE1) { S.s[2] = __builtin_nontemporal_load((const u32x4*)(o0 + (size_t)row * 1024 + col)); S.s[3] = __builtin_nontemporal_load((const u32x4*)(o0 + (size_t)row * 1024 + col + 128)); } }
        else if constexpr (mode == EM_WOUT) { const float* xin = (layer == 0) ? (row < NLAT ? f1 + (size_t)row * D : f2 + (size_t)(row - NLAT) * D) : fo + (size_t)row * D; const int col = u.pn * 256 + cl;
            S.s[0] = *(const u32x4*)(xin + col); S.s[1] = *(const u32x4*)(xin + col + 4); S.s[2] = *(const u32x4*)(xin + col + 128); S.s[3] = *(const u32x4*)(xin + col + 132); }
        else if constexpr (mode == EM_S5) { S.s[0] = *(const u32x4*)(i0 + (size_t)row * 512 + cl); S.s[1] = *(const u32x4*)(i0 + (size_t)row * 512 + 128 + cl); }
        return S;
    }
    __device__ __forceinline__ void operator()(const f32x4 (&acc)[2][2][4][2], const pg8::Unit& u, int wr, int wc, int fr_in, int fq_in) const {
        int fr = fr_in, fq = fq_in; asm volatile("" : "+v"(fr), "+v"(fq));
        const int cl = wc * 32 + 8 * fq;
        f32x4 hc[4] = {};
        if constexpr (mode == EM_GLU) { hc[0] = *(const f32x4*)(f0 + cl); hc[1] = *(const f32x4*)(f0 + cl + 4); hc[2] = *(const f32x4*)(f0 + 128 + cl); hc[3] = *(const f32x4*)(f0 + 128 + cl + 4); }
        if constexpr (mode == EM_WOUT) { const float* gt = f0 + (size_t)tok_modrow(u.pm * 256) * 6144 + 2 * 1024 + u.pn * 256 + cl;
            hc[0] = *(const f32x4*)(gt); hc[1] = *(const f32x4*)(gt + 4); hc[2] = *(const f32x4*)(gt + 128); hc[3] = *(const f32x4*)(gt + 132); }
        if constexpr (mode == EM_S5) { const float* dk = f0 + u.pn * 16 + (cl & 15); hc[0] = *(const f32x4*)(dk); hc[1] = *(const f32x4*)(dk + 4); }
        Side cur = load_side(u, 0, 0, wr, fr, cl);
#pragma unroll
        for (int it = 0; it < 8; ++it) {
                const int ai = it >> 2, m = it & 3;
                if (u.h >= 0 && ai != u.h) { if (it < 7) cur = load_side(u, (it + 1) >> 2, (it + 1) & 3, wr, fr, cl); continue; }
                Side nxt = cur; if (it < 7) nxt = load_side(u, (it + 1) >> 2, (it + 1) & 3, wr, fr, cl);
                asm volatile("" ::: "memory");
                const int row = u.pm * 256 + ai * 128 + wr * 64 + m * 16 + fr;
                if constexpr (mode == EM_Z) {
                    float s0 = 0.f;
#pragma unroll
                    for (int bj = 0; bj < 2; ++bj) {
                        f32x4 v0 = acc[ai][bj][m][0], v1 = acc[ai][bj][m][1];
                        const int col = u.pn * 256 + bj * 128 + cl;
                        if (u.pn == 1 || (u.pn == 2 && bj == 0)) s0 += (v0[0] * v0[0] + v0[1] * v0[1]) + (v0[2] * v0[2] + v0[3] * v0[3]) + (v1[0] * v1[0] + v1[1] * v1[1]) + (v1[2] * v1[2] + v1[3] * v1[3]);
                        if (u.pn == 2 && bj == 1 && wc == 0) {
                            if (row < NLAT) {
                                const int t = row & 2047, pb = 4 * fq, axis = pb >> 3, pos = axis ? (t & 63) : (t >> 6);
                                const float* cs = rope + pos * 8 + (pb & 7); const float* sn = cs + 512;
                                float x1, x2;
                                x1 = v0[0]; x2 = v0[1]; v0[0] = x1 * cs[0] - x2 * sn[0]; v0[1] = x1 * sn[0] + x2 * cs[0];
                                x1 = v0[2]; x2 = v0[3]; v0[2] = x1 * cs[1] - x2 * sn[1]; v0[3] = x1 * sn[1] + x2 * cs[1];
                                x1 = v1[0]; x2 = v1[1]; v1[0] = x1 * cs[2] - x2 * sn[2]; v1[1] = x1 * sn[2] + x2 * cs[2];
                                x1 = v1[2]; x2 = v1[3]; v1[2] = x1 * cs[3] - x2 * sn[3]; v1[3] = x1 * sn[3] + x2 * cs[3];
                            }
                            u32x4 w; w.x = pk2(v0[0], v0[1]); w.y = pk2(v0[2], v0[3]); w.z = pk2(v1[0], v1[1]); w.w = pk2(v1[2], v1[3]);
                            *(u32x4*)(o1 + (size_t)row * 32 + 8 * fq) = w;
                        }
                        u32x4 w; w.x = pk2(v0[0], v0[1]); w.y = pk2(v0[2], v0[3]); w.z = pk2(v1[0], v1[1]); w.w = pk2(v1[2], v1[3]);
                        *(u32x4*)(o0 + (size_t)row * ZC + col) = w;
                        if (u.pn == 0) {
                            int b, s; if (row < NLAT) { b = row >> 11; s = 256 + (row & 2047); } else { b = (row - NLAT) >> 8; s = (row - NLAT) & 255; }
                            const int colu = bj * 128 + cl, g = colu >> 4, h0 = colu & 15;
                            *(u32x4*)(o2 + ((size_t)g * 1280 + b * 160 + (s >> 4)) * 512 + (s & 15) * 16 + h0) = w;
                        }
                    }
                    if (u.pn == 1 || u.pn == 2) {
                        { const int ln = fr + 16 * fq; s0 += shfl_f(s0, ln ^ 16); s0 += shfl_f(s0, ln ^ 32); }
                        if (fq == 0) ssq[(size_t)(u.pn - 1) * MTOK * 4 + (size_t)row * 4 + wc] = s0;
                    }
                } else if constexpr (mode == EM_Q || mode == EM_KV) {
                    const f32x4 sp = __builtin_bit_cast(f32x4, cur.s[0]);
                    const float rs = mode == EM_Q ? rsqrtf(((sp[0] + sp[1]) + (sp[2] + sp[3])) * (1.f / 256.f) + EPS) * QSCALE : rsqrtf(((sp[0] + sp[1]) + (sp[2] + sp[3])) * (1.f / 128.f) + EPS);
#pragma unroll
                    for (int bj = 0; bj < 2; ++bj) {
                        f32x4 v0 = acc[ai][bj][m][0] * rs, v1 = acc[ai][bj][m][1] * rs;
                        const int col = u.pn * 256 + bj * 128 + cl;
                        if constexpr (mode == EM_Q) { const int cc = col % 96;
                            if (cc >= 64 && row < NLAT) {
                                const int t = row & 2047, pb = (cc - 64) >> 1, axis = pb >> 3, pos = axis ? (t & 63) : (t >> 6);
                                const float* cs = rope + pos * 8 + (pb & 7); const float* sn = cs + 512;
                                float x1, x2;
                                x1 = v0[0]; x2 = v0[1]; v0[0] = x1 * cs[0] - x2 * sn[0]; v0[1] = x1 * sn[0] + x2 * cs[0];
                                x1 = v0[2]; x2 = v0[3]; v0[2] = x1 * cs[1] - x2 * sn[1]; v0[3] = x1 * sn[1] + x2 * cs[1];
                                x1 = v1[0]; x2 = v1[1]; v1[0] = x1 * cs[2] - x2 * sn[2]; v1[1] = x1 * sn[2] + x2 * cs[2];
                                x1 = v1[2]; x2 = v1[3]; v1[2] = x1 * cs[3] - x2 * sn[3]; v1[3] = x1 * sn[3] + x2 * cs[3];
                            } }
                        u32x4 w; w.x = pk2(v0[0], v0[1]); w.y = pk2(v0[2], v0[3]); w.z = pk2(v1[0], v1[1]); w.w = pk2(v1[2], v1[3]);
                        if constexpr (mode == EM_Q) *(u32x4*)(o0 + (size_t)row * 768 + col) = w;
                        else { bf16_t* dst = col < 512 ? o0 + (size_t)row * 512 + col : o1 + (size_t)row * 512 + (col - 512); *(u32x4*)dst = w; }
                    }
                } else if constexpr (mode == EM_GLU) {
#pragma unroll
                    for (int bj = 0; bj < 2; ++bj) {
                        const int col = bj * 128 + cl;
                        const f32x4 a0 = acc[ai][bj][m][0] + hc[2 * bj], a1 = acc[ai][bj][m][1] + hc[2 * bj + 1];
                        const u32x4 y = cur.s[bj];
                        u32x4 w;
                        w.x = pk2(bflo(y.x) * sigmoidf_(a0[0]), bfhi(y.x) * sigmoidf_(a0[1])); w.y = pk2(bflo(y.y) * sigmoidf_(a0[2]), bfhi(y.y) * sigmoidf_(a0[3]));
                        w.z = pk2(bflo(y.z) * sigmoidf_(a1[0]), bfhi(y.z) * sigmoidf_(a1[1])); w.w = pk2(bflo(y.w) * sigmoidf_(a1[2]), bfhi(y.w) * sigmoidf_(a1[3]));
                        *(u32x4*)(o0 + (size_t)row * 256 + col) = w;
                    }
                } else if constexpr (mode == EM_MERGE0 || mode == EM_MERGE1) {
#pragma unroll
                    for (int bj = 0; bj < 2; ++bj) {
                        const int col = u.pn * 256 + bj * 128 + cl;
                        const u32x4 gt = cur.s[bj];
                        const f32x4 a0 = acc[ai][bj][m][0], a1 = acc[ai][bj][m][1];
                        float r[8] = { a0[0] * sigmoidf_(bflo(gt.x)), a0[1] * sigmoidf_(bfhi(gt.x)), a0[2] * sigmoidf_(bflo(gt.y)), a0[3] * sigmoidf_(bfhi(gt.y)),
                                       a1[0] * sigmoidf_(bflo(gt.z)), a1[1] * sigmoidf_(bfhi(gt.z)), a1[2] * sigmoidf_(bflo(gt.w)), a1[3] * sigmoidf_(bfhi(gt.w)) };
                        if constexpr (mode == EM_MERGE1) { const u32x4 pv = cur.s[2 + bj];
                            r[0] += bflo(pv.x); r[1] += bfhi(pv.x); r[2] += bflo(pv.y); r[3] += bfhi(pv.y); r[4] += bflo(pv.z); r[5] += bfhi(pv.z); r[6] += bflo(pv.w); r[7] += bfhi(pv.w); }
                        u32x4 w; w.x = pk2(r[0], r[1]); w.y = pk2(r[2], r[3]); w.z = pk2(r[4], r[5]); w.w = pk2(r[6], r[7]);
                        *(u32x4*)(o0 + (size_t)row * 1024 + col) = w;
                    }
                } else if constexpr (mode == EM_WOUT) {
#pragma unroll
                    for (int bj = 0; bj < 2; ++bj) {
                        const int col = u.pn * 256 + bj * 128 + cl;
#pragma unroll
                        for (int n = 0; n < 2; ++n) *(f32x4*)(fo + (size_t)row * D + col + 4 * n) = __builtin_bit_cast(f32x4, cur.s[2 * bj + n]) + hc[2 * bj + n] * acc[ai][bj][m][n];
                    }
                } else if constexpr (mode == EM_MOEUP) {
                    const f32x4 a0 = acc[ai][0][m][0], a1 = acc[ai][0][m][1], b0 = acc[ai][1][m][0], b1 = acc[ai][1][m][1];
                    u32x4 w; w.x = pk2(siluf_(a0[0]) * b0[0], siluf_(a0[1]) * b0[1]); w.y = pk2(siluf_(a0[2]) * b0[2], siluf_(a0[3]) * b0[3]);
                    w.z = pk2(siluf_(a1[0]) * b1[0], siluf_(a1[1]) * b1[1]); w.w = pk2(siluf_(a1[2]) * b1[2], siluf_(a1[3]) * b1[3]);
                    *(u32x4*)(o0 + (size_t)row * HID + (u.pn & 3) * 128 + cl) = w;
                } else if constexpr (mode == EM_MOEDN) {
#pragma unroll
                    for (int bj = 0; bj < 2; ++bj) {
                        const f32x4 v0 = acc[ai][bj][m][0], v1 = acc[ai][bj][m][1];
                        u32x4 w; w.x = pk2(v0[0], v0[1]); w.y = pk2(v0[2], v0[3]); w.z = pk2(v1[0], v1[1]); w.w = pk2(v1[2], v1[3]);
                        *(u32x4*)(o0 + (size_t)row * 1024 + (u.pn & 3) * 256 + bj * 128 + cl) = w;
                    }
                } else if constexpr (mode == EM_S5) {
                    const int g = u.pn, rr = row - g * 1280, b = rr / 160, c = rr - b * 160;
                    if (c < 144) {
#pragma unroll
                        for (int bj = 0; bj < 2; ++bj) {
                            const int n = bj * 128 + cl, i = n >> 4, h0 = n & 15, s = 16 * c + i;
                            const int trow = s < 256 ? NLAT + b * 256 + s : b * 2048 + (s - 256);
                            const u32x4 uv = cur.s[bj];
                            const f32x4 a0 = acc[ai][bj][m][0], a1 = acc[ai][bj][m][1];
                            u32x4 w;
                            w.x = pk2(gelu_tanh(a0[0] + hc[0][0] * bflo(uv.x)), gelu_tanh(a0[1] + hc[0][1] * bfhi(uv.x))); w.y = pk2(gelu_tanh(a0[2] + hc[0][2] * bflo(uv.y)), gelu_tanh(a0[3] + hc[0][3] * bfhi(uv.y)));
                            w.z = pk2(gelu_tanh(a1[0] + hc[1][0] * bflo(uv.z)), gelu_tanh(a1[1] + hc[1][1] * bfhi(uv.z))); w.w = pk2(gelu_tanh(a1[2] + hc[1][2] * bflo(uv.w)), gelu_tanh(a1[3] + hc[1][3] * bfhi(uv.w)));
                            *(u32x4*)(o0 + (size_t)trow * 256 + g * 16 + h0) = w;
                        }
                    }
                }
                cur = nxt;
        }
    }
};

#define XB_TMO      128
#define XB_XCNT(j)  (256  + 64 * (j))
#define XB_XSUB(j)  (1280 + 64 * (j))
#define XB_XGEN(j)  (2304 + 64 * (j))
#define XB_TOP      3328
#define XB_TOPGEN   3392
#define XCD_BAR_WORDS 3456
#define XB_SPIN_CAP (1u << 22)
__device__ __forceinline__ unsigned xb_ld(unsigned* p)              { return __hip_atomic_load(p, __ATOMIC_RELAXED, __HIP_MEMORY_SCOPE_AGENT); }
__device__ __forceinline__ unsigned xb_add(unsigned* p, unsigned v) { return __hip_atomic_fetch_add(p, v, __ATOMIC_RELAXED, __HIP_MEMORY_SCOPE_AGENT); }
__device__ __forceinline__ unsigned xb_xcc_id() { return (unsigned)__builtin_amdgcn_s_getreg((3 << 11) | 20) & 0xFu; }
#define XB_SPIN(cond, bar) do { unsigned _sp = 0; while (cond) { __builtin_amdgcn_s_sleep(1); \
    if ((++_sp & 255u) == 0u) { if (xb_ld(&(bar)[XB_TMO])) break; if (_sp > XB_SPIN_CAP) { atomicAdd(&(bar)[XB_TMO], 1u); break; } } } } while (0)
struct XcdBarrier { unsigned* bar; unsigned x; volatile LAS unsigned* st; };
__device__ __forceinline__ XcdBarrier xcd_barrier_post(unsigned* bar, volatile LAS unsigned* st) {
    XcdBarrier b; b.bar = bar; b.x = xb_xcc_id(); b.st = st;
    if (threadIdx.x == 0) (void)xb_add(&bar[XB_XCNT(b.x)], 1u);
    return b;
}
__device__ __forceinline__ void xcd_barrier_complete(unsigned* bar, unsigned x, unsigned& nloc, unsigned& nx) {
    const unsigned G = gridDim.x * gridDim.y * gridDim.z;
    unsigned sum, cnt, mine, sp = 0u;
    for (;;) {
        sum = 0u; cnt = 0u; mine = 0u;
#pragma unroll
        for (unsigned j = 0; j < 16; ++j) { const unsigned c = xb_ld(&bar[XB_XCNT(j)]); sum += c; cnt += (c > 0u) ? 1u : 0u; mine = (j == x) ? c : mine; }
        if (sum == G) break;
        __builtin_amdgcn_s_sleep(1);
        if ((++sp & 255u) == 0u) { if (xb_ld(&bar[XB_TMO])) break; if (sp > XB_SPIN_CAP) { atomicAdd(&bar[XB_TMO], 1u); break; } }
    }
    nloc = mine > 0u ? mine : 1u; nx = cnt > 0u ? cnt : 1u;
}
__device__ __noinline__ void xcd_barrier_fn(unsigned* bar_in, unsigned bx, unsigned st_off, int tid) {
    XcdBarrier b; b.bar = bar_in; b.x = bx; b.st = (volatile LAS unsigned*)(uintptr_t)st_off;
    asm volatile("s_waitcnt vmcnt(0)" ::: "memory");
    __syncthreads();
    if (tid == 0) {
        unsigned* bar = b.bar;
        __builtin_amdgcn_s_waitcnt(0);
        unsigned nloc = b.st[0], nx = b.st[1];
        if (nloc == 0u) { xcd_barrier_complete(bar, b.x, nloc, nx); b.st[0] = nloc; b.st[1] = nx; }
        const unsigned old = xb_add(&bar[XB_XSUB(b.x)], 1u);
        const unsigned gen = old / nloc;
        if (old + 1u == (gen + 1u) * nloc) {
            __builtin_amdgcn_fence(__ATOMIC_RELEASE, "agent");
            asm volatile("s_waitcnt vmcnt(0)" ::: "memory");
            const unsigned og = xb_add(&bar[XB_TOP], 1u);
            const unsigned tg = og / nx;
            if (og + 1u == (tg + 1u) * nx) xb_add(&bar[XB_TOPGEN], 1u);
            else XB_SPIN(xb_ld(&bar[XB_TOPGEN]) == tg, bar);
            __builtin_amdgcn_fence(__ATOMIC_ACQUIRE, "agent");
            xb_add(&bar[XB_XGEN(b.x)], 1u);
            asm volatile("s_waitcnt vmcnt(0)" ::: "memory");
        } else {
            XB_SPIN(xb_ld(&bar[XB_XGEN(b.x)]) == gen, bar);
            __builtin_amdgcn_fence(__ATOMIC_ACQUIRE, "agent");
            asm volatile("s_waitcnt vmcnt(0)" ::: "memory");
        }
    }
    __syncthreads();
}

constexpr int NWAVES = 8;
constexpr int RING_BYTES = 131072, MISC_OFF = RING_BYTES + 320, TBL_OFF = RING_BYTES + 1024, LDS_BYTES = 147456;
struct Args { const float* in[38]; float* out; unsigned char* ws; int ph_lo, ph_hi; };
typedef const __attribute__((address_space(4))) Args* ArgsP;
struct Frame {
    LAS unsigned char* lds;
    int tid, lane, wave, vcu, G, gw, NGW;
    unsigned char* ws;
};

enum RowMap { RM_ID = 0, RM_WIN = 1, RM_UQ = 2, RM_W13 = 3 };
__device__ __forceinline__ int rope_perm(int o) { const int axis = o >> 4, half = (o >> 3) & 1, i = o & 7; return 2 * (axis * 8 + i) + half; }
__device__ __forceinline__ int map_row(int rm, int n, int row_off) {
    if (rm == RM_WIN) return (n >= ZKPE && n < ZKPE + 32) ? ZKPE + rope_perm(n - ZKPE) : n;
    if (rm == RM_UQ) { const int hd = n / 96, cc = n - hd * 96; return cc >= 64 ? hd * 96 + 64 + rope_perm(cc - 64) : n; }
    if (rm == RM_W13) return row_off + (n >> 7) * 256 + (n & 127);
    return row_off + n;
}
__device__ __forceinline__ void transpose_item(const float* W, int K, int N, bf16_t* WT, int rm, int row_off, const float* kscale, LAS float* scr, int item, int lane) {
    const int nblk = N / 32, kb = item / nblk, nb = item % nblk, k0 = 64 * kb, n0 = 32 * nb;
    float tv[32];
#pragma unroll
    for (int i = 0; i < 32; ++i) tv[i] = W[(size_t)(k0 + 2 * i + (lane >> 5)) * N + n0 + (lane & 31)];
#pragma unroll
    for (int i = 0; i < 32; ++i) { const int kk = 2 * i + (lane >> 5); float v = tv[i]; if (kscale) v *= kscale[k0 + kk]; scr[kk * 33 + (lane & 31)] = v; }
    asm volatile("s_waitcnt lgkmcnt(0)" ::: "memory");
    const int c = lane & 7;
#pragma unroll
    for (int j = 0; j < 4; ++j) { const int n = (lane >> 3) + 8 * j; const LAS float* s = scr + (8 * c) * 33 + n;
        u32x4 o; o.x = pk2(s[0 * 33], s[1 * 33]); o.y = pk2(s[2 * 33], s[3 * 33]); o.z = pk2(s[4 * 33], s[5 * 33]); o.w = pk2(s[6 * 33], s[7 * 33]);
        *(u32x4*)(WT + (size_t)map_row(rm, n0 + n, row_off) * K + k0 + 8 * c) = o; }
    asm volatile("s_waitcnt lgkmcnt(0)" ::: "memory");
}

#if !NAIVE_S5
__device__ __forceinline__ void s5_build(Frame& F, ArgsP a);
#endif
__device__ __forceinline__ void prologue_phase(Frame& F, ArgsP a) {
    LAS float* scr = (LAS float*)(F.lds + F.wave * 16384);
    REP(21) for (int l = 0; l < 2; ++l) {
        unsigned char* wl = F.ws + WS_WB + (size_t)l * WL_STRIDE;
#define CONV(Wp, K_, N_, WTp, rm_, ro_, ks_) do { const int items_ = ((K_) / 64) * ((N_) / 32); \
            for (int it = F.gw; it < items_; it += F.NGW) transpose_item((Wp), (K_), (N_), (bf16_t*)(WTp), (rm_), (ro_), (ks_), scr, it, F.lane); } while (0)
        CONV(a->in[8] + (size_t)l * D * INC, D, INC, wl + WL_WIN, RM_WIN, 0, nullptr);
        CONV(a->in[21] + (size_t)l * 256 * 768, 256, 768, wl + WL_UQ, RM_UQ, 0, a->in[19] + l * 256);
        CONV(a->in[22] + (size_t)l * 128 * 512, 128, 512, wl + WL_UKV, RM_ID, 0, a->in[20] + l * 128);
        CONV(a->in[23] + (size_t)l * 128 * 512, 128, 512, wl + WL_UKV, RM_ID, 512, a->in[20] + l * 128);
        CONV(a->in[17] + (size_t)l * 256 * 256, 256, 256, wl + WL_GLU, RM_ID, 0, nullptr);
        CONV(a->in[26] + (size_t)l * 256 * 1024, 256, 1024, wl + WL_PA, RM_ID, 0, nullptr);
        CONV(a->in[27] + (size_t)l * 512 * 1024, 512, 1024, wl + WL_PB, RM_ID, 0, nullptr);
        CONV(a->in[28] + (size_t)l * 256 * 1024, 256, 1024, wl + WL_PC, RM_ID, 0, nullptr);
        CONV(a->in[29] + (size_t)l * 1024 * 1024, 1024, 1024, wl + WL_OUT, RM_ID, 0, nullptr);
#undef CONV
        u32x4* padp = (u32x4*)(wl + WL_WIN + (size_t)INC * D * 2);
        for (int i = F.gw * 64 + F.lane; i < (ZC - INC) * D * 2 / 16; i += F.NGW * 64) padp[i] = (u32x4){0u, 0u, 0u, 0u};
    }
    if (blockIdx.x == 0) {
        float* rp = (float*)(F.ws + WS_ROPE);
        const int pos = F.tid >> 3, i = F.tid & 7;
        const float ang = (float)pos * exp2f(-(float)i * (13.287712379549449f / 8.f));
        rp[F.tid] = cosf(ang); rp[512 + F.tid] = sinf(ang);
    }
    __syncthreads();
    REP(22)
    {
        LAS float* sil = (LAS float*)F.lds;
        LAS float* red = (LAS float*)(F.lds + 40960);
        bool have = false;
        for (int it = blockIdx.x; it < 192; it += F.G) {
            if (!have) {
                for (int i = F.tid; i < 9 * 1024; i += 512) { const int r = i >> 10, k = i & 1023; const float cv = r < 8 ? a->in[1][r * 1024 + k] : a->in[3][k]; sil[i] = siluf_(cv); }
                have = true; __syncthreads();
            }
            const int l = it / 96, n = (it % 96) * 64 + F.lane;
            const float* wp = a->in[4] + (size_t)l * D * 6144 + (size_t)(F.wave * 128) * 6144 + n;
            float acc[9];
#pragma unroll
            for (int r = 0; r < 9; ++r) acc[r] = 0.f;
#pragma unroll 8
            for (int k = 0; k < 128; ++k) { const float wv = wp[(size_t)k * 6144];
#pragma unroll
                for (int r = 0; r < 9; ++r) acc[r] += sil[r * 1024 + F.wave * 128 + k] * wv; }
#pragma unroll
            for (int r = 0; r < 9; ++r) red[(F.wave * 9 + r) * 64 + F.lane] = acc[r];
            __syncthreads();
            for (int i = F.tid; i < 9 * 64; i += 512) { const int r = i >> 6, ln = i & 63; float s = 0.f;
#pragma unroll
                for (int w = 0; w < 8; ++w) s += red[(w * 9 + r) * 64 + ln];
                const int nn = (it % 96) * 64 + ln;
                ((float*)(F.ws + WS_MODV))[((size_t)l * 9 + r) * 6144 + nn] = s + a->in[5][l * 6144 + nn]; }
            __syncthreads();
        }
    }
#if !NAIVE_S5
    REP(23) s5_build(F, a);
#endif
}

__device__ __forceinline__ void moe_convert(Frame& F, ArgsP a, int l) {
    LAS float* scr = (LAS float*)(F.lds + F.wave * 16384);
    bf16_t* w13 = (bf16_t*)(F.ws + WS_MIX + MW_W13); bf16_t* w2 = (bf16_t*)(F.ws + WS_MIX + MW_W2);
    for (int it = F.gw; it < NEXP * 768; it += F.NGW) {
        const int e = it / 768, r = it % 768, which = r >> 8, sub = r & 255;
        const size_t eoff = ((size_t)l * NEXP + e) * 1024 * 512;
        if (which == 0) transpose_item(a->in[34] + eoff, 1024, 512, w13, RM_W13, e * 1024, nullptr, scr, sub, F.lane);
        else if (which == 1) transpose_item(a->in[35] + eoff, 1024, 512, w13, RM_W13, e * 1024 + 128, nullptr, scr, sub, F.lane);
        else transpose_item(a->in[36] + eoff, 512, 1024, w2, RM_ID, e * 1024, nullptr, scr, sub, F.lane);
    }
}

__device__ __forceinline__ const float* x_row_ptr(ArgsP a, const float* X, int layer, int row) {
    return layer == 0 ? (row < NLAT ? a->in[0] + (size_t)row * D : a->in[2] + (size_t)(row - NLAT) * D) : X + (size_t)row * D;
}
__device__ __forceinline__ void norm_mod_row(const f32x4 (&v)[4], f32x4 (&h)[4], const float* g, const float* shift, const float* scale, int lane) {
    float ss = 0.f;
#pragma unroll
    for (int j = 0; j < 4; ++j) ss += (v[j][0] * v[j][0] + v[j][1] * v[j][1]) + (v[j][2] * v[j][2] + v[j][3] * v[j][3]);
    const float rstd = rsqrtf(wave_sum(ss) * (1.f / D) + EPS);
#pragma unroll
    for (int j = 0; j < 4; ++j) { const int c = 4 * lane + 256 * j; const f32x4 gv = *(const f32x4*)(g + c), sh = *(const f32x4*)(shift + c), sc = *(const f32x4*)(scale + c);
        h[j] = v[j] * rstd * gv * (sc + 1.f) + sh; }
}
__device__ __forceinline__ void store_row_bf16(bf16_t* orow, const f32x4 (&h)[4], int lane) {
#pragma unroll
    for (int j = 0; j < 4; ++j) { u32x2 w; w.x = pk2(h[j][0], h[j][1]); w.y = pk2(h[j][2], h[j][3]); *(u32x2*)(orow + 4 * lane + 256 * j) = w; }
}
__device__ __forceinline__ void norm1_phase(Frame& F, ArgsP a, int layer, int nrows) {
    const float* X = (const float*)(F.ws + WS_X); bf16_t* H = (bf16_t*)(F.ws + WS_H);
    const float* modv = (const float*)(F.ws + WS_MODV) + (size_t)layer * 9 * 6144;
    for (int row = F.gw; row < nrows; row += F.NGW) {
        const float* xr = x_row_ptr(a, X, layer, row); f32x4 v[4], h[4];
#pragma unroll
        for (int j = 0; j < 4; ++j) v[j] = *(const f32x4*)(xr + 4 * F.lane + 256 * j);
        const float* mv = modv + (size_t)tok_modrow(row) * 6144;
        norm_mod_row(v, h, a->in[6] + layer * D, mv, mv + 1024, F.lane);
        store_row_bf16(H + (size_t)row * D, h, F.lane);
    }
}

__device__ __forceinline__ int seq_row(int b, int s, int d) {
    if (d == 0) return s < 256 ? NLAT + b * 256 + s : b * 2048 + (s - 256);
    return s < 256 ? NLAT + b * 256 + (255 - s) : b * 2048 + (2047 - (s - 256));
}
__device__ __forceinline__ float hg_lb(ArgsP a, int l) { return l == 0 ? 0.f : 1.f / (1.f + __expf(a->in[24][0] - a->in[24][1])); }

#if NAIVE_S5
__device__ __forceinline__ void s5_naive(Frame& F, ArgsP a, int l) {
    const bf16_t* Z = (const bf16_t*)(F.ws + WS_Z); float* Yacc = (float*)(F.ws + WS_MIX + MX_S5A);
    for (int unit = F.gw; unit < 128; unit += F.NGW) {
        const int b = unit >> 4, g = unit & 15, p = F.lane;
        for (int d = 0; d < 2; ++d) {
            const int idx = (l * 2 + d) * 16 + g;
            const float lre = a->in[9][idx * 64 + p], lim = a->in[10][idx * 64 + p], dt = expf(a->in[15][idx]);
            const float mag = expf(lre * dt), lbr = mag * cosf(lim * dt), lbi = mag * sinf(lim * dt), den = lre * lre + lim * lim;
            const float fr = ((lbr - 1.f) * lre + lbi * lim) / den, fi = (lbi * lre - (lbr - 1.f) * lim) / den;
            float bbr[16], bbi[16], cre[16], cim[16];
#pragma unroll
            for (int h = 0; h < 16; ++h) { const float br = a->in[11][(size_t)(idx * 64 + p) * 16 + h], bi = a->in[12][(size_t)(idx * 64 + p) * 16 + h];
                bbr[h] = fr * br - fi * bi; bbi[h] = fr * bi + fi * br;
                cre[h] = a->in[13][(size_t)(idx * 16 + h) * 64 + p]; cim[h] = a->in[14][(size_t)(idx * 16 + h) * 64 + p]; }
            float hr = 0.f, hi = 0.f;
            for (int s = 0; s < 2304; ++s) {
                const int row = seq_row(b, s, d);
                const u32x4 u0 = *(const u32x4*)(Z + (size_t)row * ZC + g * 16), u1 = *(const u32x4*)(Z + (size_t)row * ZC + g * 16 + 8);
                const float uu[16] = { bflo(u0.x), bfhi(u0.x), bflo(u0.y), bfhi(u0.y), bflo(u0.z), bfhi(u0.z), bflo(u0.w), bfhi(u0.w),
                                       bflo(u1.x), bfhi(u1.x), bflo(u1.y), bfhi(u1.y), bflo(u1.z), bfhi(u1.z), bflo(u1.w), bfhi(u1.w) };
                float bur = 0.f, bui = 0.f;
#pragma unroll
                for (int h = 0; h < 16; ++h) { bur += bbr[h] * uu[h]; bui += bbi[h] * uu[h]; }
                const float nhr = lbr * hr - lbi * hi + bur, nhi = lbr * hi + lbi * hr + bui; hr = nhr; hi = nhi;
                float mine = 0.f;
#pragma unroll
                for (int h = 0; h < 16; ++h) { const float y = wave_sum(cre[h] * hr - cim[h] * hi); if (F.lane == h) mine = y; }
                if (F.lane < 16) { float* ptr = Yacc + (size_t)row * 256 + g * 16 + F.lane; if (d == 0) *ptr = mine; else *ptr += mine; }
            }
        }
    }
}
__device__ __forceinline__ void s5_naive_finish(Frame& F, ArgsP a, int l, int nrows) {
    const bf16_t* Z = (const bf16_t*)(F.ws + WS_Z); const float* Yacc = (const float*)(F.ws + WS_MIX + MX_S5A); bf16_t* ysp = (bf16_t*)(F.ws + WS_MIX + MX_YS5P);
    for (int i = F.gw * 64 + F.lane; i < nrows * 256; i += F.NGW * 64) { const int row = i >> 8, n = i & 255;
        ysp[i] = (bf16_t)f2bf(gelu_tanh(Yacc[i] + a->in[16][l * 256 + n] * bf2f(Z[(size_t)row * ZC + n]))); }
}
#endif

#if NAIVE_HG
__device__ __forceinline__ void hg_naive(Frame& F, ArgsP a, int l) {
    const bf16_t* Z = (const bf16_t*)(F.ws + WS_Z); float* Ohg = (float*)(F.ws + WS_H);
    LAS float* red = (LAS float*)F.lds;
    const float lb = hg_lb(a, l);
    for (int unit = blockIdx.x; unit < 32; unit += F.G) {
        const int b = unit >> 2, hd = unit & 3, v = F.tid & 63, kg = F.wave;
        for (int d = 0; d < 2; ++d) {
            float S[16];
#pragma unroll
            for (int k = 0; k < 16; ++k) S[k] = 0.f;
            for (int s = 0; s < 2304; ++s) {
                const int row = seq_row(b, s, d);
                const bf16_t* zr = Z + (size_t)row * ZC;
                const u32x4 q0 = *(const u32x4*)(zr + ZHQ + hd * 128 + kg * 16), q1 = *(const u32x4*)(zr + ZHQ + hd * 128 + kg * 16 + 8);
                const int zf = d ? ZF1 : ZF0;
                const u32x4 z0 = *(const u32x4*)(zr + zf + hd * 128 + kg * 16), z1 = *(const u32x4*)(zr + zf + hd * 128 + kg * 16 + 8);
                const float vt = bf2f(zr[ZI + hd * 64 + v]);
                const float qq[16] = { bflo(q0.x), bfhi(q0.x), bflo(q0.y), bfhi(q0.y), bflo(q0.z), bfhi(q0.z), bflo(q0.w), bfhi(q0.w),
                                       bflo(q1.x), bfhi(q1.x), bflo(q1.y), bfhi(q1.y), bflo(q1.z), bfhi(q1.z), bflo(q1.w), bfhi(q1.w) };
                const float zz[16] = { bflo(z0.x), bfhi(z0.x), bflo(z0.y), bfhi(z0.y), bflo(z0.z), bfhi(z0.z), bflo(z0.w), bfhi(z0.w),
                                       bflo(z1.x), bfhi(z1.x), bflo(z1.y), bfhi(z1.y), bflo(z1.z), bfhi(z1.z), bflo(z1.w), bfhi(z1.w) };
                float part = 0.f;
#pragma unroll
                for (int k = 0; k < 16; ++k) { const float kin = (1.f - lb) / (1.f + __expf(zz[k])), f = 1.f - kin; S[k] = f * S[k] + kin * vt; part += qq[k] * S[k]; }
                red[((s & 1) * 8 + kg) * 64 + v] = part;
                __syncthreads();
                if (F.tid < 64) { float o = 0.f;
#pragma unroll
                    for (int w = 0; w < 8; ++w) o += red[((s & 1) * 8 + w) * 64 + F.tid];
                    float* ptr = Ohg + (size_t)row * 256 + hd * 64 + F.tid; if (d == 0) *ptr = o; else *ptr += o; }
            }
            __syncthreads();
        }
    }
}
__device__ __forceinline__ void hg_naive_finish(Frame& F, ArgsP a, int l, int nrows) {
    const bf16_t* Z = (const bf16_t*)(F.ws + WS_Z); const float* Ohg = (const float*)(F.ws + WS_H); bf16_t* yhg = (bf16_t*)(F.ws + WS_MIX + MX_YHG);
    for (int it = F.gw; it < nrows * 4; it += F.NGW) { const int row = it >> 2, hd = it & 3, c = hd * 64 + F.lane;
        float o = Ohg[(size_t)row * 256 + c]; const float ms = wave_sum(o * o) * (1.f / 64.f);
        o = o * rsqrtf(ms + EPS) * a->in[25][l * 256 + c] * siluf_(bf2f(Z[(size_t)row * ZC + ZG + c]));
        yhg[(size_t)row * 256 + c] = (bf16_t)f2bf(o); }
}
#endif

#if NAIVE_ATTN
__device__ __forceinline__ void attn_naive(Frame& F, bool need_ctx) {
    const bf16_t* Q = (const bf16_t*)(F.ws + WS_MIX + MX_Q); const bf16_t* KN = (const bf16_t*)(F.ws + WS_MIX + MX_KN); const bf16_t* V = (const bf16_t*)(F.ws + WS_MIX + MX_V);
    const bf16_t* KPE = (const bf16_t*)(F.ws + WS_MIX + MX_KPE); bf16_t* YM = (bf16_t*)(F.ws + WS_MIX + MX_YMLA);
    const int nunits = need_ctx ? 320 : 256;
    for (int unit = blockIdx.x; unit < nunits; unit += F.G) {
        int b, h, qrow, nk; bool active = true; const bool lat = unit < 256;
        if (lat) { b = unit >> 5; h = (unit >> 2) & 7; qrow = b * 2048 + (unit & 3) * 512 + F.tid; nk = 2304; }
        else { const int u2 = unit - 256; b = u2 >> 3; h = u2 & 7; active = F.tid < 256; qrow = NLAT + b * 256 + (F.tid & 255); nk = 256; }
        float q[96];
#pragma unroll
        for (int c = 0; c < 12; ++c) { const u32x4 w = *(const u32x4*)(Q + (size_t)qrow * 768 + h * 96 + c * 8);
            q[c * 8 + 0] = bflo(w.x); q[c * 8 + 1] = bfhi(w.x); q[c * 8 + 2] = bflo(w.y); q[c * 8 + 3] = bfhi(w.y); q[c * 8 + 4] = bflo(w.z); q[c * 8 + 5] = bfhi(w.z); q[c * 8 + 6] = bflo(w.w); q[c * 8 + 7] = bfhi(w.w); }
        float o[64], m = -1e30f, lsum = 0.f;
#pragma unroll
        for (int dd = 0; dd < 64; ++dd) o[dd] = 0.f;
        for (int j = 0; j < nk; ++j) {
            const int krow = lat ? (j < 2048 ? b * 2048 + j : NLAT + b * 256 + (j - 2048)) : NLAT + b * 256 + j;
            const bf16_t* kn = KN + (size_t)krow * 512 + h * 64; const bf16_t* kp = KPE + (size_t)krow * 32; const bf16_t* vv = V + (size_t)krow * 512 + h * 64;
            float s = 0.f;
#pragma unroll
            for (int c = 0; c < 12; ++c) { const u32x4 w = c < 8 ? *(const u32x4*)(kn + c * 8) : *(const u32x4*)(kp + (c - 8) * 8);
                s += q[c * 8 + 0] * bflo(w.x) + q[c * 8 + 1] * bfhi(w.x) + q[c * 8 + 2] * bflo(w.y) + q[c * 8 + 3] * bfhi(w.y) + q[c * 8 + 4] * bflo(w.z) + q[c * 8 + 5] * bfhi(w.z) + q[c * 8 + 6] * bflo(w.w) + q[c * 8 + 7] * bfhi(w.w); }
            const float mn = fmaxf(m, s), al = __builtin_amdgcn_exp2f(m - mn), pp = __builtin_amdgcn_exp2f(s - mn);
            lsum = lsum * al + pp; m = mn;
#pragma unroll
            for (int c = 0; c < 8; ++c) { const u32x4 w = *(const u32x4*)(vv + c * 8);
                o[c * 8 + 0] = o[c * 8 + 0] * al + pp * bflo(w.x); o[c * 8 + 1] = o[c * 8 + 1] * al + pp * bfhi(w.x); o[c * 8 + 2] = o[c * 8 + 2] * al + pp * bflo(w.y); o[c * 8 + 3] = o[c * 8 + 3] * al + pp * bfhi(w.y);
                o[c * 8 + 4] = o[c * 8 + 4] * al + pp * bflo(w.z); o[c * 8 + 5] = o[c * 8 + 5] * al + pp * bfhi(w.z); o[c * 8 + 6] = o[c * 8 + 6] * al + pp * bflo(w.w); o[c * 8 + 7] = o[c * 8 + 7] * al + pp * bfhi(w.w); }
        }
        if (active) { const float inv = 1.f / lsum;
#pragma unroll
            for (int c = 0; c < 8; ++c) { u32x4 w; w.x = pk2(o[c * 8] * inv, o[c * 8 + 1] * inv); w.y = pk2(o[c * 8 + 2] * inv, o[c * 8 + 3] * inv); w.z = pk2(o[c * 8 + 4] * inv, o[c * 8 + 5] * inv); w.w = pk2(o[c * 8 + 6] * inv, o[c * 8 + 7] * inv);
                *(u32x4*)(YM + (size_t)qrow * 512 + h * 64 + c * 8) = w; } }
    }
}
#endif

typedef short s16x4 __attribute__((ext_vector_type(4)));
__device__ __forceinline__ f32x4 mfma16(bf16x8 a, bf16x8 b, f32x4 c) { return __builtin_amdgcn_mfma_f32_16x16x32_bf16(a, b, c, 0, 0, 0); }
__device__ __forceinline__ s16x4 vtr16(const LAS unsigned char* p) { return __builtin_bit_cast(s16x4, __builtin_amdgcn_ds_read_tr16_b64_v4i16((LAS s16x4*)p)); }
__device__ __forceinline__ float max3f_(float a, float b, float c) { float r; asm("v_max3_f32 %0, %1, %2, %3" : "=v"(r) : "v"(a), "v"(b), "v"(c)); return r; }
__device__ __forceinline__ void glds16(const void* gsrc, unsigned lds_dst) { unsigned keep;
    asm volatile("s_mov_b32 %0, m0\n\ts_mov_b32 m0, %2\n\ts_nop 0\n\tglobal_load_lds_dwordx4 %1, off\n\ts_mov_b32 m0, %0" : "=&s"(keep) : "v"(gsrc), "s"(lds_dst) : "memory"); }
#if !NAIVE_ATTN
template <int VAR> __device__ __forceinline__ void attn_fast(Frame& F, bool need_ctx, bf16_t* YM) {
    const bf16_t* Q = (const bf16_t*)(F.ws + WS_MIX + MX_Q); const bf16_t* KN = (const bf16_t*)(F.ws + WS_MIX + MX_KN); const bf16_t* V = (const bf16_t*)(F.ws + WS_MIX + MX_V);
    const bf16_t* KPE = (const bf16_t*)(F.ws + WS_MIX + MX_KPE);
    const int lane = F.lane, wid = F.wave, r32 = lane & 31, hi = lane >> 5;
    constexpr int SLOT = 20480, VOFF = 12288, NSLOT = 5;
    const unsigned lds0 = (unsigned)(uintptr_t)F.lds;
    const int nunits = need_ctx ? 576 : 512;
    const unsigned kA = (unsigned)(hi * 1024 + r32 * 16);
    const unsigned vB = (unsigned)(VOFF + ((lane >> 4) & 1) * 32 + (lane & 3) * 8 + (4 * hi + ((lane & 15) >> 2)) * 64);
    for (int unit = F.vcu; unit < nunits; unit += F.G) {
        int b, h, qrow0, NT; const bool lat = unit < 512;
        if (lat) { b = unit >> 6; h = (unit >> 3) & 7; qrow0 = b * 2048 + (unit & 7) * 256; NT = 36; }
        else { const int u2 = unit - 512; b = u2 >> 3; h = u2 & 7; qrow0 = NLAT + b * 256; NT = 4; }
#define ATT_KROW(t) (lat ? ((t) < 32 ? b * 2048 + 64 * (t) : NLAT + b * 256 + 64 * ((t) - 32)) : NLAT + b * 256 + 64 * (t))
#define ATT_ISSUE(tt, sl) do { const int tc_ = (tt) < NT ? (tt) : NT - 1; const int kr_ = ATT_KROW(tc_); const unsigned sd_ = (unsigned)__builtin_amdgcn_readfirstlane((int)(lds0 + (sl) * SLOT + wid * 1024)); \
            glds16(KN + (size_t)(kr_ + lane) * 512 + h * 64 + wid * 8, sd_); \
            if (wid < 4) glds16(KPE + (size_t)(kr_ + lane) * 32 + wid * 8, sd_ + 8 * 1024); \
            glds16(V + (size_t)(kr_ + 16 * (wid & 3) + (lane >> 2)) * 512 + h * 64 + (wid >> 2) * 32 + (lane & 3) * 8, sd_ + VOFF); } while (0)
#define ATT_QK(P0, P1, slot) do { const LAS unsigned char* sq_ = F.lds + (slot) * SLOT; _Pragma("unroll") for (int d0 = 0; d0 < 6; ++d0) { \
            const bf16x8 k0_ = *(const LAS bf16x8*)(sq_ + kA + d0 * 2048), k1_ = *(const LAS bf16x8*)(sq_ + kA + d0 * 2048 + 512); \
            if (d0 == 0) { P0 = __builtin_amdgcn_mfma_f32_32x32x16_bf16(k0_, qf[0], negm, 0, 0, 0); P1 = __builtin_amdgcn_mfma_f32_32x32x16_bf16(k1_, qf[0], negm, 0, 0, 0); } \
            else { P0 = __builtin_amdgcn_mfma_f32_32x32x16_bf16(k0_, qf[d0], P0, 0, 0, 0); P1 = __builtin_amdgcn_mfma_f32_32x32x16_bf16(k1_, qf[d0], P1, 0, 0, 0); } } } while (0)
        asm volatile("s_waitcnt vmcnt(0)" ::: "memory");
        __syncthreads();
        ATT_ISSUE(0, 0); ATT_ISSUE(1, 1); ATT_ISSUE(2, 2); ATT_ISSUE(3, 3);
        bf16x8 qf[6];
        { const bf16_t* qp = Q + (size_t)(qrow0 + wid * 32 + r32) * 768 + h * 96 + hi * 8;
#pragma unroll
          for (int d0 = 0; d0 < 6; ++d0) qf[d0] = *(const bf16x8*)(qp + d0 * 16); }
        float mref = 0.f, lsum = 0.f, dpend = 0.f; f32x16 o0 = {}, o1 = {}, negm = {};
        asm volatile("s_waitcnt vmcnt(0)" ::: "memory");
        __syncthreads();
        f32x16 p0, p1;
        ATT_QK(p0, p1, 0);
        int s_cur = 0, s_nxt = 1, s_new = 4;
        for (int t = 0; t < NT; ++t) {
            ATT_ISSUE(t + 4, s_new);
            const LAS unsigned char* sb = F.lds + s_cur * SLOT;
            f32x16 n0, n1;
            if (t + 1 < NT) ATT_QK(n0, n1, s_nxt); else { n0 = p0; n1 = p1; }
            if (__builtin_expect(__any(dpend != 0.f), 0)) {
#pragma unroll
                for (int r = 0; r < 16; ++r) { p0[r] -= dpend; p1[r] -= dpend; } }
            float mxa = max3f_(p0[0], p0[1], p1[0]), mxb = max3f_(p0[2], p0[3], p1[1]); mxa = max3f_(mxa, p1[2], p1[3]);
#pragma unroll
            for (int r = 4; r < 16; r += 4) { mxa = max3f_(mxa, p0[r], p0[r + 1]); mxb = max3f_(mxb, p0[r + 2], p0[r + 3]); mxa = max3f_(mxa, p1[r], p1[r + 1]); mxb = max3f_(mxb, p1[r + 2], p1[r + 3]); }
            float mx = fmaxf(mxa, mxb);
            { auto rr = __builtin_amdgcn_permlane32_swap(__float_as_uint(mx), __float_as_uint(mx), false, false); mx = fmaxf(__uint_as_float(rr[0]), __uint_as_float(rr[1])); }
            dpend = 0.f;
            if (__builtin_expect(t == 0 || __any(mx > 8.f), 0)) {
                const float dl = t == 0 ? mx : fmaxf(mx, 0.f); mref += dl; dpend = dl;
#pragma unroll
                for (int r = 0; r < 16; ++r) { p0[r] -= dl; p1[r] -= dl; negm[r] = -mref; }
                const float fs = __builtin_amdgcn_exp2f(-dl); lsum *= fs;
#pragma unroll
                for (int r = 0; r < 16; ++r) { o0[r] *= fs; o1[r] *= fs; } }
            f32x2 ps2 = {0.f, 0.f};
#pragma unroll
            for (int r = 0; r < 16; r += 2) { p0[r] = __builtin_amdgcn_exp2f(p0[r]); p0[r + 1] = __builtin_amdgcn_exp2f(p0[r + 1]); p1[r] = __builtin_amdgcn_exp2f(p1[r]); p1[r + 1] = __builtin_amdgcn_exp2f(p1[r + 1]);
                ps2 += (f32x2){p0[r], p0[r + 1]}; ps2 += (f32x2){p1[r], p1[r + 1]}; }
            lsum += ps2.x + ps2.y;
            bf16x8 pb[4];
#pragma unroll
            for (int s = 0; s < 4; ++s) { u32x4 w;
                if (s < 2) { w.x = pk2(p0[8 * s], p0[8 * s + 1]); w.y = pk2(p0[8 * s + 2], p0[8 * s + 3]); w.z = pk2(p0[8 * s + 4], p0[8 * s + 5]); w.w = pk2(p0[8 * s + 6], p0[8 * s + 7]); }
                else { const int q = s - 2; w.x = pk2(p1[8 * q], p1[8 * q + 1]); w.y = pk2(p1[8 * q + 2], p1[8 * q + 3]); w.z = pk2(p1[8 * q + 4], p1[8 * q + 5]); w.w = pk2(p1[8 * q + 6], p1[8 * q + 7]); }
                pb[s] = __builtin_bit_cast(bf16x8, w); }
#pragma unroll
            for (int s = 0; s < 4; ++s) {
                const s16x4 a0l = vtr16(sb + vB + s * 1024), a0h = vtr16(sb + vB + s * 1024 + 512), a1l = vtr16(sb + vB + 4096 + s * 1024), a1h = vtr16(sb + vB + 4096 + s * 1024 + 512);
                const bf16x8 va0 = {a0l[0], a0l[1], a0l[2], a0l[3], a0h[0], a0h[1], a0h[2], a0h[3]}, va1 = {a1l[0], a1l[1], a1l[2], a1l[3], a1h[0], a1h[1], a1h[2], a1h[3]};
                o0 = __builtin_amdgcn_mfma_f32_32x32x16_bf16(va0, pb[s], o0, 0, 0, 0);
                o1 = __builtin_amdgcn_mfma_f32_32x32x16_bf16(va1, pb[s], o1, 0, 0, 0);
            }
            if (wid < 4) asm volatile("s_waitcnt vmcnt(6) lgkmcnt(0)" ::: "memory"); else asm volatile("s_waitcnt vmcnt(4) lgkmcnt(0)" ::: "memory");
            __builtin_amdgcn_s_barrier();
            p0 = n0; p1 = n1;
            s_cur = s_nxt; s_nxt = s_nxt + 1 == NSLOT ? 0 : s_nxt + 1; s_new = s_new + 1 == NSLOT ? 0 : s_new + 1;
        }
#undef ATT_QK
#undef ATT_ISSUE
#undef ATT_KROW
        lsum += shfl_f(lsum, lane ^ 32);
        const float inv = 1.f / lsum;
        bf16_t* op = YM + (size_t)(qrow0 + wid * 32 + r32) * 512 + h * 64 + 4 * hi;
#pragma unroll
        for (int g = 0; g < 4; ++g) {
            u32x2 w0, w1; w0.x = pk2(o0[4 * g] * inv, o0[4 * g + 1] * inv); w0.y = pk2(o0[4 * g + 2] * inv, o0[4 * g + 3] * inv);
            w1.x = pk2(o1[4 * g] * inv, o1[4 * g + 1] * inv); w1.y = pk2(o1[4 * g + 2] * inv, o1[4 * g + 3] * inv);
            *(u32x2*)(op + 8 * g) = w0; *(u32x2*)(op + 32 + 8 * g) = w1;
        }
    }
}
#endif

#if !NAIVE_HG
__device__ __forceinline__ bf16x8 trfrag(const LAS unsigned char* p, int rowstep4) {
    const s16x4 lo = vtr16(p), hi = vtr16(p + rowstep4); return (bf16x8){lo[0], lo[1], lo[2], lo[3], hi[0], hi[1], hi[2], hi[3]}; }
__device__ __forceinline__ void hg_gate16(const bf16_t* Z, int b, int s0, int d, int zcol, float lb, float (&kin)[16], float (&gl)[16]) {
#pragma unroll
    for (int i = 0; i < 16; ++i) { const int row = seq_row(b, s0 + i, d); const float z = bf2f(Z[(size_t)row * ZC + zcol]);
        const float e = __expf(-z), sg = 1.f / (1.f + e), f = lb + (1.f - lb) * sg; kin[i] = (1.f - lb) * e * sg; gl[i] = __logf(f); }
}
__device__ __forceinline__ void hg_local_load(u32x4 (&tz)[2], u32x4& tv, const bf16_t* Z, int unit, int tid) {
    const int c = unit % 36, r = unit / 36, d = r & 1, hd = (r >> 1) & 3, b = r >> 3;
#pragma unroll
    for (int j = 0; j < 2; ++j) { const int pc = tid + 512 * j, t = pc >> 4, c16 = pc & 15, row = seq_row(b, 64 * c + t, d);
        tz[j] = *(const u32x4*)(Z + (size_t)row * ZC + (d ? ZF1 : ZF0) + hd * 128 + c16 * 8); }
    { const int t = tid >> 3, cc = tid & 7, row = seq_row(b, 64 * c + t, d); tv = *(const u32x4*)(Z + (size_t)row * ZC + ZI + hd * 64 + cc * 8); }
}
__device__ __forceinline__ void hg_local_phase(Frame& F, ArgsP a, int l) {
    const bf16_t* Z = (const bf16_t*)(F.ws + WS_Z); bf16_t* HGS = (bf16_t*)(F.ws + WS_H); float* HGD = (float*)(F.ws + WS_MIX + MX_HGD);
    const float lb = hg_lb(a, l);
    LAS unsigned char* Vl = F.lds; LAS unsigned char* KdT = F.lds + 9216; LAS float* seg = (LAS float*)(F.lds + 27648); LAS unsigned char* Zr = F.lds + 32768;
    const int tid = F.tid, lane = F.lane, w = F.wave, k = tid & 127, tq = tid >> 7;
    u32x4 tz[2], tv;
    if (F.vcu < 2304) hg_local_load(tz, tv, Z, F.vcu, tid);
    for (int unit = F.vcu; unit < 2304; unit += F.G) {
        __syncthreads();
#pragma unroll
        for (int j = 0; j < 2; ++j) { const int pc = tid + 512 * j; *(LAS u32x4*)(Zr + (pc >> 4) * 272 + (pc & 15) * 16) = tz[j]; }
        *(LAS u32x4*)(Vl + (tid >> 3) * 144 + (tid & 7) * 16) = tv;
        if (unit + F.G < 2304) hg_local_load(tz, tv, Z, unit + F.G, tid);
        __syncthreads();
        float kin0[8], kin1[8], g0[8], g1[8];
#pragma unroll
        for (int i = 0; i < 8; ++i) { const unsigned zz = *(const LAS unsigned*)(Zr + ((8 * w + i) * 136 + 2 * lane) * 2);
            { const float e = __expf(-bflo(zz)), sg = __builtin_amdgcn_rcpf(1.f + e); kin0[i] = (1.f - lb) * e * sg; g0[i] = __logf(lb + (1.f - lb) * sg); }
            { const float e = __expf(-bfhi(zz)), sg = __builtin_amdgcn_rcpf(1.f + e); kin1[i] = (1.f - lb) * e * sg; g1[i] = __logf(lb + (1.f - lb) * sg); } }
        float run0 = 0.f, run1 = 0.f;
#pragma unroll
        for (int i = 7; i >= 0; --i) { const float a0 = g0[i], a1 = g1[i]; g0[i] = run0; g1[i] = run1; run0 += a0; run1 += a1; }
        *(LAS f32x2*)(seg + w * 128 + 2 * lane) = (f32x2){run0, run1};
        __syncthreads();
        float lat0 = 0.f, lat1 = 0.f, tot0 = 0.f, tot1 = 0.f;
#pragma unroll
        for (int q = 0; q < 8; ++q) { const f32x2 sv = *(const LAS f32x2*)(seg + q * 128 + 2 * lane); tot0 += sv.x; tot1 += sv.y; if (q > w) { lat0 += sv.x; lat1 += sv.y; } }
        { u32x4 w0, w1;
          w0.x = pk2(kin0[0] * __expf(g0[0] + lat0), kin0[1] * __expf(g0[1] + lat0)); w0.y = pk2(kin0[2] * __expf(g0[2] + lat0), kin0[3] * __expf(g0[3] + lat0));
          w0.z = pk2(kin0[4] * __expf(g0[4] + lat0), kin0[5] * __expf(g0[5] + lat0)); w0.w = pk2(kin0[6] * __expf(g0[6] + lat0), kin0[7] * __expf(g0[7] + lat0));
          w1.x = pk2(kin1[0] * __expf(g1[0] + lat1), kin1[1] * __expf(g1[1] + lat1)); w1.y = pk2(kin1[2] * __expf(g1[2] + lat1), kin1[3] * __expf(g1[3] + lat1));
          w1.z = pk2(kin1[4] * __expf(g1[4] + lat1), kin1[5] * __expf(g1[5] + lat1)); w1.w = pk2(kin1[6] * __expf(g1[6] + lat1), kin1[7] * __expf(g1[7] + lat1));
          *(LAS u32x4*)(KdT + (2 * lane) * 144 + w * 16) = w0; *(LAS u32x4*)(KdT + (2 * lane + 1) * 144 + w * 16) = w1; }
        if (w == 0) *(f32x2*)(HGD + (size_t)unit * 128 + 2 * lane) = (f32x2){__expf(tot0), __expf(tot1)};
        __syncthreads();
        f32x4 acc[4] = {};
#pragma unroll
        for (int ks = 0; ks < 2; ++ks) {
            const bf16x8 bf = *(const LAS bf16x8*)(KdT + (16 * w + (lane & 15)) * 144 + (32 * ks + 8 * (lane >> 4)) * 2);
#pragma unroll
            for (int mt = 0; mt < 4; ++mt) { const bf16x8 af = trfrag(Vl + (32 * ks + 8 * (lane >> 4) + ((lane & 15) >> 2)) * 144 + (mt * 16 + 4 * (lane & 3)) * 2, 4 * 144);
                acc[mt] = mfma16(af, bf, acc[mt]); }
        }
        bf16_t* dst = HGS + (size_t)unit * 8192 + 16 * w + (lane & 15);
#pragma unroll
        for (int mt = 0; mt < 4; ++mt)
#pragma unroll
            for (int rr = 0; rr < 4; ++rr) dst[(size_t)(16 * mt + 4 * (lane >> 4) + rr) * 128] = (bf16_t)f2bf(acc[mt][rr]);
    }
}
__device__ __forceinline__ void hg_scan_phase(Frame& F) {
    bf16_t* HGS = (bf16_t*)(F.ws + WS_H); const float* HGD = (const float*)(F.ws + WS_MIX + MX_HGD);
    for (int it = F.gw * 64 + F.lane; it < 64 * 1024; it += F.NGW * 64) {
        const int r = it >> 10, e8 = (it & 1023) * 8, k0 = e8 & 127;
        float S[8];
#pragma unroll
        for (int j = 0; j < 8; ++j) S[j] = 0.f;
#pragma unroll 4
        for (int c = 0; c < 36; ++c) {
            u32x4* p = (u32x4*)(HGS + (size_t)(r * 36 + c) * 8192 + e8); const u32x4 ds = *p;
            const f32x4 d0 = *(const f32x4*)(HGD + (size_t)(r * 36 + c) * 128 + k0), d1 = *(const f32x4*)(HGD + (size_t)(r * 36 + c) * 128 + k0 + 4);
            u32x4 o; o.x = pk2(S[0], S[1]); o.y = pk2(S[2], S[3]); o.z = pk2(S[4], S[5]); o.w = pk2(S[6], S[7]); *p = o;
            S[0] = d0[0] * S[0] + bflo(ds.x); S[1] = d0[1] * S[1] + bfhi(ds.x); S[2] = d0[2] * S[2] + bflo(ds.y); S[3] = d0[3] * S[3] + bfhi(ds.y);
            S[4] = d1[0] * S[4] + bflo(ds.z); S[5] = d1[1] * S[5] + bfhi(ds.z); S[6] = d1[2] * S[6] + bflo(ds.w); S[7] = d1[3] * S[7] + bfhi(ds.w);
        }
    }
}
struct HgTile { u32x4 z[2], q[2], s[2], v; };
__device__ __forceinline__ void hg_out_decode(int unit, bool need_ctx, int& b, int& hd, int& ct) {
    if (need_ctx) { ct = unit % 36; hd = (unit / 36) & 3; b = unit / 144; } else { ct = 4 + (unit & 31); hd = (unit >> 5) & 3; b = unit >> 7; }
}
__device__ __forceinline__ void hg_out_load(HgTile& T, const bf16_t* Z, const bf16_t* HGS, int b, int hd, int ct, int d, int tid) {
    const int cs = d == 0 ? ct : (ct < 4 ? 3 - ct : 39 - ct); const size_t su = (size_t)(((b * 4 + hd) * 2 + d) * 36 + cs);
#pragma unroll
    for (int j = 0; j < 2; ++j) { const int pc = tid + 512 * j, t = pc >> 4, c16 = pc & 15, row = seq_row(b, 64 * cs + t, d);
        T.z[j] = *(const u32x4*)(Z + (size_t)row * ZC + (d ? ZF1 : ZF0) + hd * 128 + c16 * 8); T.q[j] = *(const u32x4*)(Z + (size_t)row * ZC + ZHQ + hd * 128 + c16 * 8);
        T.s[j] = *(const u32x4*)(HGS + su * 8192 + (size_t)t * 128 + c16 * 8); }
    { const int t = tid >> 3, cc = tid & 7, row = seq_row(b, 64 * cs + t, d); T.v = *(const u32x4*)(Z + (size_t)row * ZC + ZI + hd * 64 + cc * 8); }
}
__device__ __forceinline__ void hg_out_phase(Frame& F, ArgsP a, int l, bool need_ctx) {
    const bf16_t* Z = (const bf16_t*)(F.ws + WS_Z); const bf16_t* HGS = (const bf16_t*)(F.ws + WS_H); bf16_t* YHG = (bf16_t*)(F.ws + WS_MIX + MX_YHG);
    const float lb = hg_lb(a, l);
    LAS unsigned char* HQD = F.lds; LAS unsigned char* HQ1 = F.lds + 17408; LAS unsigned char* HK1 = F.lds + 34816; LAS unsigned char* HST = F.lds + 52224;
    LAS unsigned char* HV = F.lds + 69632; LAS unsigned char* HP = F.lds + 78848; LAS float* HO = (LAS float*)(F.lds + 88064); LAS float* seg = (LAS float*)(F.lds + 105472);
    const int tid = F.tid, lane = F.lane, w = F.wave, k = tid & 127, tq = tid >> 7, mt = w >> 1, nh = w & 1;
    const int nunits = need_ctx ? 1152 : 1024;
    const int nmine = F.vcu < nunits ? (nunits - 1 - F.vcu) / F.G + 1 : 0, nit = 2 * nmine;
    HgTile T;
    if (nit > 0) { int b, hd, ct; hg_out_decode(F.vcu, need_ctx, b, hd, ct); hg_out_load(T, Z, HGS, b, hd, ct, 0, tid); }
    for (int it = 0; it < nit; ++it) {
        const int unit = F.vcu + (it >> 1) * F.G, d = it & 1; int b, hd, ct; hg_out_decode(unit, need_ctx, b, hd, ct);
        __syncthreads();
#pragma unroll
        for (int j = 0; j < 2; ++j) { const int pc = tid + 512 * j, t = pc >> 4, c16 = pc & 15;
            *(LAS u32x4*)(HQD + t * 272 + c16 * 16) = T.q[j]; *(LAS u32x4*)(HK1 + t * 272 + c16 * 16) = T.z[j]; *(LAS u32x4*)(HST + t * 272 + c16 * 16) = T.s[j]; }
        *(LAS u32x4*)(HV + (tid >> 3) * 144 + (tid & 7) * 16) = T.v;
        if (it + 1 < nit) { const int un = F.vcu + ((it + 1) >> 1) * F.G; int b2, hd2, ct2; hg_out_decode(un, need_ctx, b2, hd2, ct2); hg_out_load(T, Z, HGS, b2, hd2, ct2, (it + 1) & 1, tid); }
        __syncthreads();
        float kin0[8], kin1[8], g0[8], g1[8];
#pragma unroll
        for (int i = 0; i < 8; ++i) { const unsigned zz = *(const LAS unsigned*)(HK1 + ((8 * w + i) * 136 + 2 * lane) * 2);
            { const float e = __expf(-bflo(zz)), sg = __builtin_amdgcn_rcpf(1.f + e); kin0[i] = (1.f - lb) * e * sg; g0[i] = __logf(lb + (1.f - lb) * sg); }
            { const float e = __expf(-bfhi(zz)), sg = __builtin_amdgcn_rcpf(1.f + e); kin1[i] = (1.f - lb) * e * sg; g1[i] = __logf(lb + (1.f - lb) * sg); } }
        float run0 = 0.f, run1 = 0.f;
#pragma unroll
        for (int i = 0; i < 8; ++i) { run0 += g0[i]; g0[i] = run0; run1 += g1[i]; g1[i] = run1; }
        *(LAS f32x2*)(seg + w * 128 + 2 * lane) = (f32x2){run0, run1};
        __syncthreads();
        float bef0 = 0.f, bef1 = 0.f, br0 = 0.f, br1 = 0.f;
#pragma unroll
        for (int q = 0; q < 7; ++q) { const f32x2 sv = *(const LAS f32x2*)(seg + q * 128 + 2 * lane); if (q < w) { bef0 += sv.x; bef1 += sv.y; } if (q < 4) { br0 += sv.x; br1 += sv.y; } }
        const float er0 = __expf(br0), er1 = __expf(br1);
#pragma unroll
        for (int i = 0; i < 8; ++i) { const int t = 8 * w + i, off = (t * 136 + 2 * lane) * 2;
            const unsigned qq = *(const LAS unsigned*)(HQD + off);
            const float e0 = __expf(fminf(fmaxf(bef0 + g0[i] - br0, -80.f), 80.f)), e1 = __expf(fminf(fmaxf(bef1 + g1[i] - br1, -80.f), 80.f));
            const float q10 = bflo(qq) * e0, q11 = bfhi(qq) * e1;
            *(LAS unsigned*)(HQ1 + off) = pk2(q10, q11);
            *(LAS unsigned*)(HQD + off) = pk2(q10 * er0, q11 * er1);
            *(LAS unsigned*)(HK1 + off) = pk2(kin0[i] * __builtin_amdgcn_rcpf(e0), kin1[i] * __builtin_amdgcn_rcpf(e1)); }
        __syncthreads();
        f32x4 ao[2] = {}, as[2] = {};
#pragma unroll
        for (int ks = 0; ks < 4; ++ks) {
            const int ko = (32 * ks + 8 * (lane >> 4)) * 2;
            const bf16x8 aqd = *(const LAS bf16x8*)(HQD + (16 * mt + (lane & 15)) * 272 + ko), aq1 = *(const LAS bf16x8*)(HQ1 + (16 * mt + (lane & 15)) * 272 + ko);
#pragma unroll
            for (int j = 0; j < 2; ++j) { const int nt = 2 * nh + j;
                ao[j] = mfma16(aqd, *(const LAS bf16x8*)(HST + (16 * nt + (lane & 15)) * 272 + ko), ao[j]);
                as[j] = mfma16(aq1, *(const LAS bf16x8*)(HK1 + (16 * nt + (lane & 15)) * 272 + ko), as[j]); }
        }
#pragma unroll
        for (int j = 0; j < 2; ++j) { const int sc = 16 * (2 * nh + j) + (lane & 15);
#pragma unroll
            for (int rr = 0; rr < 4; ++rr) { const int t = 16 * mt + 4 * (lane >> 4) + rr; *(LAS bf16_t*)(HP + (t * 72 + sc) * 2) = (bf16_t)f2bf(sc <= t ? as[j][rr] : 0.f); } }
        __syncthreads();
#pragma unroll
        for (int ks = 0; ks < 2; ++ks) {
            const bf16x8 ap = *(const LAS bf16x8*)(HP + (16 * mt + (lane & 15)) * 144 + (32 * ks + 8 * (lane >> 4)) * 2);
#pragma unroll
            for (int j = 0; j < 2; ++j) { const int nt = 2 * nh + j;
                const bf16x8 bv = trfrag(HV + (32 * ks + 8 * (lane >> 4) + ((lane & 15) >> 2)) * 144 + (16 * nt + 4 * (lane & 3)) * 2, 4 * 144);
                ao[j] = mfma16(ap, bv, ao[j]); }
        }
#pragma unroll
        for (int j = 0; j < 2; ++j) { const int v = 16 * (2 * nh + j) + (lane & 15);
#pragma unroll
            for (int rr = 0; rr < 4; ++rr) { const int t = 16 * mt + 4 * (lane >> 4) + rr, tt = d == 0 ? t : 63 - t;
                if (d == 0) HO[tt * 68 + v] = ao[j][rr]; else HO[tt * 68 + v] += ao[j][rr]; } }
        if (d == 1) {
            __syncthreads();
#pragma unroll
            for (int i = 0; i < 8; ++i) { const int tt = 8 * w + i, row = ct < 4 ? NLAT + b * 256 + 64 * ct + tt : b * 2048 + 64 * (ct - 4) + tt, cidx = hd * 64 + lane;
                float o = HO[tt * 68 + lane]; const float ms = wave_sum(o * o) * (1.f / 64.f);
                o = o * rsqrtf(ms + EPS) * a->in[25][l * 256 + cidx] * siluf_(bf2f(Z[(size_t)row * ZC + ZG + cidx]));
                YHG[(size_t)row * 256 + cidx] = (bf16_t)f2bf(o); }
        }
    }
}
#endif

#if !NAIVE_S5
typedef f32x2 cf32;
__device__ __forceinline__ cf32 cmul(cf32 a, cf32 b) { return (cf32){a.x * b.x - a.y * b.y, a.x * b.y + a.y * b.x}; }
__device__ __forceinline__ void s5_build(Frame& F, ArgsP a) {
    LAS cf32* lamp = (LAS cf32*)F.lds;
    LAS cf32* Bb = lamp + 2 * 17 * 64;
    LAS cf32* Cc = Bb + 2 * 64 * 16;
    LAS float* Kd = (LAS float*)(Cc + 2 * 16 * 64);
    const int tid = F.tid;
    for (int unit = blockIdx.x; unit < 128; unit += F.G) {
        const int l = unit >> 6, g = (unit >> 2) & 15, q = unit & 3;
        bf16_t* Bs_t = (bf16_t*)(F.ws + WS_WB + (size_t)l * WL_STRIDE + WL_BS); bf16_t* B2_t = (bf16_t*)(F.ws + WS_WB + (size_t)l * WL_STRIDE + WL_B2);
        __syncthreads();
        if (tid < 128) { const int d = tid >> 6, p = tid & 63, idx = (l * 2 + d) * 16 + g;
            const float lre = a->in[9][idx * 64 + p], lim = a->in[10][idx * 64 + p], dt = expf(a->in[15][idx]);
            const float ar = lre * dt, ai = lim * dt;
            for (int tau = 0; tau <= 16; ++tau) { const float mag = expf(ar * (float)tau); float sn, cs; sincosf(ai * (float)tau, &sn, &cs); lamp[(d * 17 + tau) * 64 + p] = (cf32){mag * cs, mag * sn}; }
            const cf32 lb = lamp[(d * 17 + 1) * 64 + p]; const float den = lre * lre + lim * lim;
            const cf32 f = (cf32){((lb.x - 1.f) * lre + lb.y * lim) / den, (lb.y * lre - (lb.x - 1.f) * lim) / den};
            { const f32x4* br4 = (const f32x4*)(a->in[11] + (size_t)(idx * 64 + p) * 16); const f32x4* bi4 = (const f32x4*)(a->in[12] + (size_t)(idx * 64 + p) * 16);
              f32x4 br[4], bi[4];
#pragma unroll
              for (int q4 = 0; q4 < 4; ++q4) { br[q4] = br4[q4]; bi[q4] = bi4[q4]; }
#pragma unroll
              for (int h = 0; h < 16; ++h) Bb[(d * 64 + p) * 16 + h] = cmul(f, (cf32){br[h >> 2][h & 3], bi[h >> 2][h & 3]}); }
            if (q == 0) ((cf32*)(F.ws + WS_S5P))[idx * 64 + p] = lamp[(d * 17 + 16) * 64 + p];
        }
        for (int e = tid; e < 2048; e += 512) { const int d = e >> 10, h = (e >> 6) & 15, p = e & 63, idx = (l * 2 + d) * 16 + g;
            Cc[e] = (cf32){a->in[13][(size_t)(idx * 16 + h) * 64 + p], a->in[14][(size_t)(idx * 16 + h) * 64 + p]}; }
        __syncthreads();
        { const int d = tid >> 8, tau = (tid >> 4) & 15, h = tid & 15; float kacc[16];
#pragma unroll
          for (int hp = 0; hp < 16; ++hp) kacc[hp] = 0.f;
          for (int p = 0; p < 64; ++p) { const cf32 t1 = cmul(Cc[(d * 16 + h) * 64 + p], lamp[(d * 17 + tau) * 64 + p]);
#pragma unroll
              for (int hp = 0; hp < 16; ++hp) { const cf32 bb = Bb[(d * 64 + p) * 16 + hp]; kacc[hp] += t1.x * bb.x - t1.y * bb.y; } }
#pragma unroll
          for (int hp = 0; hp < 16; ++hp) Kd[tid * 16 + hp] = kacc[hp]; }
        __syncthreads();
        for (int e = tid; e < 64 * 512; e += 512) { const int n = 64 * q + (e >> 9), kk = e & 511, i = n >> 4, h = n & 15; float val;
            if (kk < 256) { const int j = kk >> 4, hp = kk & 15; val = 0.f;
                if (j <= i) val += Kd[((i - j) * 16 + h) * 16 + hp];
                if (j >= i) val += Kd[4096 + ((j - i) * 16 + h) * 16 + hp]; }
            else { const int dd = (kk - 256) >> 7, pp = (kk - 256) & 127, p = pp & 63, pw = dd == 0 ? i + 1 : 16 - i;
                const cf32 cl = cmul(Cc[(dd * 16 + h) * 64 + p], lamp[(dd * 17 + pw) * 64 + p]); val = pp < 64 ? cl.x : -cl.y; }
            B2_t[((size_t)g * 256 + n) * 512 + kk] = (bf16_t)f2bf(val); }
        { const int d = q & 1, half = q >> 1;
          for (int e = tid; e < 64 * 256; e += 512) { const int p = e >> 8, kk = e & 255, j = kk >> 4, hp = kk & 15, pw = d == 0 ? 15 - j : j;
              const cf32 v = cmul(lamp[(d * 17 + pw) * 64 + p], Bb[(d * 64 + p) * 16 + hp]);
              Bs_t[((size_t)(g * 2 + d) * 128 + half * 64 + p) * 256 + kk] = (bf16_t)f2bf(half ? v.y : v.x); } }
    }
    __syncthreads();
}
__device__ __forceinline__ void s5_state_phase(Frame& F, int l) {
    bf16_t* S5A = (bf16_t*)(F.ws + WS_MIX + MX_S5A); const bf16_t* Bs_t = (const bf16_t*)(F.ws + WS_WB + (size_t)l * WL_STRIDE + WL_BS);
    const cf32* lam16 = (const cf32*)(F.ws + WS_S5P);
    LAS float* hl = (LAS float*)F.lds;
    const int lane = F.lane, w = F.wave;
    for (int unit = F.vcu; unit < 256; unit += F.G) {
        const int b = unit & 7, d = (unit >> 3) & 1, g = unit >> 4;
        __syncthreads();
        f32x4 acc[10] = {};
        { u32x4 ta[10]; const bf16_t* Asrc = S5A + ((size_t)g * 1280 + b * 160) * 512;
#pragma unroll
          for (int j = 0; j < 10; ++j) { const int pc = F.tid + 512 * j; ta[j] = *(const u32x4*)(Asrc + (size_t)(pc >> 5) * 512 + (pc & 31) * 8); }
          const bf16_t* Bb = Bs_t + ((size_t)(g * 2 + d) * 128 + 16 * w + (lane & 15)) * 256 + 8 * (lane >> 4);
          bf16x8 bfr[8];
#pragma unroll
          for (int ks = 0; ks < 8; ++ks) bfr[ks] = *(const bf16x8*)(Bb + 32 * ks);
#pragma unroll
          for (int j = 0; j < 10; ++j) { const int pc = F.tid + 512 * j; *(LAS u32x4*)(F.lds + (pc >> 5) * 528 + (pc & 31) * 16) = ta[j]; }
          __syncthreads();
#pragma unroll
          for (int ks = 0; ks < 8; ++ks)
#pragma unroll
              for (int mt = 0; mt < 10; ++mt) acc[mt] = mfma16(*(const LAS bf16x8*)(F.lds + (16 * mt + (lane & 15)) * 528 + (32 * ks + 8 * (lane >> 4)) * 2), bfr[ks], acc[mt]);
          __syncthreads(); }
#pragma unroll
        for (int mt = 0; mt < 10; ++mt)
#pragma unroll
            for (int rr = 0; rr < 4; ++rr) hl[(16 * mt + 4 * (lane >> 4) + rr) * 132 + 16 * w + (lane & 15)] = acc[mt][rr];
        __syncthreads();
        if (w == 0) { const cf32 lm = lam16[((l * 2 + d) * 16 + g) * 64 + lane]; float hr = 0.f, hi = 0.f;
            bf16_t* dst = S5A + ((size_t)g * 1280 + b * 160) * 512 + 256 + d * 128 + lane;
            for (int s = 0; s < 144; ++s) { const int c = d == 0 ? s : (s < 16 ? 15 - s : 159 - s);
                dst[(size_t)c * 512] = (bf16_t)f2bf(hr); dst[(size_t)c * 512 + 64] = (bf16_t)f2bf(hi);
                const float lr = hl[c * 132 + lane], li = hl[c * 132 + 64 + lane];
                const float nr = lm.x * hr - lm.y * hi + lr, ni = lm.x * hi + lm.y * hr + li; hr = nr; hi = ni; }
        }
    }
}
struct WinOrderLast { pg8::StaticOrder S0; int G, c;
    __device__ bool next(int i, pg8::Unit& u) const { const int L = i * G + c; if (L < S0.nwg) return S0.next(i, u); const int e = L - S0.nwg; if (e >= 64) return false;
        const int t = e >> 3; u.pm = 64 + (e & 7); u.pn = t == 0 ? 0 : (t == 1 ? 2 : t + 2); u.h = -1; return true; } };
struct S5Order { int G, c; __device__ bool next(int i, pg8::Unit& u) const { const int L = i * G + c; if (L >= 80) return false; u.pm = L; u.pn = L / 5; u.h = -1; return true; } };
struct HalfTailOrder { pg8::StaticOrder S0; int G, c;
    __device__ bool next(int i, pg8::Unit& u) const { const int L = i * G + c; if (L < S0.nwg) return S0.next(i, u); const int e = L - S0.nwg; if (e >= 64) return false;
        u.pm = 64 + (e >> 3); u.pn = (e >> 1) & 3; u.h = e & 1; return true; } };
#endif

__device__ __forceinline__ bf16x8 pack8(const float (&v)[8]) { u32x4 w; w.x = pk2(v[0], v[1]); w.y = pk2(v[2], v[3]); w.z = pk2(v[4], v[5]); w.w = pk2(v[6], v[7]); return __builtin_bit_cast(bf16x8, w); }
__device__ __forceinline__ void norm2_router_phase(Frame& F, ArgsP a, int l, int nrows) {
    const float* X = (const float*)(F.ws + WS_X); bf16_t* H = (bf16_t*)(F.ws + WS_H);
    const float* modv = (const float*)(F.ws + WS_MODV) + (size_t)l * 9 * 6144;
    const float* Wg = a->in[30] + (size_t)l * D * 4; const float* bg = a->in[31] + l * 4; const float* We = a->in[32] + (size_t)l * D * 32; const float* be = a->in[33] + l * 32;
    int* ri = (int*)(F.ws + WS_ROUTE); float* rg = (float*)(F.ws + WS_ROUTE + (size_t)MTOK * 16);
    unsigned* cnt = (unsigned*)(F.ws + WS_CTL) + CW_CNT + l * 32 * 64;
    LAS unsigned char* hhi = F.lds; LAS unsigned char* hlo = F.lds + 33024; LAS float* part = (LAS float*)(F.lds + 66048); LAS float* lg = (LAS float*)(F.lds + 90624);
    const int w = F.wave, lane = F.lane, tid = F.tid;
    bf16x8 whi[4][3], wlo[4][3];
#pragma unroll
    for (int ks = 0; ks < 4; ++ks)
#pragma unroll
        for (int nt = 0; nt < 3; ++nt) { float hv[8], lv[8]; const int col = 16 * nt + (lane & 15);
#pragma unroll
            for (int i = 0; i < 8; ++i) { const int k = 128 * w + 32 * ks + 8 * (lane >> 4) + i;
                const float wv = col < 32 ? We[(size_t)k * 32 + col] : (col < 36 ? Wg[(size_t)k * 4 + (col - 32)] : 0.f);
                const float hi = bflo(pk2(wv, 0.f)); hv[i] = hi; lv[i] = wv - hi; }
            whi[ks][nt] = pack8(hv); wlo[ks][nt] = pack8(lv); }
    const int niter = nrows >> 4;
    for (int it = F.vcu; it < niter; it += F.G) {
        const int base = it * 16;
        __syncthreads();
#pragma unroll
        for (int rr = 0; rr < 2; ++rr) { const int lr = 2 * w + rr, row = base + lr; f32x4 v[4], h[4];
#pragma unroll
            for (int j = 0; j < 4; ++j) v[j] = *(const f32x4*)(X + (size_t)row * D + 4 * lane + 256 * j);
            const float* mv = modv + (size_t)tok_modrow(row) * 6144;
            norm_mod_row(v, h, a->in[7] + l * D, mv + 3 * 1024, mv + 4 * 1024, lane);
            store_row_bf16(H + (size_t)row * D, h, lane);
#pragma unroll
            for (int j = 0; j < 4; ++j) { u32x2 ph, pl; ph.x = pk2(h[j][0], h[j][1]); ph.y = pk2(h[j][2], h[j][3]);
                pl.x = pk2(h[j][0] - bflo(ph.x), h[j][1] - bfhi(ph.x)); pl.y = pk2(h[j][2] - bflo(ph.y), h[j][3] - bfhi(ph.y));
                *(LAS u32x2*)(hhi + (lr * 1032 + 4 * lane + 256 * j) * 2) = ph; *(LAS u32x2*)(hlo + (lr * 1032 + 4 * lane + 256 * j) * 2) = pl; } }
        __syncthreads();
        f32x4 acc[3] = {};
#pragma unroll
        for (int ks = 0; ks < 4; ++ks) { const int ao = ((lane & 15) * 1032 + 128 * w + 32 * ks + 8 * (lane >> 4)) * 2;
            const bf16x8 ahi = *(const LAS bf16x8*)(hhi + ao), alo = *(const LAS bf16x8*)(hlo + ao);
#pragma unroll
            for (int nt = 0; nt < 3; ++nt) { acc[nt] = mfma16(ahi, whi[ks][nt], acc[nt]); acc[nt] = mfma16(ahi, wlo[ks][nt], acc[nt]); acc[nt] = mfma16(alo, whi[ks][nt], acc[nt]); } }
#pragma unroll
        for (int nt = 0; nt < 3; ++nt)
#pragma unroll
            for (int r = 0; r < 4; ++r) part[(w * 16 + 4 * (lane >> 4) + r) * 48 + 16 * nt + (lane & 15)] = acc[nt][r];
        __syncthreads();
        for (int t = tid; t < 576; t += 512) { const int r = t / 36, c = t - r * 36; float sacc = 0.f;
#pragma unroll
            for (int q = 0; q < 8; ++q) sacc += part[(q * 16 + r) * 48 + c];
            lg[r * 40 + c] = sacc + (c < 32 ? be[c] : bg[c - 32]); }
        __syncthreads();
        if (tid < 16) { const int row = base + tid; const LAS float* lr = lg + tid * 40;
            int gi = 0; float gm = lr[32];
#pragma unroll
            for (int i = 1; i < 4; ++i) if (lr[32 + i] > gm) { gm = lr[32 + i]; gi = i; }
            float gs = 0.f;
#pragma unroll
            for (int i = 0; i < 4; ++i) gs += __expf(lr[32 + i] - gm);
            const float gw_ = 1.f / gs;
            const LAS float* el = lr + gi * 8;
            int i1 = 0; float v1 = el[0];
#pragma unroll
            for (int j = 1; j < 8; ++j) if (el[j] > v1) { v1 = el[j]; i1 = j; }
            int i2 = -1; float v2 = -3.0e38f;
#pragma unroll
            for (int j = 0; j < 8; ++j) if (j != i1 && el[j] > v2) { v2 = el[j]; i2 = j; }
            const float e2 = __expf(v2 - v1), g1 = gw_ / (1.f + e2), g2 = gw_ * e2 / (1.f + e2);
            const int e0 = gi * 8 + i1, e1 = gi * 8 + i2;
            const unsigned r0 = __hip_atomic_fetch_add(cnt + e0 * 64, 1u, __ATOMIC_RELAXED, __HIP_MEMORY_SCOPE_AGENT), r1 = __hip_atomic_fetch_add(cnt + e1 * 64, 1u, __ATOMIC_RELAXED, __HIP_MEMORY_SCOPE_AGENT);
            *(int4*)(ri + (size_t)row * 4) = make_int4(e0, e1, (int)r0, (int)r1);
            { int* lists = (int*)(F.ws + WS_LISTS); lists[(size_t)e0 * MTOK + r0] = row; lists[(size_t)e1 * MTOK + r1] = row; }
            rg[(size_t)row * 2 + 0] = g1; rg[(size_t)row * 2 + 1] = g2; }
    }
}
__device__ __forceinline__ int moe_starts(Frame& F, int l, int& total) {
    unsigned* cnt = (unsigned*)(F.ws + WS_CTL) + CW_CNT + l * 32 * 64;
    const int c = F.lane < 32 ? (int)__hip_atomic_load(cnt + (F.lane & 31) * 64, __ATOMIC_RELAXED, __HIP_MEMORY_SCOPE_AGENT) : 0;
    const int padded = (c + 255) & ~255; int incl = padded;
#pragma unroll
    for (int o = 1; o < 32; o <<= 1) { const int t = shfl_i(incl, F.lane - o); if (F.lane >= o) incl += t; }
    total = shfl_i(incl, 31);
    return incl - padded;
}
__device__ __forceinline__ void moe_gather_phase(Frame& F, int l, int nrows) {
    const bf16_t* H = (const bf16_t*)(F.ws + WS_H); bf16_t* XS = (bf16_t*)(F.ws + WS_Z + MZ_XS); const int* ri = (const int*)(F.ws + WS_ROUTE);
    int total; const int st = moe_starts(F, l, total);
    for (int row = F.gw; row < nrows; row += F.NGW) {
        const int e0 = ri[(size_t)row * 4], e1 = ri[(size_t)row * 4 + 1], r0 = ri[(size_t)row * 4 + 2], r1 = ri[(size_t)row * 4 + 3];
        const int d0 = shfl_i(st, e0) + r0, d1 = shfl_i(st, e1) + r1;
#pragma unroll
        for (int j = 0; j < 2; ++j) { const u32x4 w = *(const u32x4*)(H + (size_t)row * D + j * 512 + F.lane * 8);
            *(u32x4*)(XS + (size_t)d0 * D + j * 512 + F.lane * 8) = w; *(u32x4*)(XS + (size_t)d1 * D + j * 512 + F.lane * 8) = w; }
    }
}
__device__ __forceinline__ int moe_unit_wgid(int L, int nunits) { const int q = nunits / 8, r = nunits % 8, xcd = L % 8, off = L / 8; return (xcd < r ? xcd * (q + 1) : r * (q + 1) + (xcd - r) * q) + off; }
struct MoeOrder {
    int nunits, G, c; const LAS int* tile_e; const LAS int* rows;
    __device__ bool next(int i, pg8::Unit& u) const {
        const long L = (long)i * G + c; if (L >= nunits) return false;
        const int wgid = moe_unit_wgid((int)L, nunits), tile = wgid >> 2; const int te = tile_e[tile]; u.pm = tile; u.pn = (te & 255) * 4 + (wgid & 3); u.h = (te & 256) ? 0 : -1; return true;
    }
    __device__ unsigned a_row(int ui, int r) const { return (unsigned)rows[ui * 256 + r]; }
};
__device__ __forceinline__ int moe_build_tiles(Frame& F, int l, bool fill_rows) {
    LAS int* tbl = (LAS int*)(F.lds + TBL_OFF);
    __syncthreads();
    if (F.wave == 0) { int total; const int st = moe_starts(F, l, total); if (F.lane < 32) { tbl[F.lane] = st;
            tbl[256 + F.lane] = (int)__hip_atomic_load((unsigned*)(F.ws + WS_CTL) + CW_CNT + (l * 32 + F.lane) * 64, __ATOMIC_RELAXED, __HIP_MEMORY_SCOPE_AGENT); }
        if (F.lane == 0) tbl[32] = total; }
    __syncthreads();
    const int total = tbl[32], ntiles = total >> 8;
    for (int t = F.tid; t < ntiles; t += 512) { int e = 0;
#pragma unroll
        for (int j = 1; j < 32; ++j) if (tbl[j] <= t * 256) e = j;
        tbl[64 + t] = e | ((tbl[256 + e] - (t * 256 - tbl[e]) <= 128) ? 256 : 0); }
    __syncthreads();
    if (fill_rows) { const int* lists = (const int*)(F.ws + WS_LISTS); const int nunits = ntiles * 4;
        for (int x = F.tid; x < 768; x += 512) { const int ui = x >> 8, r = x & 255, L = ui * F.G + (int)blockIdx.x; int src = 0;
            if (L < nunits) { const int tile = moe_unit_wgid(L, nunits) >> 2, e = tbl[64 + tile] & 255, rank = tile * 256 - tbl[e] + r; if (rank < tbl[256 + e]) src = lists[(size_t)e * MTOK + rank]; }
            tbl[512 + x] = src; }
        __syncthreads(); }
    return ntiles;
}
__device__ __forceinline__ void moe_combine_phase(Frame& F, ArgsP a, int l, int nrows, bool dry = false) {
    float* X = (float*)(F.ws + WS_X); float* Xo = dry ? (float*)(F.ws + WS_Z + 132 * MiB) : X; float* outp = dry ? Xo : a->out; bf16_t* H = (bf16_t*)(F.ws + WS_H); const bf16_t* Y = (const bf16_t*)(F.ws + WS_Z + MZ_XS);
    const int* ri = (const int*)(F.ws + WS_ROUTE); const float* rg = (const float*)(F.ws + WS_ROUTE + (size_t)MTOK * 16);
    const float* modv = (const float*)(F.ws + WS_MODV);
    int total; const int st = moe_starts(F, l, total);
    for (int row = F.gw; row < nrows; row += F.NGW) {
        const int e0 = ri[(size_t)row * 4], e1 = ri[(size_t)row * 4 + 1], r0 = ri[(size_t)row * 4 + 2], r1 = ri[(size_t)row * 4 + 3];
        const int p0 = shfl_i(st, e0) + r0, p1 = shfl_i(st, e1) + r1; const float g0 = rg[(size_t)row * 2], g1 = rg[(size_t)row * 2 + 1];
        const float* mv = modv + ((size_t)l * 9 + tok_modrow(row)) * 6144;
        f32x4 v[4];
#pragma unroll
        for (int j = 0; j < 4; ++j) { const int c = 4 * F.lane + 256 * j;
            const u32x2 y0 = *(const u32x2*)(Y + (size_t)p0 * D + c), y1 = *(const u32x2*)(Y + (size_t)p1 * D + c);
            const f32x4 f = { g0 * bflo(y0.x) + g1 * bflo(y1.x), g0 * bfhi(y0.x) + g1 * bfhi(y1.x), g0 * bflo(y0.y) + g1 * bflo(y1.y), g0 * bfhi(y0.y) + g1 * bfhi(y1.y) };
            v[j] = *(const f32x4*)(X + (size_t)row * D + c) + *(const f32x4*)(mv + 5 * 1024 + c) * f; }
        if (l == 0) {
#pragma unroll
            for (int j = 0; j < 4; ++j) *(f32x4*)(Xo + (size_t)row * D + 4 * F.lane + 256 * j) = v[j];
            f32x4 h[4]; const float* mv1 = modv + ((size_t)9 + tok_modrow(row)) * 6144;
            norm_mod_row(v, h, a->in[6] + D, mv1, mv1 + 1024, F.lane);
            store_row_bf16(H + (size_t)row * D, h, F.lane);
        } else {
            float ss = 0.f;
#pragma unroll
            for (int j = 0; j < 4; ++j) ss += (v[j][0] * v[j][0] + v[j][1] * v[j][1]) + (v[j][2] * v[j][2] + v[j][3] * v[j][3]);
            const float rstd = rsqrtf(wave_sum(ss) * (1.f / D) + EPS);
#pragma unroll
            for (int j = 0; j < 4; ++j) { const int c = 4 * F.lane + 256 * j; *(f32x4*)(outp + (size_t)row * D + c) = v[j] * rstd * *(const f32x4*)(a->in[37] + c); }
        }
    }
}

#define REOPAQUE() { unsigned m1_ = ~0u; asm volatile("" : "+s"(m1_)); int ln_ = __builtin_amdgcn_mbcnt_hi(m1_, __builtin_amdgcn_mbcnt_lo(m1_, 0u)); asm volatile("" : "+v"(ln_)); F.lane = ln_; F.wave = wave_s; F.tid = wave_s * 64 + ln_; F.gw = F.vcu * NWAVES + F.wave; int z_ = 0; asm volatile("" : "+s"(z_)); args = (ArgsP)__builtin_amdgcn_kernarg_segment_ptr() + z_; F.ws = args->ws; }
#define PH_BEGIN if (ph >= lo && ph < hi) { REOPAQUE()
#define PH_END } if (ph >= lo && ph + 1 < hi) { if (!MK_PER_PHASE) REP(15) xcd_barrier_fn(bar.bar, bar.x, (unsigned)(uintptr_t)bar.st, F.tid); } ++ph;

#define pH ((bf16_t*)(F.ws + WS_H))
#define pZ ((bf16_t*)(F.ws + WS_Z))
#define pX ((float*)(F.ws + WS_X))
#define pMix (F.ws + WS_MIX)
#define pSsq ((float*)(F.ws + WS_SSQ))
#define pRope ((const float*)(F.ws + WS_ROPE))
#define pWl (F.ws + WS_WB + (size_t)l * WL_STRIDE)
#define pModv ((const float*)(F.ws + WS_MODV) + (size_t)l * 9 * 6144)


template <int l> __device__ __forceinline__ void layer_prog(Frame& F, ArgsP& args, int& ph, const int lo, const int hi, const XcdBarrier& bar, const int wave_s) {
        const bool need_ctx = (l == 0); const int nrows = need_ctx ? MTOK : NLAT;

        PH_BEGIN REP(1) { pg8::Gemm g{pH, (const bf16_t*)(pWl + WL_WIN), D, D, D};
            Epi<EM_Z> E{}; E.ssq = pSsq; E.rope = pRope; E.o0 = pZ; E.o1 = (bf16_t*)(pMix + MX_KPE); E.o2 = (bf16_t*)(pMix + MX_S5A);
            if constexpr (l == 0) { pg8::StaticOrder S; S.init(MTOK, ZC, F.G, (int)blockIdx.x); pg8::gemm_phase(F.lds, F.tid, g, S, E); }
            else { WinOrderLast S; S.S0.init(NLAT, ZC, F.G, (int)blockIdx.x); S.G = F.G; S.c = (int)blockIdx.x; pg8::gemm_phase(F.lds, F.tid, g, S, E); } } PH_END

        PH_BEGIN {
            REP(2) { pg8::Gemm g{pZ + ZCQ, (const bf16_t*)(pWl + WL_UQ), 256, ZC, 256}; pg8::StaticOrder S; S.init(nrows, 768, F.G, ((int)blockIdx.x + F.G - 32) % F.G);
              Epi<EM_Q> E{}; E.ssq = pSsq; E.rope = pRope; E.o0 = (bf16_t*)(pMix + MX_Q); pg8::gemm_phase(F.lds, F.tid, g, S, E); }
            REOPAQUE()
            REP(2) { pg8::Gemm g{pZ + ZCKV, (const bf16_t*)(pWl + WL_UKV), 128, ZC, 128}; pg8::StaticOrder S; S.init(MTOK, 1024, F.G, (int)blockIdx.x);
              Epi<EM_KV> E{}; E.ssq = pSsq; E.o0 = (bf16_t*)(pMix + MX_KN); E.o1 = (bf16_t*)(pMix + MX_V); pg8::gemm_phase(F.lds, F.tid, g, S, E); }
            REOPAQUE()
#if NAIVE_S5
            s5_naive(F, args, l);
#else
            REP(3) s5_state_phase(F, l);
#endif
            REOPAQUE()
#if NAIVE_HG
            hg_naive(F, args, l);
#else
            REP(4) hg_local_phase(F, args, l);
#endif
        } PH_END

        PH_BEGIN {
#if NAIVE_ATTN
            attn_naive(F, need_ctx);
#else
#if PROBE_PH >= 50 && PROBE_PH < 60
            attn_fast<PROBE_PH - 49>(F, need_ctx, (bf16_t*)args->out); REOPAQUE()
#endif
            attn_fast<0>(F, need_ctx, (bf16_t*)(pMix + MX_YMLA));
#endif
            REOPAQUE()
#if NAIVE_S5
            s5_naive_finish(F, args, l, nrows);
#else
            REP(6) { pg8::Gemm g{(const bf16_t*)(pMix + MX_S5A), (const bf16_t*)(pWl + WL_B2), 512, 512, 512}; S5Order S{F.G, (F.vcu + F.G - 64) % F.G};
              Epi<EM_S5> E{}; E.o0 = (bf16_t*)(pMix + MX_YS5P); E.i0 = (const bf16_t*)(pMix + MX_S5A); E.f0 = args->in[16] + l * 256; pg8::gemm_phase(F.lds, F.tid, g, S, E); }
#endif
            REOPAQUE()
#if NAIVE_HG
            hg_naive_finish(F, args, l, nrows);
#else
            hg_scan_phase(F);
#endif
        } PH_END

        PH_BEGIN {
#if !NAIVE_HG
            REP(7) hg_out_phase(F, args, l, need_ctx);
            REOPAQUE()
#endif
            REP(8) { pg8::Gemm g{(const bf16_t*)(pMix + MX_YS5P), (const bf16_t*)(pWl + WL_GLU), 256, 256, 256}; pg8::StaticOrder S; S.init(nrows, 256, F.G, (F.vcu + F.G - 128) % F.G);
            Epi<EM_GLU> E{}; E.o0 = (bf16_t*)(pMix + MX_YS5); E.i0 = (const bf16_t*)(pMix + MX_YS5P); E.f0 = args->in[18] + l * 256;
            pg8::gemm_phase(F.lds, F.tid, g, S, E); } } PH_END

        PH_BEGIN {
#define MERGE3(S) do { \
            { pg8::Gemm g{(const bf16_t*)(pMix + MX_YS5), (const bf16_t*)(pWl + WL_PA), 256, 256, 256}; Epi<EM_MERGE0> E{}; E.o0 = pH; E.i0 = pZ + ZGA; pg8::gemm_phase(F.lds, F.tid, g, S, E); } \
            { pg8::Gemm g{(const bf16_t*)(pMix + MX_YMLA), (const bf16_t*)(pWl + WL_PB), 512, 512, 512}; Epi<EM_MERGE1> E{}; E.o0 = pH; E.i0 = pZ + ZGB; pg8::gemm_phase(F.lds, F.tid, g, S, E); } \
            { pg8::Gemm g{(const bf16_t*)(pMix + MX_YHG), (const bf16_t*)(pWl + WL_PC), 256, 256, 256}; Epi<EM_MERGE1> E{}; E.o0 = pH; E.i0 = pZ + ZGC; pg8::gemm_phase(F.lds, F.tid, g, S, E); } } while (0)
            if constexpr (l == 0) { HalfTailOrder S; S.S0.init(NLAT, 1024, F.G, (int)blockIdx.x); S.G = F.G; S.c = (int)blockIdx.x; MERGE3(S); }
            else { pg8::StaticOrder S; S.init(NLAT, 1024, F.G, (int)blockIdx.x); MERGE3(S); }
#undef MERGE3
        } PH_END

        PH_BEGIN { pg8::Gemm g{pH, (const bf16_t*)(pWl + WL_OUT), D, D, D};
            Epi<EM_WOUT> E{}; E.layer = l; E.f0 = pModv; E.f1 = args->in[0]; E.f2 = args->in[2]; E.fo = pX;
            if constexpr (l == 0) { HalfTailOrder S; S.S0.init(NLAT, 1024, F.G, (int)blockIdx.x); S.G = F.G; S.c = (int)blockIdx.x; pg8::gemm_phase(F.lds, F.tid, g, S, E); }
            else { pg8::StaticOrder S; S.init(NLAT, 1024, F.G, (int)blockIdx.x); pg8::gemm_phase(F.lds, F.tid, g, S, E); } } PH_END

        PH_BEGIN { norm2_router_phase(F, args, l, nrows); REOPAQUE() REP(11) moe_convert(F, args, l); } PH_END
        PH_BEGIN REP(13) { const int nt = moe_build_tiles(F, l, true); MoeOrder S{nt * 4, F.G, (int)blockIdx.x, (const LAS int*)(F.lds + TBL_OFF) + 64, (const LAS int*)(F.lds + TBL_OFF) + 512};
            pg8::Gemm g{pH, (const bf16_t*)(pMix + MW_W13), D, D, D};
            Epi<EM_MOEUP> E{}; E.o0 = (bf16_t*)(F.ws + WS_Z + MZ_HID); pg8::gemm_phase<Epi<EM_MOEUP>, MoeOrder, true>(F.lds, F.tid, g, S, E); } PH_END
        PH_BEGIN REP(14) { const int nt = moe_build_tiles(F, l, false); MoeOrder S{nt * 4, F.G, (int)blockIdx.x, (const LAS int*)(F.lds + TBL_OFF) + 64, (const LAS int*)(F.lds + TBL_OFF) + 512};
            pg8::Gemm g{(const bf16_t*)(F.ws + WS_Z + MZ_HID), (const bf16_t*)(pMix + MW_W2), HID, HID, HID};
            Epi<EM_MOEDN> E{}; E.o0 = (bf16_t*)(F.ws + WS_Z + MZ_XS); pg8::gemm_phase(F.lds, F.tid, g, S, E); } PH_END
        PH_BEGIN { if (PROBE_PH == 19) { moe_combine_phase(F, args, l, nrows, true); REOPAQUE() } moe_combine_phase(F, args, l, nrows); } PH_END
    }

__global__ void __launch_bounds__(NWAVES * 64, 2) mega_fwd(Args args_by_value) {
    ArgsP args = (ArgsP)__builtin_amdgcn_kernarg_segment_ptr();
    extern __shared__ __attribute__((aligned(16))) unsigned char lds_raw[];
    Frame F;
    F.lds = (LAS unsigned char*)lds_raw;
    F.tid = threadIdx.x; F.lane = F.tid & 63; F.wave = __builtin_amdgcn_readfirstlane(F.tid >> 6);
    const int wave_s = F.wave;
    F.G = gridDim.x; { const int bx = blockIdx.x; F.vcu = (F.G % 8 == 0) ? (bx % 8) * (F.G / 8) + bx / 8 : bx; }
    F.gw = F.vcu * NWAVES + F.wave; F.NGW = F.G * NWAVES; F.ws = args->ws;
    volatile LAS unsigned* MISC = (volatile LAS unsigned*)(F.lds + MISC_OFF);
    for (int u = F.tid; u < (LDS_BYTES - RING_BYTES) / 4; u += NWAVES * 64) ((LAS unsigned*)(F.lds + RING_BYTES))[u] = 0u;
    __syncthreads();
    unsigned* ctl = (unsigned*)(F.ws + WS_CTL);
    XcdBarrier bar; bar.bar = ctl + CW_BAR; bar.x = 0; bar.st = nullptr;
    if (!MK_PER_PHASE) bar = xcd_barrier_post(ctl + CW_BAR, MISC + 8);
    const int lo = args->ph_lo, hi = args->ph_hi;
    int ph = 0;
    PH_BEGIN REP(17) prologue_phase(F, args); PH_END
    PH_BEGIN REP(16) norm1_phase(F, args, 0, MTOK); PH_END

    layer_prog<0>(F, args, ph, lo, hi, bar, wave_s);
    layer_prog<1>(F, args, ph, lo, hi, bar, wave_s);
#undef PH_BEGIN
#undef REOPAQUE
#undef PH_END
#undef pH
#undef pZ
#undef pX
#undef pMix
#undef pSsq
#undef pRope
#undef pWl
#undef pModv
}
constexpr int N_PHASES = 2 + 2 * 10;

extern "C" void kernel_launch(void* const* d_in, const int* in_sizes, int n_in, void* d_out, int out_size, void* d_ws, size_t ws_size, hipStream_t stream) {
    static int grid = 0;
    if (grid == 0) {
        if (n_in != 38 || out_size != NLAT * D || ws_size < WS_END) { fprintf(stderr, "kernel_launch: unexpected shapes (n_in %d out %d ws %zu need %zu)\n", n_in, out_size, ws_size, (size_t)WS_END); grid = -1; return; }
        int dev = 0, cus = 0, per_cu = 0;
        if (hipGetDevice(&dev) != hipSuccess || hipDeviceGetAttribute(&cus, hipDeviceAttributeMultiprocessorCount, dev) != hipSuccess) { grid = -1; return; }
        if (hipFuncSetAttribute((const void*)mega_fwd, hipFuncAttributeMaxDynamicSharedMemorySize, LDS_BYTES) != hipSuccess) { fprintf(stderr, "kernel_launch: hipFuncSetAttribute failed\n"); grid = -1; return; }
        if (hipOccupancyMaxActiveBlocksPerMultiprocessor(&per_cu, (const void*)mega_fwd, NWAVES * 64, LDS_BYTES) != hipSuccess || per_cu < 1) { fprintf(stderr, "kernel_launch: occupancy query says %d\n", per_cu); }
        (void)hipGetLastError();
        grid = cus;
    }
    if (grid < 0) return;
    (void)hipMemsetAsync((char*)d_ws + WS_CTL, 0, CTL_ZERO_BYTES, stream);
    Args a{};
    for (int i = 0; i < 38; ++i) a.in[i] = (const float*)d_in[i];
    a.out = (float*)d_out; a.ws = (unsigned char*)d_ws;
#if MK_PER_PHASE
    for (int p = 0; p < N_PHASES; ++p) { a.ph_lo = p; a.ph_hi = p + 1; hipLaunchKernelGGL(mega_fwd, dim3(grid), dim3(NWAVES * 64), LDS_BYTES, stream, a); }
#else
    a.ph_lo = 0; a.ph_hi = N_PHASES;
    hipLaunchKernelGGL(mega_fwd, dim3(grid), dim3(NWAVES * 64), LDS_BYTES, stream, a);
#endif
}
```

```cpp
#include <hip/hip_runtime.h>
#include <cstdio>
#include <cstdint>

#ifndef NAIVE_ATTN
#define NAIVE_ATTN 0
#endif
#ifndef NAIVE_S5
#define NAIVE_S5 0
#endif
#ifndef NAIVE_HG
#define NAIVE_HG 0
#endif
#ifndef PROBE_PH
#define PROBE_PH 0
#endif
#ifndef PROBE_N
#define PROBE_N 1
#endif
#define REP(id) for (int rep_ = 0; rep_ < ((PROBE_PH == (id)) ? PROBE_N : 1); ++rep_)
#ifndef MK_PER_PHASE
#define MK_PER_PHASE 0
#endif

#define GAS __attribute__((address_space(1)))
#define LAS __attribute__((address_space(3)))
typedef unsigned short bf16_t;
typedef short bf16x8 __attribute__((ext_vector_type(8)));
typedef float f32x4 __attribute__((ext_vector_type(4)));
typedef float f32x2 __attribute__((ext_vector_type(2)));
typedef float f32x16 __attribute__((ext_vector_type(16)));
typedef unsigned u32x4 __attribute__((ext_vector_type(4)));
typedef unsigned u32x2 __attribute__((ext_vector_type(2)));
typedef GAS unsigned gu32;

constexpr int D = 1024, NB = 8, SEQ = 2048, CTXL = 256, NLAT = NB * SEQ, NCTX = NB * CTXL, MTOK = NLAT + NCTX;
constexpr int ZC = 5888, INC = 5792;
constexpr int ZU = 0, ZCQ = 256, ZCKV = 512, ZKPE = 640, ZHQ = 672, ZF0 = 1184, ZF1 = 1696, ZI = 2208, ZG = 2464, ZGA = 2720, ZGB = 3744, ZGC = 4768;
constexpr float EPS = 1e-6f;
constexpr float QSCALE = 0.10206207261596577f * 1.4426950408889634f;
constexpr int NEXP = 32, HID = 512;
constexpr int XS_ROWS = 45056;

constexpr size_t MiB = 1u << 20;
constexpr size_t WS_CTL = 0, CTL_ZERO_BYTES = 96 * 1024;
constexpr size_t WS_MODV = 1 * MiB;
constexpr size_t WS_ROPE = 2 * MiB;
constexpr size_t WS_SSQ = 2 * MiB + 65536;
constexpr size_t WS_ROUTE = 3 * MiB;
constexpr size_t WS_S5P = 4 * MiB;
constexpr size_t WS_LISTS = 5 * MiB;
constexpr size_t WS_WB = 8 * MiB;
constexpr size_t WL_WIN = 0, WL_UQ = WL_WIN + (size_t)ZC * D * 2, WL_UKV = WL_UQ + 768 * 256 * 2, WL_GLU = WL_UKV + 1024 * 128 * 2,
                 WL_PA = WL_GLU + 256 * 256 * 2, WL_PB = WL_PA + 1024 * 256 * 2, WL_PC = WL_PB + 1024 * 512 * 2, WL_OUT = WL_PC + 1024 * 256 * 2,
                 WL_BS = WL_OUT + 1024 * 1024 * 2, WL_B2 = WL_BS + 32 * 128 * 256 * 2, WL_END = WL_B2 + 16 * 256 * 512 * 2;
constexpr size_t WL_STRIDE = 24 * MiB;
static_assert(WL_END <= WL_STRIDE, "weights per layer");
constexpr size_t WS_X = 56 * MiB;
constexpr size_t WS_H = 128 * MiB;
constexpr size_t WS_MIX = 164 * MiB;
constexpr size_t MX_Q = 0, MX_KN = MX_Q + (size_t)MTOK * 768 * 2, MX_V = MX_KN + (size_t)MTOK * 512 * 2, MX_KPE = MX_V + (size_t)MTOK * 512 * 2,
                 MX_YS5P = MX_KPE + (size_t)MTOK * 32 * 2, MX_YS5 = MX_YS5P + (size_t)MTOK * 256 * 2, MX_YHG = MX_YS5 + (size_t)MTOK * 256 * 2,
                 MX_YMLA = MX_YHG + (size_t)MTOK * 256 * 2, MX_S5A = MX_YMLA + (size_t)MTOK * 512 * 2, MX_HGD = MX_S5A + (size_t)16 * 1280 * 512 * 2,
                 MX_END = MX_HGD + (size_t)2304 * 128 * 4;
static_assert(MX_END <= 132 * MiB, "mixer region");
constexpr size_t MW_W13 = 0, MW_W2 = (size_t)NEXP * 1024 * 1024 * 2;
static_assert(MW_W2 + (size_t)NEXP * 1024 * 512 * 2 <= 132 * MiB, "moe weights");
constexpr size_t WS_Z = 296 * MiB;
constexpr size_t MZ_XS = 0, MZ_HID = (size_t)XS_ROWS * 1024 * 2;
constexpr size_t WS_END = WS_Z + (size_t)MTOK * ZC * 2;
static_assert(MZ_HID + (size_t)XS_ROWS * 512 * 2 <= (size_t)MTOK * ZC * 2, "moe buffers");
constexpr int CW_BAR = 4096;
constexpr int CW_CNT = 16384;

__device__ __forceinline__ unsigned f2bf(float f) { unsigned u = __builtin_bit_cast(unsigned, f); return (u + 0x7fffu + ((u >> 16) & 1u)) >> 16; }
typedef __bf16 bf16x2_t __attribute__((ext_vector_type(2)));
__device__ __forceinline__ unsigned pk2(float lo, float hi) { const f32x2 v = {lo, hi}; return __builtin_bit_cast(unsigned, __builtin_convertvector(v, bf16x2_t)); }
__device__ __forceinline__ float bf2f(unsigned short b) { return __builtin_bit_cast(float, (unsigned)b << 16); }
__device__ __forceinline__ float bflo(unsigned w) { return __builtin_bit_cast(float, w << 16); }
__device__ __forceinline__ float bfhi(unsigned w) { return __builtin_bit_cast(float, w & 0xffff0000u); }
template <int CTRL> __device__ __forceinline__ float dppf(float v) { return __builtin_bit_cast(float, __builtin_amdgcn_update_dpp(0, __builtin_bit_cast(int, v), CTRL, 0xf, 0xf, true)); }
__device__ __forceinline__ float rlanef(float v, int l) { return __builtin_bit_cast(float, __builtin_amdgcn_readlane(__builtin_bit_cast(int, v), l)); }
__device__ __forceinline__ float wave_sum(float v) {
    v += dppf<0xB1>(v); v += dppf<0x4E>(v); v += dppf<0x141>(v); v += dppf<0x140>(v);
    return (rlanef(v, 0) + rlanef(v, 16)) + (rlanef(v, 32) + rlanef(v, 48));
}
__device__ __forceinline__ int shfl_i(int v, int src_lane) { return __builtin_amdgcn_ds_bpermute(src_lane << 2, v); }
__device__ __forceinline__ float shfl_f(float v, int src_lane) { return __builtin_bit_cast(float, __builtin_amdgcn_ds_bpermute(src_lane << 2, __builtin_bit_cast(int, v))); }
__device__ __forceinline__ float sigmoidf_(float x) { return __builtin_amdgcn_rcpf(1.f + __expf(-x)); }
__device__ __forceinline__ float siluf_(float x) { return x * __builtin_amdgcn_rcpf(1.f + __expf(-x)); }
__device__ __forceinline__ float gelu_tanh(float x) { const float t = 0.7978845608028654f * (x + 0.044715f * x * x * x); return x * __builtin_amdgcn_rcpf(1.f + __expf(-2.f * t)); }
__device__ __forceinline__ int tok_modrow(int row) { return row < NLAT ? (row >> 11) : 8; }

namespace pg8 {
constexpr int BM = 256, BK = 64, HALF = 128, HTB = HALF * BK * 2, STAGE_BYTES = 8 * HTB, NXCD = 8, WGM = 8;
__host__ __device__ __forceinline__ int lds_byte(int r, int c) { const int st = (r >> 4) * 2 + (c >> 5), rr = r & 15, cc = c & 31, ob = rr * 64 + cc * 2; return st * 1024 + (ob ^ (((ob >> 9) & 1) << 5)); }
__host__ __device__ __forceinline__ void stage_rc(int b, int& R, int& C) { const int st = b / 1024, sb = b % 1024, swz = sb ^ (((sb >> 9) & 1) << 5); R = (st >> 1) * 16 + swz / 64; C = (st & 1) * 32 + (swz % 64) / 2; }
__host__ __device__ __forceinline__ int perm32(int rho) { const int n = rho >> 4, i = rho & 15; return 8 * (i >> 2) + 4 * n + (i & 3); }
struct Unit { int pm, pn, h; };
struct Gemm { const bf16_t* A; const bf16_t* Bt; int K, lda, ldb; };
struct StaticOrder {
    int nM, nN, nwg, G, c;
    __device__ void init(int M, int N, int G_, int c_) { nM = M / BM; nN = N / BM; nwg = nM * nN; G = G_; c = c_; }
    __device__ bool next(int i, Unit& u) const {
        const long L = (long)i * G + c; if (L >= nwg) return false;
        int wgid = (int)L; { const int q = nwg / NXCD, r = nwg % NXCD, xcd = wgid % NXCD, off = wgid / NXCD; wgid = (xcd < r ? xcd * (q + 1) : r * (q + 1) + (xcd - r) * q) + off; }
        const int nig = WGM * nN, gid = wgid / nig, fm = gid * WGM, gsz = (nM - fm) < WGM ? (nM - fm) : WGM;
        u.pm = fm + ((wgid % nig) % gsz); u.pn = (wgid % nig) / gsz; u.h = -1; return true;
    }
};
template <class Epi, class Sched, bool GATHER = false, bool HALFS = false>
__device__ __forceinline__ void gemm_phase(LAS unsigned char* lds, int tid_in, const Gemm g, const Sched& S, const Epi& E) {
    int tid_ = tid_in; asm volatile("" : "+v"(tid_));
    const int tid = tid_, wid = __builtin_amdgcn_readfirstlane(tid >> 6), lane = tid & 63, wr = wid >> 2, wc = wid & 3, fr = lane & 15, fq = lane >> 4;
    const int K = g.K, nt = K / BK;
    unsigned voffB[2], vAc[2][2], vAx[2][2];
#pragma unroll
    for (int i = 0; i < 2; ++i) { int R, C; stage_rc(tid * 16 + i * 8192, R, C); const int Rb = (R & ~31) + perm32(R & 31);
        voffB[i] = (unsigned)(Rb * g.ldb + C) * 2u;
#pragma unroll
        for (int h = 0; h < 2; ++h) vAc[h][i] = vAx[h][i] = (unsigned)((R + 128 * h) * g.lda + C) * 2u; }
#define PG8_GROWS(dst, uidx) do { if constexpr (GATHER) { _Pragma("unroll") for (int i_ = 0; i_ < 2; ++i_) { int R_, C_; stage_rc(tid * 16 + i_ * 8192, R_, C_); \
        _Pragma("unroll") for (int h_ = 0; h_ < 2; ++h_) dst[h_][i_] = (unsigned)(S.a_row((uidx), R_ + 128 * h_) * g.lda + C_) * 2u; } } } while (0)
    const size_t kstep = (size_t)(BK * 2);
    const size_t hstepA = (size_t)HALF * g.lda * 2, hstepB = (size_t)HALF * g.ldb * 2;
    const size_t tstepA = 2 * hstepA, tstepB = 2 * hstepB;
    const unsigned ldsw = (unsigned)wid * 1024u;
    const int aoff = lds_byte(wr * 64 + fr, fq * 8), boff = lds_byte(wc * 32 + fr, fq * 8);
#define PG8_SA(b, h) (((b) * 2 + (h)) * HTB)
#define PG8_SB(b, h) ((4 + (b) * 2 + (h)) * HTB)
#define PG8_STAGE(bufoff, gbase, voff) do { _Pragma("unroll") for (int _i = 0; _i < 2; ++_i) \
        __builtin_amdgcn_global_load_lds((const unsigned*)((const char*)(gbase) + (voff)[_i]), (LAS unsigned*)(lds + (bufoff) + ldsw + _i * 8192), 16, 0, 0); } while (0)
#define PG8_LDA(dst, b, h) do { _Pragma("unroll") for (int m = 0; m < 4; ++m) _Pragma("unroll") for (int k = 0; k < 2; ++k) dst[m][k] = *(const LAS bf16x8*)(lds + PG8_SA(b, h) + aoff + m * 2048 + k * 1024); } while (0)
#define PG8_LDB(dst, b, h) do { _Pragma("unroll") for (int n = 0; n < 2; ++n) _Pragma("unroll") for (int k = 0; k < 2; ++k) dst[n][k] = *(const LAS bf16x8*)(lds + PG8_SB(b, h) + boff + n * 2048 + k * 1024); } while (0)
#define PG8_MMA(ai, bj, At, Bt) do { __builtin_amdgcn_s_setprio(1); _Pragma("unroll") for (int m = 0; m < 4; ++m) _Pragma("unroll") for (int n = 0; n < 2; ++n) _Pragma("unroll") for (int k = 0; k < 2; ++k) \
        acc[ai][bj][m][n] = __builtin_amdgcn_mfma_f32_16x16x32_bf16(Bt[n][k], At[m][k], acc[ai][bj][m][n], 0, 0, 0); __builtin_amdgcn_s_setprio(0); } while (0)
#define PG8_WAIT_V(n) asm volatile("s_waitcnt vmcnt(" #n ")" ::: "memory")
#define PG8_WAIT_L(n) asm volatile("s_waitcnt lgkmcnt(" #n ")" ::: "memory")
#define PG8_BAR __builtin_amdgcn_s_barrier()
#define PG8_SCHED __builtin_amdgcn_sched_barrier(0)
    Unit cur, nxt; int ui = 0;
    if (!S.next(0, cur)) return;
    f32x4 acc[2][2][4][2];
#pragma unroll
    for (int a = 0; a < 2; ++a)
#pragma unroll
        for (int b = 0; b < 2; ++b)
#pragma unroll
            for (int m = 0; m < 4; ++m)
#pragma unroll
                for (int n = 0; n < 2; ++n) acc[a][b][m][n] = (f32x4){0.f, 0.f, 0.f, 0.f};
    bf16x8 At[4][2], B0[2][2], B1[2][2];
    const char* cA = (const char*)g.A + (GATHER ? (size_t)0 : (size_t)cur.pm * tstepA); const char* cB = (const char*)g.Bt + (size_t)cur.pn * tstepB;
    PG8_GROWS(vAc, 0);
    PG8_STAGE(PG8_SB(0, 0), cB, voffB); PG8_STAGE(PG8_SB(0, 1), cB + hstepB, voffB); PG8_STAGE(PG8_SA(0, 0), cA, vAc[0]); PG8_STAGE(PG8_SA(0, 1), cA, vAc[1]);
    if (wr == 1) PG8_BAR;
    PG8_WAIT_V(2); PG8_BAR;
    PG8_STAGE(PG8_SB(1, 0), cB + kstep, voffB); PG8_STAGE(PG8_SA(1, 0), cA + kstep, vAc[0]); PG8_STAGE(PG8_SB(1, 1), cB + hstepB + kstep, voffB);
    PG8_WAIT_V(6); PG8_BAR;
    for (;;) {
        const bool has_next = S.next(ui + 1, nxt);
        const char* nA = (has_next && !GATHER) ? (const char*)g.A + (size_t)nxt.pm * tstepA : cA;
        if constexpr (GATHER) { if (has_next) PG8_GROWS(vAx, ui + 1); else {
#pragma unroll
            for (int h = 0; h < 2; ++h) { vAx[h][0] = vAc[h][0]; vAx[h][1] = vAc[h][1]; } } }
        const char* nB = has_next ? (const char*)g.Bt + (size_t)nxt.pn * tstepB : cB;
        for (int t = 0; t < nt; t += 2) {
            const bool last = (t == nt - 2);
            const char* a1 = cA + (size_t)(t + 1) * kstep;
            const char* a2 = last ? nA : cA + (size_t)(t + 2) * kstep; const char* b2 = last ? nB : cB + (size_t)(t + 2) * kstep;
            const char* a3 = a2 + kstep; const char* b3 = b2 + kstep;
            unsigned vS0[2], vS1[2];
            if constexpr (GATHER) { vS0[0] = last ? vAx[0][0] : vAc[0][0]; vS0[1] = last ? vAx[0][1] : vAc[0][1]; vS1[0] = last ? vAx[1][0] : vAc[1][0]; vS1[1] = last ? vAx[1][1] : vAc[1][1]; }
            else { vS0[0] = vAc[0][0]; vS0[1] = vAc[0][1]; vS1[0] = vAc[1][0]; vS1[1] = vAc[1][1]; }
            PG8_LDB(B0, 0, 0); PG8_LDB(B1, 0, 1); PG8_SCHED; PG8_LDA(At, 0, 0); PG8_STAGE(PG8_SA(1, 1), a1, vAc[1]);
            PG8_WAIT_V(8); PG8_WAIT_L(0); PG8_BAR; if (!HALFS || cur.h != 1) { PG8_MMA(0, 0, At, B0); PG8_MMA(0, 1, At, B1); } PG8_BAR; PG8_SCHED;
            PG8_LDA(At, 0, 1); PG8_STAGE(PG8_SB(0, 0), b2, voffB); PG8_STAGE(PG8_SB(0, 1), b2 + hstepB, voffB); PG8_STAGE(PG8_SA(0, 0), a2, vS0);
            PG8_WAIT_V(8); PG8_WAIT_L(0); PG8_BAR; if (!HALFS || cur.h != 0) { PG8_MMA(1, 0, At, B0); PG8_MMA(1, 1, At, B1); } PG8_BAR; PG8_SCHED;
            PG8_LDB(B0, 1, 0); PG8_LDB(B1, 1, 1); PG8_SCHED; PG8_LDA(At, 1, 0); PG8_STAGE(PG8_SA(0, 1), a2, vS1);
            PG8_WAIT_V(8); PG8_WAIT_L(0); PG8_BAR; if (!HALFS || cur.h != 1) { PG8_MMA(0, 0, At, B0); PG8_MMA(0, 1, At, B1); } PG8_BAR; PG8_SCHED;
            PG8_LDA(At, 1, 1); PG8_STAGE(PG8_SB(1, 0), b3, voffB); PG8_STAGE(PG8_SB(1, 1), b3 + hstepB, voffB); PG8_STAGE(PG8_SA(1, 0), a3, vS0);
            PG8_WAIT_V(8); PG8_WAIT_L(0); PG8_BAR; if (!HALFS || cur.h != 0) { PG8_MMA(1, 0, At, B0); PG8_MMA(1, 1, At, B1); } PG8_BAR; PG8_SCHED;
        }
        if (wr == 0) PG8_BAR;
        E(acc, cur, wr, wc, fr, fq);
        if (!has_next) break;
#pragma unroll
        for (int a = 0; a < 2; ++a)
#pragma unroll
            for (int b = 0; b < 2; ++b)
#pragma unroll
                for (int m = 0; m < 4; ++m)
#pragma unroll
                    for (int n = 0; n < 2; ++n) acc[a][b][m][n] = (f32x4){0.f, 0.f, 0.f, 0.f};
        cur = nxt; cA = nA; cB = nB; ++ui;
        if constexpr (GATHER) {
#pragma unroll
            for (int h = 0; h < 2; ++h) { vAc[h][0] = vAx[h][0]; vAc[h][1] = vAx[h][1]; } }
        if (wr == 1) PG8_BAR;
    }
    PG8_WAIT_V(0);
    PG8_BAR;
#undef PG8_SA
#undef PG8_SB
#undef PG8_STAGE
#undef PG8_GROWS
#undef PG8_LDA
#undef PG8_LDB
#undef PG8_MMA
#undef PG8_WAIT_V
#undef PG8_WAIT_L
#undef PG8_BAR
#undef PG8_SCHED
}
}

enum EpiMode { EM_Z = 0, EM_Q = 1, EM_KV = 2, EM_GLU = 3, EM_MERGE0 = 4, EM_MERGE1 = 5, EM_WOUT = 6, EM_MOEUP = 7, EM_MOEDN = 8, EM_S5 = 9 };
template <int mode> struct Epi {
    bf16_t* o0; bf16_t* o1; bf16_t* o2;
    const bf16_t* i0;
    const float* f0; const float* f1; const float* f2;
    float* fo;
    float* ssq;
    const float* rope;
    int layer;
    struct Side { u32x4 s[4]; };
    __device__ __forceinline__ Side load_side(const pg8::Unit& u, int ai, int m, int wr, int fr, int cl) const {
        Side S; const int row = u.pm * 256 + ai * 128 + wr * 64 + m * 16 + fr;
        if constexpr (mode == EM_Q) S.s[0] = *(const u32x4*)(ssq + (size_t)row * 4);
        else if constexpr (mode == EM_KV) S.s[0] = *(const u32x4*)(ssq + (size_t)MTOK * 4 + (size_t)row * 4);
        else if constexpr (mode == EM_GLU) { S.s[0] = *(const u32x4*)(i0 + (size_t)row * 256 + cl); S.s[1] = *(const u32x4*)(i0 + (size_t)row * 256 + 128 + cl); }
        else if constexpr (mode == EM_MERGE0 || mode == EM_MERGE1) { const int col = u.pn * 256 + cl;
            S.s[0] = *(const u32x4*)(i0 + (size_t)row * ZC + col); S.s[1] = *(const u32x4*)(i0 + (size_t)row * ZC + col + 128);
            if constexpr (mode == EM_MERGE1) { S.s[2] = __builtin_nontemporal_load((const u32x4*)(o0 + (size_t)row * 1024 + col)); S.s[3] = __builtin_nontemporal_load((const u32x4*)(o0 + (size_t)row * 1024 + col + 128)); } }
        else if constexpr (mode == EM_WOUT) { const float* xin = (layer == 0) ? (row < NLAT ? f1 + (size_t)row * D : f2 + (size_t)(row - NLAT) * D) : fo + (size_t)row * D; const int col = u.pn * 256 + cl;
            S.s[0] = *(const u32x4*)(xin + col); S.s[1] = *(const u32x4*)(xin + col + 4); S.s[2] = *(const u32x4*)(xin + col + 128); S.s[3] = *(const u32x4*)(xin + col + 132); }
        else if constexpr (mode == EM_S5) { S.s[0] = *(const u32x4*)(i0 + (size_t)row * 512 + cl); S.s[1] = *(const u32x4*)(i0 + (size_t)row * 512 + 128 + cl); }
        return S;
    }
    __device__ __forceinline__ void operator()(const f32x4 (&acc)[2][2][4][2], const pg8::Unit& u, int wr, int wc, int fr_in, int fq_in) const {
        int fr = fr_in, fq = fq_in; asm volatile("" : "+v"(fr), "+v"(fq));
        const int cl = wc * 32 + 8 * fq;
        f32x4 hc[4] = {};
        if constexpr (mode == EM_GLU) { hc[0] = *(const f32x4*)(f0 + cl); hc[1] = *(const f32x4*)(f0 + cl + 4); hc[2] = *(const f32x4*)(f0 + 128 + cl); hc[3] = *(const f32x4*)(f0 + 128 + cl + 4); }
        if constexpr (mode == EM_WOUT) { const float* gt = f0 + (size_t)tok_modrow(u.pm * 256) * 6144 + 2 * 1024 + u.pn * 256 + cl;
            hc[0] = *(const f32x4*)(gt); hc[1] = *(const f32x4*)(gt + 4); hc[2] = *(const f32x4*)(gt + 128); hc[3] = *(const f32x4*)(gt + 132); }
        if constexpr (mode == EM_S5) { const float* dk = f0 + u.pn * 16 + (cl & 15); hc[0] = *(const f32x4*)(dk); hc[1] = *(const f32x4*)(dk + 4); }
        Side cur = load_side(u, 0, 0, wr, fr, cl);
#pragma unroll
        for (int it = 0; it < 8; ++it) {
                const int ai = it >> 2, m = it & 3;
                if (u.h >= 0 && ai != u.h) { if (it < 7) cur = load_side(u, (it + 1) >> 2, (it + 1) & 3, wr, fr, cl); continue; }
                Side nxt = cur; if (it < 7) nxt = load_side(u, (it + 1) >> 2, (it + 1) & 3, wr, fr, cl);
                asm volatile("" ::: "memory");
                const int row = u.pm * 256 + ai * 128 + wr * 64 + m * 16 + fr;
                if constexpr (mode == EM_Z) {
                    float s0 = 0.f;
#pragma unroll
                    for (int bj = 0; bj < 2; ++bj) {
                        f32x4 v0 = acc[ai][bj][m][0], v1 = acc[ai][bj][m][1];
                        const int col = u.pn * 256 + bj * 128 + cl;
                        if (u.pn == 1 || (u.pn == 2 && bj == 0)) s0 += (v0[0] * v0[0] + v0[1] * v0[1]) + (v0[2] * v0[2] + v0[3] * v0[3]) + (v1[0] * v1[0] + v1[1] * v1[1]) + (v1[2] * v1[2] + v1[3] * v1[3]);
                        if (u.pn == 2 && bj == 1 && wc == 0) {
                            if (row < NLAT) {
                                const int t = row & 2047, pb = 4 * fq, axis = pb >> 3, pos = axis ? (t & 63) : (t >> 6);
                                const float* cs = rope + pos * 8 + (pb & 7); const float* sn = cs + 512;
                                float x1, x2;
                                x1 = v0[0]; x2 = v0[1]; v0[0] = x1 * cs[0] - x2 * sn[0]; v0[1] = x1 * sn[0] + x2 * cs[0];
                                x1 = v0[2]; x2 = v0[3]; v0[2] = x1 * cs[1] - x2 * sn[1]; v0[3] = x1 * sn[1] + x2 * cs[1];
                                x1 = v1[0]; x2 = v1[1]; v1[0] = x1 * cs[2] - x2 * sn[2]; v1[1] = x1 * sn[2] + x2 * cs[2];
                                x1 = v1[2]; x2 = v1[3]; v1[2] = x1 * cs[3] - x2 * sn[3]; v1[3] = x1 * sn[3] + x2 * cs[3];
                            }
                            u32x4 w; w.x = pk2(v0[0], v0[1]); w.y = pk2(v0[2], v0[3]); w.z = pk2(v1[0], v1[1]); w.w = pk2(v1[2], v1[3]);
                            *(u32x4*)(o1 + (size_t)row * 32 + 8 * fq) = w;
                        }
                        u32x4 w; w.x = pk2(v0[0], v0[1]); w.y = pk2(v0[2], v0[3]); w.z = pk2(v1[0], v1[1]); w.w = pk2(v1[2], v1[3]);
                        *(u32x4*)(o0 + (size_t)row * ZC + col) = w;
                        if (u.pn == 0) {
                            int b, s; if (row < NLAT) { b = row >> 11; s = 256 + (row & 2047); } else { b = (row - NLAT) >> 8; s = (row - NLAT) & 255; }
                            const int colu = bj * 128 + cl, g = colu >> 4, h0 = colu & 15;
                            *(u32x4*)(o2 + ((size_t)g * 1280 + b * 160 + (s >> 4)) * 512 + (s & 15) * 16 + h0) = w;
                        }
                    }
                    if (u.pn == 1 || u.pn == 2) {
                        { const int ln = fr + 16 * fq; s0 += shfl_f(s0, ln ^ 16); s0 += shfl_f(s0, ln ^ 32); }
                        if (fq == 0) ssq[(size_t)(u.pn - 1) * MTOK * 4 + (size_t)row * 4 + wc] = s0;
                    }
                } else if constexpr (mode == EM_Q || mode == EM_KV) {
                    const f32x4 sp = __builtin_bit_cast(f32x4, cur.s[0]);
                    const float rs = mode == EM_Q ? rsqrtf(((sp[0] + sp[1]) + (sp[2] + sp[3])) * (1.f / 256.f) + EPS) * QSCALE : rsqrtf(((sp[0] + sp[1]) + (sp[2] + sp[3])) * (1.f / 128.f) + EPS);
#pragma unroll
                    for (int bj = 0; bj < 2; ++bj) {
                        f32x4 v0 = acc[ai][bj][m][0] * rs, v1 = acc[ai][bj][m][1] * rs;
                        const int col = u.pn * 256 + bj * 128 + cl;
                        if constexpr (mode == EM_Q) { const int cc = col % 96;
                            if (cc >= 64 && row < NLAT) {
                                const int t = row & 2047, pb = (cc - 64) >> 1, axis = pb >> 3, pos = axis ? (t & 63) : (t >> 6);
                                const float* cs = rope + pos * 8 + (pb & 7); const float* sn = cs + 512;
                                float x1, x2;
                                x1 = v0[0]; x2 = v0[1]; v0[0] = x1 * cs[0] - x2 * sn[0]; v0[1] = x1 * sn[0] + x2 * cs[0];
                                x1 = v0[2]; x2 = v0[3]; v0[2] = x1 * cs[1] - x2 * sn[1]; v0[3] = x1 * sn[1] + x2 * cs[1];
                                x1 = v1[0]; x2 = v1[1]; v1[0] = x1 * cs[2] - x2 * sn[2]; v1[1] = x1 * sn[2] + x2 * cs[2];
                                x1 = v1[2]; x2 = v1[3]; v1[2] = x1 * cs[3] - x2 * sn[3]; v1[3] = x1 * sn[3] + x2 * cs[3];
                            } }
                        u32x4 w; w.x = pk2(v0[0], v0[1]); w.y = pk2(v0[2], v0[3]); w.z = pk2(v1[0], v1[1]); w.w = pk2(v1[2], v1[3]);
                        if constexpr (mode == EM_Q) *(u32x4*)(o0 + (size_t)row * 768 + col) = w;
                        else { bf16_t* dst = col < 512 ? o0 + (size_t)row * 512 + col : o1 + (size_t)row * 512 + (col - 512); *(u32x4*)dst = w; }
                    }
                } else if constexpr (mode == EM_GLU) {
#pragma unroll
                    for (int bj = 0; bj < 2; ++bj) {
                        const int col = bj * 128 + cl;
                        const f32x4 a0 = acc[ai][bj][m][0] + hc[2 * bj], a1 = acc[ai][bj][m][1] + hc[2 * bj + 1];
                        const u32x4 y = cur.s[bj];
                        u32x4 w;
                        w.x = pk2(bflo(y.x) * sigmoidf_(a0[0]), bfhi(y.x) * sigmoidf_(a0[1])); w.y = pk2(bflo(y.y) * sigmoidf_(a0[2]), bfhi(y.y) * sigmoidf_(a0[3]));
                        w.z = pk2(bflo(y.z) * sigmoidf_(a1[0]), bfhi(y.z) * sigmoidf_(a1[1])); w.w = pk2(bflo(y.w) * sigmoidf_(a1[2]), bfhi(y.w) * sigmoidf_(a1[3]));
                        *(u32x4*)(o0 + (size_t)row * 256 + col) = w;
                    }
                } else if constexpr (mode == EM_MERGE0 || mode == EM_MERGE1) {
#pragma unroll
                    for (int bj = 0; bj < 2; ++bj) {
                        const int col = u.pn * 256 + bj * 128 + cl;
                        const u32x4 gt = cur.s[bj];
                        const f32x4 a0 = acc[ai][bj][m][0], a1 = acc[ai][bj][m][1];
                        float r[8] = { a0[0] * sigmoidf_(bflo(gt.x)), a0[1] * sigmoidf_(bfhi(gt.x)), a0[2] * sigmoidf_(bflo(gt.y)), a0[3] * sigmoidf_(bfhi(gt.y)),
                                       a1[0] * sigmoidf_(bflo(gt.z)), a1[1] * sigmoidf_(bfhi(gt.z)), a1[2] * sigmoidf_(bflo(gt.w)), a1[3] * sigmoidf_(bfhi(gt.w)) };
                        if constexpr (mode == EM_MERGE1) { const u32x4 pv = cur.s[2 + bj];
                            r[0] += bflo(pv.x); r[1] += bfhi(pv.x); r[2] += bflo(pv.y); r[3] += bfhi(pv.y); r[4] += bflo(pv.z); r[5] += bfhi(pv.z); r[6] += bflo(pv.w); r[7] += bfhi(pv.w); }
                        u32x4 w; w.x = pk2(r[0], r[1]); w.y = pk2(r[2], r[3]); w.z = pk2(r[4], r[5]); w.w = pk2(r[6], r[7]);
                        *(u32x4*)(o0 + (size_t)row * 1024 + col) = w;
                    }
                } else if constexpr (mode == EM_WOUT) {
#pragma unroll
                    for (int bj = 0; bj < 2; ++bj) {
                        const int col = u.pn * 256 + bj * 128 + cl;
#pragma unroll
                        for (int n = 0; n < 2; ++n) *(f32x4*)(fo + (size_t)row * D + col + 4 * n) = __builtin_bit_cast(f32x4, cur.s[2 * bj + n]) + hc[2 * bj + n] * acc[ai][bj][m][n];
                    }
                } else if constexpr (mode == EM_MOEUP) {
                    const f32x4 a0 = acc[ai][0][m][0], a1 = acc[ai][0][m][1], b0 = acc[ai][1][m][0], b1 = acc[ai][1][m][1];
                    u32x4 w; w.x = pk2(siluf_(a0[0]) * b0[0], siluf_(a0[1]) * b0[1]); w.y = pk2(siluf_(a0[2]) * b0[2], siluf_(a0[3]) * b0[3]);
                    w.z = pk2(siluf_(a1[0]) * b1[0], siluf_(a1[1]) * b1[1]); w.w = pk2(siluf_(a1[2]) * b1[2], siluf_(a1[3]) * b1[3]);
                    *(u32x4*)(o0 + (size_t)row * HID + (u.pn & 3) * 128 + cl) = w;
                } else if constexpr (mode == EM_MOEDN) {
#pragma unroll
                    for (int bj = 0; bj < 2; ++bj) {
                        const f32x4 v0 = acc[ai][bj][m][0], v1 = acc[ai][bj][m][1];
                        u32x4 w; w.x = pk2(v0[0], v0[1]); w.y = pk2(v0[2], v0[3]); w.z = pk2(v1[0], v1[1]); w.w = pk2(v1[2], v1[3]);
                        *(u32x4*)(o0 + (size_t)row * 1024 + (u.pn & 3) * 256 + bj * 128 + cl) = w;
                    }
                } else if constexpr (mode == EM_S5) {
                    const int g = u.pn, rr = row - g * 1280, b = rr / 160, c = rr - b * 160;
                    if (c < 144) {
#pragma unroll
                        for (int bj = 0; bj < 2; ++bj) {
                            const int n = bj * 128 + cl, i = n >> 4, h0 = n & 15, s = 16 * c + i;
                            const int trow = s < 256 ? NLAT + b * 256 + s : b * 2048 + (s - 256);
                            const u32x4 uv = cur.s[bj];
                            const f32x4 a0 = acc[ai][bj][m][0], a1 = acc[ai][bj][m][1];
                            u32x4 w;
                            w.x = pk2(gelu_tanh(a0[0] + hc[0][0] * bflo(uv.x)), gelu_tanh(a0[1] + hc[0][1] * bfhi(uv.x))); w.y = pk2(gelu_tanh(a0[2] + hc[0][2] * bflo(uv.y)), gelu_tanh(a0[3] + hc[0][3] * bfhi(uv.y)));
                            w.z = pk2(gelu_tanh(a1[0] + hc[1][0] * bflo(uv.z)), gelu_tanh(a1[1] + hc[1][1] * bfhi(uv.z))); w.w = pk2(gelu_tanh(a1[2] + hc[1][2] * bflo(uv.w)), gelu_tanh(a1[3] + hc[1][3] * bfhi(uv.w)));
                            *(u32x4*)(o0 + (size_t)trow * 256 + g * 16 + h0) = w;
                        }
                    }
                }
                cur = nxt;
        }
    }
};

#define XB_TMO      128
#define XB_XCNT(j)  (256  + 64 * (j))
#define XB_XSUB(j)  (1280 + 64 * (j))
#define XB_XGEN(j)  (2304 + 64 * (j))
#define XB_TOP      3328
#define XB_TOPGEN   3392
#define XCD_BAR_WORDS 3456
#define XB_SPIN_CAP (1u << 22)
__device__ __forceinline__ unsigned xb_ld(unsigned* p)              { return __hip_atomic_load(p, __ATOMIC_RELAXED, __HIP_MEMORY_SCOPE_AGENT); }
__device__ __forceinline__ unsigned xb_add(unsigned* p, unsigned v) { return __hip_atomic_fetch_add(p, v, __ATOMIC_RELAXED, __HIP_MEMORY_SCOPE_AGENT); }
__device__ __forceinline__ unsigned xb_xcc_id() { return (unsigned)__builtin_amdgcn_s_getreg((3 << 11) | 20) & 0xFu; }
#define XB_SPIN(cond, bar) do { unsigned _sp = 0; while (cond) { __builtin_amdgcn_s_sleep(1); \
    if ((++_sp & 255u) == 0u) { if (xb_ld(&(bar)[XB_TMO])) break; if (_sp > XB_SPIN_CAP) { atomicAdd(&(bar)[XB_TMO], 1u); break; } } } } while (0)
struct XcdBarrier { unsigned* bar; unsigned x; volatile LAS unsigned* st; };
__device__ __forceinline__ XcdBarrier xcd_barrier_post(unsigned* bar, volatile LAS unsigned* st) {
    XcdBarrier b; b.bar = bar; b.x = xb_xcc_id(); b.st = st;
    if (threadIdx.x == 0) (void)xb_add(&bar[XB_XCNT(b.x)], 1u);
    return b;
}
__device__ __forceinline__ void xcd_barrier_complete(unsigned* bar, unsigned x, unsigned& nloc, unsigned& nx) {
    const unsigned G = gridDim.x * gridDim.y * gridDim.z;
    unsigned sum, cnt, mine, sp = 0u;
    for (;;) {
        sum = 0u; cnt = 0u; mine = 0u;
#pragma unroll
        for (unsigned j = 0; j < 16; ++j) { const unsigned c = xb_ld(&bar[XB_XCNT(j)]); sum += c; cnt += (c > 0u) ? 1u : 0u; mine = (j == x) ? c : mine; }
        if (sum == G) break;
        __builtin_amdgcn_s_sleep(1);
        if ((++sp & 255u) == 0u) { if (xb_ld(&bar[XB_TMO])) break; if (sp > XB_SPIN_CAP) { atomicAdd(&bar[XB_TMO], 1u); break; } }
    }
    nloc = mine > 0u ? mine : 1u; nx = cnt > 0u ? cnt : 1u;
}
__device__ __noinline__ void xcd_barrier_fn(unsigned* bar_in, unsigned bx, unsigned st_off, int tid) {
    XcdBarrier b; b.bar = bar_in; b.x = bx; b.st = (volatile LAS unsigned*)(uintptr_t)st_off;
    asm volatile("s_waitcnt vmcnt(0)" ::: "memory");
    __syncthreads();
    if (tid == 0) {
        unsigned* bar = b.bar;
        __builtin_amdgcn_s_waitcnt(0);
        unsigned nloc = b.st[0], nx = b.st[1];
        if (nloc == 0u) { xcd_barrier_complete(bar, b.x, nloc, nx); b.st[0] = nloc; b.st[1] = nx; }
        const unsigned old = xb_add(&bar[XB_XSUB(b.x)], 1u);
        const unsigned gen = old / nloc;
        if (old + 1u == (gen + 1u) * nloc) {
            __builtin_amdgcn_fence(__ATOMIC_RELEASE, "agent");
            asm volatile("s_waitcnt vmcnt(0)" ::: "memory");
            const unsigned og = xb_add(&bar[XB_TOP], 1u);
            const unsigned tg = og / nx;
            if (og + 1u == (tg + 1u) * nx) xb_add(&bar[XB_TOPGEN], 1u);
            else XB_SPIN(xb_ld(&bar[XB_TOPGEN]) == tg, bar);
            __builtin_amdgcn_fence(__ATOMIC_ACQUIRE, "agent");
            xb_add(&bar[XB_XGEN(b.x)], 1u);
            asm volatile("s_waitcnt vmcnt(0)" ::: "memory");
        } else {
            XB_SPIN(xb_ld(&bar[XB_XGEN(b.x)]) == gen, bar);
            __builtin_amdgcn_fence(__ATOMIC_ACQUIRE, "agent");
            asm volatile("s_waitcnt vmcnt(0)" ::: "memory");
        }
    }
    __syncthreads();
}

constexpr int NWAVES = 8;
constexpr int RING_BYTES = 131072, MISC_OFF = RING_BYTES + 320, TBL_OFF = RING_BYTES + 1024, LDS_BYTES = 147456;
struct Args { const float* in[38]; float* out; unsigned char* ws; int ph_lo, ph_hi; };
typedef const __attribute__((address_space(4))) Args* ArgsP;
struct Frame {
    LAS unsigned char* lds;
    int tid, lane, wave, vcu, G, gw, NGW;
    unsigned char* ws;
};

enum RowMap { RM_ID = 0, RM_WIN = 1, RM_UQ = 2, RM_W13 = 3 };
__device__ __forceinline__ int rope_perm(int o) { const int axis = o >> 4, half = (o >> 3) & 1, i = o & 7; return 2 * (axis * 8 + i) + half; }
__device__ __forceinline__ int map_row(int rm, int n, int row_off) {
    if (rm == RM_WIN) return (n >= ZKPE && n < ZKPE + 32) ? ZKPE + rope_perm(n - ZKPE) : n;
    if (rm == RM_UQ) { const int hd = n / 96, cc = n - hd * 96; return cc >= 64 ? hd * 96 + 64 + rope_perm(cc - 64) : n; }
    if (rm == RM_W13) return row_off + (n >> 7) * 256 + (n & 127);
    return row_off + n;
}
__device__ __forceinline__ void transpose_item(const float* W, int K, int N, bf16_t* WT, int rm, int row_off, const float* kscale, LAS float* scr, int item, int lane) {
    const int nblk = N / 32, kb = item / nblk, nb = item % nblk, k0 = 64 * kb, n0 = 32 * nb;
    float tv[32];
#pragma unroll
    for (int i = 0; i < 32; ++i) tv[i] = W[(size_t)(k0 + 2 * i + (lane >> 5)) * N + n0 + (lane & 31)];
#pragma unroll
    for (int i = 0; i < 32; ++i) { const int kk = 2 * i + (lane >> 5); float v = tv[i]; if (kscale) v *= kscale[k0 + kk]; scr[kk * 33 + (lane & 31)] = v; }
    asm volatile("s_waitcnt lgkmcnt(0)" ::: "memory");
    const int c = lane & 7;
#pragma unroll
    for (int j = 0; j < 4; ++j) { const int n = (lane >> 3) + 8 * j; const LAS float* s = scr + (8 * c) * 33 + n;
        u32x4 o; o.x = pk2(s[0 * 33], s[1 * 33]); o.y = pk2(s[2 * 33], s[3 * 33]); o.z = pk2(s[4 * 33], s[5 * 33]); o.w = pk2(s[6 * 33], s[7 * 33]);
        *(u32x4*)(WT + (size_t)map_row(rm, n0 + n, row_off) * K + k0 + 8 * c) = o; }
    asm volatile("s_waitcnt lgkmcnt(0)" ::: "memory");
}

#if !NAIVE_S5
__device__ __forceinline__ void s5_build(Frame& F, ArgsP a);
#endif
__device__ __forceinline__ void prologue_phase(Frame& F, ArgsP a) {
    LAS float* scr = (LAS float*)(F.lds + F.wave * 16384);
    REP(21) for (int l = 0; l < 2; ++l) {
        unsigned char* wl = F.ws + WS_WB + (size_t)l * WL_STRIDE;
#define CONV(Wp, K_, N_, WTp, rm_, ro_, ks_) do { const int items_ = ((K_) / 64) * ((N_) / 32); \
            for (int it = F.gw; it < items_; it += F.NGW) transpose_item((Wp), (K_), (N_), (bf16_t*)(WTp), (rm_), (ro_), (ks_), scr, it, F.lane); } while (0)
        CONV(a->in[8] + (size_t)l * D * INC, D, INC, wl + WL_WIN, RM_WIN, 0, nullptr);
        CONV(a->in[21] + (size_t)l * 256 * 768, 256, 768, wl + WL_UQ, RM_UQ, 0, a->in[19] + l * 256);
        CONV(a->in[22] + (size_t)l * 128 * 512, 128, 512, wl + WL_UKV, RM_ID, 0, a->in[20] + l * 128);
        CONV(a->in[23] + (size_t)l * 128 * 512, 128, 512, wl + WL_UKV, RM_ID, 512, a->in[20] + l * 128);
        CONV(a->in[17] + (size_t)l * 256 * 256, 256, 256, wl + WL_GLU, RM_ID, 0, nullptr);
        CONV(a->in[26] + (size_t)l * 256 * 1024, 256, 1024, wl + WL_PA, RM_ID, 0, nullptr);
        CONV(a->in[27] + (size_t)l * 512 * 1024, 512, 1024, wl + WL_PB, RM_ID, 0, nullptr);
        CONV(a->in[28] + (size_t)l * 256 * 1024, 256, 1024, wl + WL_PC, RM_ID, 0, nullptr);
        CONV(a->in[29] + (size_t)l * 1024 * 1024, 1024, 1024, wl + WL_OUT, RM_ID, 0, nullptr);
#undef CONV
        u32x4* padp = (u32x4*)(wl + WL_WIN + (size_t)INC * D * 2);
        for (int i = F.gw * 64 + F.lane; i < (ZC - INC) * D * 2 / 16; i += F.NGW * 64) padp[i] = (u32x4){0u, 0u, 0u, 0u};
    }
    if (blockIdx.x == 0) {
        float* rp = (float*)(F.ws + WS_ROPE);
        const int pos = F.tid >> 3, i = F.tid & 7;
        const float ang = (float)pos * exp2f(-(float)i * (13.287712379549449f / 8.f));
        rp[F.tid] = cosf(ang); rp[512 + F.tid] = sinf(ang);
    }
    __syncthreads();
    REP(22)
    {
        LAS float* sil = (LAS float*)F.lds;
        LAS float* red = (LAS float*)(F.lds + 40960);
        bool have = false;
        for (int it = blockIdx.x; it < 192; it += F.G) {
            if (!have) {
                for (int i = F.tid; i < 9 * 1024; i += 512) { const int r = i >> 10, k = i & 1023; const float cv = r < 8 ? a->in[1][r * 1024 + k] : a->in[3][k]; sil[i] = siluf_(cv); }
                have = true; __syncthreads();
            }
            const int l = it / 96, n = (it % 96) * 64 + F.lane;
            const float* wp = a->in[4] + (size_t)l * D * 6144 + (size_t)(F.wave * 128) * 6144 + n;
            float acc[9];
#pragma unroll
            for (int r = 0; r < 9; ++r) acc[r] = 0.f;
#pragma unroll 8
            for (int k = 0; k < 128; ++k) { const float wv = wp[(size_t)k * 6144];
#pragma unroll
                for (int r = 0; r < 9; ++r) acc[r] += sil[r * 1024 + F.wave * 128 + k] * wv; }
#pragma unroll
            for (int r = 0; r < 9; ++r) red[(F.wave * 9 + r) * 64 + F.lane] = acc[r];
            __syncthreads();
            for (int i = F.tid; i < 9 * 64; i += 512) { const int r = i >> 6, ln = i & 63; float s = 0.f;
#pragma unroll
                for (int w = 0; w < 8; ++w) s += red[(w * 9 + r) * 64 + ln];
                const int nn = (it % 96) * 64 + ln;
                ((float*)(F.ws + WS_MODV))[((size_t)l * 9 + r) * 6144 + nn] = s + a->in[5][l * 6144 + nn]; }
            __syncthreads();
        }
    }
#if !NAIVE_S5
    REP(23) s5_build(F, a);
#endif
}

__device__ __forceinline__ void moe_convert(Frame& F, ArgsP a, int l) {
    LAS float* scr = (LAS float*)(F.lds + F.wave * 16384);
    bf16_t* w13 = (bf16_t*)(F.ws + WS_MIX + MW_W13); bf16_t* w2 = (bf16_t*)(F.ws + WS_MIX + MW_W2);
    for (int it = F.gw; it < NEXP * 768; it += F.NGW) {
        const int e = it / 768, r = it % 768, which = r >> 8, sub = r & 255;
        const size_t eoff = ((size_t)l * NEXP + e) * 1024 * 512;
        if (which == 0) transpose_item(a->in[34] + eoff, 1024, 512, w13, RM_W13, e * 1024, nullptr, scr, sub, F.lane);
        else if (which == 1) transpose_item(a->in[35] + eoff, 1024, 512, w13, RM_W13, e * 1024 + 128, nullptr, scr, sub, F.lane);
        else transpose_item(a->in[36] + eoff, 512, 1024, w2, RM_ID, e * 1024, nullptr, scr, sub, F.lane);
    }
}

__device__ __forceinline__ const float* x_row_ptr(ArgsP a, const float* X, int layer, int row) {
    return layer == 0 ? (row < NLAT ? a->in[0] + (size_t)row * D : a->in[2] + (size_t)(row - NLAT) * D) : X + (size_t)row * D;
}
__device__ __forceinline__ void norm_mod_row(const f32x4 (&v)[4], f32x4 (&h)[4], const float* g, const float* shift, const float* scale, int lane) {
    float ss = 0.f;
#pragma unroll
    for (int j = 0; j < 4; ++j) ss += (v[j][0] * v[j][0] + v[j][1] * v[j][1]) + (v[j][2] * v[j][2] + v[j][3] * v[j][3]);
    const float rstd = rsqrtf(wave_sum(ss) * (1.f / D) + EPS);
#pragma unroll
    for (int j = 0; j < 4; ++j) { const int c = 4 * lane + 256 * j; const f32x4 gv = *(const f32x4*)(g + c), sh = *(const f32x4*)(shift + c), sc = *(const f32x4*)(scale + c);
        h[j] = v[j] * rstd * gv * (sc + 1.f) + sh; }
}
__device__ __forceinline__ void store_row_bf16(bf16_t* orow, const f32x4 (&h)[4], int lane) {
#pragma unroll
    for (int j = 0; j < 4; ++j) { u32x2 w; w.x = pk2(h[j][0], h[j][1]); w.y = pk2(h[j][2], h[j][3]); *(u32x2*)(orow + 4 * lane + 256 * j) = w; }
}
__device__ __forceinline__ void norm1_phase(Frame& F, ArgsP a, int layer, int nrows) {
    const float* X = (const float*)(F.ws + WS_X); bf16_t* H = (bf16_t*)(F.ws + WS_H);
    const float* modv = (const float*)(F.ws + WS_MODV) + (size_t)layer * 9 * 6144;
    for (int row = F.gw; row < nrows; row += F.NGW) {
        const float* xr = x_row_ptr(a, X, layer, row); f32x4 v[4], h[4];
#pragma unroll
        for (int j = 0; j < 4; ++j) v[j] = *(const f32x4*)(xr + 4 * F.lane + 256 * j);
        const float* mv = modv + (size_t)tok_modrow(row) * 6144;
        norm_mod_row(v, h, a->in[6] + layer * D, mv, mv + 1024, F.lane);
        store_row_bf16(H + (size_t)row * D, h, F.lane);
    }
}

__device__ __forceinline__ int seq_row(int b, int s, int d) {
    if (d == 0) return s < 256 ? NLAT + b * 256 + s : b * 2048 + (s - 256);
    return s < 256 ? NLAT + b * 256 + (255 - s) : b * 2048 + (2047 - (s - 256));
}
__device__ __forceinline__ float hg_lb(ArgsP a, int l) { return l == 0 ? 0.f : 1.f / (1.f + __expf(a->in[24][0] - a->in[24][1])); }

#if NAIVE_S5
__device__ __forceinline__ void s5_naive(Frame& F, ArgsP a, int l) {
    const bf16_t* Z = (const bf16_t*)(F.ws + WS_Z); float* Yacc = (float*)(F.ws + WS_MIX + MX_S5A);
    for (int unit = F.gw; unit < 128; unit += F.NGW) {
        const int b = unit >> 4, g = unit & 15, p = F.lane;
        for (int d = 0; d < 2; ++d) {
            const int idx = (l * 2 + d) * 16 + g;
            const float lre = a->in[9][idx * 64 + p], lim = a->in[10][idx * 64 + p], dt = expf(a->in[15][idx]);
            const float mag = expf(lre * dt), lbr = mag * cosf(lim * dt), lbi = mag * sinf(lim * dt), den = lre * lre + lim * lim;
            const float fr = ((lbr - 1.f) * lre + lbi * lim) / den, fi = (lbi * lre - (lbr - 1.f) * lim) / den;
            float bbr[16], bbi[16], cre[16], cim[16];
#pragma unroll
            for (int h = 0; h < 16; ++h) { const float br = a->in[11][(size_t)(idx * 64 + p) * 16 + h], bi = a->in[12][(size_t)(idx * 64 + p) * 16 + h];
                bbr[h] = fr * br - fi * bi; bbi[h] = fr * bi + fi * br;
                cre[h] = a->in[13][(size_t)(idx * 16 + h) * 64 + p]; cim[h] = a->in[14][(size_t)(idx * 16 + h) * 64 + p]; }
            float hr = 0.f, hi = 0.f;
            for (int s = 0; s < 2304; ++s) {
                const int row = seq_row(b, s, d);
                const u32x4 u0 = *(const u32x4*)(Z + (size_t)row * ZC + g * 16), u1 = *(const u32x4*)(Z + (size_t)row * ZC + g * 16 + 8);
                const float uu[16] = { bflo(u0.x), bfhi(u0.x), bflo(u0.y), bfhi(u0.y), bflo(u0.z), bfhi(u0.z), bflo(u0.w), bfhi(u0.w),
                                       bflo(u1.x), bfhi(u1.x), bflo(u1.y), bfhi(u1.y), bflo(u1.z), bfhi(u1.z), bflo(u1.w), bfhi(u1.w) };
                float bur = 0.f, bui = 0.f;
#pragma unroll
                for (int h = 0; h < 16; ++h) { bur += bbr[h] * uu[h]; bui += bbi[h] * uu[h]; }
                const float nhr = lbr * hr - lbi * hi + bur, nhi = lbr * hi + lbi * hr + bui; hr = nhr; hi = nhi;
                float mine = 0.f;
#pragma unroll
                for (int h = 0; h < 16; ++h) { const float y = wave_sum(cre[h] * hr - cim[h] * hi); if (F.lane == h) mine = y; }
                if (F.lane < 16) { float* ptr = Yacc + (size_t)row * 256 + g * 16 + F.lane; if (d == 0) *ptr = mine; else *ptr += mine; }
            }
        }
    }
}
__device__ __forceinline__ void s5_naive_finish(Frame& F, ArgsP a, int l, int nrows) {
    const bf16_t* Z = (const bf16_t*)(F.ws + WS_Z); const float* Yacc = (const float*)(F.ws + WS_MIX + MX_S5A); bf16_t* ysp = (bf16_t*)(F.ws + WS_MIX + MX_YS5P);
    for (int i = F.gw * 64 + F.lane; i < nrows * 256; i += F.NGW * 64) { const int row = i >> 8, n = i & 255;
        ysp[i] = (bf16_t)f2bf(gelu_tanh(Yacc[i] + a->in[16][l * 256 + n] * bf2f(Z[(size_t)row * ZC + n]))); }
}
#endif

#if NAIVE_HG
__device__ __forceinline__ void hg_naive(Frame& F, ArgsP a, int l) {
    const bf16_t* Z = (const bf16_t*)(F.ws + WS_Z); float* Ohg = (float*)(F.ws + WS_H);
    LAS float* red = (LAS float*)F.lds;
    const float lb = hg_lb(a, l);
    for (int unit = blockIdx.x; unit < 32; unit += F.G) {
        const int b = unit >> 2, hd = unit & 3, v = F.tid & 63, kg = F.wave;
        for (int d = 0; d < 2; ++d) {
            float S[16];
#pragma unroll
            for (int k = 0; k < 16; ++k) S[k] = 0.f;
            for (int s = 0; s < 2304; ++s) {
                const int row = seq_row(b, s, d);
                const bf16_t* zr = Z + (size_t)row * ZC;
                const u32x4 q0 = *(const u32x4*)(zr + ZHQ + hd * 128 + kg * 16), q1 = *(const u32x4*)(zr + ZHQ + hd * 128 + kg * 16 + 8);
                const int zf = d ? ZF1 : ZF0;
                const u32x4 z0 = *(const u32x4*)(zr + zf + hd * 128 + kg * 16), z1 = *(const u32x4*)(zr + zf + hd * 128 + kg * 16 + 8);
                const float vt = bf2f(zr[ZI + hd * 64 + v]);
                const float qq[16] = { bflo(q0.x), bfhi(q0.x), bflo(q0.y), bfhi(q0.y), bflo(q0.z), bfhi(q0.z), bflo(q0.w), bfhi(q0.w),
                                       bflo(q1.x), bfhi(q1.x), bflo(q1.y), bfhi(q1.y), bflo(q1.z), bfhi(q1.z), bflo(q1.w), bfhi(q1.w) };
                const float zz[16] = { bflo(z0.x), bfhi(z0.x), bflo(z0.y), bfhi(z0.y), bflo(z0.z), bfhi(z0.z), bflo(z0.w), bfhi(z0.w),
                                       bflo(z1.x), bfhi(z1.x), bflo(z1.y), bfhi(z1.y), bflo(z1.z), bfhi(z1.z), bflo(z1.w), bfhi(z1.w) };
                float part = 0.f;
#pragma unroll
                for (int k = 0; k < 16; ++k) { const float kin = (1.f - lb) / (1.f + __expf(zz[k])), f = 1.f - kin; S[k] = f * S[k] + kin * vt; part += qq[k] * S[k]; }
                red[((s & 1) * 8 + kg) * 64 + v] = part;
                __syncthreads();
                if (F.tid < 64) { float o = 0.f;
#pragma unroll
                    for (int w = 0; w < 8; ++w) o += red[((s & 1) * 8 + w) * 64 + F.tid];
                    float* ptr = Ohg + (size_t)row * 256 + hd * 64 + F.tid; if (d == 0) *ptr = o; else *ptr += o; }
            }
            __syncthreads();
        }
    }
}
__device__ __forceinline__ void hg_naive_finish(Frame& F, ArgsP a, int l, int nrows) {
    const bf16_t* Z = (const bf16_t*)(F.ws + WS_Z); const float* Ohg = (const float*)(F.ws + WS_H); bf16_t* yhg = (bf16_t*)(F.ws + WS_MIX + MX_YHG);
    for (int it = F.gw; it < nrows * 4; it += F.NGW) { const int row = it >> 2, hd = it & 3, c = hd * 64 + F.lane;
        float o = Ohg[(size_t)row * 256 + c]; const float ms = wave_sum(o * o) * (1.f / 64.f);
        o = o * rsqrtf(ms + EPS) * a->in[25][l * 256 + c] * siluf_(bf2f(Z[(size_t)row * ZC + ZG + c]));
        yhg[(size_t)row * 256 + c] = (bf16_t)f2bf(o); }
}
#endif

#if NAIVE_ATTN
__device__ __forceinline__ void attn_naive(Frame& F, bool need_ctx) {
    const bf16_t* Q = (const bf16_t*)(F.ws + WS_MIX + MX_Q); const bf16_t* KN = (const bf16_t*)(F.ws + WS_MIX + MX_KN); const bf16_t* V = (const bf16_t*)(F.ws + WS_MIX + MX_V);
    const bf16_t* KPE = (const bf16_t*)(F.ws + WS_MIX + MX_KPE); bf16_t* YM = (bf16_t*)(F.ws + WS_MIX + MX_YMLA);
    const int nunits = need_ctx ? 320 : 256;
    for (int unit = blockIdx.x; unit < nunits; unit += F.G) {
        int b, h, qrow, nk; bool active = true; const bool lat = unit < 256;
        if (lat) { b = unit >> 5; h = (unit >> 2) & 7; qrow = b * 2048 + (unit & 3) * 512 + F.tid; nk = 2304; }
        else { const int u2 = unit - 256; b = u2 >> 3; h = u2 & 7; active = F.tid < 256; qrow = NLAT + b * 256 + (F.tid & 255); nk = 256; }
        float q[96];
#pragma unroll
        for (int c = 0; c < 12; ++c) { const u32x4 w = *(const u32x4*)(Q + (size_t)qrow * 768 + h * 96 + c * 8);
            q[c * 8 + 0] = bflo(w.x); q[c * 8 + 1] = bfhi(w.x); q[c * 8 + 2] = bflo(w.y); q[c * 8 + 3] = bfhi(w.y); q[c * 8 + 4] = bflo(w.z); q[c * 8 + 5] = bfhi(w.z); q[c * 8 + 6] = bflo(w.w); q[c * 8 + 7] = bfhi(w.w); }
        float o[64], m = -1e30f, lsum = 0.f;
#pragma unroll
        for (int dd = 0; dd < 64; ++dd) o[dd] = 0.f;
        for (int j = 0; j < nk; ++j) {
            const int krow = lat ? (j < 2048 ? b * 2048 + j : NLAT + b * 256 + (j - 2048)) : NLAT + b * 256 + j;
            const bf16_t* kn = KN + (size_t)krow * 512 + h * 64; const bf16_t* kp = KPE + (size_t)krow * 32; const bf16_t* vv = V + (size_t)krow * 512 + h * 64;
            float s = 0.f;
#pragma unroll
            for (int c = 0; c < 12; ++c) { const u32x4 w = c < 8 ? *(const u32x4*)(kn + c * 8) : *(const u32x4*)(kp + (c - 8) * 8);
                s += q[c * 8 + 0] * bflo(w.x) + q[c * 8 + 1] * bfhi(w.x) + q[c * 8 + 2] * bflo(w.y) + q[c * 8 + 3] * bfhi(w.y) + q[c * 8 + 4] * bflo(w.z) + q[c * 8 + 5] * bfhi(w.z) + q[c * 8 + 6] * bflo(w.w) + q[c * 8 + 7] * bfhi(w.w); }
            const float mn = fmaxf(m, s), al = __builtin_amdgcn_exp2f(m - mn), pp = __builtin_amdgcn_exp2f(s - mn);
            lsum = lsum * al + pp; m = mn;
#pragma unroll
            for (int c = 0; c < 8; ++c) { const u32x4 w = *(const u32x4*)(vv + c * 8);
                o[c * 8 + 0] = o[c * 8 + 0] * al + pp * bflo(w.x); o[c * 8 + 1] = o[c * 8 + 1] * al + pp * bfhi(w.x); o[c * 8 + 2] = o[c * 8 + 2] * al + pp * bflo(w.y); o[c * 8 + 3] = o[c * 8 + 3] * al + pp * bfhi(w.y);
                o[c * 8 + 4] = o[c * 8 + 4] * al + pp * bflo(w.z); o[c * 8 + 5] = o[c * 8 + 5] * al + pp * bfhi(w.z); o[c * 8 + 6] = o[c * 8 + 6] * al + pp * bflo(w.w); o[c * 8 + 7] = o[c * 8 + 7] * al + pp * bfhi(w.w); }
        }
        if (active) { const float inv = 1.f / lsum;
#pragma unroll
            for (int c = 0; c < 8; ++c) { u32x4 w; w.x = pk2(o[c * 8] * inv, o[c * 8 + 1] * inv); w.y = pk2(o[c * 8 + 2] * inv, o[c * 8 + 3] * inv); w.z = pk2(o[c * 8 + 4] * inv, o[c * 8 + 5] * inv); w.w = pk2(o[c * 8 + 6] * inv, o[c * 8 + 7] * inv);
                *(u32x4*)(YM + (size_t)qrow * 512 + h * 64 + c * 8) = w; } }
    }
}
#endif

typedef short s16x4 __attribute__((ext_vector_type(4)));
__device__ __forceinline__ f32x4 mfma16(bf16x8 a, bf16x8 b, f32x4 c) { return __builtin_amdgcn_mfma_f32_16x16x32_bf16(a, b, c, 0, 0, 0); }
__device__ __forceinline__ s16x4 vtr16(const LAS unsigned char* p) { return __builtin_bit_cast(s16x4, __builtin_amdgcn_ds_read_tr16_b64_v4i16((LAS s16x4*)p)); }
__device__ __forceinline__ float max3f_(float a, float b, float c) { float r; asm("v_max3_f32 %0, %1, %2, %3" : "=v"(r) : "v"(a), "v"(b), "v"(c)); return r; }
__device__ __forceinline__ void glds16(const void* gsrc, unsigned lds_dst) { unsigned keep;
    asm volatile("s_mov_b32 %0, m0\n\ts_mov_b32 m0, %2\n\ts_nop 0\n\tglobal_load_lds_dwordx4 %1, off\n\ts_mov_b32 m0, %0" : "=&s"(keep) : "v"(gsrc), "s"(lds_dst) : "memory"); }
#if !NAIVE_ATTN
template <int VAR> __device__ __forceinline__ void attn_fast(Frame& F, bool need_ctx, bf16_t* YM) {
    const bf16_t* Q = (const bf16_t*)(F.ws + WS_MIX + MX_Q); const bf16_t* KN = (const bf16_t*)(F.ws + WS_MIX + MX_KN); const bf16_t* V = (const bf16_t*)(F.ws + WS_MIX + MX_V);
    const bf16_t* KPE = (const bf16_t*)(F.ws + WS_MIX + MX_KPE);
    const int lane = F.lane, wid = F.wave, r32 = lane & 31, hi = lane >> 5;
    constexpr int SLOT = 20480, VOFF = 12288, NSLOT = 5;
    const unsigned lds0 = (unsigned)(uintptr_t)F.lds;
    const int nunits = need_ctx ? 576 : 512;
    const unsigned kA = (unsigned)(hi * 1024 + r32 * 16);
    const unsigned vB = (unsigned)(VOFF + ((lane >> 4) & 1) * 32 + (lane & 3) * 8 + (4 * hi + ((lane & 15) >> 2)) * 64);
    for (int unit = F.vcu; unit < nunits; unit += F.G) {
        int b, h, qrow0, NT; const bool lat = unit < 512;
        if (lat) { b = unit >> 6; h = (unit >> 3) & 7; qrow0 = b * 2048 + (unit & 7) * 256; NT = 36; }
        else { const int u2 = unit - 512; b = u2 >> 3; h = u2 & 7; qrow0 = NLAT + b * 256; NT = 4; }
#define ATT_KROW(t) (lat ? ((t) < 32 ? b * 2048 + 64 * (t) : NLAT + b * 256 + 64 * ((t) - 32)) : NLAT + b * 256 + 64 * (t))
#define ATT_ISSUE(tt, sl) do { const int tc_ = (tt) < NT ? (tt) : NT - 1; const int kr_ = ATT_KROW(tc_); const unsigned sd_ = (unsigned)__builtin_amdgcn_readfirstlane((int)(lds0 + (sl) * SLOT + wid * 1024)); \
            glds16(KN + (size_t)(kr_ + lane) * 512 + h * 64 + wid * 8, sd_); \
            if (wid < 4) glds16(KPE + (size_t)(kr_ + lane) * 32 + wid * 8, sd_ + 8 * 1024); \
            glds16(V + (size_t)(kr_ + 16 * (wid & 3) + (lane >> 2)) * 512 + h * 64 + (wid >> 2) * 32 + (lane & 3) * 8, sd_ + VOFF); } while (0)
#define ATT_QK(P0, P1, slot) do { const LAS unsigned char* sq_ = F.lds + (slot) * SLOT; _Pragma("unroll") for (int d0 = 0; d0 < 6; ++d0) { \
            const bf16x8 k0_ = *(const LAS bf16x8*)(sq_ + kA + d0 * 2048), k1_ = *(const LAS bf16x8*)(sq_ + kA + d0 * 2048 + 512); \
            if (d0 == 0) { P0 = __builtin_amdgcn_mfma_f32_32x32x16_bf16(k0_, qf[0], negm, 0, 0, 0); P1 = __builtin_amdgcn_mfma_f32_32x32x16_bf16(k1_, qf[0], negm, 0, 0, 0); } \
            else { P0 = __builtin_amdgcn_mfma_f32_32x32x16_bf16(k0_, qf[d0], P0, 0, 0, 0); P1 = __builtin_amdgcn_mfma_f32_32x32x16_bf16(k1_, qf[d0], P1, 0, 0, 0); } } } while (0)
        asm volatile("s_waitcnt vmcnt(0)" ::: "memory");
        __syncthreads();
        ATT_ISSUE(0, 0); ATT_ISSUE(1, 1); ATT_ISSUE(2, 2); ATT_ISSUE(3, 3);
        bf16x8 qf[6];
        { const bf16_t* qp = Q + (size_t)(qrow0 + wid * 32 + r32) * 768 + h * 96 + hi * 8;
#pragma unroll
          for (int d0 = 0; d0 < 6; ++d0) qf[d0] = *(const bf16x8*)(qp + d0 * 16); }
        float mref = 0.f, lsum = 0.f, dpend = 0.f; f32x16 o0 = {}, o1 = {}, negm = {};
        asm volatile("s_waitcnt vmcnt(0)" ::: "memory");
        __syncthreads();
        f32x16 p0, p1;
        ATT_QK(p0, p1, 0);
        int s_cur = 0, s_nxt = 1, s_new = 4;
        for (int t = 0; t < NT; ++t) {
            ATT_ISSUE(t + 4, s_new);
            const LAS unsigned char* sb = F.lds + s_cur * SLOT;
            f32x16 n0, n1;
            if (t + 1 < NT) ATT_QK(n0, n1, s_nxt); else { n0 = p0; n1 = p1; }
            if (__builtin_expect(__any(dpend != 0.f), 0)) {
#pragma unroll
                for (int r = 0; r < 16; ++r) { p0[r] -= dpend; p1[r] -= dpend; } }
            float mxa = max3f_(p0[0], p0[1], p1[0]), mxb = max3f_(p0[2], p0[3], p1[1]); mxa = max3f_(mxa, p1[2], p1[3]);
#pragma unroll
            for (int r = 4; r < 16; r += 4) { mxa = max3f_(mxa, p0[r], p0[r + 1]); mxb = max3f_(mxb, p0[r + 2], p0[r + 3]); mxa = max3f_(mxa, p1[r], p1[r + 1]); mxb = max3f_(mxb, p1[r + 2], p1[r + 3]); }
            float mx = fmaxf(mxa, mxb);
            { auto rr = __builtin_amdgcn_permlane32_swap(__float_as_uint(mx), __float_as_uint(mx), false, false); mx = fmaxf(__uint_as_float(rr[0]), __uint_as_float(rr[1])); }
            dpend = 0.f;
            if (__builtin_expect(t == 0 || __any(mx > 8.f), 0)) {
                const float dl = t == 0 ? mx : fmaxf(mx, 0.f); mref += dl; dpend = dl;
#pragma unroll
                for (int r = 0; r < 16; ++r) { p0[r] -= dl; p1[r] -= dl; negm[r] = -mref; }
                const float fs = __builtin_amdgcn_exp2f(-dl); lsum *= fs;
#pragma unroll
                for (int r = 0; r < 16; ++r) { o0[r] *= fs; o1[r] *= fs; } }
            f32x2 ps2 = {0.f, 0.f};
#pragma unroll
            for (int r = 0; r < 16; r += 2) { p0[r] = __builtin_amdgcn_exp2f(p0[r]); p0[r + 1] = __builtin_amdgcn_exp2f(p0[r + 1]); p1[r] = __builtin_amdgcn_exp2f(p1[r]); p1[r + 1] = __builtin_amdgcn_exp2f(p1[r + 1]);
                ps2 += (f32x2){p0[r], p0[r + 1]}; ps2 += (f32x2){p1[r], p1[r + 1]}; }
            lsum += ps2.x + ps2.y;
            bf16x8 pb[4];
#pragma unroll
            for (int s = 0; s < 4; ++s) { u32x4 w;
                if (s < 2) { w.x = pk2(p0[8 * s], p0[8 * s + 1]); w.y = pk2(p0[8 * s + 2], p0[8 * s + 3]); w.z = pk2(p0[8 * s + 4], p0[8 * s + 5]); w.w = pk2(p0[8 * s + 6], p0[8 * s + 7]); }
                else { const int q = s - 2; w.x = pk2(p1[8 * q], p1[8 * q + 1]); w.y = pk2(p1[8 * q + 2], p1[8 * q + 3]); w.z = pk2(p1[8 * q + 4], p1[8 * q + 5]); w.w = pk2(p1[8 * q + 6], p1[8 * q + 7]); }
                pb[s] = __builtin_bit_cast(bf16x8, w); }
#pragma unroll
            for (int s = 0; s < 4; ++s) {
                const s16x4 a0l = vtr16(sb + vB + s * 1024), a0h = vtr16(sb + vB + s * 1024 + 512), a1l = vtr16(sb + vB + 4096 + s * 1024), a1h = vtr16(sb + vB + 4096 + s * 1024 + 512);
                const bf16x8 va0 = {a0l[0], a0l[1], a0l[2], a0l[3], a0h[0], a0h[1], a0h[2], a0h[3]}, va1 = {a1l[0], a1l[1], a1l[2], a1l[3], a1h[0], a1h[1], a1h[2], a1h[3]};
                o0 = __builtin_amdgcn_mfma_f32_32x32x16_bf16(va0, pb[s], o0, 0, 0, 0);
                o1 = __builtin_amdgcn_mfma_f32_32x32x16_bf16(va1, pb[s], o1, 0, 0, 0);
            }
            if (wid < 4) asm volatile("s_waitcnt vmcnt(6) lgkmcnt(0)" ::: "memory"); else asm volatile("s_waitcnt vmcnt(4) lgkmcnt(0)" ::: "memory");
            __builtin_amdgcn_s_barrier();
            p0 = n0; p1 = n1;
            s_cur = s_nxt; s_nxt = s_nxt + 1 == NSLOT ? 0 : s_nxt + 1; s_new = s_new + 1 == NSLOT ? 0 : s_new + 1;
        }
#undef ATT_QK
#undef ATT_ISSUE
#undef ATT_KROW
        lsum += shfl_f(lsum, lane ^ 32);
        const float inv = 1.f / lsum;
        bf16_t* op = YM + (size_t)(qrow0 + wid * 32 + r32) * 512 + h * 64 + 4 * hi;
#pragma unroll
        for (int g = 0; g < 4; ++g) {
            u32x2 w0, w1; w0.x = pk2(o0[4 * g] * inv, o0[4 * g + 1] * inv); w0.y = pk2(o0[4 * g + 2] * inv, o0[4 * g + 3] * inv);
            w1.x = pk2(o1[4 * g] * inv, o1[4 * g + 1] * inv); w1.y = pk2(o1[4 * g + 2] * inv, o1[4 * g + 3] * inv);
            *(u32x2*)(op + 8 * g) = w0; *(u32x2*)(op + 32 + 8 * g) = w1;
        }
    }
}
#endif

#if !NAIVE_HG
__device__ __forceinline__ bf16x8 trfrag(const LAS unsigned char* p, int rowstep4) {
    const s16x4 lo = vtr16(p), hi = vtr16(p + rowstep4); return (bf16x8){lo[0], lo[1], lo[2], lo[3], hi[0], hi[1], hi[2], hi[3]}; }
__device__ __forceinline__ void hg_gate16(const bf16_t* Z, int b, int s0, int d, int zcol, float lb, float (&kin)[16], float (&gl)[16]) {
#pragma unroll
    for (int i = 0; i < 16; ++i) { const int row = seq_row(b, s0 + i, d); const float z = bf2f(Z[(size_t)row * ZC + zcol]);
        const float e = __expf(-z), sg = 1.f / (1.f + e), f = lb + (1.f - lb) * sg; kin[i] = (1.f - lb) * e * sg; gl[i] = __logf(f); }
}
__device__ __forceinline__ void hg_local_load(u32x4 (&tz)[2], u32x4& tv, const bf16_t* Z, int unit, int tid) {
    const int c = unit % 36, r = unit / 36, d = r & 1, hd = (r >> 1) & 3, b = r >> 3;
#pragma unroll
    for (int j = 0; j < 2; ++j) { const int pc = tid + 512 * j, t = pc >> 4, c16 = pc & 15, row = seq_row(b, 64 * c + t, d);
        tz[j] = *(const u32x4*)(Z + (size_t)row * ZC + (d ? ZF1 : ZF0) + hd * 128 + c16 * 8); }
    { const int t = tid >> 3, cc = tid & 7, row = seq_row(b, 64 * c + t, d); tv = *(const u32x4*)(Z + (size_t)row * ZC + ZI + hd * 64 + cc * 8); }
}
__device__ __forceinline__ void hg_local_phase(Frame& F, ArgsP a, int l) {
    const bf16_t* Z = (const bf16_t*)(F.ws + WS_Z); bf16_t* HGS = (bf16_t*)(F.ws + WS_H); float* HGD = (float*)(F.ws + WS_MIX + MX_HGD);
    const float lb = hg_lb(a, l);
    LAS unsigned char* Vl = F.lds; LAS unsigned char* KdT = F.lds + 9216; LAS float* seg = (LAS float*)(F.lds + 27648); LAS unsigned char* Zr = F.lds + 32768;
    const int tid = F.tid, lane = F.lane, w = F.wave, k = tid & 127, tq = tid >> 7;
    u32x4 tz[2], tv;
    if (F.vcu < 2304) hg_local_load(tz, tv, Z, F.vcu, tid);
    for (int unit = F.vcu; unit < 2304; unit += F.G) {
        __syncthreads();
#pragma unroll
        for (int j = 0; j < 2; ++j) { const int pc = tid + 512 * j; *(LAS u32x4*)(Zr + (pc >> 4) * 272 + (pc & 15) * 16) = tz[j]; }
        *(LAS u32x4*)(Vl + (tid >> 3) * 144 + (tid & 7) * 16) = tv;
        if (unit + F.G < 2304) hg_local_load(tz, tv, Z, unit + F.G, tid);
        __syncthreads();
        float kin0[8], kin1[8], g0[8], g1[8];
#pragma unroll
        for (int i = 0; i < 8; ++i) { const unsigned zz = *(const LAS unsigned*)(Zr + ((8 * w + i) * 136 + 2 * lane) * 2);
            { const float e = __expf(-bflo(zz)), sg = __builtin_amdgcn_rcpf(1.f + e); kin0[i] = (1.f - lb) * e * sg; g0[i] = __logf(lb + (1.f - lb) * sg); }
            { const float e = __expf(-bfhi(zz)), sg = __builtin_amdgcn_rcpf(1.f + e); kin1[i] = (1.f - lb) * e * sg; g1[i] = __logf(lb + (1.f - lb) * sg); } }
        float run0 = 0.f, run1 = 0.f;
#pragma unroll
        for (int i = 7; i >= 0; --i) { const float a0 = g0[i], a1 = g1[i]; g0[i] = run0; g1[i] = run1; run0 += a0; run1 += a1; }
        *(LAS f32x2*)(seg + w * 128 + 2 * lane) = (f32x2){run0, run1};
        __syncthreads();
        float lat0 = 0.f, lat1 = 0.f, tot0 = 0.f, tot1 = 0.f;
#pragma unroll
        for (int q = 0; q < 8; ++q) { const f32x2 sv = *(const LAS f32x2*)(seg + q * 128 + 2 * lane); tot0 += sv.x; tot1 += sv.y; if (q > w) { lat0 += sv.x; lat1 += sv.y; } }
        { u32x4 w0, w1;
          w0.x = pk2(kin0[0] * __expf(g0[0] + lat0), kin0[1] * __expf(g0[1] + lat0)); w0.y = pk2(kin0[2] * __expf(g0[2] + lat0), kin0[3] * __expf(g0[3] + lat0));
          w0.z = pk2(kin0[4] * __expf(g0[4] + lat0), kin0[5] * __expf(g0[5] + lat0)); w0.w = pk2(kin0[6] * __expf(g0[6] + lat0), kin0[7] * __expf(g0[7] + lat0));
          w1.x = pk2(kin1[0] * __expf(g1[0] + lat1), kin1[1] * __expf(g1[1] + lat1)); w1.y = pk2(kin1[2] * __expf(g1[2] + lat1), kin1[3] * __expf(g1[3] + lat1));
          w1.z = pk2(kin1[4] * __expf(g1[4] + lat1), kin1[5] * __expf(g1[5] + lat1)); w1.w = pk2(kin1[6] * __expf(g1[6] + lat1), kin1[7] * __expf(g1[7] + lat1));
          *(LAS u32x4*)(KdT + (2 * lane) * 144 + w * 16) = w0; *(LAS u32x4*)(KdT + (2 * lane + 1) * 144 + w * 16) = w1; }
        if (w == 0) *(f32x2*)(HGD + (size_t)unit * 128 + 2 * lane) = (f32x2){__expf(tot0), __expf(tot1)};
        __syncthreads();
        f32x4 acc[4] = {};
#pragma unroll
        for (int ks = 0; ks < 2; ++ks) {
            const bf16x8 bf = *(const LAS bf16x8*)(KdT + (16 * w + (lane & 15)) * 144 + (32 * ks + 8 * (lane >> 4)) * 2);
#pragma unroll
            for (int mt = 0; mt < 4; ++mt) { const bf16x8 af = trfrag(Vl + (32 * ks + 8 * (lane >> 4) + ((lane & 15) >> 2)) * 144 + (mt * 16 + 4 * (lane & 3)) * 2, 4 * 144);
                acc[mt] = mfma16(af, bf, acc[mt]); }
        }
        bf16_t* dst = HGS + (size_t)unit * 8192 + 16 * w + (lane & 15);
#pragma unroll
        for (int mt = 0; mt < 4; ++mt)
#pragma unroll
            for (int rr = 0; rr < 4; ++rr) dst[(size_t)(16 * mt + 4 * (lane >> 4) + rr) * 128] = (bf16_t)f2bf(acc[mt][rr]);
    }
}
__device__ __forceinline__ void hg_scan_phase(Frame& F) {
    bf16_t* HGS = (bf16_t*)(F.ws + WS_H); const float* HGD = (const float*)(F.ws + WS_MIX + MX_HGD);
    for (int it = F.gw * 64 + F.lane; it < 64 * 1024; it += F.NGW * 64) {
        const int r = it >> 10, e8 = (it & 1023) * 8, k0 = e8 & 127;
        float S[8];
#pragma unroll
        for (int j = 0; j < 8; ++j) S[j] = 0.f;
#pragma unroll 4
        for (int c = 0; c < 36; ++c) {
            u32x4* p = (u32x4*)(HGS + (size_t)(r * 36 + c) * 8192 + e8); const u32x4 ds = *p;
            const f32x4 d0 = *(const f32x4*)(HGD + (size_t)(r * 36 + c) * 128 + k0), d1 = *(const f32x4*)(HGD + (size_t)(r * 36 + c) * 128 + k0 + 4);
            u32x4 o; o.x = pk2(S[0], S[1]); o.y = pk2(S[2], S[3]); o.z = pk2(S[4], S[5]); o.w = pk2(S[6], S[7]); *p = o;
            S[0] = d0[0] * S[0] + bflo(ds.x); S[1] = d0[1] * S[1] + bfhi(ds.x); S[2] = d0[2] * S[2] + bflo(ds.y); S[3] = d0[3] * S[3] + bfhi(ds.y);
            S[4] = d1[0] * S[4] + bflo(ds.z); S[5] = d1[1] * S[5] + bfhi(ds.z); S[6] = d1[2] * S[6] + bflo(ds.w); S[7] = d1[3] * S[7] + bfhi(ds.w);
        }
    }
}
struct HgTile { u32x4 z[2], q[2], s[2], v; };
__device__ __forceinline__ void hg_out_decode(int unit, bool need_ctx, int& b, int& hd, int& ct) {
    if (need_ctx) { ct = unit % 36; hd = (unit / 36) & 3; b = unit / 144; } else { ct = 4 + (unit & 31); hd = (unit >> 5) & 3; b = unit >> 7; }
}
__device__ __forceinline__ void hg_out_load(HgTile& T, const bf16_t* Z, const bf16_t* HGS, int b, int hd, int ct, int d, int tid) {
    const int cs = d == 0 ? ct : (ct < 4 ? 3 - ct : 39 - ct); const size_t su = (size_t)(((b * 4 + hd) * 2 + d) * 36 + cs);
#pragma unroll
    for (int j = 0; j < 2; ++j) { const int pc = tid + 512 * j, t = pc >> 4, c16 = pc & 15, row = seq_row(b, 64 * cs + t, d);
        T.z[j] = *(const u32x4*)(Z + (size_t)row * ZC + (d ? ZF1 : ZF0) + hd * 128 + c16 * 8); T.q[j] = *(const u32x4*)(Z + (size_t)row * ZC + ZHQ + hd * 128 + c16 * 8);
        T.s[j] = *(const u32x4*)(HGS + su * 8192 + (size_t)t * 128 + c16 * 8); }
    { const int t = tid >> 3, cc = tid & 7, row = seq_row(b, 64 * cs + t, d); T.v = *(const u32x4*)(Z + (size_t)row * ZC + ZI + hd * 64 + cc * 8); }
}
__device__ __forceinline__ void hg_out_phase(Frame& F, ArgsP a, int l, bool need_ctx) {
    const bf16_t* Z = (const bf16_t*)(F.ws + WS_Z); const bf16_t* HGS = (const bf16_t*)(F.ws + WS_H); bf16_t* YHG = (bf16_t*)(F.ws + WS_MIX + MX_YHG);
    const float lb = hg_lb(a, l);
    LAS unsigned char* HQD = F.lds; LAS unsigned char* HQ1 = F.lds + 17408; LAS unsigned char* HK1 = F.lds + 34816; LAS unsigned char* HST = F.lds + 52224;
    LAS unsigned char* HV = F.lds + 69632; LAS unsigned char* HP = F.lds + 78848; LAS float* HO = (LAS float*)(F.lds + 88064); LAS float* seg = (LAS float*)(F.lds + 105472);
    const int tid = F.tid, lane = F.lane, w = F.wave, k = tid & 127, tq = tid >> 7, mt = w >> 1, nh = w & 1;
    const int nunits = need_ctx ? 1152 : 1024;
    const int nmine = F.vcu < nunits ? (nunits - 1 - F.vcu) / F.G + 1 : 0, nit = 2 * nmine;
    HgTile T;
    if (nit > 0) { int b, hd, ct; hg_out_decode(F.vcu, need_ctx, b, hd, ct); hg_out_load(T, Z, HGS, b, hd, ct, 0, tid); }
    for (int it = 0; it < nit; ++it) {
        const int unit = F.vcu + (it >> 1) * F.G, d = it & 1; int b, hd, ct; hg_out_decode(unit, need_ctx, b, hd, ct);
        __syncthreads();
#pragma unroll
        for (int j = 0; j < 2; ++j) { const int pc = tid + 512 * j, t = pc >> 4, c16 = pc & 15;
            *(LAS u32x4*)(HQD + t * 272 + c16 * 16) = T.q[j]; *(LAS u32x4*)(HK1 + t * 272 + c16 * 16) = T.z[j]; *(LAS u32x4*)(HST + t * 272 + c16 * 16) = T.s[j]; }
        *(LAS u32x4*)(HV + (tid >> 3) * 144 + (tid & 7) * 16) = T.v;
        if (it + 1 < nit) { const int un = F.vcu + ((it + 1) >> 1) * F.G; int b2, hd2, ct2; hg_out_decode(un, need_ctx, b2, hd2, ct2); hg_out_load(T, Z, HGS, b2, hd2, ct2, (it + 1) & 1, tid); }
        __syncthreads();
        float kin0[8], kin1[8], g0[8], g1[8];
#pragma unroll
        for (int i = 0; i < 8; ++i) { const unsigned zz = *(const LAS unsigned*)(HK1 + ((8 * w + i) * 136 + 2 * lane) * 2);
            { const float e = __expf(-bflo(zz)), sg = __builtin_amdgcn_rcpf(1.f + e); kin0[i] = (1.f - lb) * e * sg; g0[i] = __logf(lb + (1.f - lb) * sg); }
            { const float e = __expf(-bfhi(zz)), sg = __builtin_amdgcn_rcpf(1.f + e); kin1[i] = (1.f - lb) * e * sg; g1[i] = __logf(lb + (1.f - lb) * sg); } }
        float run0 = 0.f, run1 = 0.f;
#pragma unroll
        for (int i = 0; i < 8; ++i) { run0 += g0[i]; g0[i] = run0; run1 += g1[i]; g1[i] = run1; }
        *(LAS f32x2*)(seg + w * 128 + 2 * lane) = (f32x2){run0, run1};
        __syncthreads();
        float bef0 = 0.f, bef1 = 0.f, br0 = 0.f, br1 = 0.f;
#pragma unroll
        for (int q = 0; q < 7; ++q) { const f32x2 sv = *(const LAS f32x2*)(seg + q * 128 + 2 * lane); if (q < w) { bef0 += sv.x; bef1 += sv.y; } if (q < 4) { br0 += sv.x; br1 += sv.y; } }
        const float er0 = __expf(br0), er1 = __expf(br1);
#pragma unroll
        for (int i = 0; i < 8; ++i) { const int t = 8 * w + i, off = (t * 136 + 2 * lane) * 2;
            const unsigned qq = *(const LAS unsigned*)(HQD + off);
            const float e0 = __expf(fminf(fmaxf(bef0 + g0[i] - br0, -80.f), 80.f)), e1 = __expf(fminf(fmaxf(bef1 + g1[i] - br1, -80.f), 80.f));
            const float q10 = bflo(qq) * e0, q11 = bfhi(qq) * e1;
            *(LAS unsigned*)(HQ1 + off) = pk2(q10, q11);
            *(LAS unsigned*)(HQD + off) = pk2(q10 * er0, q11 * er1);
            *(LAS unsigned*)(HK1 + off) = pk2(kin0[i] * __builtin_amdgcn_rcpf(e0), kin1[i] * __builtin_amdgcn_rcpf(e1)); }
        __syncthreads();
        f32x4 ao[2] = {}, as[2] = {};
#pragma unroll
        for (int ks = 0; ks < 4; ++ks) {
            const int ko = (32 * ks + 8 * (lane >> 4)) * 2;
            const bf16x8 aqd = *(const LAS bf16x8*)(HQD + (16 * mt + (lane & 15)) * 272 + ko), aq1 = *(const LAS bf16x8*)(HQ1 + (16 * mt + (lane & 15)) * 272 + ko);
#pragma unroll
            for (int j = 0; j < 2; ++j) { const int nt = 2 * nh + j;
                ao[j] = mfma16(aqd, *(const LAS bf16x8*)(HST + (16 * nt + (lane & 15)) * 272 + ko), ao[j]);
                as[j] = mfma16(aq1, *(const LAS bf16x8*)(HK1 + (16 * nt + (lane & 15)) * 272 + ko), as[j]); }
        }
#pragma unroll
        for (int j = 0; j < 2; ++j) { const int sc = 16 * (2 * nh + j) + (lane & 15);
#pragma unroll
            for (int rr = 0; rr < 4; ++rr) { const int t = 16 * mt + 4 * (lane >> 4) + rr; *(LAS bf16_t*)(HP + (t * 72 + sc) * 2) = (bf16_t)f2bf(sc <= t ? as[j][rr] : 0.f); } }
        __syncthreads();
#pragma unroll
        for (int ks = 0; ks < 2; ++ks) {
            const bf16x8 ap = *(const LAS bf16x8*)(HP + (16 * mt + (lane & 15)) * 144 + (32 * ks + 8 * (lane >> 4)) * 2);
#pragma unroll
            for (int j = 0; j < 2; ++j) { const int nt = 2 * nh + j;
                const bf16x8 bv = trfrag(HV + (32 * ks + 8 * (lane >> 4) + ((lane & 15) >> 2)) * 144 + (16 * nt + 4 * (lane & 3)) * 2, 4 * 144);
                ao[j] = mfma16(ap, bv, ao[j]); }
        }
#pragma unroll
        for (int j = 0; j < 2; ++j) { const int v = 16 * (2 * nh + j) + (lane & 15);
#pragma unroll
            for (int rr = 0; rr < 4; ++rr) { const int t = 16 * mt + 4 * (lane >> 4) + rr, tt = d == 0 ? t : 63 - t;
                if (d == 0) HO[tt * 68 + v] = ao[j][rr]; else HO[tt * 68 + v] += ao[j][rr]; } }
        if (d == 1) {
            __syncthreads();
#pragma unroll
            for (int i = 0; i < 8; ++i) { const int tt = 8 * w + i, row = ct < 4 ? NLAT + b * 256 + 64 * ct + tt : b * 2048 + 64 * (ct - 4) + tt, cidx = hd * 64 + lane;
                float o = HO[tt * 68 + lane]; const float ms = wave_sum(o * o) * (1.f / 64.f);
                o = o * rsqrtf(ms + EPS) * a->in[25][l * 256 + cidx] * siluf_(bf2f(Z[(size_t)row * ZC + ZG + cidx]));
                YHG[(size_t)row * 256 + cidx] = (bf16_t)f2bf(o); }
        }
    }
}
#endif

#if !NAIVE_S5
typedef f32x2 cf32;
__device__ __forceinline__ cf32 cmul(cf32 a, cf32 b) { return (cf32){a.x * b.x - a.y * b.y, a.x * b.y + a.y * b.x}; }
__device__ __forceinline__ void s5_build(Frame& F, ArgsP a) {
    LAS cf32* lamp = (LAS cf32*)F.lds;
    LAS cf32* Bb = lamp + 2 * 17 * 64;
    LAS cf32* Cc = Bb + 2 * 64 * 16;
    LAS float* Kd = (LAS float*)(Cc + 2 * 16 * 64);
    const int tid = F.tid;
    for (int unit = blockIdx.x; unit < 128; unit += F.G) {
        const int l = unit >> 6, g = (unit >> 2) & 15, q = unit & 3;
        bf16_t* Bs_t = (bf16_t*)(F.ws + WS_WB + (size_t)l * WL_STRIDE + WL_BS); bf16_t* B2_t = (bf16_t*)(F.ws + WS_WB + (size_t)l * WL_STRIDE + WL_B2);
        __syncthreads();
        if (tid < 128) { const int d = tid >> 6, p = tid & 63, idx = (l * 2 + d) * 16 + g;
            const float lre = a->in[9][idx * 64 + p], lim = a->in[10][idx * 64 + p], dt = expf(a->in[15][idx]);
            const float ar = lre * dt, ai = lim * dt;
            for (int tau = 0; tau <= 16; ++tau) { const float mag = expf(ar * (float)tau); float sn, cs; sincosf(ai * (float)tau, &sn, &cs); lamp[(d * 17 + tau) * 64 + p] = (cf32){mag * cs, mag * sn}; }
            const cf32 lb = lamp[(d * 17 + 1) * 64 + p]; const float den = lre * lre + lim * lim;
            const cf32 f = (cf32){((lb.x - 1.f) * lre + lb.y * lim) / den, (lb.y * lre - (lb.x - 1.f) * lim) / den};
            { const f32x4* br4 = (const f32x4*)(a->in[11] + (size_t)(idx * 64 + p) * 16); const f32x4* bi4 = (const f32x4*)(a->in[12] + (size_t)(idx * 64 + p) * 16);
              f32x4 br[4], bi[4];
#pragma unroll
              for (int q4 = 0; q4 < 4; ++q4) { br[q4] = br4[q4]; bi[q4] = bi4[q4]; }
#pragma unroll
              for (int h = 0; h < 16; ++h) Bb[(d * 64 + p) * 16 + h] = cmul(f, (cf32){br[h >> 2][h & 3], bi[h >> 2][h & 3]}); }
            if (q == 0) ((cf32*)(F.ws + WS_S5P))[idx * 64 + p] = lamp[(d * 17 + 16) * 64 + p];
        }
        for (int e = tid; e < 2048; e += 512) { const int d = e >> 10, h = (e >> 6) & 15, p = e & 63, idx = (l * 2 + d) * 16 + g;
            Cc[e] = (cf32){a->in[13][(size_t)(idx * 16 + h) * 64 + p], a->in[14][(size_t)(idx * 16 + h) * 64 + p]}; }
        __syncthreads();
        { const int d = tid >> 8, tau = (tid >> 4) & 15, h = tid & 15; float kacc[16];
#pragma unroll
          for (int hp = 0; hp < 16; ++hp) kacc[hp] = 0.f;
          for (int p = 0; p < 64; ++p) { const cf32 t1 = cmul(Cc[(d * 16 + h) * 64 + p], lamp[(d * 17 + tau) * 64 + p]);
#pragma unroll
              for (int hp = 0; hp < 16; ++hp) { const cf32 bb = Bb[(d * 64 + p) * 16 + hp]; kacc[hp] += t1.x * bb.x - t1.y * bb.y; } }
#pragma unroll
          for (int hp = 0; hp < 16; ++hp) Kd[tid * 16 + hp] = kacc[hp]; }
        __syncthreads();
        for (int e = tid; e < 64 * 512; e += 512) { const int n = 64 * q + (e >> 9), kk = e & 511, i = n >> 4, h = n & 15; float val;
            if (kk < 256) { const int j = kk >> 4, hp = kk & 15; val = 0.f;
                if (j <= i) val += Kd[((i - j) * 16 + h) * 16 + hp];
                if (j >= i) val += Kd[4096 + ((j - i) * 16 + h) * 16 + hp]; }
            else { const int dd = (kk - 256) >> 7, pp = (kk - 256) & 127, p = pp & 63, pw = dd == 0 ? i + 1 : 16 - i;
                const cf32 cl = cmul(Cc[(dd * 16 + h) * 64 + p], lamp[(dd * 17 + pw) * 64 + p]); val = pp < 64 ? cl.x : -cl.y; }
            B2_t[((size_t)g * 256 + n) * 512 + kk] = (bf16_t)f2bf(val); }
        { const int d = q & 1, half = q >> 1;
          for (int e = tid; e < 64 * 256; e += 512) { const int p = e >> 8, kk = e & 255, j = kk >> 4, hp = kk & 15, pw = d == 0 ? 15 - j : j;
              const cf32 v = cmul(lamp[(d * 17 + pw) * 64 + p], Bb[(d * 64 + p) * 16 + hp]);
              Bs_t[((size_t)(g * 2 + d) * 128 + half * 64 + p) * 256 + kk] = (bf16_t)f2bf(half ? v.y : v.x); } }
    }
    __syncthreads();
}
__device__ __forceinline__ void s5_state_phase(Frame& F, int l) {
    bf16_t* S5A = (bf16_t*)(F.ws + WS_MIX + MX_S5A); const bf16_t* Bs_t = (const bf16_t*)(F.ws + WS_WB + (size_t)l * WL_STRIDE + WL_BS);
    const cf32* lam16 = (const cf32*)(F.ws + WS_S5P);
    LAS float* hl = (LAS float*)F.lds;
    const int lane = F.lane, w = F.wave;
    for (int unit = F.vcu; unit < 256; unit += F.G) {
        const int b = unit & 7, d = (unit >> 3) & 1, g = unit >> 4;
        __syncthreads();
        f32x4 acc[10] = {};
        { u32x4 ta[10]; const bf16_t* Asrc = S5A + ((size_t)g * 1280 + b * 160) * 512;
#pragma unroll
          for (int j = 0; j < 10; ++j) { const int pc = F.tid + 512 * j; ta[j] = *(const u32x4*)(Asrc + (size_t)(pc >> 5) * 512 + (pc & 31) * 8); }
          const bf16_t* Bb = Bs_t + ((size_t)(g * 2 + d) * 128 + 16 * w + (lane & 15)) * 256 + 8 * (lane >> 4);
          bf16x8 bfr[8];
#pragma unroll
          for (int ks = 0; ks < 8; ++ks) bfr[ks] = *(const bf16x8*)(Bb + 32 * ks);
#pragma unroll
          for (int j = 0; j < 10; ++j) { const int pc = F.tid + 512 * j; *(LAS u32x4*)(F.lds + (pc >> 5) * 528 + (pc & 31) * 16) = ta[j]; }
          __syncthreads();
#pragma unroll
          for (int ks = 0; ks < 8; ++ks)
#pragma unroll
              for (int mt = 0; mt < 10; ++mt) acc[mt] = mfma16(*(const LAS bf16x8*)(F.lds + (16 * mt + (lane & 15)) * 528 + (32 * ks + 8 * (lane >> 4)) * 2), bfr[ks], acc[mt]);
          __syncthreads(); }
#pragma unroll
        for (int mt = 0; mt < 10; ++mt)
#pragma unroll
            for (int rr = 0; rr < 4; ++rr) hl[(16 * mt + 4 * (lane >> 4) + rr) * 132 + 16 * w + (lane & 15)] = acc[mt][rr];
        __syncthreads();
        if (w == 0) { const cf32 lm = lam16[((l * 2 + d) * 16 + g) * 64 + lane]; float hr = 0.f, hi = 0.f;
            bf16_t* dst = S5A + ((size_t)g * 1280 + b * 160) * 512 + 256 + d * 128 + lane;
            for (int s = 0; s < 144; ++s) { const int c = d == 0 ? s : (s < 16 ? 15 - s : 159 - s);
                dst[(size_t)c * 512] = (bf16_t)f2bf(hr); dst[(size_t)c * 512 + 64] = (bf16_t)f2bf(hi);
                const float lr = hl[c * 132 + lane], li = hl[c * 132 + 64 + lane];
                const float nr = lm.x * hr - lm.y * hi + lr, ni = lm.x * hi + lm.y * hr + li; hr = nr; hi = ni; }
        }
    }
}
struct WinOrderLast { pg8::StaticOrder S0; int G, c;
    __device__ bool next(int i, pg8::Unit& u) const { const int L = i * G + c; if (L < S0.nwg) return S0.next(i, u); const int e = L - S0.nwg; if (e >= 64) return false;
        const int t = e >> 3; u.pm = 64 + (e & 7); u.pn = t == 0 ? 0 : (t == 1 ? 2 : t + 2); u.h = -1; return true; } };
struct S5Order { int G, c; __device__ bool next(int i, pg8::Unit& u) const { const int L = i * G + c; if (L >= 80) return false; u.pm = L; u.pn = L / 5; u.h = -1; return true; } };
struct HalfTailOrder { pg8::StaticOrder S0; int G, c;
    __device__ bool next(int i, pg8::Unit& u) const { const int L = i * G + c; if (L < S0.nwg) return S0.next(i, u); const int e = L - S0.nwg; if (e >= 64) return false;
        u.pm = 64 + (e >> 3); u.pn = (e >> 1) & 3; u.h = e & 1; return true; } };
#endif

__device__ __forceinline__ bf16x8 pack8(const float (&v)[8]) { u32x4 w; w.x = pk2(v[0], v[1]); w.y = pk2(v[2], v[3]); w.z = pk2(v[4], v[5]); w.w = pk2(v[6], v[7]); return __builtin_bit_cast(bf16x8, w); }
__device__ __forceinline__ void norm2_router_phase(Frame& F, ArgsP a, int l, int nrows) {
    const float* X = (const float*)(F.ws + WS_X); bf16_t* H = (bf16_t*)(F.ws + WS_H);
    const float* modv = (const float*)(F.ws + WS_MODV) + (size_t)l * 9 * 6144;
    const float* Wg = a->in[30] + (size_t)l * D * 4; const float* bg = a->in[31] + l * 4; const float* We = a->in[32] + (size_t)l * D * 32; const float* be = a->in[33] + l * 32;
    int* ri = (int*)(F.ws + WS_ROUTE); float* rg = (float*)(F.ws + WS_ROUTE + (size_t)MTOK * 16);
    unsigned* cnt = (unsigned*)(F.ws + WS_CTL) + CW_CNT + l * 32 * 64;
    LAS unsigned char* hhi = F.lds; LAS unsigned char* hlo = F.lds + 33024; LAS float* part = (LAS float*)(F.lds + 66048); LAS float* lg = (LAS float*)(F.lds + 90624);
    const int w = F.wave, lane = F.lane, tid = F.tid;
    bf16x8 whi[4][3], wlo[4][3];
#pragma unroll
    for (int ks = 0; ks < 4; ++ks)
#pragma unroll
        for (int nt = 0; nt < 3; ++nt) { float hv[8], lv[8]; const int col = 16 * nt + (lane & 15);
#pragma unroll
            for (int i = 0; i < 8; ++i) { const int k = 128 * w + 32 * ks + 8 * (lane >> 4) + i;
                const float wv = col < 32 ? We[(size_t)k * 32 + col] : (col < 36 ? Wg[(size_t)k * 4 + (col - 32)] : 0.f);
                const float hi = bflo(pk2(wv, 0.f)); hv[i] = hi; lv[i] = wv - hi; }
            whi[ks][nt] = pack8(hv); wlo[ks][nt] = pack8(lv); }
    const int niter = nrows >> 4;
    for (int it = F.vcu; it < niter; it += F.G) {
        const int base = it * 16;
        __syncthreads();
#pragma unroll
        for (int rr = 0; rr < 2; ++rr) { const int lr = 2 * w + rr, row = base + lr; f32x4 v[4], h[4];
#pragma unroll
            for (int j = 0; j < 4; ++j) v[j] = *(const f32x4*)(X + (size_t)row * D + 4 * lane + 256 * j);
            const float* mv = modv + (size_t)tok_modrow(row) * 6144;
            norm_mod_row(v, h, a->in[7] + l * D, mv + 3 * 1024, mv + 4 * 1024, lane);
            store_row_bf16(H + (size_t)row * D, h, lane);
#pragma unroll
            for (int j = 0; j < 4; ++j) { u32x2 ph, pl; ph.x = pk2(h[j][0], h[j][1]); ph.y = pk2(h[j][2], h[j][3]);
                pl.x = pk2(h[j][0] - bflo(ph.x), h[j][1] - bfhi(ph.x)); pl.y = pk2(h[j][2] - bflo(ph.y), h[j][3] - bfhi(ph.y));
                *(LAS u32x2*)(hhi + (lr * 1032 + 4 * lane + 256 * j) * 2) = ph; *(LAS u32x2*)(hlo + (lr * 1032 + 4 * lane + 256 * j) * 2) = pl; } }
        __syncthreads();
        f32x4 acc[3] = {};
#pragma unroll
        for (int ks = 0; ks < 4; ++ks) { const int ao = ((lane & 15) * 1032 + 128 * w + 32 * ks + 8 * (lane >> 4)) * 2;
            const bf16x8 ahi = *(const LAS bf16x8*)(hhi + ao), alo = *(const LAS bf16x8*)(hlo + ao);
#pragma unroll
            for (int nt = 0; nt < 3; ++nt) { acc[nt] = mfma16(ahi, whi[ks][nt], acc[nt]); acc[nt] = mfma16(ahi, wlo[ks][nt], acc[nt]); acc[nt] = mfma16(alo, whi[ks][nt], acc[nt]); } }
#pragma unroll
        for (int nt = 0; nt < 3; ++nt)
#pragma unroll
            for (int r = 0; r < 4; ++r) part[(w * 16 + 4 * (lane >> 4) + r) * 48 + 16 * nt + (lane & 15)] = acc[nt][r];
        __syncthreads();
        for (int t = tid; t < 576; t += 512) { const int r = t / 36, c = t - r * 36; float sacc = 0.f;
#pragma unroll
            for (int q = 0; q < 8; ++q) sacc += part[(q * 16 + r) * 48 + c];
            lg[r * 40 + c] = sacc + (c < 32 ? be[c] : bg[c - 32]); }
        __syncthreads();
        if (tid < 16) { const int row = base + tid; const LAS float* lr = lg + tid * 40;
            int gi = 0; float gm = lr[32];
#pragma unroll
            for (int i = 1; i < 4; ++i) if (lr[32 + i] > gm) { gm = lr[32 + i]; gi = i; }
            float gs = 0.f;
#pragma unroll
            for (int i = 0; i < 4; ++i) gs += __expf(lr[32 + i] - gm);
            const float gw_ = 1.f / gs;
            const LAS float* el = lr + gi * 8;
            int i1 = 0; float v1 = el[0];
#pragma unroll
            for (int j = 1; j < 8; ++j) if (el[j] > v1) { v1 = el[j]; i1 = j; }
            int i2 = -1; float v2 = -3.0e38f;
#pragma unroll
            for (int j = 0; j < 8; ++j) if (j != i1 && el[j] > v2) { v2 = el[j]; i2 = j; }
            const float e2 = __expf(v2 - v1), g1 = gw_ / (1.f + e2), g2 = gw_ * e2 / (1.f + e2);
            const int e0 = gi * 8 + i1, e1 = gi * 8 + i2;
            const unsigned r0 = __hip_atomic_fetch_add(cnt + e0 * 64, 1u, __ATOMIC_RELAXED, __HIP_MEMORY_SCOPE_AGENT), r1 = __hip_atomic_fetch_add(cnt + e1 * 64, 1u, __ATOMIC_RELAXED, __HIP_MEMORY_SCOPE_AGENT);
            *(int4*)(ri + (size_t)row * 4) = make_int4(e0, e1, (int)r0, (int)r1);
            { int* lists = (int*)(F.ws + WS_LISTS); lists[(size_t)e0 * MTOK + r0] = row; lists[(size_t)e1 * MTOK + r1] = row; }
            rg[(size_t)row * 2 + 0] = g1; rg[(size_t)row * 2 + 1] = g2; }
    }
}
__device__ __forceinline__ int moe_starts(Frame& F, int l, int& total) {
    unsigned* cnt = (unsigned*)(F.ws + WS_CTL) + CW_CNT + l * 32 * 64;
    const int c = F.lane < 32 ? (int)__hip_atomic_load(cnt + (F.lane & 31) * 64, __ATOMIC_RELAXED, __HIP_MEMORY_SCOPE_AGENT) : 0;
    const int padded = (c + 255) & ~255; int incl = padded;
#pragma unroll
    for (int o = 1; o < 32; o <<= 1) { const int t = shfl_i(incl, F.lane - o); if (F.lane >= o) incl += t; }
    total = shfl_i(incl, 31);
    return incl - padded;
}
__device__ __forceinline__ void moe_gather_phase(Frame& F, int l, int nrows) {
    const bf16_t* H = (const bf16_t*)(F.ws + WS_H); bf16_t* XS = (bf16_t*)(F.ws + WS_Z + MZ_XS); const int* ri = (const int*)(F.ws + WS_ROUTE);
    int total; const int st = moe_starts(F, l, total);
    for (int row = F.gw; row < nrows; row += F.NGW) {
        const int e0 = ri[(size_t)row * 4], e1 = ri[(size_t)row * 4 + 1], r0 = ri[(size_t)row * 4 + 2], r1 = ri[(size_t)row * 4 + 3];
        const int d0 = shfl_i(st, e0) + r0, d1 = shfl_i(st, e1) + r1;
#pragma unroll
        for (int j = 0; j < 2; ++j) { const u32x4 w = *(const u32x4*)(H + (size_t)row * D + j * 512 + F.lane * 8);
            *(u32x4*)(XS + (size_t)d0 * D + j * 512 + F.lane * 8) = w; *(u32x4*)(XS + (size_t)d1 * D + j * 512 + F.lane * 8) = w; }
    }
}
__device__ __forceinline__ int moe_unit_wgid(int L, int nunits) { const int q = nunits / 8, r = nunits % 8, xcd = L % 8, off = L / 8; return (xcd < r ? xcd * (q + 1) : r * (q + 1) + (xcd - r) * q) + off; }
struct MoeOrder {
    int nunits, G, c; const LAS int* tile_e; const LAS int* rows;
    __device__ bool next(int i, pg8::Unit& u) const {
        const long L = (long)i * G + c; if (L >= nunits) return false;
        const int wgid = moe_unit_wgid((int)L, nunits), tile = wgid >> 2; const int te = tile_e[tile]; u.pm = tile; u.pn = (te & 255) * 4 + (wgid & 3); u.h = (te & 256) ? 0 : -1; return true;
    }
    __device__ unsigned a_row(int ui, int r) const { return (unsigned)rows[ui * 256 + r]; }
};
__device__ __forceinline__ int moe_build_tiles(Frame& F, int l, bool fill_rows) {
    LAS int* tbl = (LAS int*)(F.lds + TBL_OFF);
    __syncthreads();
    if (F.wave == 0) { int total; const int st = moe_starts(F, l, total); if (F.lane < 32) { tbl[F.lane] = st;
            tbl[256 + F.lane] = (int)__hip_atomic_load((unsigned*)(F.ws + WS_CTL) + CW_CNT + (l * 32 + F.lane) * 64, __ATOMIC_RELAXED, __HIP_MEMORY_SCOPE_AGENT); }
        if (F.lane == 0) tbl[32] = total; }
    __syncthreads();
    const int total = tbl[32], ntiles = total >> 8;
    for (int t = F.tid; t < ntiles; t += 512) { int e = 0;
#pragma unroll
        for (int j = 1; j < 32; ++j) if (tbl[j] <= t * 256) e = j;
        tbl[64 + t] = e | ((tbl[256 + e] - (t * 256 - tbl[e]) <= 128) ? 256 : 0); }
    __syncthreads();
    if (fill_rows) { const int* lists = (const int*)(F.ws + WS_LISTS); const int nunits = ntiles * 4;
        for (int x = F.tid; x < 768; x += 512) { const int ui = x >> 8, r = x & 255, L = ui * F.G + (int)blockIdx.x; int src = 0;
            if (L < nunits) { const int tile = moe_unit_wgid(L, nunits) >> 2, e = tbl[64 + tile] & 255, rank = tile * 256 - tbl[e] + r; if (rank < tbl[256 + e]) src = lists[(size_t)e * MTOK + rank]; }
            tbl[512 + x] = src; }
        __syncthreads(); }
    return ntiles;
}
__device__ __forceinline__ void moe_combine_phase(Frame& F, ArgsP a, int l, int nrows, bool dry = false) {
    float* X = (float*)(F.ws + WS_X); float* Xo = dry ? (float*)(F.ws + WS_Z + 132 * MiB) : X; float* outp = dry ? Xo : a->out; bf16_t* H = (bf16_t*)(F.ws + WS_H); const bf16_t* Y = (const bf16_t*)(F.ws + WS_Z + MZ_XS);
    const int* ri = (const int*)(F.ws + WS_ROUTE); const float* rg = (const float*)(F.ws + WS_ROUTE + (size_t)MTOK * 16);
    const float* modv = (const float*)(F.ws + WS_MODV);
    int total; const int st = moe_starts(F, l, total);
    for (int row = F.gw; row < nrows; row += F.NGW) {
        const int e0 = ri[(size_t)row * 4], e1 = ri[(size_t)row * 4 + 1], r0 = ri[(size_t)row * 4 + 2], r1 = ri[(size_t)row * 4 + 3];
        const int p0 = shfl_i(st, e0) + r0, p1 = shfl_i(st, e1) + r1; const float g0 = rg[(size_t)row * 2], g1 = rg[(size_t)row * 2 + 1];
        const float* mv = modv + ((size_t)l * 9 + tok_modrow(row)) * 6144;
        f32x4 v[4];
#pragma unroll
        for (int j = 0; j < 4; ++j) { const int c = 4 * F.lane + 256 * j;
            const u32x2 y0 = *(const u32x2*)(Y + (size_t)p0 * D + c), y1 = *(const u32x2*)(Y + (size_t)p1 * D + c);
            const f32x4 f = { g0 * bflo(y0.x) + g1 * bflo(y1.x), g0 * bfhi(y0.x) + g1 * bfhi(y1.x), g0 * bflo(y0.y) + g1 * bflo(y1.y), g0 * bfhi(y0.y) + g1 * bfhi(y1.y) };
            v[j] = *(const f32x4*)(X + (size_t)row * D + c) + *(const f32x4*)(mv + 5 * 1024 + c) * f; }
        if (l == 0) {
#pragma unroll
            for (int j = 0; j < 4; ++j) *(f32x4*)(Xo + (size_t)row * D + 4 * F.lane + 256 * j) = v[j];
            f32x4 h[4]; const float* mv1 = modv + ((size_t)9 + tok_modrow(row)) * 6144;
            norm_mod_row(v, h, a->in[6] + D, mv1, mv1 + 1024, F.lane);
            store_row_bf16(H + (size_t)row * D, h, F.lane);
        } else {
            float ss = 0.f;
#pragma unroll
            for (int j = 0; j < 4; ++j) ss += (v[j][0] * v[j][0] + v[j][1] * v[j][1]) + (v[j][2] * v[j][2] + v[j][3] * v[j][3]);
            const float rstd = rsqrtf(wave_sum(ss) * (1.f / D) + EPS);
#pragma unroll
            for (int j = 0; j < 4; ++j) { const int c = 4 * F.lane + 256 * j; *(f32x4*)(outp + (size_t)row * D + c) = v[j] * rstd * *(const f32x4*)(a->in[37] + c); }
        }
    }
}

#define REOPAQUE() { unsigned m1_ = ~0u; asm volatile("" : "+s"(m1_)); int ln_ = __builtin_amdgcn_mbcnt_hi(m1_, __builtin_amdgcn_mbcnt_lo(m1_, 0u)); asm volatile("" : "+v"(ln_)); F.lane = ln_; F.wave = wave_s; F.tid = wave_s * 64 + ln_; F.gw = F.vcu * NWAVES + F.wave; int z_ = 0; asm volatile("" : "+s"(z_)); args = (ArgsP)__builtin_amdgcn_kernarg_segment_ptr() + z_; F.ws = args->ws; }
#define PH_BEGIN if (ph >= lo && ph < hi) { REOPAQUE()
#define PH_END } if (ph >= lo && ph + 1 < hi) { if (!MK_PER_PHASE) REP(15) xcd_barrier_fn(bar.bar, bar.x, (unsigned)(uintptr_t)bar.st, F.tid); } ++ph;

#define pH ((bf16_t*)(F.ws + WS_H))
#define pZ ((bf16_t*)(F.ws + WS_Z))
#define pX ((float*)(F.ws + WS_X))
#define pMix (F.ws + WS_MIX)
#define pSsq ((float*)(F.ws + WS_SSQ))
#define pRope ((const float*)(F.ws + WS_ROPE))
#define pWl (F.ws + WS_WB + (size_t)l * WL_STRIDE)
#define pModv ((const float*)(F.ws + WS_MODV) + (size_t)l * 9 * 6144)


template <int l> __device__ __forceinline__ void layer_prog(Frame& F, ArgsP& args, int& ph, const int lo, const int hi, const XcdBarrier& bar, const int wave_s) {
        const bool need_ctx = (l == 0); const int nrows = need_ctx ? MTOK : NLAT;

        PH_BEGIN REP(1) { pg8::Gemm g{pH, (const bf16_t*)(pWl + WL_WIN), D, D, D};
            Epi<EM_Z> E{}; E.ssq = pSsq; E.rope = pRope; E.o0 = pZ; E.o1 = (bf16_t*)(pMix + MX_KPE); E.o2 = (bf16_t*)(pMix + MX_S5A);
            if constexpr (l == 0) { pg8::StaticOrder S; S.init(MTOK, ZC, F.G, (int)blockIdx.x); pg8::gemm_phase(F.lds, F.tid, g, S, E); }
            else { WinOrderLast S; S.S0.init(NLAT, ZC, F.G, (int)blockIdx.x); S.G = F.G; S.c = (int)blockIdx.x; pg8::gemm_phase(F.lds, F.tid, g, S, E); } } PH_END

        PH_BEGIN {
            REP(2) { pg8::Gemm g{pZ + ZCQ, (const bf16_t*)(pWl + WL_UQ), 256, ZC, 256}; pg8::StaticOrder S; S.init(nrows, 768, F.G, ((int)blockIdx.x + F.G - 32) % F.G);
              Epi<EM_Q> E{}; E.ssq = pSsq; E.rope = pRope; E.o0 = (bf16_t*)(pMix + MX_Q); pg8::gemm_phase(F.lds, F.tid, g, S, E); }
            REOPAQUE()
            REP(2) { pg8::Gemm g{pZ + ZCKV, (const bf16_t*)(pWl + WL_UKV), 128, ZC, 128}; pg8::StaticOrder S; S.init(MTOK, 1024, F.G, (int)blockIdx.x);
              Epi<EM_KV> E{}; E.ssq = pSsq; E.o0 = (bf16_t*)(pMix + MX_KN); E.o1 = (bf16_t*)(pMix + MX_V); pg8::gemm_phase(F.lds, F.tid, g, S, E); }
            REOPAQUE()
#if NAIVE_S5
            s5_naive(F, args, l);
#else
            REP(3) s5_state_phase(F, l);
#endif
            REOPAQUE()
#if NAIVE_HG
            hg_naive(F, args, l);
#else
            REP(4) hg_local_phase(F, args, l);
#endif
        } PH_END

        PH_BEGIN {
#if NAIVE_ATTN
            attn_naive(F, need_ctx);
#else
#if PROBE_PH >= 50 && PROBE_PH < 60
            attn_fast<PROBE_PH - 49>(F, need_ctx, (bf16_t*)args->out); REOPAQUE()
#endif
            attn_fast<0>(F, need_ctx, (bf16_t*)(pMix + MX_YMLA));
#endif
            REOPAQUE()
#if NAIVE_S5
            s5_naive_finish(F, args, l, nrows);
#else
            REP(6) { pg8::Gemm g{(const bf16_t*)(pMix + MX_S5A), (const bf16_t*)(pWl + WL_B2), 512, 512, 512}; S5Order S{F.G, (F.vcu + F.G - 64) % F.G};
              Epi<EM_S5> E{}; E.o0 = (bf16_t*)(pMix + MX_YS5P); E.i0 = (const bf16_t*)(pMix + MX_S5A); E.f0 = args->in[16] + l * 256; pg8::gemm_phase(F.lds, F.tid, g, S, E); }
#endif
            REOPAQUE()
#if NAIVE_HG
            hg_naive_finish(F, args, l, nrows);
#else
            hg_scan_phase(F);
#endif
        } PH_END

        PH_BEGIN {
#if !NAIVE_HG
            REP(7) hg_out_phase(F, args, l, need_ctx);
            REOPAQUE()
#endif
            REP(8) { pg8::Gemm g{(const bf16_t*)(pMix + MX_YS5P), (const bf16_t*)(pWl + WL_GLU), 256, 256, 256}; pg8::StaticOrder S; S.init(nrows, 256, F.G, (F.vcu + F.G - 128) % F.G);
            Epi<EM_GLU> E{}; E.o0 = (bf16_t*)(pMix + MX_YS5); E.i0 = (const bf16_t*)(pMix + MX_YS5P); E.f0 = args->in[18] + l * 256;
            pg8::gemm_phase(F.lds, F.tid, g, S, E); } } PH_END

        PH_BEGIN {
#define MERGE3(S, HS) do { \
            { pg8::Gemm g{(const bf16_t*)(pMix + MX_YS5), (const bf16_t*)(pWl + WL_PA), 256, 256, 256}; Epi<EM_MERGE0> E{}; E.o0 = pH; E.i0 = pZ + ZGA; pg8::gemm_phase<Epi<EM_MERGE0>, decltype(S), false, HS>(F.lds, F.tid, g, S, E); } \
            { pg8::Gemm g{(const bf16_t*)(pMix + MX_YMLA), (const bf16_t*)(pWl + WL_PB), 512, 512, 512}; Epi<EM_MERGE1> E{}; E.o0 = pH; E.i0 = pZ + ZGB; pg8::gemm_phase<Epi<EM_MERGE1>, decltype(S), false, HS>(F.lds, F.tid, g, S, E); } \
            { pg8::Gemm g{(const bf16_t*)(pMix + MX_YHG), (const bf16_t*)(pWl + WL_PC), 256, 256, 256}; Epi<EM_MERGE1> E{}; E.o0 = pH; E.i0 = pZ + ZGC; pg8::gemm_phase<Epi<EM_MERGE1>, decltype(S), false, HS>(F.lds, F.tid, g, S, E); } } while (0)
            if constexpr (l == 0) { HalfTailOrder S; S.S0.init(NLAT, 1024, F.G, (int)blockIdx.x); S.G = F.G; S.c = (int)blockIdx.x; MERGE3(S, true); }
            else { pg8::StaticOrder S; S.init(NLAT, 1024, F.G, (int)blockIdx.x); MERGE3(S, false); }
#undef MERGE3
        } PH_END

        PH_BEGIN { pg8::Gemm g{pH, (const bf16_t*)(pWl + WL_OUT), D, D, D};
            Epi<EM_WOUT> E{}; E.layer = l; E.f0 = pModv; E.f1 = args->in[0]; E.f2 = args->in[2]; E.fo = pX;
            if constexpr (l == 0) { HalfTailOrder S; S.S0.init(NLAT, 1024, F.G, (int)blockIdx.x); S.G = F.G; S.c = (int)blockIdx.x; pg8::gemm_phase<Epi<EM_WOUT>, HalfTailOrder, false, true>(F.lds, F.tid, g, S, E); }
            else { pg8::StaticOrder S; S.init(NLAT, 1024, F.G, (int)blockIdx.x); pg8::gemm_phase(F.lds, F.tid, g, S, E); } } PH_END

        PH_BEGIN { norm2_router_phase(F, args, l, nrows); REOPAQUE() REP(11) moe_convert(F, args, l); } PH_END
        PH_BEGIN REP(13) { const int nt = moe_build_tiles(F, l, true); MoeOrder S{nt * 4, F.G, (int)blockIdx.x, (const LAS int*)(F.lds + TBL_OFF) + 64, (const LAS int*)(F.lds + TBL_OFF) + 512};
            pg8::Gemm g{pH, (const bf16_t*)(pMix + MW_W13), D, D, D};
            Epi<EM_MOEUP> E{}; E.o0 = (bf16_t*)(F.ws + WS_Z + MZ_HID); pg8::gemm_phase<Epi<EM_MOEUP>, MoeOrder, true, true>(F.lds, F.tid, g, S, E); } PH_END
        PH_BEGIN REP(14) { const int nt = moe_build_tiles(F, l, false); MoeOrder S{nt * 4, F.G, (int)blockIdx.x, (const LAS int*)(F.lds + TBL_OFF) + 64, (const LAS int*)(F.lds + TBL_OFF) + 512};
            pg8::Gemm g{(const bf16_t*)(F.ws + WS_Z + MZ_HID), (const bf16_t*)(pMix + MW_W2), HID, HID, HID};
            Epi<EM_MOEDN> E{}; E.o0 = (bf16_t*)(F.ws + WS_Z + MZ_XS); pg8::gemm_phase<Epi<EM_MOEDN>, MoeOrder, false, true>(F.lds, F.tid, g, S, E); } PH_END
        PH_BEGIN { if (PROBE_PH == 19) { moe_combine_phase(F, args, l, nrows, true); REOPAQUE() } moe_combine_phase(F, args, l, nrows); } PH_END
    }

__global__ void __launch_bounds__(NWAVES * 64, 2) mega_fwd(Args args_by_value) {
    ArgsP args = (ArgsP)__builtin_amdgcn_kernarg_segment_ptr();
    extern __shared__ __attribute__((aligned(16))) unsigned char lds_raw[];
    Frame F;
    F.lds = (LAS unsigned char*)lds_raw;
    F.tid = threadIdx.x; F.lane = F.tid & 63; F.wave = __builtin_amdgcn_readfirstlane(F.tid >> 6);
    const int wave_s = F.wave;
    F.G = gridDim.x; { const int bx = blockIdx.x; F.vcu = (F.G % 8 == 0) ? (bx % 8) * (F.G / 8) + bx / 8 : bx; }
    F.gw = F.vcu * NWAVES + F.wave; F.NGW = F.G * NWAVES; F.ws = args->ws;
    volatile LAS unsigned* MISC = (volatile LAS unsigned*)(F.lds + MISC_OFF);
    for (int u = F.tid; u < (LDS_BYTES - RING_BYTES) / 4; u += NWAVES * 64) ((LAS unsigned*)(F.lds + RING_BYTES))[u] = 0u;
    __syncthreads();
    unsigned* ctl = (unsigned*)(F.ws + WS_CTL);
    XcdBarrier bar; bar.bar = ctl + CW_BAR; bar.x = 0; bar.st = nullptr;
    if (!MK_PER_PHASE) bar = xcd_barrier_post(ctl + CW_BAR, MISC + 8);
    const int lo = args->ph_lo, hi = args->ph_hi;
    int ph = 0;
    PH_BEGIN REP(17) prologue_phase(F, args); PH_END
    PH_BEGIN REP(16) norm1_phase(F, args, 0, MTOK); PH_END

    layer_prog<0>(F, args, ph, lo, hi, bar, wave_s);
    layer_prog<1>(F, args, ph, lo, hi, bar, wave_s);
#undef PH_BEGIN
#undef REOPAQUE
#undef PH_END
#undef pH
#undef pZ
#undef pX
#undef pMix
#undef pSsq
#undef pRope
#undef pWl
#undef pModv
}
constexpr int N_PHASES = 2 + 2 * 10;

extern "C" void kernel_launch(void* const* d_in, const int* in_sizes, int n_in, void* d_out, int out_size, void* d_ws, size_t ws_size, hipStream_t stream) {
    static int grid = 0;
    if (grid == 0) {
        if (n_in != 38 || out_size != NLAT * D || ws_size < WS_END) { fprintf(stderr, "kernel_launch: unexpected shapes (n_in %d out %d ws %zu need %zu)\n", n_in, out_size, ws_size, (size_t)WS_END); grid = -1; return; }
        int dev = 0, cus = 0, per_cu = 0;
        if (hipGetDevice(&dev) != hipSuccess || hipDeviceGetAttribute(&cus, hipDeviceAttributeMultiprocessorCount, dev) != hipSuccess) { grid = -1; return; }
        if (hipFuncSetAttribute((const void*)mega_fwd, hipFuncAttributeMaxDynamicSharedMemorySize, LDS_BYTES) != hipSuccess) { fprintf(stderr, "kernel_launch: hipFuncSetAttribute failed\n"); grid = -1; return; }
        if (hipOccupancyMaxActiveBlocksPerMultiprocessor(&per_cu, (const void*)mega_fwd, NWAVES * 64, LDS_BYTES) != hipSuccess || per_cu < 1) { fprintf(stderr, "kernel_launch: occupancy query says %d\n", per_cu); }
        (void)hipGetLastError();
        grid = cus;
    }
    if (grid < 0) return;
    (void)hipMemsetAsync((char*)d_ws + WS_CTL, 0, CTL_ZERO_BYTES, stream);
    Args a{};
    for (int i = 0; i < 38; ++i) a.in[i] = (const float*)d_in[i];
    a.out = (float*)d_out; a.ws = (unsigned char*)d_ws;
#if MK_PER_PHASE
    for (int p = 0; p < N_PHASES; ++p) { a.ph_lo = p; a.ph_hi = p + 1; hipLaunchKernelGGL(mega_fwd, dim3(grid), dim3(NWAVES * 64), LDS_BYTES, stream, a); }
#else
    a.ph_lo = 0; a.ph_hi = N_PHASES;
    hipLaunchKernelGGL(mega_fwd, dim3(grid), dim3(NWAVES * 64), LDS_BYTES, stream, a);
#endif
}
```

```cpp
#include <hip/hip_runtime.h>
#include <cstdio>
#include <cstdint>

#ifndef NAIVE_ATTN
#define NAIVE_ATTN 0
#endif
#ifndef NAIVE_S5
#define NAIVE_S5 0
#endif
#ifndef NAIVE_HG
#define NAIVE_HG 0
#endif
#ifndef PROBE_PH
#define PROBE_PH 0
#endif
#ifndef PROBE_N
#define PROBE_N 1
#endif
#define REP(id) for (int rep_ = 0; rep_ < ((PROBE_PH == (id)) ? PROBE_N : 1); ++rep_)
#ifndef MK_PER_PHASE
#define MK_PER_PHASE 0
#endif

#define GAS __attribute__((address_space(1)))
#define LAS __attribute__((address_space(3)))
typedef unsigned short bf16_t;
typedef short bf16x8 __attribute__((ext_vector_type(8)));
typedef float f32x4 __attribute__((ext_vector_type(4)));
typedef float f32x2 __attribute__((ext_vector_type(2)));
typedef float f32x16 __attribute__((ext_vector_type(16)));
typedef unsigned u32x4 __attribute__((ext_vector_type(4)));
typedef unsigned u32x2 __attribute__((ext_vector_type(2)));
typedef GAS unsigned gu32;

constexpr int D = 1024, NB = 8, SEQ = 2048, CTXL = 256, NLAT = NB * SEQ, NCTX = NB * CTXL, MTOK = NLAT + NCTX;
constexpr int ZC = 5888, INC = 5792;
constexpr int ZU = 0, ZCQ = 256, ZCKV = 512, ZKPE = 640, ZHQ = 672, ZF0 = 1184, ZF1 = 1696, ZI = 2208, ZG = 2464, ZGA = 2720, ZGB = 3744, ZGC = 4768;
constexpr float EPS = 1e-6f;
constexpr float QSCALE = 0.10206207261596577f * 1.4426950408889634f;
constexpr int NEXP = 32, HID = 512;
constexpr int XS_ROWS = 45056;

constexpr size_t MiB = 1u << 20;
constexpr size_t WS_CTL = 0, CTL_ZERO_BYTES = 96 * 1024;
constexpr size_t WS_MODV = 1 * MiB;
constexpr size_t WS_ROPE = 2 * MiB;
constexpr size_t WS_SSQ = 2 * MiB + 65536;
constexpr size_t WS_ROUTE = 3 * MiB;
constexpr size_t WS_S5P = 4 * MiB;
constexpr size_t WS_LISTS = 5 * MiB;
constexpr size_t WS_WB = 8 * MiB;
constexpr size_t WL_WIN = 0, WL_UQ = WL_WIN + (size_t)ZC * D * 2, WL_UKV = WL_UQ + 768 * 256 * 2, WL_GLU = WL_UKV + 1024 * 128 * 2,
                 WL_PA = WL_GLU + 256 * 256 * 2, WL_PB = WL_PA + 1024 * 256 * 2, WL_PC = WL_PB + 1024 * 512 * 2, WL_OUT = WL_PC + 1024 * 256 * 2,
                 WL_BS = WL_OUT + 1024 * 1024 * 2, WL_B2 = WL_BS + 32 * 128 * 256 * 2, WL_END = WL_B2 + 16 * 256 * 512 * 2;
constexpr size_t WL_STRIDE = 24 * MiB;
static_assert(WL_END <= WL_STRIDE, "weights per layer");
constexpr size_t WS_X = 56 * MiB;
constexpr size_t WS_H = 128 * MiB;
constexpr size_t WS_MIX = 164 * MiB;
constexpr size_t MX_Q = 0, MX_KN = MX_Q + (size_t)MTOK * 768 * 2, MX_V = MX_KN + (size_t)MTOK * 512 * 2, MX_KPE = MX_V + (size_t)MTOK * 512 * 2,
                 MX_YS5P = MX_KPE + (size_t)MTOK * 32 * 2, MX_YS5 = MX_YS5P + (size_t)MTOK * 256 * 2, MX_YHG = MX_YS5 + (size_t)MTOK * 256 * 2,
                 MX_YMLA = MX_YHG + (size_t)MTOK * 256 * 2, MX_S5A = MX_YMLA + (size_t)MTOK * 512 * 2, MX_HGD = MX_S5A + (size_t)16 * 1280 * 512 * 2,
                 MX_END = MX_HGD + (size_t)2304 * 128 * 4;
static_assert(MX_END <= 132 * MiB, "mixer region");
constexpr size_t MW_W13 = 0, MW_W2 = (size_t)NEXP * 1024 * 1024 * 2;
static_assert(MW_W2 + (size_t)NEXP * 1024 * 512 * 2 <= 132 * MiB, "moe weights");
constexpr size_t WS_Z = 296 * MiB;
constexpr size_t MZ_XS = 0, MZ_HID = (size_t)XS_ROWS * 1024 * 2;
constexpr size_t WS_END = WS_Z + (size_t)MTOK * ZC * 2;
static_assert(MZ_HID + (size_t)XS_ROWS * 512 * 2 <= (size_t)MTOK * ZC * 2, "moe buffers");
constexpr int CW_BAR = 4096;
constexpr int CW_CNT = 16384;

__device__ __forceinline__ unsigned f2bf(float f) { unsigned u = __builtin_bit_cast(unsigned, f); return (u + 0x7fffu + ((u >> 16) & 1u)) >> 16; }
typedef __bf16 bf16x2_t __attribute__((ext_vector_type(2)));
__device__ __forceinline__ unsigned pk2(float lo, float hi) { const f32x2 v = {lo, hi}; return __builtin_bit_cast(unsigned, __builtin_convertvector(v, bf16x2_t)); }
__device__ __forceinline__ float bf2f(unsigned short b) { return __builtin_bit_cast(float, (unsigned)b << 16); }
__device__ __forceinline__ float bflo(unsigned w) { return __builtin_bit_cast(float, w << 16); }
__device__ __forceinline__ float bfhi(unsigned w) { return __builtin_bit_cast(float, w & 0xffff0000u); }
template <int CTRL> __device__ __forceinline__ float dppf(float v) { return __builtin_bit_cast(float, __builtin_amdgcn_update_dpp(0, __builtin_bit_cast(int, v), CTRL, 0xf, 0xf, true)); }
__device__ __forceinline__ float rlanef(float v, int l) { return __builtin_bit_cast(float, __builtin_amdgcn_readlane(__builtin_bit_cast(int, v), l)); }
__device__ __forceinline__ float wave_sum(float v) {
    v += dppf<0xB1>(v); v += dppf<0x4E>(v); v += dppf<0x141>(v); v += dppf<0x140>(v);
    return (rlanef(v, 0) + rlanef(v, 16)) + (rlanef(v, 32) + rlanef(v, 48));
}
__device__ __forceinline__ int shfl_i(int v, int src_lane) { return __builtin_amdgcn_ds_bpermute(src_lane << 2, v); }
__device__ __forceinline__ float shfl_f(float v, int src_lane) { return __builtin_bit_cast(float, __builtin_amdgcn_ds_bpermute(src_lane << 2, __builtin_bit_cast(int, v))); }
__device__ __forceinline__ float sigmoidf_(float x) { return __builtin_amdgcn_rcpf(1.f + __expf(-x)); }
__device__ __forceinline__ float siluf_(float x) { return x * __builtin_amdgcn_rcpf(1.f + __expf(-x)); }
__device__ __forceinline__ float gelu_tanh(float x) { const float t = 0.7978845608028654f * (x + 0.044715f * x * x * x); return x * __builtin_amdgcn_rcpf(1.f + __expf(-2.f * t)); }
__device__ __forceinline__ int tok_modrow(int row) { return row < NLAT ? (row >> 11) : 8; }

namespace pg8 {
constexpr int BM = 256, BK = 64, HALF = 128, HTB = HALF * BK * 2, STAGE_BYTES = 8 * HTB, NXCD = 8, WGM = 8;
__host__ __device__ __forceinline__ int lds_byte(int r, int c) { const int st = (r >> 4) * 2 + (c >> 5), rr = r & 15, cc = c & 31, ob = rr * 64 + cc * 2; return st * 1024 + (ob ^ (((ob >> 9) & 1) << 5)); }
__host__ __device__ __forceinline__ void stage_rc(int b, int& R, int& C) { const int st = b / 1024, sb = b % 1024, swz = sb ^ (((sb >> 9) & 1) << 5); R = (st >> 1) * 16 + swz / 64; C = (st & 1) * 32 + (swz % 64) / 2; }
__host__ __device__ __forceinline__ int perm32(int rho) { const int n = rho >> 4, i = rho & 15; return 8 * (i >> 2) + 4 * n + (i & 3); }
struct Unit { int pm, pn, h; };
struct Gemm { const bf16_t* A; const bf16_t* Bt; int K, lda, ldb; };
struct StaticOrder {
    int nM, nN, nwg, G, c;
    __device__ void init(int M, int N, int G_, int c_) { nM = M / BM; nN = N / BM; nwg = nM * nN; G = G_; c = c_; }
    __device__ bool next(int i, Unit& u) const {
        const long L = (long)i * G + c; if (L >= nwg) return false;
        int wgid = (int)L; { const int q = nwg / NXCD, r = nwg % NXCD, xcd = wgid % NXCD, off = wgid / NXCD; wgid = (xcd < r ? xcd * (q + 1) : r * (q + 1) + (xcd - r) * q) + off; }
        const int nig = WGM * nN, gid = wgid / nig, fm = gid * WGM, gsz = (nM - fm) < WGM ? (nM - fm) : WGM;
        u.pm = fm + ((wgid % nig) % gsz); u.pn = (wgid % nig) / gsz; u.h = -1; return true;
    }
};
template <class Epi, class Sched, bool GATHER = false, bool HALFS = false>
__device__ __forceinline__ void gemm_phase(LAS unsigned char* lds, int tid_in, const Gemm g, const Sched& S, const Epi& E) {
    int tid_ = tid_in; asm volatile("" : "+v"(tid_));
    const int tid = tid_, wid = __builtin_amdgcn_readfirstlane(tid >> 6), lane = tid & 63, wr = wid >> 2, wc = wid & 3, fr = lane & 15, fq = lane >> 4;
    const int K = g.K, nt = K / BK;
    unsigned voffB[2], vAc[2][2], vAx[2][2];
#pragma unroll
    for (int i = 0; i < 2; ++i) { int R, C; stage_rc(tid * 16 + i * 8192, R, C); const int Rb = (R & ~31) + perm32(R & 31);
        voffB[i] = (unsigned)(Rb * g.ldb + C) * 2u;
#pragma unroll
        for (int h = 0; h < 2; ++h) vAc[h][i] = vAx[h][i] = (unsigned)((R + 128 * h) * g.lda + C) * 2u; }
#define PG8_GROWS(dst, uidx) do { if constexpr (GATHER) { _Pragma("unroll") for (int i_ = 0; i_ < 2; ++i_) { int R_, C_; stage_rc(tid * 16 + i_ * 8192, R_, C_); \
        _Pragma("unroll") for (int h_ = 0; h_ < 2; ++h_) dst[h_][i_] = (unsigned)(S.a_row((uidx), R_ + 128 * h_) * g.lda + C_) * 2u; } } } while (0)
    const size_t kstep = (size_t)(BK * 2);
    const size_t hstepA = (size_t)HALF * g.lda * 2, hstepB = (size_t)HALF * g.ldb * 2;
    const size_t tstepA = 2 * hstepA, tstepB = 2 * hstepB;
    const unsigned ldsw = (unsigned)wid * 1024u;
    const int aoff = lds_byte(wr * 64 + fr, fq * 8), boff = lds_byte(wc * 32 + fr, fq * 8);
#define PG8_SA(b, h) (((b) * 2 + (h)) * HTB)
#define PG8_SB(b, h) ((4 + (b) * 2 + (h)) * HTB)
#define PG8_STAGE(bufoff, gbase, voff) do { _Pragma("unroll") for (int _i = 0; _i < 2; ++_i) \
        __builtin_amdgcn_global_load_lds((const unsigned*)((const char*)(gbase) + (voff)[_i]), (LAS unsigned*)(lds + (bufoff) + ldsw + _i * 8192), 16, 0, 0); } while (0)
#define PG8_LDA(dst, b, h) do { _Pragma("unroll") for (int m = 0; m < 4; ++m) _Pragma("unroll") for (int k = 0; k < 2; ++k) dst[m][k] = *(const LAS bf16x8*)(lds + PG8_SA(b, h) + aoff + m * 2048 + k * 1024); } while (0)
#define PG8_LDB(dst, b, h) do { _Pragma("unroll") for (int n = 0; n < 2; ++n) _Pragma("unroll") for (int k = 0; k < 2; ++k) dst[n][k] = *(const LAS bf16x8*)(lds + PG8_SB(b, h) + boff + n * 2048 + k * 1024); } while (0)
#define PG8_MMA(ai, bj, At, Bt) do { __builtin_amdgcn_s_setprio(1); _Pragma("unroll") for (int m = 0; m < 4; ++m) _Pragma("unroll") for (int n = 0; n < 2; ++n) _Pragma("unroll") for (int k = 0; k < 2; ++k) \
        acc[ai][bj][m][n] = __builtin_amdgcn_mfma_f32_16x16x32_bf16(Bt[n][k], At[m][k], acc[ai][bj][m][n], 0, 0, 0); __builtin_amdgcn_s_setprio(0); } while (0)
#define PG8_WAIT_V(n) asm volatile("s_waitcnt vmcnt(" #n ")" ::: "memory")
#define PG8_WAIT_L(n) asm volatile("s_waitcnt lgkmcnt(" #n ")" ::: "memory")
#define PG8_BAR __builtin_amdgcn_s_barrier()
#define PG8_SCHED __builtin_amdgcn_sched_barrier(0)
    Unit cur, nxt; int ui = 0;
    if (!S.next(0, cur)) return;
    f32x4 acc[2][2][4][2];
#pragma unroll
    for (int a = 0; a < 2; ++a)
#pragma unroll
        for (int b = 0; b < 2; ++b)
#pragma unroll
            for (int m = 0; m < 4; ++m)
#pragma unroll
                for (int n = 0; n < 2; ++n) acc[a][b][m][n] = (f32x4){0.f, 0.f, 0.f, 0.f};
    bf16x8 At[4][2], B0[2][2], B1[2][2];
    const char* cA = (const char*)g.A + (GATHER ? (size_t)0 : (size_t)cur.pm * tstepA); const char* cB = (const char*)g.Bt + (size_t)cur.pn * tstepB;
    PG8_GROWS(vAc, 0);
    PG8_STAGE(PG8_SB(0, 0), cB, voffB); PG8_STAGE(PG8_SB(0, 1), cB + hstepB, voffB); PG8_STAGE(PG8_SA(0, 0), cA, vAc[0]); PG8_STAGE(PG8_SA(0, 1), cA, vAc[1]);
    if (wr == 1) PG8_BAR;
    PG8_WAIT_V(2); PG8_BAR;
    PG8_STAGE(PG8_SB(1, 0), cB + kstep, voffB); PG8_STAGE(PG8_SA(1, 0), cA + kstep, vAc[0]); PG8_STAGE(PG8_SB(1, 1), cB + hstepB + kstep, voffB);
    PG8_WAIT_V(6); PG8_BAR;
    for (;;) {
        const bool has_next = S.next(ui + 1, nxt);
        const char* nA = (has_next && !GATHER) ? (const char*)g.A + (size_t)nxt.pm * tstepA : cA;
        if constexpr (GATHER) { if (has_next) PG8_GROWS(vAx, ui + 1); else {
#pragma unroll
            for (int h = 0; h < 2; ++h) { vAx[h][0] = vAc[h][0]; vAx[h][1] = vAc[h][1]; } } }
        const char* nB = has_next ? (const char*)g.Bt + (size_t)nxt.pn * tstepB : cB;
        asm volatile(".p2align 8" ::: "memory");
        for (int t = 0; t < nt; t += 2) {
            const bool last = (t == nt - 2);
            const char* a1 = cA + (size_t)(t + 1) * kstep;
            const char* a2 = last ? nA : cA + (size_t)(t + 2) * kstep; const char* b2 = last ? nB : cB + (size_t)(t + 2) * kstep;
            const char* a3 = a2 + kstep; const char* b3 = b2 + kstep;
            unsigned vS0[2], vS1[2];
            if constexpr (GATHER) { vS0[0] = last ? vAx[0][0] : vAc[0][0]; vS0[1] = last ? vAx[0][1] : vAc[0][1]; vS1[0] = last ? vAx[1][0] : vAc[1][0]; vS1[1] = last ? vAx[1][1] : vAc[1][1]; }
            else { vS0[0] = vAc[0][0]; vS0[1] = vAc[0][1]; vS1[0] = vAc[1][0]; vS1[1] = vAc[1][1]; }
            PG8_LDB(B0, 0, 0); PG8_LDB(B1, 0, 1); PG8_SCHED; PG8_LDA(At, 0, 0); PG8_STAGE(PG8_SA(1, 1), a1, vAc[1]);
            PG8_WAIT_V(8); PG8_WAIT_L(0); PG8_BAR; if (!HALFS || cur.h != 1) { PG8_MMA(0, 0, At, B0); PG8_MMA(0, 1, At, B1); } PG8_BAR; PG8_SCHED;
            PG8_LDA(At, 0, 1); PG8_STAGE(PG8_SB(0, 0), b2, voffB); PG8_STAGE(PG8_SB(0, 1), b2 + hstepB, voffB); PG8_STAGE(PG8_SA(0, 0), a2, vS0);
            PG8_WAIT_V(8); PG8_WAIT_L(0); PG8_BAR; if (!HALFS || cur.h != 0) { PG8_MMA(1, 0, At, B0); PG8_MMA(1, 1, At, B1); } PG8_BAR; PG8_SCHED;
            PG8_LDB(B0, 1, 0); PG8_LDB(B1, 1, 1); PG8_SCHED; PG8_LDA(At, 1, 0); PG8_STAGE(PG8_SA(0, 1), a2, vS1);
            PG8_WAIT_V(8); PG8_WAIT_L(0); PG8_BAR; if (!HALFS || cur.h != 1) { PG8_MMA(0, 0, At, B0); PG8_MMA(0, 1, At, B1); } PG8_BAR; PG8_SCHED;
            PG8_LDA(At, 1, 1); PG8_STAGE(PG8_SB(1, 0), b3, voffB); PG8_STAGE(PG8_SB(1, 1), b3 + hstepB, voffB); PG8_STAGE(PG8_SA(1, 0), a3, vS0);
            PG8_WAIT_V(8); PG8_WAIT_L(0); PG8_BAR; if (!HALFS || cur.h != 0) { PG8_MMA(1, 0, At, B0); PG8_MMA(1, 1, At, B1); } PG8_BAR; PG8_SCHED;
        }
        if (wr == 0) PG8_BAR;
        E(acc, cur, wr, wc, fr, fq);
        if (!has_next) break;
#pragma unroll
        for (int a = 0; a < 2; ++a)
#pragma unroll
            for (int b = 0; b < 2; ++b)
#pragma unroll
                for (int m = 0; m < 4; ++m)
#pragma unroll
                    for (int n = 0; n < 2; ++n) acc[a][b][m][n] = (f32x4){0.f, 0.f, 0.f, 0.f};
        cur = nxt; cA = nA; cB = nB; ++ui;
        if constexpr (GATHER) {
#pragma unroll
            for (int h = 0; h < 2; ++h) { vAc[h][0] = vAx[h][0]; vAc[h][1] = vAx[h][1]; } }
        if (wr == 1) PG8_BAR;
    }
    PG8_WAIT_V(0);
    PG8_BAR;
#undef PG8_SA
#undef PG8_SB
#undef PG8_STAGE
#undef PG8_GROWS
#undef PG8_LDA
#undef PG8_LDB
#undef PG8_MMA
#undef PG8_WAIT_V
#undef PG8_WAIT_L
#undef PG8_BAR
#undef PG8_SCHED
}
}

enum EpiMode { EM_Z = 0, EM_Q = 1, EM_KV = 2, EM_GLU = 3, EM_MERGE0 = 4, EM_MERGE1 = 5, EM_WOUT = 6, EM_MOEUP = 7, EM_MOEDN = 8, EM_S5 = 9 };
template <int mode> struct Epi {
    bf16_t* o0; bf16_t* o1; bf16_t* o2;
    const bf16_t* i0;
    const float* f0; const float* f1; const float* f2;
    float* fo;
    float* ssq;
    const float* rope;
    int layer;
    struct Side { u32x4 s[4]; };
    __device__ __forceinline__ Side load_side(const pg8::Unit& u, int ai, int m, int wr, int fr, int cl) const {
        Side S; const int row = u.pm * 256 + ai * 128 + wr * 64 + m * 16 + fr;
        if constexpr (mode == EM_Q) S.s[0] = *(const u32x4*)(ssq + (size_t)row * 4);
        else if constexpr (mode == EM_KV) S.s[0] = *(const u32x4*)(ssq + (size_t)MTOK * 4 + (size_t)row * 4);
        else if constexpr (mode == EM_GLU) { S.s[0] = *(const u32x4*)(i0 + (size_t)row * 256 + cl); S.s[1] = *(const u32x4*)(i0 + (size_t)row * 256 + 128 + cl); }
        else if constexpr (mode == EM_MERGE0 || mode == EM_MERGE1) { const int col = u.pn * 256 + cl;
            S.s[0] = *(const u32x4*)(i0 + (size_t)row * ZC + col); S.s[1] = *(const u32x4*)(i0 + (size_t)row * ZC + col + 128);
            if constexpr (mode == EM_MERGE1) { S.s[2] = __builtin_nontemporal_load((const u32x4*)(o0 + (size_t)row * 1024 + col)); S.s[3] = __builtin_nontemporal_load((const u32x4*)(o0 + (size_t)row * 1024 + col + 128)); } }
        else if constexpr (mode == EM_WOUT) { const float* xin = (layer == 0) ? (row < NLAT ? f1 + (size_t)row * D : f2 + (size_t)(row - NLAT) * D) : fo + (size_t)row * D; const int col = u.pn * 256 + cl;
            S.s[0] = *(const u32x4*)(xin + col); S.s[1] = *(const u32x4*)(xin + col + 4); S.s[2] = *(const u32x4*)(xin + col + 128); S.s[3] = *(const u32x4*)(xin + col + 132); }
        else if constexpr (mode == EM_S5) { S.s[0] = *(const u32x4*)(i0 + (size_t)row * 512 + cl); S.s[1] = *(const u32x4*)(i0 + (size_t)row * 512 + 128 + cl); }
        return S;
    }
    __device__ __forceinline__ void operator()(const f32x4 (&acc)[2][2][4][2], const pg8::Unit& u, int wr, int wc, int fr_in, int fq_in) const {
        int fr = fr_in, fq = fq_in; asm volatile("" : "+v"(fr), "+v"(fq));
        const int cl = wc * 32 + 8 * fq;
        f32x4 hc[4] = {};
        if constexpr (mode == EM_GLU) { hc[0] = *(const f32x4*)(f0 + cl); hc[1] = *(const f32x4*)(f0 + cl + 4); hc[2] = *(const f32x4*)(f0 + 128 + cl); hc[3] = *(const f32x4*)(f0 + 128 + cl + 4); }
        if constexpr (mode == EM_WOUT) { const float* gt = f0 + (size_t)tok_modrow(u.pm * 256) * 6144 + 2 * 1024 + u.pn * 256 + cl;
            hc[0] = *(const f32x4*)(gt); hc[1] = *(const f32x4*)(gt + 4); hc[2] = *(const f32x4*)(gt + 128); hc[3] = *(const f32x4*)(gt + 132); }
        if constexpr (mode == EM_S5) { const float* dk = f0 + u.pn * 16 + (cl & 15); hc[0] = *(const f32x4*)(dk); hc[1] = *(const f32x4*)(dk + 4); }
        Side cur = load_side(u, 0, 0, wr, fr, cl);
#pragma unroll
        for (int it = 0; it < 8; ++it) {
                const int ai = it >> 2, m = it & 3;
                if (u.h >= 0 && ai != u.h) { if (it < 7) cur = load_side(u, (it + 1) >> 2, (it + 1) & 3, wr, fr, cl); continue; }
                Side nxt = cur; if (it < 7) nxt = load_side(u, (it + 1) >> 2, (it + 1) & 3, wr, fr, cl);
                asm volatile("" ::: "memory");
                const int row = u.pm * 256 + ai * 128 + wr * 64 + m * 16 + fr;
                if constexpr (mode == EM_Z) {
                    float s0 = 0.f;
#pragma unroll
                    for (int bj = 0; bj < 2; ++bj) {
                        f32x4 v0 = acc[ai][bj][m][0], v1 = acc[ai][bj][m][1];
                        const int col = u.pn * 256 + bj * 128 + cl;
                        if (u.pn == 1 || (u.pn == 2 && bj == 0)) s0 += (v0[0] * v0[0] + v0[1] * v0[1]) + (v0[2] * v0[2] + v0[3] * v0[3]) + (v1[0] * v1[0] + v1[1] * v1[1]) + (v1[2] * v1[2] + v1[3] * v1[3]);
                        if (u.pn == 2 && bj == 1 && wc == 0) {
                            if (row < NLAT) {
                                const int t = row & 2047, pb = 4 * fq, axis = pb >> 3, pos = axis ? (t & 63) : (t >> 6);
                                const float* cs = rope + pos * 8 + (pb & 7); const float* sn = cs + 512;
                                float x1, x2;
                                x1 = v0[0]; x2 = v0[1]; v0[0] = x1 * cs[0] - x2 * sn[0]; v0[1] = x1 * sn[0] + x2 * cs[0];
                                x1 = v0[2]; x2 = v0[3]; v0[2] = x1 * cs[1] - x2 * sn[1]; v0[3] = x1 * sn[1] + x2 * cs[1];
                                x1 = v1[0]; x2 = v1[1]; v1[0] = x1 * cs[2] - x2 * sn[2]; v1[1] = x1 * sn[2] + x2 * cs[2];
                                x1 = v1[2]; x2 = v1[3]; v1[2] = x1 * cs[3] - x2 * sn[3]; v1[3] = x1 * sn[3] + x2 * cs[3];
                            }
                            u32x4 w; w.x = pk2(v0[0], v0[1]); w.y = pk2(v0[2], v0[3]); w.z = pk2(v1[0], v1[1]); w.w = pk2(v1[2], v1[3]);
                            *(u32x4*)(o1 + (size_t)row * 32 + 8 * fq) = w;
                        }
                        u32x4 w; w.x = pk2(v0[0], v0[1]); w.y = pk2(v0[2], v0[3]); w.z = pk2(v1[0], v1[1]); w.w = pk2(v1[2], v1[3]);
                        *(u32x4*)(o0 + (size_t)row * ZC + col) = w;
                        if (u.pn == 0) {
                            int b, s; if (row < NLAT) { b = row >> 11; s = 256 + (row & 2047); } else { b = (row - NLAT) >> 8; s = (row - NLAT) & 255; }
                            const int colu = bj * 128 + cl, g = colu >> 4, h0 = colu & 15;
                            *(u32x4*)(o2 + ((size_t)g * 1280 + b * 160 + (s >> 4)) * 512 + (s & 15) * 16 + h0) = w;
                        }
                    }
                    if (u.pn == 1 || u.pn == 2) {
                        { const int ln = fr + 16 * fq; s0 += shfl_f(s0, ln ^ 16); s0 += shfl_f(s0, ln ^ 32); }
                        if (fq == 0) ssq[(size_t)(u.pn - 1) * MTOK * 4 + (size_t)row * 4 + wc] = s0;
                    }
                } else if constexpr (mode == EM_Q || mode == EM_KV) {
                    const f32x4 sp = __builtin_bit_cast(f32x4, cur.s[0]);
                    const float rs = mode == EM_Q ? rsqrtf(((sp[0] + sp[1]) + (sp[2] + sp[3])) * (1.f / 256.f) + EPS) * QSCALE : rsqrtf(((sp[0] + sp[1]) + (sp[2] + sp[3])) * (1.f / 128.f) + EPS);
#pragma unroll
                    for (int bj = 0; bj < 2; ++bj) {
                        f32x4 v0 = acc[ai][bj][m][0] * rs, v1 = acc[ai][bj][m][1] * rs;
                        const int col = u.pn * 256 + bj * 128 + cl;
                        if constexpr (mode == EM_Q) { const int cc = col % 96;
                            if (cc >= 64 && row < NLAT) {
                                const int t = row & 2047, pb = (cc - 64) >> 1, axis = pb >> 3, pos = axis ? (t & 63) : (t >> 6);
                                const float* cs = rope + pos * 8 + (pb & 7); const float* sn = cs + 512;
                                float x1, x2;
                                x1 = v0[0]; x2 = v0[1]; v0[0] = x1 * cs[0] - x2 * sn[0]; v0[1] = x1 * sn[0] + x2 * cs[0];
                                x1 = v0[2]; x2 = v0[3]; v0[2] = x1 * cs[1] - x2 * sn[1]; v0[3] = x1 * sn[1] + x2 * cs[1];
                                x1 = v1[0]; x2 = v1[1]; v1[0] = x1 * cs[2] - x2 * sn[2]; v1[1] = x1 * sn[2] + x2 * cs[2];
                                x1 = v1[2]; x2 = v1[3]; v1[2] = x1 * cs[3] - x2 * sn[3]; v1[3] = x1 * sn[3] + x2 * cs[3];
                            } }
                        u32x4 w; w.x = pk2(v0[0], v0[1]); w.y = pk2(v0[2], v0[3]); w.z = pk2(v1[0], v1[1]); w.w = pk2(v1[2], v1[3]);
                        if constexpr (mode == EM_Q) *(u32x4*)(o0 + (size_t)row * 768 + col) = w;
                        else { bf16_t* dst = col < 512 ? o0 + (size_t)row * 512 + col : o1 + (size_t)row * 512 + (col - 512); *(u32x4*)dst = w; }
                    }
                } else if constexpr (mode == EM_GLU) {
#pragma unroll
                    for (int bj = 0; bj < 2; ++bj) {
                        const int col = bj * 128 + cl;
                        const f32x4 a0 = acc[ai][bj][m][0] + hc[2 * bj], a1 = acc[ai][bj][m][1] + hc[2 * bj + 1];
                        const u32x4 y = cur.s[bj];
                        u32x4 w;
                        w.x = pk2(bflo(y.x) * sigmoidf_(a0[0]), bfhi(y.x) * sigmoidf_(a0[1])); w.y = pk2(bflo(y.y) * sigmoidf_(a0[2]), bfhi(y.y) * sigmoidf_(a0[3]));
                        w.z = pk2(bflo(y.z) * sigmoidf_(a1[0]), bfhi(y.z) * sigmoidf_(a1[1])); w.w = pk2(bflo(y.w) * sigmoidf_(a1[2]), bfhi(y.w) * sigmoidf_(a1[3]));
                        *(u32x4*)(o0 + (size_t)row * 256 + col) = w;
                    }
                } else if constexpr (mode == EM_MERGE0 || mode == EM_MERGE1) {
#pragma unroll
                    for (int bj = 0; bj < 2; ++bj) {
                        const int col = u.pn * 256 + bj * 128 + cl;
                        const u32x4 gt = cur.s[bj];
                        const f32x4 a0 = acc[ai][bj][m][0], a1 = acc[ai][bj][m][1];
                        float r[8] = { a0[0] * sigmoidf_(bflo(gt.x)), a0[1] * sigmoidf_(bfhi(gt.x)), a0[2] * sigmoidf_(bflo(gt.y)), a0[3] * sigmoidf_(bfhi(gt.y)),
                                       a1[0] * sigmoidf_(bflo(gt.z)), a1[1] * sigmoidf_(bfhi(gt.z)), a1[2] * sigmoidf_(bflo(gt.w)), a1[3] * sigmoidf_(bfhi(gt.w)) };
                        if constexpr (mode == EM_MERGE1) { const u32x4 pv = cur.s[2 + bj];
                            r[0] += bflo(pv.x); r[1] += bfhi(pv.x); r[2] += bflo(pv.y); r[3] += bfhi(pv.y); r[4] += bflo(pv.z); r[5] += bfhi(pv.z); r[6] += bflo(pv.w); r[7] += bfhi(pv.w); }
                        u32x4 w; w.x = pk2(r[0], r[1]); w.y = pk2(r[2], r[3]); w.z = pk2(r[4], r[5]); w.w = pk2(r[6], r[7]);
                        *(u32x4*)(o0 + (size_t)row * 1024 + col) = w;
                    }
                } else if constexpr (mode == EM_WOUT) {
#pragma unroll
                    for (int bj = 0; bj < 2; ++bj) {
                        const int col = u.pn * 256 + bj * 128 + cl;
#pragma unroll
                        for (int n = 0; n < 2; ++n) *(f32x4*)(fo + (size_t)row * D + col + 4 * n) = __builtin_bit_cast(f32x4, cur.s[2 * bj + n]) + hc[2 * bj + n] * acc[ai][bj][m][n];
                    }
                } else if constexpr (mode == EM_MOEUP) {
                    const f32x4 a0 = acc[ai][0][m][0], a1 = acc[ai][0][m][1], b0 = acc[ai][1][m][0], b1 = acc[ai][1][m][1];
                    u32x4 w; w.x = pk2(siluf_(a0[0]) * b0[0], siluf_(a0[1]) * b0[1]); w.y = pk2(siluf_(a0[2]) * b0[2], siluf_(a0[3]) * b0[3]);
                    w.z = pk2(siluf_(a1[0]) * b1[0], siluf_(a1[1]) * b1[1]); w.w = pk2(siluf_(a1[2]) * b1[2], siluf_(a1[3]) * b1[3]);
                    *(u32x4*)(o0 + (size_t)row * HID + (u.pn & 3) * 128 + cl) = w;
                } else if constexpr (mode == EM_MOEDN) {
#pragma unroll
                    for (int bj = 0; bj < 2; ++bj) {
                        const f32x4 v0 = acc[ai][bj][m][0], v1 = acc[ai][bj][m][1];
                        u32x4 w; w.x = pk2(v0[0], v0[1]); w.y = pk2(v0[2], v0[3]); w.z = pk2(v1[0], v1[1]); w.w = pk2(v1[2], v1[3]);
                        *(u32x4*)(o0 + (size_t)row * 1024 + (u.pn & 3) * 256 + bj * 128 + cl) = w;
                    }
                } else if constexpr (mode == EM_S5) {
                    const int g = u.pn, rr = row - g * 1280, b = rr / 160, c = rr - b * 160;
                    if (c < 144) {
#pragma unroll
                        for (int bj = 0; bj < 2; ++bj) {
                            const int n = bj * 128 + cl, i = n >> 4, h0 = n & 15, s = 16 * c + i;
                            const int trow = s < 256 ? NLAT + b * 256 + s : b * 2048 + (s - 256);
                            const u32x4 uv = cur.s[bj];
                            const f32x4 a0 = acc[ai][bj][m][0], a1 = acc[ai][bj][m][1];
                            u32x4 w;
                            w.x = pk2(gelu_tanh(a0[0] + hc[0][0] * bflo(uv.x)), gelu_tanh(a0[1] + hc[0][1] * bfhi(uv.x))); w.y = pk2(gelu_tanh(a0[2] + hc[0][2] * bflo(uv.y)), gelu_tanh(a0[3] + hc[0][3] * bfhi(uv.y)));
                            w.z = pk2(gelu_tanh(a1[0] + hc[1][0] * bflo(uv.z)), gelu_tanh(a1[1] + hc[1][1] * bfhi(uv.z))); w.w = pk2(gelu_tanh(a1[2] + hc[1][2] * bflo(uv.w)), gelu_tanh(a1[3] + hc[1][3] * bfhi(uv.w)));
                            *(u32x4*)(o0 + (size_t)trow * 256 + g * 16 + h0) = w;
                        }
                    }
                }
                cur = nxt;
        }
    }
};

#define XB_TMO      128
#define XB_XCNT(j)  (256  + 64 * (j))
#define XB_XSUB(j)  (1280 + 64 * (j))
#define XB_XGEN(j)  (2304 + 64 * (j))
#define XB_TOP      3328
#define XB_TOPGEN   3392
#define XCD_BAR_WORDS 3456
#define XB_SPIN_CAP (1u << 22)
__device__ __forceinline__ unsigned xb_ld(unsigned* p)              { return __hip_atomic_load(p, __ATOMIC_RELAXED, __HIP_MEMORY_SCOPE_AGENT); }
__device__ __forceinline__ unsigned xb_add(unsigned* p, unsigned v) { return __hip_atomic_fetch_add(p, v, __ATOMIC_RELAXED, __HIP_MEMORY_SCOPE_AGENT); }
__device__ __forceinline__ unsigned xb_xcc_id() { return (unsigned)__builtin_amdgcn_s_getreg((3 << 11) | 20) & 0xFu; }
#define XB_SPIN(cond, bar) do { unsigned _sp = 0; while (cond) { __builtin_amdgcn_s_sleep(1); \
    if ((++_sp & 255u) == 0u) { if (xb_ld(&(bar)[XB_TMO])) break; if (_sp > XB_SPIN_CAP) { atomicAdd(&(bar)[XB_TMO], 1u); break; } } } } while (0)
struct XcdBarrier { unsigned* bar; unsigned x; volatile LAS unsigned* st; };
__device__ __forceinline__ XcdBarrier xcd_barrier_post(unsigned* bar, volatile LAS unsigned* st) {
    XcdBarrier b; b.bar = bar; b.x = xb_xcc_id(); b.st = st;
    if (threadIdx.x == 0) (void)xb_add(&bar[XB_XCNT(b.x)], 1u);
    return b;
}
__device__ __forceinline__ void xcd_barrier_complete(unsigned* bar, unsigned x, unsigned& nloc, unsigned& nx) {
    const unsigned G = gridDim.x * gridDim.y * gridDim.z;
    unsigned sum, cnt, mine, sp = 0u;
    for (;;) {
        sum = 0u; cnt = 0u; mine = 0u;
#pragma unroll
        for (unsigned j = 0; j < 16; ++j) { const unsigned c = xb_ld(&bar[XB_XCNT(j)]); sum += c; cnt += (c > 0u) ? 1u : 0u; mine = (j == x) ? c : mine; }
        if (sum == G) break;
        __builtin_amdgcn_s_sleep(1);
        if ((++sp & 255u) == 0u) { if (xb_ld(&bar[XB_TMO])) break; if (sp > XB_SPIN_CAP) { atomicAdd(&bar[XB_TMO], 1u); break; } }
    }
    nloc = mine > 0u ? mine : 1u; nx = cnt > 0u ? cnt : 1u;
}
__device__ __noinline__ void xcd_barrier_fn(unsigned* bar_in, unsigned bx, unsigned st_off, int tid) {
    XcdBarrier b; b.bar = bar_in; b.x = bx; b.st = (volatile LAS unsigned*)(uintptr_t)st_off;
    asm volatile("s_waitcnt vmcnt(0)" ::: "memory");
    __syncthreads();
    if (tid == 0) {
        unsigned* bar = b.bar;
        __builtin_amdgcn_s_waitcnt(0);
        unsigned nloc = b.st[0], nx = b.st[1];
        if (nloc == 0u) { xcd_barrier_complete(bar, b.x, nloc, nx); b.st[0] = nloc; b.st[1] = nx; }
        const unsigned old = xb_add(&bar[XB_XSUB(b.x)], 1u);
        const unsigned gen = old / nloc;
        if (old + 1u == (gen + 1u) * nloc) {
            __builtin_amdgcn_fence(__ATOMIC_RELEASE, "agent");
            asm volatile("s_waitcnt vmcnt(0)" ::: "memory");
            const unsigned og = xb_add(&bar[XB_TOP], 1u);
            const unsigned tg = og / nx;
            if (og + 1u == (tg + 1u) * nx) xb_add(&bar[XB_TOPGEN], 1u);
            else XB_SPIN(xb_ld(&bar[XB_TOPGEN]) == tg, bar);
            __builtin_amdgcn_fence(__ATOMIC_ACQUIRE, "agent");
            xb_add(&bar[XB_XGEN(b.x)], 1u);
            asm volatile("s_waitcnt vmcnt(0)" ::: "memory");
        } else {
            XB_SPIN(xb_ld(&bar[XB_XGEN(b.x)]) == gen, bar);
            __builtin_amdgcn_fence(__ATOMIC_ACQUIRE, "agent");
            asm volatile("s_waitcnt vmcnt(0)" ::: "memory");
        }
    }
    __syncthreads();
}

constexpr int NWAVES = 8;
constexpr int RING_BYTES = 131072, MISC_OFF = RING_BYTES + 320, TBL_OFF = RING_BYTES + 1024, LDS_BYTES = 147456;
struct Args { const float* in[38]; float* out; unsigned char* ws; int ph_lo, ph_hi; };
typedef const __attribute__((address_space(4))) Args* ArgsP;
struct Frame {
    LAS unsigned char* lds;
    int tid, lane, wave, vcu, G, gw, NGW;
    unsigned char* ws;
};

enum RowMap { RM_ID = 0, RM_WIN = 1, RM_UQ = 2, RM_W13 = 3 };
__device__ __forceinline__ int rope_perm(int o) { const int axis = o >> 4, half = (o >> 3) & 1, i = o & 7; return 2 * (axis * 8 + i) + half; }
__device__ __forceinline__ int map_row(int rm, int n, int row_off) {
    if (rm == RM_WIN) return (n >= ZKPE && n < ZKPE + 32) ? ZKPE + rope_perm(n - ZKPE) : n;
    if (rm == RM_UQ) { const int hd = n / 96, cc = n - hd * 96; return cc >= 64 ? hd * 96 + 64 + rope_perm(cc - 64) : n; }
    if (rm == RM_W13) return row_off + (n >> 7) * 256 + (n & 127);
    return row_off + n;
}
__device__ __forceinline__ void transpose_item(const float* W, int K, int N, bf16_t* WT, int rm, int row_off, const float* kscale, LAS float* scr, int item, int lane) {
    const int nblk = N / 32, kb = item / nblk, nb = item % nblk, k0 = 64 * kb, n0 = 32 * nb;
    float tv[32];
#pragma unroll
    for (int i = 0; i < 32; ++i) tv[i] = W[(size_t)(k0 + 2 * i + (lane >> 5)) * N + n0 + (lane & 31)];
#pragma unroll
    for (int i = 0; i < 32; ++i) { const int kk = 2 * i + (lane >> 5); float v = tv[i]; if (kscale) v *= kscale[k0 + kk]; scr[kk * 33 + (lane & 31)] = v; }
    asm volatile("s_waitcnt lgkmcnt(0)" ::: "memory");
    const int c = lane & 7;
#pragma unroll
    for (int j = 0; j < 4; ++j) { const int n = (lane >> 3) + 8 * j; const LAS float* s = scr + (8 * c) * 33 + n;
        u32x4 o; o.x = pk2(s[0 * 33], s[1 * 33]); o.y = pk2(s[2 * 33], s[3 * 33]); o.z = pk2(s[4 * 33], s[5 * 33]); o.w = pk2(s[6 * 33], s[7 * 33]);
        *(u32x4*)(WT + (size_t)map_row(rm, n0 + n, row_off) * K + k0 + 8 * c) = o; }
    asm volatile("s_waitcnt lgkmcnt(0)" ::: "memory");
}

#if !NAIVE_S5
__device__ __forceinline__ void s5_build(Frame& F, ArgsP a);
#endif
__device__ __forceinline__ void prologue_phase(Frame& F, ArgsP a) {
    LAS float* scr = (LAS float*)(F.lds + F.wave * 16384);
    REP(21) for (int l = 0; l < 2; ++l) {
        unsigned char* wl = F.ws + WS_WB + (size_t)l * WL_STRIDE;
#define CONV(Wp, K_, N_, WTp, rm_, ro_, ks_) do { const int items_ = ((K_) / 64) * ((N_) / 32); \
            for (int it = F.gw; it < items_; it += F.NGW) transpose_item((Wp), (K_), (N_), (bf16_t*)(WTp), (rm_), (ro_), (ks_), scr, it, F.lane); } while (0)
        CONV(a->in[8] + (size_t)l * D * INC, D, INC, wl + WL_WIN, RM_WIN, 0, nullptr);
        CONV(a->in[21] + (size_t)l * 256 * 768, 256, 768, wl + WL_UQ, RM_UQ, 0, a->in[19] + l * 256);
        CONV(a->in[22] + (size_t)l * 128 * 512, 128, 512, wl + WL_UKV, RM_ID, 0, a->in[20] + l * 128);
        CONV(a->in[23] + (size_t)l * 128 * 512, 128, 512, wl + WL_UKV, RM_ID, 512, a->in[20] + l * 128);
        CONV(a->in[17] + (size_t)l * 256 * 256, 256, 256, wl + WL_GLU, RM_ID, 0, nullptr);
        CONV(a->in[26] + (size_t)l * 256 * 1024, 256, 1024, wl + WL_PA, RM_ID, 0, nullptr);
        CONV(a->in[27] + (size_t)l * 512 * 1024, 512, 1024, wl + WL_PB, RM_ID, 0, nullptr);
        CONV(a->in[28] + (size_t)l * 256 * 1024, 256, 1024, wl + WL_PC, RM_ID, 0, nullptr);
        CONV(a->in[29] + (size_t)l * 1024 * 1024, 1024, 1024, wl + WL_OUT, RM_ID, 0, nullptr);
#undef CONV
        u32x4* padp = (u32x4*)(wl + WL_WIN + (size_t)INC * D * 2);
        for (int i = F.gw * 64 + F.lane; i < (ZC - INC) * D * 2 / 16; i += F.NGW * 64) padp[i] = (u32x4){0u, 0u, 0u, 0u};
    }
    if (blockIdx.x == 0) {
        float* rp = (float*)(F.ws + WS_ROPE);
        const int pos = F.tid >> 3, i = F.tid & 7;
        const float ang = (float)pos * exp2f(-(float)i * (13.287712379549449f / 8.f));
        rp[F.tid] = cosf(ang); rp[512 + F.tid] = sinf(ang);
    }
    __syncthreads();
    REP(22)
    {
        LAS float* sil = (LAS float*)F.lds;
        LAS float* red = (LAS float*)(F.lds + 40960);
        bool have = false;
        for (int it = blockIdx.x; it < 192; it += F.G) {
            if (!have) {
                for (int i = F.tid; i < 9 * 1024; i += 512) { const int r = i >> 10, k = i & 1023; const float cv = r < 8 ? a->in[1][r * 1024 + k] : a->in[3][k]; sil[i] = siluf_(cv); }
                have = true; __syncthreads();
            }
            const int l = it / 96, n = (it % 96) * 64 + F.lane;
            const float* wp = a->in[4] + (size_t)l * D * 6144 + (size_t)(F.wave * 128) * 6144 + n;
            float acc[9];
#pragma unroll
            for (int r = 0; r < 9; ++r) acc[r] = 0.f;
#pragma unroll 8
            for (int k = 0; k < 128; ++k) { const float wv = wp[(size_t)k * 6144];
#pragma unroll
                for (int r = 0; r < 9; ++r) acc[r] += sil[r * 1024 + F.wave * 128 + k] * wv; }
#pragma unroll
            for (int r = 0; r < 9; ++r) red[(F.wave * 9 + r) * 64 + F.lane] = acc[r];
            __syncthreads();
            for (int i = F.tid; i < 9 * 64; i += 512) { const int r = i >> 6, ln = i & 63; float s = 0.f;
#pragma unroll
                for (int w = 0; w < 8; ++w) s += red[(w * 9 + r) * 64 + ln];
                const int nn = (it % 96) * 64 + ln;
                ((float*)(F.ws + WS_MODV))[((size_t)l * 9 + r) * 6144 + nn] = s + a->in[5][l * 6144 + nn]; }
            __syncthreads();
        }
    }
#if !NAIVE_S5
    REP(23) s5_build(F, a);
#endif
}

__device__ __forceinline__ void moe_convert(Frame& F, ArgsP a, int l) {
    LAS float* scr = (LAS float*)(F.lds + F.wave * 16384);
    bf16_t* w13 = (bf16_t*)(F.ws + WS_MIX + MW_W13); bf16_t* w2 = (bf16_t*)(F.ws + WS_MIX + MW_W2);
    for (int it = F.gw; it < NEXP * 768; it += F.NGW) {
        const int e = it / 768, r = it % 768, which = r >> 8, sub = r & 255;
        const size_t eoff = ((size_t)l * NEXP + e) * 1024 * 512;
        if (which == 0) transpose_item(a->in[34] + eoff, 1024, 512, w13, RM_W13, e * 1024, nullptr, scr, sub, F.lane);
        else if (which == 1) transpose_item(a->in[35] + eoff, 1024, 512, w13, RM_W13, e * 1024 + 128, nullptr, scr, sub, F.lane);
        else transpose_item(a->in[36] + eoff, 512, 1024, w2, RM_ID, e * 1024, nullptr, scr, sub, F.lane);
    }
}

__device__ __forceinline__ const float* x_row_ptr(ArgsP a, const float* X, int layer, int row) {
    return layer == 0 ? (row < NLAT ? a->in[0] + (size_t)row * D : a->in[2] + (size_t)(row - NLAT) * D) : X + (size_t)row * D;
}
__device__ __forceinline__ void norm_mod_row(const f32x4 (&v)[4], f32x4 (&h)[4], const float* g, const float* shift, const float* scale, int lane) {
    float ss = 0.f;
#pragma unroll
    for (int j = 0; j < 4; ++j) ss += (v[j][0] * v[j][0] + v[j][1] * v[j][1]) + (v[j][2] * v[j][2] + v[j][3] * v[j][3]);
    const float rstd = rsqrtf(wave_sum(ss) * (1.f / D) + EPS);
#pragma unroll
    for (int j = 0; j < 4; ++j) { const int c = 4 * lane + 256 * j; const f32x4 gv = *(const f32x4*)(g + c), sh = *(const f32x4*)(shift + c), sc = *(const f32x4*)(scale + c);
        h[j] = v[j] * rstd * gv * (sc + 1.f) + sh; }
}
__device__ __forceinline__ void store_row_bf16(bf16_t* orow, const f32x4 (&h)[4], int lane) {
#pragma unroll
    for (int j = 0; j < 4; ++j) { u32x2 w; w.x = pk2(h[j][0], h[j][1]); w.y = pk2(h[j][2], h[j][3]); *(u32x2*)(orow + 4 * lane + 256 * j) = w; }
}
__device__ __forceinline__ void norm1_phase(Frame& F, ArgsP a, int layer, int nrows) {
    const float* X = (const float*)(F.ws + WS_X); bf16_t* H = (bf16_t*)(F.ws + WS_H);
    const float* modv = (const float*)(F.ws + WS_MODV) + (size_t)layer * 9 * 6144;
    for (int row = F.gw; row < nrows; row += F.NGW) {
        const float* xr = x_row_ptr(a, X, layer, row); f32x4 v[4], h[4];
#pragma unroll
        for (int j = 0; j < 4; ++j) v[j] = *(const f32x4*)(xr + 4 * F.lane + 256 * j);
        const float* mv = modv + (size_t)tok_modrow(row) * 6144;
        norm_mod_row(v, h, a->in[6] + layer * D, mv, mv + 1024, F.lane);
        store_row_bf16(H + (size_t)row * D, h, F.lane);
    }
}

__device__ __forceinline__ int seq_row(int b, int s, int d) {
    if (d == 0) return s < 256 ? NLAT + b * 256 + s : b * 2048 + (s - 256);
    return s < 256 ? NLAT + b * 256 + (255 - s) : b * 2048 + (2047 - (s - 256));
}
__device__ __forceinline__ float hg_lb(ArgsP a, int l) { return l == 0 ? 0.f : 1.f / (1.f + __expf(a->in[24][0] - a->in[24][1])); }

#if NAIVE_S5
__device__ __forceinline__ void s5_naive(Frame& F, ArgsP a, int l) {
    const bf16_t* Z = (const bf16_t*)(F.ws + WS_Z); float* Yacc = (float*)(F.ws + WS_MIX + MX_S5A);
    for (int unit = F.gw; unit < 128; unit += F.NGW) {
        const int b = unit >> 4, g = unit & 15, p = F.lane;
        for (int d = 0; d < 2; ++d) {
            const int idx = (l * 2 + d) * 16 + g;
            const float lre = a->in[9][idx * 64 + p], lim = a->in[10][idx * 64 + p], dt = expf(a->in[15][idx]);
            const float mag = expf(lre * dt), lbr = mag * cosf(lim * dt), lbi = mag * sinf(lim * dt), den = lre * lre + lim * lim;
            const float fr = ((lbr - 1.f) * lre + lbi * lim) / den, fi = (lbi * lre - (lbr - 1.f) * lim) / den;
            float bbr[16], bbi[16], cre[16], cim[16];
#pragma unroll
            for (int h = 0; h < 16; ++h) { const float br = a->in[11][(size_t)(idx * 64 + p) * 16 + h], bi = a->in[12][(size_t)(idx * 64 + p) * 16 + h];
                bbr[h] = fr * br - fi * bi; bbi[h] = fr * bi + fi * br;
                cre[h] = a->in[13][(size_t)(idx * 16 + h) * 64 + p]; cim[h] = a->in[14][(size_t)(idx * 16 + h) * 64 + p]; }
            float hr = 0.f, hi = 0.f;
            for (int s = 0; s < 2304; ++s) {
                const int row = seq_row(b, s, d);
                const u32x4 u0 = *(const u32x4*)(Z + (size_t)row * ZC + g * 16), u1 = *(const u32x4*)(Z + (size_t)row * ZC + g * 16 + 8);
                const float uu[16] = { bflo(u0.x), bfhi(u0.x), bflo(u0.y), bfhi(u0.y), bflo(u0.z), bfhi(u0.z), bflo(u0.w), bfhi(u0.w),
                                       bflo(u1.x), bfhi(u1.x), bflo(u1.y), bfhi(u1.y), bflo(u1.z), bfhi(u1.z), bflo(u1.w), bfhi(u1.w) };
                float bur = 0.f, bui = 0.f;
#pragma unroll
                for (int h = 0; h < 16; ++h) { bur += bbr[h] * uu[h]; bui += bbi[h] * uu[h]; }
                const float nhr = lbr * hr - lbi * hi + bur, nhi = lbr * hi + lbi * hr + bui; hr = nhr; hi = nhi;
                float mine = 0.f;
#pragma unroll
                for (int h = 0; h < 16; ++h) { const float y = wave_sum(cre[h] * hr - cim[h] * hi); if (F.lane == h) mine = y; }
                if (F.lane < 16) { float* ptr = Yacc + (size_t)row * 256 + g * 16 + F.lane; if (d == 0) *ptr = mine; else *ptr += mine; }
            }
        }
    }
}
__device__ __forceinline__ void s5_naive_finish(Frame& F, ArgsP a, int l, int nrows) {
    const bf16_t* Z = (const bf16_t*)(F.ws + WS_Z); const float* Yacc = (const float*)(F.ws + WS_MIX + MX_S5A); bf16_t* ysp = (bf16_t*)(F.ws + WS_MIX + MX_YS5P);
    for (int i = F.gw * 64 + F.lane; i < nrows * 256; i += F.NGW * 64) { const int row = i >> 8, n = i & 255;
        ysp[i] = (bf16_t)f2bf(gelu_tanh(Yacc[i] + a->in[16][l * 256 + n] * bf2f(Z[(size_t)row * ZC + n]))); }
}
#endif

#if NAIVE_HG
__device__ __forceinline__ void hg_naive(Frame& F, ArgsP a, int l) {
    const bf16_t* Z = (const bf16_t*)(F.ws + WS_Z); float* Ohg = (float*)(F.ws + WS_H);
    LAS float* red = (LAS float*)F.lds;
    const float lb = hg_lb(a, l);
    for (int unit = blockIdx.x; unit < 32; unit += F.G) {
        const int b = unit >> 2, hd = unit & 3, v = F.tid & 63, kg = F.wave;
        for (int d = 0; d < 2; ++d) {
            float S[16];
#pragma unroll
            for (int k = 0; k < 16; ++k) S[k] = 0.f;
            for (int s = 0; s < 2304; ++s) {
                const int row = seq_row(b, s, d);
                const bf16_t* zr = Z + (size_t)row * ZC;
                const u32x4 q0 = *(const u32x4*)(zr + ZHQ + hd * 128 + kg * 16), q1 = *(const u32x4*)(zr + ZHQ + hd * 128 + kg * 16 + 8);
                const int zf = d ? ZF1 : ZF0;
                const u32x4 z0 = *(const u32x4*)(zr + zf + hd * 128 + kg * 16), z1 = *(const u32x4*)(zr + zf + hd * 128 + kg * 16 + 8);
                const float vt = bf2f(zr[ZI + hd * 64 + v]);
                const float qq[16] = { bflo(q0.x), bfhi(q0.x), bflo(q0.y), bfhi(q0.y), bflo(q0.z), bfhi(q0.z), bflo(q0.w), bfhi(q0.w),
                                       bflo(q1.x), bfhi(q1.x), bflo(q1.y), bfhi(q1.y), bflo(q1.z), bfhi(q1.z), bflo(q1.w), bfhi(q1.w) };
                const float zz[16] = { bflo(z0.x), bfhi(z0.x), bflo(z0.y), bfhi(z0.y), bflo(z0.z), bfhi(z0.z), bflo(z0.w), bfhi(z0.w),
                                       bflo(z1.x), bfhi(z1.x), bflo(z1.y), bfhi(z1.y), bflo(z1.z), bfhi(z1.z), bflo(z1.w), bfhi(z1.w) };
                float part = 0.f;
#pragma unroll
                for (int k = 0; k < 16; ++k) { const float kin = (1.f - lb) / (1.f + __expf(zz[k])), f = 1.f - kin; S[k] = f * S[k] + kin * vt; part += qq[k] * S[k]; }
                red[((s & 1) * 8 + kg) * 64 + v] = part;
                __syncthreads();
                if (F.tid < 64) { float o = 0.f;
#pragma unroll
                    for (int w = 0; w < 8; ++w) o += red[((s & 1) * 8 + w) * 64 + F.tid];
                    float* ptr = Ohg + (size_t)row * 256 + hd * 64 + F.tid; if (d == 0) *ptr = o; else *ptr += o; }
            }
            __syncthreads();
        }
    }
}
__device__ __forceinline__ void hg_naive_finish(Frame& F, ArgsP a, int l, int nrows) {
    const bf16_t* Z = (const bf16_t*)(F.ws + WS_Z); const float* Ohg = (const float*)(F.ws + WS_H); bf16_t* yhg = (bf16_t*)(F.ws + WS_MIX + MX_YHG);
    for (int it = F.gw; it < nrows * 4; it += F.NGW) { const int row = it >> 2, hd = it & 3, c = hd * 64 + F.lane;
        float o = Ohg[(size_t)row * 256 + c]; const float ms = wave_sum(o * o) * (1.f / 64.f);
        o = o * rsqrtf(ms + EPS) * a->in[25][l * 256 + c] * siluf_(bf2f(Z[(size_t)row * ZC + ZG + c]));
        yhg[(size_t)row * 256 + c] = (bf16_t)f2bf(o); }
}
#endif

#if NAIVE_ATTN
__device__ __forceinline__ void attn_naive(Frame& F, bool need_ctx) {
    const bf16_t* Q = (const bf16_t*)(F.ws + WS_MIX + MX_Q); const bf16_t* KN = (const bf16_t*)(F.ws + WS_MIX + MX_KN); const bf16_t* V = (const bf16_t*)(F.ws + WS_MIX + MX_V);
    const bf16_t* KPE = (const bf16_t*)(F.ws + WS_MIX + MX_KPE); bf16_t* YM = (bf16_t*)(F.ws + WS_MIX + MX_YMLA);
    const int nunits = need_ctx ? 320 : 256;
    for (int unit = blockIdx.x; unit < nunits; unit += F.G) {
        int b, h, qrow, nk; bool active = true; const bool lat = unit < 256;
        if (lat) { b = unit >> 5; h = (unit >> 2) & 7; qrow = b * 2048 + (unit & 3) * 512 + F.tid; nk = 2304; }
        else { const int u2 = unit - 256; b = u2 >> 3; h = u2 & 7; active = F.tid < 256; qrow = NLAT + b * 256 + (F.tid & 255); nk = 256; }
        float q[96];
#pragma unroll
        for (int c = 0; c < 12; ++c) { const u32x4 w = *(const u32x4*)(Q + (size_t)qrow * 768 + h * 96 + c * 8);
            q[c * 8 + 0] = bflo(w.x); q[c * 8 + 1] = bfhi(w.x); q[c * 8 + 2] = bflo(w.y); q[c * 8 + 3] = bfhi(w.y); q[c * 8 + 4] = bflo(w.z); q[c * 8 + 5] = bfhi(w.z); q[c * 8 + 6] = bflo(w.w); q[c * 8 + 7] = bfhi(w.w); }
        float o[64], m = -1e30f, lsum = 0.f;
#pragma unroll
        for (int dd = 0; dd < 64; ++dd) o[dd] = 0.f;
        for (int j = 0; j < nk; ++j) {
            const int krow = lat ? (j < 2048 ? b * 2048 + j : NLAT + b * 256 + (j - 2048)) : NLAT + b * 256 + j;
            const bf16_t* kn = KN + (size_t)krow * 512 + h * 64; const bf16_t* kp = KPE + (size_t)krow * 32; const bf16_t* vv = V + (size_t)krow * 512 + h * 64;
            float s = 0.f;
#pragma unroll
            for (int c = 0; c < 12; ++c) { const u32x4 w = c < 8 ? *(const u32x4*)(kn + c * 8) : *(const u32x4*)(kp + (c - 8) * 8);
                s += q[c * 8 + 0] * bflo(w.x) + q[c * 8 + 1] * bfhi(w.x) + q[c * 8 + 2] * bflo(w.y) + q[c * 8 + 3] * bfhi(w.y) + q[c * 8 + 4] * bflo(w.z) + q[c * 8 + 5] * bfhi(w.z) + q[c * 8 + 6] * bflo(w.w) + q[c * 8 + 7] * bfhi(w.w); }
            const float mn = fmaxf(m, s), al = __builtin_amdgcn_exp2f(m - mn), pp = __builtin_amdgcn_exp2f(s - mn);
            lsum = lsum * al + pp; m = mn;
#pragma unroll
            for (int c = 0; c < 8; ++c) { const u32x4 w = *(const u32x4*)(vv + c * 8);
                o[c * 8 + 0] = o[c * 8 + 0] * al + pp * bflo(w.x); o[c * 8 + 1] = o[c * 8 + 1] * al + pp * bfhi(w.x); o[c * 8 + 2] = o[c * 8 + 2] * al + pp * bflo(w.y); o[c * 8 + 3] = o[c * 8 + 3] * al + pp * bfhi(w.y);
                o[c * 8 + 4] = o[c * 8 + 4] * al + pp * bflo(w.z); o[c * 8 + 5] = o[c * 8 + 5] * al + pp * bfhi(w.z); o[c * 8 + 6] = o[c * 8 + 6] * al + pp * bflo(w.w); o[c * 8 + 7] = o[c * 8 + 7] * al + pp * bfhi(w.w); }
        }
        if (active) { const float inv = 1.f / lsum;
#pragma unroll
            for (int c = 0; c < 8; ++c) { u32x4 w; w.x = pk2(o[c * 8] * inv, o[c * 8 + 1] * inv); w.y = pk2(o[c * 8 + 2] * inv, o[c * 8 + 3] * inv); w.z = pk2(o[c * 8 + 4] * inv, o[c * 8 + 5] * inv); w.w = pk2(o[c * 8 + 6] * inv, o[c * 8 + 7] * inv);
                *(u32x4*)(YM + (size_t)qrow * 512 + h * 64 + c * 8) = w; } }
    }
}
#endif

typedef short s16x4 __attribute__((ext_vector_type(4)));
__device__ __forceinline__ f32x4 mfma16(bf16x8 a, bf16x8 b, f32x4 c) { return __builtin_amdgcn_mfma_f32_16x16x32_bf16(a, b, c, 0, 0, 0); }
__device__ __forceinline__ s16x4 vtr16(const LAS unsigned char* p) { return __builtin_bit_cast(s16x4, __builtin_amdgcn_ds_read_tr16_b64_v4i16((LAS s16x4*)p)); }
__device__ __forceinline__ float max3f_(float a, float b, float c) { float r; asm("v_max3_f32 %0, %1, %2, %3" : "=v"(r) : "v"(a), "v"(b), "v"(c)); return r; }
__device__ __forceinline__ void glds16(const void* gsrc, unsigned lds_dst) { unsigned keep;
    asm volatile("s_mov_b32 %0, m0\n\ts_mov_b32 m0, %2\n\ts_nop 0\n\tglobal_load_lds_dwordx4 %1, off\n\ts_mov_b32 m0, %0" : "=&s"(keep) : "v"(gsrc), "s"(lds_dst) : "memory"); }
#if !NAIVE_ATTN
template <int VAR> __device__ __forceinline__ void attn_fast(Frame& F, bool need_ctx, bf16_t* YM) {
    const bf16_t* Q = (const bf16_t*)(F.ws + WS_MIX + MX_Q); const bf16_t* KN = (const bf16_t*)(F.ws + WS_MIX + MX_KN); const bf16_t* V = (const bf16_t*)(F.ws + WS_MIX + MX_V);
    const bf16_t* KPE = (const bf16_t*)(F.ws + WS_MIX + MX_KPE);
    const int lane = F.lane, wid = F.wave, r32 = lane & 31, hi = lane >> 5;
    constexpr int SLOT = 20480, VOFF = 12288, NSLOT = 5;
    const unsigned lds0 = (unsigned)(uintptr_t)F.lds;
    const int nunits = need_ctx ? 576 : 512;
    const unsigned kA = (unsigned)(hi * 1024 + r32 * 16);
    const unsigned vB = (unsigned)(VOFF + ((lane >> 4) & 1) * 32 + (lane & 3) * 8 + (4 * hi + ((lane & 15) >> 2)) * 64);
    for (int unit = F.vcu; unit < nunits; unit += F.G) {
        int b, h, qrow0, NT; const bool lat = unit < 512;
        if (lat) { b = unit >> 6; h = (unit >> 3) & 7; qrow0 = b * 2048 + (unit & 7) * 256; NT = 36; }
        else { const int u2 = unit - 512; b = u2 >> 3; h = u2 & 7; qrow0 = NLAT + b * 256; NT = 4; }
#define ATT_KROW(t) (lat ? ((t) < 32 ? b * 2048 + 64 * (t) : NLAT + b * 256 + 64 * ((t) - 32)) : NLAT + b * 256 + 64 * (t))
#define ATT_ISSUE(tt, sl) do { const int tc_ = (tt) < NT ? (tt) : NT - 1; const int kr_ = ATT_KROW(tc_); const unsigned sd_ = (unsigned)__builtin_amdgcn_readfirstlane((int)(lds0 + (sl) * SLOT + wid * 1024)); \
            glds16(KN + (size_t)(kr_ + lane) * 512 + h * 64 + wid * 8, sd_); \
            if (wid < 4) glds16(KPE + (size_t)(kr_ + lane) * 32 + wid * 8, sd_ + 8 * 1024); \
            glds16(V + (size_t)(kr_ + 16 * (wid & 3) + (lane >> 2)) * 512 + h * 64 + (wid >> 2) * 32 + (lane & 3) * 8, sd_ + VOFF); } while (0)
#define ATT_QK(P0, P1, slot) do { const LAS unsigned char* sq_ = F.lds + (slot) * SLOT; _Pragma("unroll") for (int d0 = 0; d0 < 6; ++d0) { \
            const bf16x8 k0_ = *(const LAS bf16x8*)(sq_ + kA + d0 * 2048), k1_ = *(const LAS bf16x8*)(sq_ + kA + d0 * 2048 + 512); \
            if (d0 == 0) { P0 = __builtin_amdgcn_mfma_f32_32x32x16_bf16(k0_, qf[0], negm, 0, 0, 0); P1 = __builtin_amdgcn_mfma_f32_32x32x16_bf16(k1_, qf[0], negm, 0, 0, 0); } \
            else { P0 = __builtin_amdgcn_mfma_f32_32x32x16_bf16(k0_, qf[d0], P0, 0, 0, 0); P1 = __builtin_amdgcn_mfma_f32_32x32x16_bf16(k1_, qf[d0], P1, 0, 0, 0); } } } while (0)
        asm volatile("s_waitcnt vmcnt(0)" ::: "memory");
        __syncthreads();
        ATT_ISSUE(0, 0); ATT_ISSUE(1, 1); ATT_ISSUE(2, 2); ATT_ISSUE(3, 3);
        bf16x8 qf[6];
        { const bf16_t* qp = Q + (size_t)(qrow0 + wid * 32 + r32) * 768 + h * 96 + hi * 8;
#pragma unroll
          for (int d0 = 0; d0 < 6; ++d0) qf[d0] = *(const bf16x8*)(qp + d0 * 16); }
        float mref = 0.f, lsum = 0.f, dpend = 0.f; f32x16 o0 = {}, o1 = {}, negm = {};
        asm volatile("s_waitcnt vmcnt(0)" ::: "memory");
        __syncthreads();
        f32x16 p0, p1;
        ATT_QK(p0, p1, 0);
        int s_cur = 0, s_nxt = 1, s_new = 4;
        for (int t = 0; t < NT; ++t) {
            ATT_ISSUE(t + 4, s_new);
            const LAS unsigned char* sb = F.lds + s_cur * SLOT;
            f32x16 n0, n1;
            if (t + 1 < NT) ATT_QK(n0, n1, s_nxt); else { n0 = p0; n1 = p1; }
            if (__builtin_expect(__any(dpend != 0.f), 0)) {
#pragma unroll
                for (int r = 0; r < 16; ++r) { p0[r] -= dpend; p1[r] -= dpend; } }
            float mxa = max3f_(p0[0], p0[1], p1[0]), mxb = max3f_(p0[2], p0[3], p1[1]); mxa = max3f_(mxa, p1[2], p1[3]);
#pragma unroll
            for (int r = 4; r < 16; r += 4) { mxa = max3f_(mxa, p0[r], p0[r + 1]); mxb = max3f_(mxb, p0[r + 2], p0[r + 3]); mxa = max3f_(mxa, p1[r], p1[r + 1]); mxb = max3f_(mxb, p1[r + 2], p1[r + 3]); }
            float mx = fmaxf(mxa, mxb);
            { auto rr = __builtin_amdgcn_permlane32_swap(__float_as_uint(mx), __float_as_uint(mx), false, false); mx = fmaxf(__uint_as_float(rr[0]), __uint_as_float(rr[1])); }
            dpend = 0.f;
            if (__builtin_expect(t == 0 || __any(mx > 8.f), 0)) {
                const float dl = t == 0 ? mx : fmaxf(mx, 0.f); mref += dl; dpend = dl;
#pragma unroll
                for (int r = 0; r < 16; ++r) { p0[r] -= dl; p1[r] -= dl; negm[r] = -mref; }
                const float fs = __builtin_amdgcn_exp2f(-dl); lsum *= fs;
#pragma unroll
                for (int r = 0; r < 16; ++r) { o0[r] *= fs; o1[r] *= fs; } }
            f32x2 ps2 = {0.f, 0.f};
#pragma unroll
            for (int r = 0; r < 16; r += 2) { p0[r] = __builtin_amdgcn_exp2f(p0[r]); p0[r + 1] = __builtin_amdgcn_exp2f(p0[r + 1]); p1[r] = __builtin_amdgcn_exp2f(p1[r]); p1[r + 1] = __builtin_amdgcn_exp2f(p1[r + 1]);
                ps2 += (f32x2){p0[r], p0[r + 1]}; ps2 += (f32x2){p1[r], p1[r + 1]}; }
            lsum += ps2.x + ps2.y;
            bf16x8 pb[4];
#pragma unroll
            for (int s = 0; s < 4; ++s) { u32x4 w;
                if (s < 2) { w.x = pk2(p0[8 * s], p0[8 * s + 1]); w.y = pk2(p0[8 * s + 2], p0[8 * s + 3]); w.z = pk2(p0[8 * s + 4], p0[8 * s + 5]); w.w = pk2(p0[8 * s + 6], p0[8 * s + 7]); }
                else { const int q = s - 2; w.x = pk2(p1[8 * q], p1[8 * q + 1]); w.y = pk2(p1[8 * q + 2], p1[8 * q + 3]); w.z = pk2(p1[8 * q + 4], p1[8 * q + 5]); w.w = pk2(p1[8 * q + 6], p1[8 * q + 7]); }
                pb[s] = __builtin_bit_cast(bf16x8, w); }
#pragma unroll
            for (int s = 0; s < 4; ++s) {
                const s16x4 a0l = vtr16(sb + vB + s * 1024), a0h = vtr16(sb + vB + s * 1024 + 512), a1l = vtr16(sb + vB + 4096 + s * 1024), a1h = vtr16(sb + vB + 4096 + s * 1024 + 512);
                const bf16x8 va0 = {a0l[0], a0l[1], a0l[2], a0l[3], a0h[0], a0h[1], a0h[2], a0h[3]}, va1 = {a1l[0], a1l[1], a1l[2], a1l[3], a1h[0], a1h[1], a1h[2], a1h[3]};
                o0 = __builtin_amdgcn_mfma_f32_32x32x16_bf16(va0, pb[s], o0, 0, 0, 0);
                o1 = __builtin_amdgcn_mfma_f32_32x32x16_bf16(va1, pb[s], o1, 0, 0, 0);
            }
            if (wid < 4) asm volatile("s_waitcnt vmcnt(6) lgkmcnt(0)" ::: "memory"); else asm volatile("s_waitcnt vmcnt(4) lgkmcnt(0)" ::: "memory");
            __builtin_amdgcn_s_barrier();
            p0 = n0; p1 = n1;
            s_cur = s_nxt; s_nxt = s_nxt + 1 == NSLOT ? 0 : s_nxt + 1; s_new = s_new + 1 == NSLOT ? 0 : s_new + 1;
        }
#undef ATT_QK
#undef ATT_ISSUE
#undef ATT_KROW
        lsum += shfl_f(lsum, lane ^ 32);
        const float inv = 1.f / lsum;
        bf16_t* op = YM + (size_t)(qrow0 + wid * 32 + r32) * 512 + h * 64 + 4 * hi;
#pragma unroll
        for (int g = 0; g < 4; ++g) {
            u32x2 w0, w1; w0.x = pk2(o0[4 * g] * inv, o0[4 * g + 1] * inv); w0.y = pk2(o0[4 * g + 2] * inv, o0[4 * g + 3] * inv);
            w1.x = pk2(o1[4 * g] * inv, o1[4 * g + 1] * inv); w1.y = pk2(o1[4 * g + 2] * inv, o1[4 * g + 3] * inv);
            *(u32x2*)(op + 8 * g) = w0; *(u32x2*)(op + 32 + 8 * g) = w1;
        }
    }
}
#endif

#if !NAIVE_HG
__device__ __forceinline__ bf16x8 trfrag(const LAS unsigned char* p, int rowstep4) {
    const s16x4 lo = vtr16(p), hi = vtr16(p + rowstep4); return (bf16x8){lo[0], lo[1], lo[2], lo[3], hi[0], hi[1], hi[2], hi[3]}; }
__device__ __forceinline__ void hg_gate16(const bf16_t* Z, int b, int s0, int d, int zcol, float lb, float (&kin)[16], float (&gl)[16]) {
#pragma unroll
    for (int i = 0; i < 16; ++i) { const int row = seq_row(b, s0 + i, d); const float z = bf2f(Z[(size_t)row * ZC + zcol]);
        const float e = __expf(-z), sg = 1.f / (1.f + e), f = lb + (1.f - lb) * sg; kin[i] = (1.f - lb) * e * sg; gl[i] = __logf(f); }
}
__device__ __forceinline__ void hg_local_load(u32x4 (&tz)[2], u32x4& tv, const bf16_t* Z, int unit, int tid) {
    const int c = unit % 36, r = unit / 36, d = r & 1, hd = (r >> 1) & 3, b = r >> 3;
#pragma unroll
    for (int j = 0; j < 2; ++j) { const int pc = tid + 512 * j, t = pc >> 4, c16 = pc & 15, row = seq_row(b, 64 * c + t, d);
        tz[j] = *(const u32x4*)(Z + (size_t)row * ZC + (d ? ZF1 : ZF0) + hd * 128 + c16 * 8); }
    { const int t = tid >> 3, cc = tid & 7, row = seq_row(b, 64 * c + t, d); tv = *(const u32x4*)(Z + (size_t)row * ZC + ZI + hd * 64 + cc * 8); }
}
__device__ __forceinline__ void hg_local_phase(Frame& F, ArgsP a, int l) {
    const bf16_t* Z = (const bf16_t*)(F.ws + WS_Z); bf16_t* HGS = (bf16_t*)(F.ws + WS_H); float* HGD = (float*)(F.ws + WS_MIX + MX_HGD);
    const float lb = hg_lb(a, l);
    LAS unsigned char* Vl = F.lds; LAS unsigned char* KdT = F.lds + 9216; LAS float* seg = (LAS float*)(F.lds + 27648); LAS unsigned char* Zr = F.lds + 32768;
    const int tid = F.tid, lane = F.lane, w = F.wave, k = tid & 127, tq = tid >> 7;
    u32x4 tz[2], tv;
    if (F.vcu < 2304) hg_local_load(tz, tv, Z, F.vcu, tid);
    for (int unit = F.vcu; unit < 2304; unit += F.G) {
        __syncthreads();
#pragma unroll
        for (int j = 0; j < 2; ++j) { const int pc = tid + 512 * j; *(LAS u32x4*)(Zr + (pc >> 4) * 272 + (pc & 15) * 16) = tz[j]; }
        *(LAS u32x4*)(Vl + (tid >> 3) * 144 + (tid & 7) * 16) = tv;
        if (unit + F.G < 2304) hg_local_load(tz, tv, Z, unit + F.G, tid);
        __syncthreads();
        float kin0[8], kin1[8], g0[8], g1[8];
#pragma unroll
        for (int i = 0; i < 8; ++i) { const unsigned zz = *(const LAS unsigned*)(Zr + ((8 * w + i) * 136 + 2 * lane) * 2);
            { const float e = __expf(-bflo(zz)), sg = __builtin_amdgcn_rcpf(1.f + e); kin0[i] = (1.f - lb) * e * sg; g0[i] = __logf(lb + (1.f - lb) * sg); }
            { const float e = __expf(-bfhi(zz)), sg = __builtin_amdgcn_rcpf(1.f + e); kin1[i] = (1.f - lb) * e * sg; g1[i] = __logf(lb + (1.f - lb) * sg); } }
        float run0 = 0.f, run1 = 0.f;
#pragma unroll
        for (int i = 7; i >= 0; --i) { const float a0 = g0[i], a1 = g1[i]; g0[i] = run0; g1[i] = run1; run0 += a0; run1 += a1; }
        *(LAS f32x2*)(seg + w * 128 + 2 * lane) = (f32x2){run0, run1};
        __syncthreads();
        float lat0 = 0.f, lat1 = 0.f, tot0 = 0.f, tot1 = 0.f;
#pragma unroll
        for (int q = 0; q < 8; ++q) { const f32x2 sv = *(const LAS f32x2*)(seg + q * 128 + 2 * lane); tot0 += sv.x; tot1 += sv.y; if (q > w) { lat0 += sv.x; lat1 += sv.y; } }
        { u32x4 w0, w1;
          w0.x = pk2(kin0[0] * __expf(g0[0] + lat0), kin0[1] * __expf(g0[1] + lat0)); w0.y = pk2(kin0[2] * __expf(g0[2] + lat0), kin0[3] * __expf(g0[3] + lat0));
          w0.z = pk2(kin0[4] * __expf(g0[4] + lat0), kin0[5] * __expf(g0[5] + lat0)); w0.w = pk2(kin0[6] * __expf(g0[6] + lat0), kin0[7] * __expf(g0[7] + lat0));
          w1.x = pk2(kin1[0] * __expf(g1[0] + lat1), kin1[1] * __expf(g1[1] + lat1)); w1.y = pk2(kin1[2] * __expf(g1[2] + lat1), kin1[3] * __expf(g1[3] + lat1));
          w1.z = pk2(kin1[4] * __expf(g1[4] + lat1), kin1[5] * __expf(g1[5] + lat1)); w1.w = pk2(kin1[6] * __expf(g1[6] + lat1), kin1[7] * __expf(g1[7] + lat1));
          *(LAS u32x4*)(KdT + (2 * lane) * 144 + w * 16) = w0; *(LAS u32x4*)(KdT + (2 * lane + 1) * 144 + w * 16) = w1; }
        if (w == 0) *(f32x2*)(HGD + (size_t)unit * 128 + 2 * lane) = (f32x2){__expf(tot0), __expf(tot1)};
        __syncthreads();
        f32x4 acc[4] = {};
#pragma unroll
        for (int ks = 0; ks < 2; ++ks) {
            const bf16x8 bf = *(const LAS bf16x8*)(KdT + (16 * w + (lane & 15)) * 144 + (32 * ks + 8 * (lane >> 4)) * 2);
#pragma unroll
            for (int mt = 0; mt < 4; ++mt) { const bf16x8 af = trfrag(Vl + (32 * ks + 8 * (lane >> 4) + ((lane & 15) >> 2)) * 144 + (mt * 16 + 4 * (lane & 3)) * 2, 4 * 144);
                acc[mt] = mfma16(af, bf, acc[mt]); }
        }
        bf16_t* dst = HGS + (size_t)unit * 8192 + 16 * w + (lane & 15);
#pragma unroll
        for (int mt = 0; mt < 4; ++mt)
#pragma unroll
            for (int rr = 0; rr < 4; ++rr) dst[(size_t)(16 * mt + 4 * (lane >> 4) + rr) * 128] = (bf16_t)f2bf(acc[mt][rr]);
    }
}
__device__ __forceinline__ void hg_scan_phase(Frame& F) {
    bf16_t* HGS = (bf16_t*)(F.ws + WS_H); const float* HGD = (const float*)(F.ws + WS_MIX + MX_HGD);
    for (int it = F.gw * 64 + F.lane; it < 64 * 1024; it += F.NGW * 64) {
        const int r = it >> 10, e8 = (it & 1023) * 8, k0 = e8 & 127;
        float S[8];
#pragma unroll
        for (int j = 0; j < 8; ++j) S[j] = 0.f;
#pragma unroll 4
        for (int c = 0; c < 36; ++c) {
            u32x4* p = (u32x4*)(HGS + (size_t)(r * 36 + c) * 8192 + e8); const u32x4 ds = *p;
            const f32x4 d0 = *(const f32x4*)(HGD + (size_t)(r * 36 + c) * 128 + k0), d1 = *(const f32x4*)(HGD + (size_t)(r * 36 + c) * 128 + k0 + 4);
            u32x4 o; o.x = pk2(S[0], S[1]); o.y = pk2(S[2], S[3]); o.z = pk2(S[4], S[5]); o.w = pk2(S[6], S[7]); *p = o;
            S[0] = d0[0] * S[0] + bflo(ds.x); S[1] = d0[1] * S[1] + bfhi(ds.x); S[2] = d0[2] * S[2] + bflo(ds.y); S[3] = d0[3] * S[3] + bfhi(ds.y);
            S[4] = d1[0] * S[4] + bflo(ds.z); S[5] = d1[1] * S[5] + bfhi(ds.z); S[6] = d1[2] * S[6] + bflo(ds.w); S[7] = d1[3] * S[7] + bfhi(ds.w);
        }
    }
}
struct HgTile { u32x4 z[2], q[2], s[2], v; };
__device__ __forceinline__ void hg_out_decode(int unit, bool need_ctx, int& b, int& hd, int& ct) {
    if (need_ctx) { ct = unit % 36; hd = (unit / 36) & 3; b = unit / 144; } else { ct = 4 + (unit & 31); hd = (unit >> 5) & 3; b = unit >> 7; }
}
__device__ __forceinline__ void hg_out_load(HgTile& T, const bf16_t* Z, const bf16_t* HGS, int b, int hd, int ct, int d, int tid) {
    const int cs = d == 0 ? ct : (ct < 4 ? 3 - ct : 39 - ct); const size_t su = (size_t)(((b * 4 + hd) * 2 + d) * 36 + cs);
#pragma unroll
    for (int j = 0; j < 2; ++j) { const int pc = tid + 512 * j, t = pc >> 4, c16 = pc & 15, row = seq_row(b, 64 * cs + t, d);
        T.z[j] = *(const u32x4*)(Z + (size_t)row * ZC + (d ? ZF1 : ZF0) + hd * 128 + c16 * 8); T.q[j] = *(const u32x4*)(Z + (size_t)row * ZC + ZHQ + hd * 128 + c16 * 8);
        T.s[j] = *(const u32x4*)(HGS + su * 8192 + (size_t)t * 128 + c16 * 8); }
    { const int t = tid >> 3, cc = tid & 7, row = seq_row(b, 64 * cs + t, d); T.v = *(const u32x4*)(Z + (size_t)row * ZC + ZI + hd * 64 + cc * 8); }
}
__device__ __forceinline__ void hg_out_phase(Frame& F, ArgsP a, int l, bool need_ctx) {
    const bf16_t* Z = (const bf16_t*)(F.ws + WS_Z); const bf16_t* HGS = (const bf16_t*)(F.ws + WS_H); bf16_t* YHG = (bf16_t*)(F.ws + WS_MIX + MX_YHG);
    const float lb = hg_lb(a, l);
    LAS unsigned char* HQD = F.lds; LAS unsigned char* HQ1 = F.lds + 17408; LAS unsigned char* HK1 = F.lds + 34816; LAS unsigned char* HST = F.lds + 52224;
    LAS unsigned char* HV = F.lds + 69632; LAS unsigned char* HP = F.lds + 78848; LAS float* HO = (LAS float*)(F.lds + 88064); LAS float* seg = (LAS float*)(F.lds + 105472);
    const int tid = F.tid, lane = F.lane, w = F.wave, k = tid & 127, tq = tid >> 7, mt = w >> 1, nh = w & 1;
    const int nunits = need_ctx ? 1152 : 1024;
    const int nmine = F.vcu < nunits ? (nunits - 1 - F.vcu) / F.G + 1 : 0, nit = 2 * nmine;
    HgTile T;
    if (nit > 0) { int b, hd, ct; hg_out_decode(F.vcu, need_ctx, b, hd, ct); hg_out_load(T, Z, HGS, b, hd, ct, 0, tid); }
    for (int it = 0; it < nit; ++it) {
        const int unit = F.vcu + (it >> 1) * F.G, d = it & 1; int b, hd, ct; hg_out_decode(unit, need_ctx, b, hd, ct);
        __syncthreads();
#pragma unroll
        for (int j = 0; j < 2; ++j) { const int pc = tid + 512 * j, t = pc >> 4, c16 = pc & 15;
            *(LAS u32x4*)(HQD + t * 272 + c16 * 16) = T.q[j]; *(LAS u32x4*)(HK1 + t * 272 + c16 * 16) = T.z[j]; *(LAS u32x4*)(HST + t * 272 + c16 * 16) = T.s[j]; }
        *(LAS u32x4*)(HV + (tid >> 3) * 144 + (tid & 7) * 16) = T.v;
        if (it + 1 < nit) { const int un = F.vcu + ((it + 1) >> 1) * F.G; int b2, hd2, ct2; hg_out_decode(un, need_ctx, b2, hd2, ct2); hg_out_load(T, Z, HGS, b2, hd2, ct2, (it + 1) & 1, tid); }
        __syncthreads();
        float kin0[8], kin1[8], g0[8], g1[8];
#pragma unroll
        for (int i = 0; i < 8; ++i) { const unsigned zz = *(const LAS unsigned*)(HK1 + ((8 * w + i) * 136 + 2 * lane) * 2);
            { const float e = __expf(-bflo(zz)), sg = __builtin_amdgcn_rcpf(1.f + e); kin0[i] = (1.f - lb) * e * sg; g0[i] = __logf(lb + (1.f - lb) * sg); }
            { const float e = __expf(-bfhi(zz)), sg = __builtin_amdgcn_rcpf(1.f + e); kin1[i] = (1.f - lb) * e * sg; g1[i] = __logf(lb + (1.f - lb) * sg); } }
        float run0 = 0.f, run1 = 0.f;
#pragma unroll
        for (int i = 0; i < 8; ++i) { run0 += g0[i]; g0[i] = run0; run1 += g1[i]; g1[i] = run1; }
        *(LAS f32x2*)(seg + w * 128 + 2 * lane) = (f32x2){run0, run1};
        __syncthreads();
        float bef0 = 0.f, bef1 = 0.f, br0 = 0.f, br1 = 0.f;
#pragma unroll
        for (int q = 0; q < 7; ++q) { const f32x2 sv = *(const LAS f32x2*)(seg + q * 128 + 2 * lane); if (q < w) { bef0 += sv.x; bef1 += sv.y; } if (q < 4) { br0 += sv.x; br1 += sv.y; } }
        const float er0 = __expf(br0), er1 = __expf(br1);
#pragma unroll
        for (int i = 0; i < 8; ++i) { const int t = 8 * w + i, off = (t * 136 + 2 * lane) * 2;
            const unsigned qq = *(const LAS unsigned*)(HQD + off);
            const float e0 = __expf(fminf(fmaxf(bef0 + g0[i] - br0, -80.f), 80.f)), e1 = __expf(fminf(fmaxf(bef1 + g1[i] - br1, -80.f), 80.f));
            const float q10 = bflo(qq) * e0, q11 = bfhi(qq) * e1;
            *(LAS unsigned*)(HQ1 + off) = pk2(q10, q11);
            *(LAS unsigned*)(HQD + off) = pk2(q10 * er0, q11 * er1);
            *(LAS unsigned*)(HK1 + off) = pk2(kin0[i] * __builtin_amdgcn_rcpf(e0), kin1[i] * __builtin_amdgcn_rcpf(e1)); }
        __syncthreads();
        f32x4 ao[2] = {}, as[2] = {};
#pragma unroll
        for (int ks = 0; ks < 4; ++ks) {
            const int ko = (32 * ks + 8 * (lane >> 4)) * 2;
            const bf16x8 aqd = *(const LAS bf16x8*)(HQD + (16 * mt + (lane & 15)) * 272 + ko), aq1 = *(const LAS bf16x8*)(HQ1 + (16 * mt + (lane & 15)) * 272 + ko);
#pragma unroll
            for (int j = 0; j < 2; ++j) { const int nt = 2 * nh + j;
                ao[j] = mfma16(aqd, *(const LAS bf16x8*)(HST + (16 * nt + (lane & 15)) * 272 + ko), ao[j]);
                as[j] = mfma16(aq1, *(const LAS bf16x8*)(HK1 + (16 * nt + (lane & 15)) * 272 + ko), as[j]); }
        }
#pragma unroll
        for (int j = 0; j < 2; ++j) { const int sc = 16 * (2 * nh + j) + (lane & 15);
#pragma unroll
            for (int rr = 0; rr < 4; ++rr) { const int t = 16 * mt + 4 * (lane >> 4) + rr; *(LAS bf16_t*)(HP + (t * 72 + sc) * 2) = (bf16_t)f2bf(sc <= t ? as[j][rr] : 0.f); } }
        __syncthreads();
#pragma unroll
        for (int ks = 0; ks < 2; ++ks) {
            const bf16x8 ap = *(const LAS bf16x8*)(HP + (16 * mt + (lane & 15)) * 144 + (32 * ks + 8 * (lane >> 4)) * 2);
#pragma unroll
            for (int j = 0; j < 2; ++j) { const int nt = 2 * nh + j;
                const bf16x8 bv = trfrag(HV + (32 * ks + 8 * (lane >> 4) + ((lane & 15) >> 2)) * 144 + (16 * nt + 4 * (lane & 3)) * 2, 4 * 144);
                ao[j] = mfma16(ap, bv, ao[j]); }
        }
#pragma unroll
        for (int j = 0; j < 2; ++j) { const int v = 16 * (2 * nh + j) + (lane & 15);
#pragma unroll
            for (int rr = 0; rr < 4; ++rr) { const int t = 16 * mt + 4 * (lane >> 4) + rr, tt = d == 0 ? t : 63 - t;
                if (d == 0) HO[tt * 68 + v] = ao[j][rr]; else HO[tt * 68 + v] += ao[j][rr]; } }
        if (d == 1) {
            __syncthreads();
#pragma unroll
            for (int i = 0; i < 8; ++i) { const int tt = 8 * w + i, row = ct < 4 ? NLAT + b * 256 + 64 * ct + tt : b * 2048 + 64 * (ct - 4) + tt, cidx = hd * 64 + lane;
                float o = HO[tt * 68 + lane]; const float ms = wave_sum(o * o) * (1.f / 64.f);
                o = o * rsqrtf(ms + EPS) * a->in[25][l * 256 + cidx] * siluf_(bf2f(Z[(size_t)row * ZC + ZG + cidx]));
                YHG[(size_t)row * 256 + cidx] = (bf16_t)f2bf(o); }
        }
    }
}
#endif

#if !NAIVE_S5
typedef f32x2 cf32;
__device__ __forceinline__ cf32 cmul(cf32 a, cf32 b) { return (cf32){a.x * b.x - a.y * b.y, a.x * b.y + a.y * b.x}; }
__device__ __forceinline__ void s5_build(Frame& F, ArgsP a) {
    LAS cf32* lamp = (LAS cf32*)F.lds;
    LAS cf32* Bb = lamp + 2 * 17 * 64;
    LAS cf32* Cc = Bb + 2 * 64 * 16;
    LAS float* Kd = (LAS float*)(Cc + 2 * 16 * 64);
    const int tid = F.tid;
    for (int unit = blockIdx.x; unit < 128; unit += F.G) {
        const int l = unit >> 6, g = (unit >> 2) & 15, q = unit & 3;
        bf16_t* Bs_t = (bf16_t*)(F.ws + WS_WB + (size_t)l * WL_STRIDE + WL_BS); bf16_t* B2_t = (bf16_t*)(F.ws + WS_WB + (size_t)l * WL_STRIDE + WL_B2);
        __syncthreads();
        if (tid < 128) { const int d = tid >> 6, p = tid & 63, idx = (l * 2 + d) * 16 + g;
            const float lre = a->in[9][idx * 64 + p], lim = a->in[10][idx * 64 + p], dt = expf(a->in[15][idx]);
            const float ar = lre * dt, ai = lim * dt;
            for (int tau = 0; tau <= 16; ++tau) { const float mag = expf(ar * (float)tau); float sn, cs; sincosf(ai * (float)tau, &sn, &cs); lamp[(d * 17 + tau) * 64 + p] = (cf32){mag * cs, mag * sn}; }
            const cf32 lb = lamp[(d * 17 + 1) * 64 + p]; const float den = lre * lre + lim * lim;
            const cf32 f = (cf32){((lb.x - 1.f) * lre + lb.y * lim) / den, (lb.y * lre - (lb.x - 1.f) * lim) / den};
            { const f32x4* br4 = (const f32x4*)(a->in[11] + (size_t)(idx * 64 + p) * 16); const f32x4* bi4 = (const f32x4*)(a->in[12] + (size_t)(idx * 64 + p) * 16);
              f32x4 br[4], bi[4];
#pragma unroll
              for (int q4 = 0; q4 < 4; ++q4) { br[q4] = br4[q4]; bi[q4] = bi4[q4]; }
#pragma unroll
              for (int h = 0; h < 16; ++h) Bb[(d * 64 + p) * 16 + h] = cmul(f, (cf32){br[h >> 2][h & 3], bi[h >> 2][h & 3]}); }
            if (q == 0) ((cf32*)(F.ws + WS_S5P))[idx * 64 + p] = lamp[(d * 17 + 16) * 64 + p];
        }
        for (int e = tid; e < 2048; e += 512) { const int d = e >> 10, h = (e >> 6) & 15, p = e & 63, idx = (l * 2 + d) * 16 + g;
            Cc[e] = (cf32){a->in[13][(size_t)(idx * 16 + h) * 64 + p], a->in[14][(size_t)(idx * 16 + h) * 64 + p]}; }
        __syncthreads();
        { const int d = tid >> 8, tau = (tid >> 4) & 15, h = tid & 15; float kacc[16];
#pragma unroll
          for (int hp = 0; hp < 16; ++hp) kacc[hp] = 0.f;
          for (int p = 0; p < 64; ++p) { const cf32 t1 = cmul(Cc[(d * 16 + h) * 64 + p], lamp[(d * 17 + tau) * 64 + p]);
#pragma unroll
              for (int hp = 0; hp < 16; ++hp) { const cf32 bb = Bb[(d * 64 + p) * 16 + hp]; kacc[hp] += t1.x * bb.x - t1.y * bb.y; } }
#pragma unroll
          for (int hp = 0; hp < 16; ++hp) Kd[tid * 16 + hp] = kacc[hp]; }
        __syncthreads();
        for (int e = tid; e < 64 * 512; e += 512) { const int n = 64 * q + (e >> 9), kk = e & 511, i = n >> 4, h = n & 15; float val;
            if (kk < 256) { const int j = kk >> 4, hp = kk & 15; val = 0.f;
                if (j <= i) val += Kd[((i - j) * 16 + h) * 16 + hp];
                if (j >= i) val += Kd[4096 + ((j - i) * 16 + h) * 16 + hp]; }
            else { const int dd = (kk - 256) >> 7, pp = (kk - 256) & 127, p = pp & 63, pw = dd == 0 ? i + 1 : 16 - i;
                const cf32 cl = cmul(Cc[(dd * 16 + h) * 64 + p], lamp[(dd * 17 + pw) * 64 + p]); val = pp < 64 ? cl.x : -cl.y; }
            B2_t[((size_t)g * 256 + n) * 512 + kk] = (bf16_t)f2bf(val); }
        { const int d = q & 1, half = q >> 1;
          for (int e = tid; e < 64 * 256; e += 512) { const int p = e >> 8, kk = e & 255, j = kk >> 4, hp = kk & 15, pw = d == 0 ? 15 - j : j;
              const cf32 v = cmul(lamp[(d * 17 + pw) * 64 + p], Bb[(d * 64 + p) * 16 + hp]);
              Bs_t[((size_t)(g * 2 + d) * 128 + half * 64 + p) * 256 + kk] = (bf16_t)f2bf(half ? v.y : v.x); } }
    }
    __syncthreads();
}
__device__ __forceinline__ void s5_state_phase(Frame& F, int l) {
    bf16_t* S5A = (bf16_t*)(F.ws + WS_MIX + MX_S5A); const bf16_t* Bs_t = (const bf16_t*)(F.ws + WS_WB + (size_t)l * WL_STRIDE + WL_BS);
    const cf32* lam16 = (const cf32*)(F.ws + WS_S5P);
    LAS float* hl = (LAS float*)F.lds;
    const int lane = F.lane, w = F.wave;
    for (int unit = F.vcu; unit < 256; unit += F.G) {
        const int b = unit & 7, d = (unit >> 3) & 1, g = unit >> 4;
        __syncthreads();
        f32x4 acc[10] = {};
        { u32x4 ta[10]; const bf16_t* Asrc = S5A + ((size_t)g * 1280 + b * 160) * 512;
#pragma unroll
          for (int j = 0; j < 10; ++j) { const int pc = F.tid + 512 * j; ta[j] = *(const u32x4*)(Asrc + (size_t)(pc >> 5) * 512 + (pc & 31) * 8); }
          const bf16_t* Bb = Bs_t + ((size_t)(g * 2 + d) * 128 + 16 * w + (lane & 15)) * 256 + 8 * (lane >> 4);
          bf16x8 bfr[8];
#pragma unroll
          for (int ks = 0; ks < 8; ++ks) bfr[ks] = *(const bf16x8*)(Bb + 32 * ks);
#pragma unroll
          for (int j = 0; j < 10; ++j) { const int pc = F.tid + 512 * j; *(LAS u32x4*)(F.lds + (pc >> 5) * 528 + (pc & 31) * 16) = ta[j]; }
          __syncthreads();
#pragma unroll
          for (int ks = 0; ks < 8; ++ks)
#pragma unroll
              for (int mt = 0; mt < 10; ++mt) acc[mt] = mfma16(*(const LAS bf16x8*)(F.lds + (16 * mt + (lane & 15)) * 528 + (32 * ks + 8 * (lane >> 4)) * 2), bfr[ks], acc[mt]);
          __syncthreads(); }
#pragma unroll
        for (int mt = 0; mt < 10; ++mt)
#pragma unroll
            for (int rr = 0; rr < 4; ++rr) hl[(16 * mt + 4 * (lane >> 4) + rr) * 132 + 16 * w + (lane & 15)] = acc[mt][rr];
        __syncthreads();
        if (w == 0) { const cf32 lm = lam16[((l * 2 + d) * 16 + g) * 64 + lane]; float hr = 0.f, hi = 0.f;
            bf16_t* dst = S5A + ((size_t)g * 1280 + b * 160) * 512 + 256 + d * 128 + lane;
            for (int s = 0; s < 144; ++s) { const int c = d == 0 ? s : (s < 16 ? 15 - s : 159 - s);
                dst[(size_t)c * 512] = (bf16_t)f2bf(hr); dst[(size_t)c * 512 + 64] = (bf16_t)f2bf(hi);
                const float lr = hl[c * 132 + lane], li = hl[c * 132 + 64 + lane];
                const float nr = lm.x * hr - lm.y * hi + lr, ni = lm.x * hi + lm.y * hr + li; hr = nr; hi = ni; }
        }
    }
}
struct WinOrderLast { pg8::StaticOrder S0; int G, c;
    __device__ bool next(int i, pg8::Unit& u) const { const int L = i * G + c; if (L < S0.nwg) return S0.next(i, u); const int e = L - S0.nwg; if (e >= 64) return false;
        const int t = e >> 3; u.pm = 64 + (e & 7); u.pn = t == 0 ? 0 : (t == 1 ? 2 : t + 2); u.h = -1; return true; } };
struct S5Order { int G, c; __device__ bool next(int i, pg8::Unit& u) const { const int L = i * G + c; if (L >= 80) return false; u.pm = L; u.pn = L / 5; u.h = -1; return true; } };
struct HalfTailOrder { pg8::StaticOrder S0; int G, c;
    __device__ bool next(int i, pg8::Unit& u) const { const int L = i * G + c; if (L < S0.nwg) return S0.next(i, u); const int e = L - S0.nwg; if (e >= 64) return false;
        u.pm = 64 + (e >> 3); u.pn = (e >> 1) & 3; u.h = e & 1; return true; } };
#endif

__device__ __forceinline__ bf16x8 pack8(const float (&v)[8]) { u32x4 w; w.x = pk2(v[0], v[1]); w.y = pk2(v[2], v[3]); w.z = pk2(v[4], v[5]); w.w = pk2(v[6], v[7]); return __builtin_bit_cast(bf16x8, w); }
__device__ __forceinline__ void norm2_router_phase(Frame& F, ArgsP a, int l, int nrows) {
    const float* X = (const float*)(F.ws + WS_X); bf16_t* H = (bf16_t*)(F.ws + WS_H);
    const float* modv = (const float*)(F.ws + WS_MODV) + (size_t)l * 9 * 6144;
    const float* Wg = a->in[30] + (size_t)l * D * 4; const float* bg = a->in[31] + l * 4; const float* We = a->in[32] + (size_t)l * D * 32; const float* be = a->in[33] + l * 32;
    int* ri = (int*)(F.ws + WS_ROUTE); float* rg = (float*)(F.ws + WS_ROUTE + (size_t)MTOK * 16);
    unsigned* cnt = (unsigned*)(F.ws + WS_CTL) + CW_CNT + l * 32 * 64;
    LAS unsigned char* hhi = F.lds; LAS unsigned char* hlo = F.lds + 33024; LAS float* part = (LAS float*)(F.lds + 66048); LAS float* lg = (LAS float*)(F.lds + 90624);
    const int w = F.wave, lane = F.lane, tid = F.tid;
    bf16x8 whi[4][3], wlo[4][3];
#pragma unroll
    for (int ks = 0; ks < 4; ++ks)
#pragma unroll
        for (int nt = 0; nt < 3; ++nt) { float hv[8], lv[8]; const int col = 16 * nt + (lane & 15);
#pragma unroll
            for (int i = 0; i < 8; ++i) { const int k = 128 * w + 32 * ks + 8 * (lane >> 4) + i;
                const float wv = col < 32 ? We[(size_t)k * 32 + col] : (col < 36 ? Wg[(size_t)k * 4 + (col - 32)] : 0.f);
                const float hi = bflo(pk2(wv, 0.f)); hv[i] = hi; lv[i] = wv - hi; }
            whi[ks][nt] = pack8(hv); wlo[ks][nt] = pack8(lv); }
    const int niter = nrows >> 4;
    for (int it = F.vcu; it < niter; it += F.G) {
        const int base = it * 16;
        __syncthreads();
#pragma unroll
        for (int rr = 0; rr < 2; ++rr) { const int lr = 2 * w + rr, row = base + lr; f32x4 v[4], h[4];
#pragma unroll
            for (int j = 0; j < 4; ++j) v[j] = *(const f32x4*)(X + (size_t)row * D + 4 * lane + 256 * j);
            const float* mv = modv + (size_t)tok_modrow(row) * 6144;
            norm_mod_row(v, h, a->in[7] + l * D, mv + 3 * 1024, mv + 4 * 1024, lane);
            store_row_bf16(H + (size_t)row * D, h, lane);
#pragma unroll
            for (int j = 0; j < 4; ++j) { u32x2 ph, pl; ph.x = pk2(h[j][0], h[j][1]); ph.y = pk2(h[j][2], h[j][3]);
                pl.x = pk2(h[j][0] - bflo(ph.x), h[j][1] - bfhi(ph.x)); pl.y = pk2(h[j][2] - bflo(ph.y), h[j][3] - bfhi(ph.y));
                *(LAS u32x2*)(hhi + (lr * 1032 + 4 * lane + 256 * j) * 2) = ph; *(LAS u32x2*)(hlo + (lr * 1032 + 4 * lane + 256 * j) * 2) = pl; } }
        __syncthreads();
        f32x4 acc[3] = {};
#pragma unroll
        for (int ks = 0; ks < 4; ++ks) { const int ao = ((lane & 15) * 1032 + 128 * w + 32 * ks + 8 * (lane >> 4)) * 2;
            const bf16x8 ahi = *(const LAS bf16x8*)(hhi + ao), alo = *(const LAS bf16x8*)(hlo + ao);
#pragma unroll
            for (int nt = 0; nt < 3; ++nt) { acc[nt] = mfma16(ahi, whi[ks][nt], acc[nt]); acc[nt] = mfma16(ahi, wlo[ks][nt], acc[nt]); acc[nt] = mfma16(alo, whi[ks][nt], acc[nt]); } }
#pragma unroll
        for (int nt = 0; nt < 3; ++nt)
#pragma unroll
            for (int r = 0; r < 4; ++r) part[(w * 16 + 4 * (lane >> 4) + r) * 48 + 16 * nt + (lane & 15)] = acc[nt][r];
        __syncthreads();
        for (int t = tid; t < 576; t += 512) { const int r = t / 36, c = t - r * 36; float sacc = 0.f;
#pragma unroll
            for (int q = 0; q < 8; ++q) sacc += part[(q * 16 + r) * 48 + c];
            lg[r * 40 + c] = sacc + (c < 32 ? be[c] : bg[c - 32]); }
        __syncthreads();
        if (tid < 16) { const int row = base + tid; const LAS float* lr = lg + tid * 40;
            int gi = 0; float gm = lr[32];
#pragma unroll
            for (int i = 1; i < 4; ++i) if (lr[32 + i] > gm) { gm = lr[32 + i]; gi = i; }
            float gs = 0.f;
#pragma unroll
            for (int i = 0; i < 4; ++i) gs += __expf(lr[32 + i] - gm);
            const float gw_ = 1.f / gs;
            const LAS float* el = lr + gi * 8;
            int i1 = 0; float v1 = el[0];
#pragma unroll
            for (int j = 1; j < 8; ++j) if (el[j] > v1) { v1 = el[j]; i1 = j; }
            int i2 = -1; float v2 = -3.0e38f;
#pragma unroll
            for (int j = 0; j < 8; ++j) if (j != i1 && el[j] > v2) { v2 = el[j]; i2 = j; }
            const float e2 = __expf(v2 - v1), g1 = gw_ / (1.f + e2), g2 = gw_ * e2 / (1.f + e2);
            const int e0 = gi * 8 + i1, e1 = gi * 8 + i2;
            const unsigned r0 = __hip_atomic_fetch_add(cnt + e0 * 64, 1u, __ATOMIC_RELAXED, __HIP_MEMORY_SCOPE_AGENT), r1 = __hip_atomic_fetch_add(cnt + e1 * 64, 1u, __ATOMIC_RELAXED, __HIP_MEMORY_SCOPE_AGENT);
            *(int4*)(ri + (size_t)row * 4) = make_int4(e0, e1, (int)r0, (int)r1);
            { int* lists = (int*)(F.ws + WS_LISTS); lists[(size_t)e0 * MTOK + r0] = row; lists[(size_t)e1 * MTOK + r1] = row; }
            rg[(size_t)row * 2 + 0] = g1; rg[(size_t)row * 2 + 1] = g2; }
    }
}
__device__ __forceinline__ int moe_starts(Frame& F, int l, int& total) {
    unsigned* cnt = (unsigned*)(F.ws + WS_CTL) + CW_CNT + l * 32 * 64;
    const int c = F.lane < 32 ? (int)__hip_atomic_load(cnt + (F.lane & 31) * 64, __ATOMIC_RELAXED, __HIP_MEMORY_SCOPE_AGENT) : 0;
    const int padded = (c + 255) & ~255; int incl = padded;
#pragma unroll
    for (int o = 1; o < 32; o <<= 1) { const int t = shfl_i(incl, F.lane - o); if (F.lane >= o) incl += t; }
    total = shfl_i(incl, 31);
    return incl - padded;
}
__device__ __forceinline__ void moe_gather_phase(Frame& F, int l, int nrows) {
    const bf16_t* H = (const bf16_t*)(F.ws + WS_H); bf16_t* XS = (bf16_t*)(F.ws + WS_Z + MZ_XS); const int* ri = (const int*)(F.ws + WS_ROUTE);
    int total; const int st = moe_starts(F, l, total);
    for (int row = F.gw; row < nrows; row += F.NGW) {
        const int e0 = ri[(size_t)row * 4], e1 = ri[(size_t)row * 4 + 1], r0 = ri[(size_t)row * 4 + 2], r1 = ri[(size_t)row * 4 + 3];
        const int d0 = shfl_i(st, e0) + r0, d1 = shfl_i(st, e1) + r1;
#pragma unroll
        for (int j = 0; j < 2; ++j) { const u32x4 w = *(const u32x4*)(H + (size_t)row * D + j * 512 + F.lane * 8);
            *(u32x4*)(XS + (size_t)d0 * D + j * 512 + F.lane * 8) = w; *(u32x4*)(XS + (size_t)d1 * D + j * 512 + F.lane * 8) = w; }
    }
}
__device__ __forceinline__ int moe_unit_wgid(int L, int nunits) { const int q = nunits / 8, r = nunits % 8, xcd = L % 8, off = L / 8; return (xcd < r ? xcd * (q + 1) : r * (q + 1) + (xcd - r) * q) + off; }
struct MoeOrder {
    int nunits, G, c; const LAS int* tile_e; const LAS int* rows;
    __device__ bool next(int i, pg8::Unit& u) const {
        const long L = (long)i * G + c; if (L >= nunits) return false;
        const int wgid = moe_unit_wgid((int)L, nunits), tile = wgid >> 2; const int te = tile_e[tile]; u.pm = tile; u.pn = (te & 255) * 4 + (wgid & 3); u.h = (te & 256) ? 0 : -1; return true;
    }
    __device__ unsigned a_row(int ui, int r) const { return (unsigned)rows[ui * 256 + r]; }
};
__device__ __forceinline__ int moe_build_tiles(Frame& F, int l, bool fill_rows) {
    LAS int* tbl = (LAS int*)(F.lds + TBL_OFF);
    __syncthreads();
    if (F.wave == 0) { int total; const int st = moe_starts(F, l, total); if (F.lane < 32) { tbl[F.lane] = st;
            tbl[256 + F.lane] = (int)__hip_atomic_load((unsigned*)(F.ws + WS_CTL) + CW_CNT + (l * 32 + F.lane) * 64, __ATOMIC_RELAXED, __HIP_MEMORY_SCOPE_AGENT); }
        if (F.lane == 0) tbl[32] = total; }
    __syncthreads();
    const int total = tbl[32], ntiles = total >> 8;
    for (int t = F.tid; t < ntiles; t += 512) { int e = 0;
#pragma unroll
        for (int j = 1; j < 32; ++j) if (tbl[j] <= t * 256) e = j;
        tbl[64 + t] = e | ((tbl[256 + e] - (t * 256 - tbl[e]) <= 128) ? 256 : 0); }
    __syncthreads();
    if (fill_rows) { const int* lists = (const int*)(F.ws + WS_LISTS); const int nunits = ntiles * 4;
        for (int x = F.tid; x < 768; x += 512) { const int ui = x >> 8, r = x & 255, L = ui * F.G + (int)blockIdx.x; int src = 0;
            if (L < nunits) { const int tile = moe_unit_wgid(L, nunits) >> 2, e = tbl[64 + tile] & 255, rank = tile * 256 - tbl[e] + r; if (rank < tbl[256 + e]) src = lists[(size_t)e * MTOK + rank]; }
            tbl[512 + x] = src; }
        __syncthreads(); }
    return ntiles;
}
__device__ __forceinline__ void moe_combine_phase(Frame& F, ArgsP a, int l, int nrows, bool dry = false) {
    float* X = (float*)(F.ws + WS_X); float* Xo = dry ? (float*)(F.ws + WS_Z + 132 * MiB) : X; float* outp = dry ? Xo : a->out; bf16_t* H = (bf16_t*)(F.ws + WS_H); const bf16_t* Y = (const bf16_t*)(F.ws + WS_Z + MZ_XS);
    const int* ri = (const int*)(F.ws + WS_ROUTE); const float* rg = (const float*)(F.ws + WS_ROUTE + (size_t)MTOK * 16);
    const float* modv = (const float*)(F.ws + WS_MODV);
    int total; const int st = moe_starts(F, l, total);
    for (int row = F.gw; row < nrows; row += F.NGW) {
        const int e0 = ri[(size_t)row * 4], e1 = ri[(size_t)row * 4 + 1], r0 = ri[(size_t)row * 4 + 2], r1 = ri[(size_t)row * 4 + 3];
        const int p0 = shfl_i(st, e0) + r0, p1 = shfl_i(st, e1) + r1; const float g0 = rg[(size_t)row * 2], g1 = rg[(size_t)row * 2 + 1];
        const float* mv = modv + ((size_t)l * 9 + tok_modrow(row)) * 6144;
        f32x4 v[4];
#pragma unroll
        for (int j = 0; j < 4; ++j) { const int c = 4 * F.lane + 256 * j;
            const u32x2 y0 = *(const u32x2*)(Y + (size_t)p0 * D + c), y1 = *(const u32x2*)(Y + (size_t)p1 * D + c);
            const f32x4 f = { g0 * bflo(y0.x) + g1 * bflo(y1.x), g0 * bfhi(y0.x) + g1 * bfhi(y1.x), g0 * bflo(y0.y) + g1 * bflo(y1.y), g0 * bfhi(y0.y) + g1 * bfhi(y1.y) };
            v[j] = *(const f32x4*)(X + (size_t)row * D + c) + *(const f32x4*)(mv + 5 * 1024 + c) * f; }
        if (l == 0) {
#pragma unroll
            for (int j = 0; j < 4; ++j) *(f32x4*)(Xo + (size_t)row * D + 4 * F.lane + 256 * j) = v[j];
            f32x4 h[4]; const float* mv1 = modv + ((size_t)9 + tok_modrow(row)) * 6144;
            norm_mod_row(v, h, a->in[6] + D, mv1, mv1 + 1024, F.lane);
            store_row_bf16(H + (size_t)row * D, h, F.lane);
        } else {
            float ss = 0.f;
#pragma unroll
            for (int j = 0; j < 4; ++j) ss += (v[j][0] * v[j][0] + v[j][1] * v[j][1]) + (v[j][2] * v[j][2] + v[j][3] * v[j][3]);
            const float rstd = rsqrtf(wave_sum(ss) * (1.f / D) + EPS);
#pragma unroll
            for (int j = 0; j < 4; ++j) { const int c = 4 * F.lane + 256 * j; *(f32x4*)(outp + (size_t)row * D + c) = v[j] * rstd * *(const f32x4*)(a->in[37] + c); }
        }
    }
}

#define REOPAQUE() { unsigned m1_ = ~0u; asm volatile("" : "+s"(m1_)); int ln_ = __builtin_amdgcn_mbcnt_hi(m1_, __builtin_amdgcn_mbcnt_lo(m1_, 0u)); asm volatile("" : "+v"(ln_)); F.lane = ln_; F.wave = wave_s; F.tid = wave_s * 64 + ln_; F.gw = F.vcu * NWAVES + F.wave; int z_ = 0; asm volatile("" : "+s"(z_)); args = (ArgsP)__builtin_amdgcn_kernarg_segment_ptr() + z_; F.ws = args->ws; }
#define PH_BEGIN if (ph >= lo && ph < hi) { REOPAQUE()
#define PH_END } if (ph >= lo && ph + 1 < hi) { if (!MK_PER_PHASE) REP(15) xcd_barrier_fn(bar.bar, bar.x, (unsigned)(uintptr_t)bar.st, F.tid); } ++ph;

#define pH ((bf16_t*)(F.ws + WS_H))
#define pZ ((bf16_t*)(F.ws + WS_Z))
#define pX ((float*)(F.ws + WS_X))
#define pMix (F.ws + WS_MIX)
#define pSsq ((float*)(F.ws + WS_SSQ))
#define pRope ((const float*)(F.ws + WS_ROPE))
#define pWl (F.ws + WS_WB + (size_t)l * WL_STRIDE)
#define pModv ((const float*)(F.ws + WS_MODV) + (size_t)l * 9 * 6144)


template <int l> __device__ __forceinline__ void layer_prog(Frame& F, ArgsP& args, int& ph, const int lo, const int hi, const XcdBarrier& bar, const int wave_s) {
        const bool need_ctx = (l == 0); const int nrows = need_ctx ? MTOK : NLAT;

        PH_BEGIN REP(1) { pg8::Gemm g{pH, (const bf16_t*)(pWl + WL_WIN), D, D, D};
            Epi<EM_Z> E{}; E.ssq = pSsq; E.rope = pRope; E.o0 = pZ; E.o1 = (bf16_t*)(pMix + MX_KPE); E.o2 = (bf16_t*)(pMix + MX_S5A);
            if constexpr (l == 0) { pg8::StaticOrder S; S.init(MTOK, ZC, F.G, (int)blockIdx.x); pg8::gemm_phase(F.lds, F.tid, g, S, E); }
            else { WinOrderLast S; S.S0.init(NLAT, ZC, F.G, (int)blockIdx.x); S.G = F.G; S.c = (int)blockIdx.x; pg8::gemm_phase(F.lds, F.tid, g, S, E); } } PH_END

        PH_BEGIN {
            REP(2) { pg8::Gemm g{pZ + ZCQ, (const bf16_t*)(pWl + WL_UQ), 256, ZC, 256}; pg8::StaticOrder S; S.init(nrows, 768, F.G, ((int)blockIdx.x + F.G - 32) % F.G);
              Epi<EM_Q> E{}; E.ssq = pSsq; E.rope = pRope; E.o0 = (bf16_t*)(pMix + MX_Q); pg8::gemm_phase(F.lds, F.tid, g, S, E); }
            REOPAQUE()
            REP(2) { pg8::Gemm g{pZ + ZCKV, (const bf16_t*)(pWl + WL_UKV), 128, ZC, 128}; pg8::StaticOrder S; S.init(MTOK, 1024, F.G, (int)blockIdx.x);
              Epi<EM_KV> E{}; E.ssq = pSsq; E.o0 = (bf16_t*)(pMix + MX_KN); E.o1 = (bf16_t*)(pMix + MX_V); pg8::gemm_phase(F.lds, F.tid, g, S, E); }
            REOPAQUE()
#if NAIVE_S5
            s5_naive(F, args, l);
#else
            REP(3) s5_state_phase(F, l);
#endif
            REOPAQUE()
#if NAIVE_HG
            hg_naive(F, args, l);
#else
            REP(4) hg_local_phase(F, args, l);
#endif
        } PH_END

        PH_BEGIN {
#if NAIVE_ATTN
            attn_naive(F, need_ctx);
#else
#if PROBE_PH >= 50 && PROBE_PH < 60
            attn_fast<PROBE_PH - 49>(F, need_ctx, (bf16_t*)args->out); REOPAQUE()
#endif
            attn_fast<0>(F, need_ctx, (bf16_t*)(pMix + MX_YMLA));
#endif
            REOPAQUE()
#if NAIVE_S5
            s5_naive_finish(F, args, l, nrows);
#else
            REP(6) { pg8::Gemm g{(const bf16_t*)(pMix + MX_S5A), (const bf16_t*)(pWl + WL_B2), 512, 512, 512}; S5Order S{F.G, (F.vcu + F.G - 64) % F.G};
              Epi<EM_S5> E{}; E.o0 = (bf16_t*)(pMix + MX_YS5P); E.i0 = (const bf16_t*)(pMix + MX_S5A); E.f0 = args->in[16] + l * 256; pg8::gemm_phase(F.lds, F.tid, g, S, E); }
#endif
            REOPAQUE()
#if NAIVE_HG
            hg_naive_finish(F, args, l, nrows);
#else
            hg_scan_phase(F);
#endif
        } PH_END

        PH_BEGIN {
#if !NAIVE_HG
            REP(7) hg_out_phase(F, args, l, need_ctx);
            REOPAQUE()
#endif
            REP(8) { pg8::Gemm g{(const bf16_t*)(pMix + MX_YS5P), (const bf16_t*)(pWl + WL_GLU), 256, 256, 256}; pg8::StaticOrder S; S.init(nrows, 256, F.G, (F.vcu + F.G - 128) % F.G);
            Epi<EM_GLU> E{}; E.o0 = (bf16_t*)(pMix + MX_YS5); E.i0 = (const bf16_t*)(pMix + MX_YS5P); E.f0 = args->in[18] + l * 256;
            pg8::gemm_phase(F.lds, F.tid, g, S, E); } } PH_END

        PH_BEGIN {
#define MERGE3(S, HS) do { \
            { pg8::Gemm g{(const bf16_t*)(pMix + MX_YS5), (const bf16_t*)(pWl + WL_PA), 256, 256, 256}; Epi<EM_MERGE0> E{}; E.o0 = pH; E.i0 = pZ + ZGA; pg8::gemm_phase<Epi<EM_MERGE0>, decltype(S), false, HS>(F.lds, F.tid, g, S, E); } \
            { pg8::Gemm g{(const bf16_t*)(pMix + MX_YMLA), (const bf16_t*)(pWl + WL_PB), 512, 512, 512}; Epi<EM_MERGE1> E{}; E.o0 = pH; E.i0 = pZ + ZGB; pg8::gemm_phase<Epi<EM_MERGE1>, decltype(S), false, HS>(F.lds, F.tid, g, S, E); } \
            { pg8::Gemm g{(const bf16_t*)(pMix + MX_YHG), (const bf16_t*)(pWl + WL_PC), 256, 256, 256}; Epi<EM_MERGE1> E{}; E.o0 = pH; E.i0 = pZ + ZGC; pg8::gemm_phase<Epi<EM_MERGE1>, decltype(S), false, HS>(F.lds, F.tid, g, S, E); } } while (0)
            if constexpr (l == 0) { HalfTailOrder S; S.S0.init(NLAT, 1024, F.G, (int)blockIdx.x); S.G = F.G; S.c = (int)blockIdx.x; MERGE3(S, true); }
            else { pg8::StaticOrder S; S.init(NLAT, 1024, F.G, (int)blockIdx.x); MERGE3(S, false); }
#undef MERGE3
        } PH_END

        PH_BEGIN { pg8::Gemm g{pH, (const bf16_t*)(pWl + WL_OUT), D, D, D};
            Epi<EM_WOUT> E{}; E.layer = l; E.f0 = pModv; E.f1 = args->in[0]; E.f2 = args->in[2]; E.fo = pX;
            if constexpr (l == 0) { HalfTailOrder S; S.S0.init(NLAT, 1024, F.G, (int)blockIdx.x); S.G = F.G; S.c = (int)blockIdx.x; pg8::gemm_phase<Epi<EM_WOUT>, HalfTailOrder, false, true>(F.lds, F.tid, g, S, E); }
            else { pg8::StaticOrder S; S.init(NLAT, 1024, F.G, (int)blockIdx.x); pg8::gemm_phase(F.lds, F.tid, g, S, E); } } PH_END

        PH_BEGIN { norm2_router_phase(F, args, l, nrows); REOPAQUE() REP(11) moe_convert(F, args, l); } PH_END
        PH_BEGIN REP(13) { const int nt = moe_build_tiles(F, l, true); MoeOrder S{nt * 4, F.G, (int)blockIdx.x, (const LAS int*)(F.lds + TBL_OFF) + 64, (const LAS int*)(F.lds + TBL_OFF) + 512};
            pg8::Gemm g{pH, (const bf16_t*)(pMix + MW_W13), D, D, D};
            Epi<EM_MOEUP> E{}; E.o0 = (bf16_t*)(F.ws + WS_Z + MZ_HID); pg8::gemm_phase<Epi<EM_MOEUP>, MoeOrder, true, true>(F.lds, F.tid, g, S, E); } PH_END
        PH_BEGIN REP(14) { const int nt = moe_build_tiles(F, l, false); MoeOrder S{nt * 4, F.G, (int)blockIdx.x, (const LAS int*)(F.lds + TBL_OFF) + 64, (const LAS int*)(F.lds + TBL_OFF) + 512};
            pg8::Gemm g{(const bf16_t*)(F.ws + WS_Z + MZ_HID), (const bf16_t*)(pMix + MW_W2), HID, HID, HID};
            Epi<EM_MOEDN> E{}; E.o0 = (bf16_t*)(F.ws + WS_Z + MZ_XS); pg8::gemm_phase<Epi<EM_MOEDN>, MoeOrder, false, true>(F.lds, F.tid, g, S, E); } PH_END
        PH_BEGIN { if (PROBE_PH == 19) { moe_combine_phase(F, args, l, nrows, true); REOPAQUE() } moe_combine_phase(F, args, l, nrows); } PH_END
    }

__global__ void __launch_bounds__(NWAVES * 64, 2) mega_fwd(Args args_by_value) {
    ArgsP args = (ArgsP)__builtin_amdgcn_kernarg_segment_ptr();
    extern __shared__ __attribute__((aligned(16))) unsigned char lds_raw[];
    Frame F;
    F.lds = (LAS unsigned char*)lds_raw;
    F.tid = threadIdx.x; F.lane = F.tid & 63; F.wave = __builtin_amdgcn_readfirstlane(F.tid >> 6);
    const int wave_s = F.wave;
    F.G = gridDim.x; { const int bx = blockIdx.x; F.vcu = (F.G % 8 == 0) ? (bx % 8) * (F.G / 8) + bx / 8 : bx; }
    F.gw = F.vcu * NWAVES + F.wave; F.NGW = F.G * NWAVES; F.ws = args->ws;
    volatile LAS unsigned* MISC = (volatile LAS unsigned*)(F.lds + MISC_OFF);
    for (int u = F.tid; u < (LDS_BYTES - RING_BYTES) / 4; u += NWAVES * 64) ((LAS unsigned*)(F.lds + RING_BYTES))[u] = 0u;
    __syncthreads();
    unsigned* ctl = (unsigned*)(F.ws + WS_CTL);
    XcdBarrier bar; bar.bar = ctl + CW_BAR; bar.x = 0; bar.st = nullptr;
    if (!MK_PER_PHASE) bar = xcd_barrier_post(ctl + CW_BAR, MISC + 8);
    const int lo = args->ph_lo, hi = args->ph_hi;
    int ph = 0;
    PH_BEGIN REP(17) prologue_phase(F, args); PH_END
    PH_BEGIN REP(16) norm1_phase(F, args, 0, MTOK); PH_END

    layer_prog<0>(F, args, ph, lo, hi, bar, wave_s);
    layer_prog<1>(F, args, ph, lo, hi, bar, wave_s);
#undef PH_BEGIN
#undef REOPAQUE
#undef PH_END
#undef pH
#undef pZ
#undef pX
#undef pMix
#undef pSsq
#undef pRope
#undef pWl
#undef pModv
}
constexpr int N_PHASES = 2 + 2 * 10;

extern "C" void kernel_launch(void* const* d_in, const int* in_sizes, int n_in, void* d_out, int out_size, void* d_ws, size_t ws_size, hipStream_t stream) {
    static int grid = 0;
    if (grid == 0) {
        if (n_in != 38 || out_size != NLAT * D || ws_size < WS_END) { fprintf(stderr, "kernel_launch: unexpected shapes (n_in %d out %d ws %zu need %zu)\n", n_in, out_size, ws_size, (size_t)WS_END); grid = -1; return; }
        int dev = 0, cus = 0, per_cu = 0;
        if (hipGetDevice(&dev) != hipSuccess || hipDeviceGetAttribute(&cus, hipDeviceAttributeMultiprocessorCount, dev) != hipSuccess) { grid = -1; return; }
        if (hipFuncSetAttribute((const void*)mega_fwd, hipFuncAttributeMaxDynamicSharedMemorySize, LDS_BYTES) != hipSuccess) { fprintf(stderr, "kernel_launch: hipFuncSetAttribute failed\n"); grid = -1; return; }
        if (hipOccupancyMaxActiveBlocksPerMultiprocessor(&per_cu, (const void*)mega_fwd, NWAVES * 64, LDS_BYTES) != hipSuccess || per_cu < 1) { fprintf(stderr, "kernel_launch: occupancy query says %d\n", per_cu); }
        (void)hipGetLastError();
        grid = cus;
    }
    if (grid < 0) return;
    (void)hipMemsetAsync((char*)d_ws + WS_CTL, 0, CTL_ZERO_BYTES, stream);
    Args a{};
    for (int i = 0; i < 38; ++i) a.in[i] = (const float*)d_in[i];
    a.out = (float*)d_out; a.ws = (unsigned char*)d_ws;
#if MK_PER_PHASE
    for (int p = 0; p < N_PHASES; ++p) { a.ph_lo = p; a.ph_hi = p + 1; hipLaunchKernelGGL(mega_fwd, dim3(grid), dim3(NWAVES * 64), LDS_BYTES, stream, a); }
#else
    a.ph_lo = 0; a.ph_hi = N_PHASES;
    hipLaunchKernelGGL(mega_fwd, dim3(grid), dim3(NWAVES * 64), LDS_BYTES, stream, a);
#endif
}
```

```cpp
#include <hip/hip_runtime.h>
#include <cstdio>
#include <cstdint>

#ifndef NAIVE_ATTN
#define NAIVE_ATTN 0
#endif
#ifndef NAIVE_S5
#define NAIVE_S5 0
#endif
#ifndef NAIVE_HG
#define NAIVE_HG 0
#endif
#ifndef PROBE_PH
#define PROBE_PH 0
#endif
#ifndef PROBE_N
#define PROBE_N 1
#endif
#define REP(id) for (int rep_ = 0; rep_ < ((PROBE_PH == (id)) ? PROBE_N : 1); ++rep_)
#ifndef MK_PER_PHASE
#define MK_PER_PHASE 0
#endif

#define GAS __attribute__((address_space(1)))
#define LAS __attribute__((address_space(3)))
typedef unsigned short bf16_t;
typedef short bf16x8 __attribute__((ext_vector_type(8)));
typedef float f32x4 __attribute__((ext_vector_type(4)));
typedef float f32x2 __attribute__((ext_vector_type(2)));
typedef float f32x16 __attribute__((ext_vector_type(16)));
typedef unsigned u32x4 __attribute__((ext_vector_type(4)));
typedef unsigned u32x2 __attribute__((ext_vector_type(2)));
typedef GAS unsigned gu32;

constexpr int D = 1024, NB = 8, SEQ = 2048, CTXL = 256, NLAT = NB * SEQ, NCTX = NB * CTXL, MTOK = NLAT + NCTX;
constexpr int ZC = 5888, INC = 5792;
constexpr int ZU = 0, ZCQ = 256, ZCKV = 512, ZKPE = 640, ZHQ = 672, ZF0 = 1184, ZF1 = 1696, ZI = 2208, ZG = 2464, ZGA = 2720, ZGB = 3744, ZGC = 4768;
constexpr float EPS = 1e-6f;
constexpr float QSCALE = 0.10206207261596577f * 1.4426950408889634f;
constexpr int NEXP = 32, HID = 512;
constexpr int XS_ROWS = 45056;

constexpr size_t MiB = 1u << 20;
constexpr size_t WS_CTL = 0, CTL_ZERO_BYTES = 96 * 1024;
constexpr size_t WS_MODV = 1 * MiB;
constexpr size_t WS_ROPE = 2 * MiB;
constexpr size_t WS_SSQ = 2 * MiB + 65536;
constexpr size_t WS_ROUTE = 3 * MiB;
constexpr size_t WS_S5P = 4 * MiB;
constexpr size_t WS_LISTS = 5 * MiB;
constexpr size_t WS_WB = 8 * MiB;
constexpr size_t WL_WIN = 0, WL_UQ = WL_WIN + (size_t)ZC * D * 2, WL_UKV = WL_UQ + 768 * 256 * 2, WL_GLU = WL_UKV + 1024 * 128 * 2,
                 WL_PA = WL_GLU + 256 * 256 * 2, WL_PB = WL_PA + 1024 * 256 * 2, WL_PC = WL_PB + 1024 * 512 * 2, WL_OUT = WL_PC + 1024 * 256 * 2,
                 WL_BS = WL_OUT + 1024 * 1024 * 2, WL_B2 = WL_BS + 32 * 128 * 256 * 2, WL_END = WL_B2 + 16 * 256 * 512 * 2;
constexpr size_t WL_STRIDE = 24 * MiB;
static_assert(WL_END <= WL_STRIDE, "weights per layer");
constexpr size_t WS_X = 56 * MiB;
constexpr size_t WS_H = 128 * MiB;
constexpr size_t WS_MIX = 164 * MiB;
constexpr size_t MX_Q = 0, MX_KN = MX_Q + (size_t)MTOK * 768 * 2, MX_V = MX_KN + (size_t)MTOK * 512 * 2, MX_KPE = MX_V + (size_t)MTOK * 512 * 2,
                 MX_YS5P = MX_KPE + (size_t)MTOK * 32 * 2, MX_YS5 = MX_YS5P + (size_t)MTOK * 256 * 2, MX_YHG = MX_YS5 + (size_t)MTOK * 256 * 2,
                 MX_YMLA = MX_YHG + (size_t)MTOK * 256 * 2, MX_S5A = MX_YMLA + (size_t)MTOK * 512 * 2, MX_HGD = MX_S5A + (size_t)16 * 1280 * 512 * 2,
                 MX_END = MX_HGD + (size_t)2304 * 128 * 4;
static_assert(MX_END <= 132 * MiB, "mixer region");
constexpr size_t MW_W13 = 0, MW_W2 = (size_t)NEXP * 1024 * 1024 * 2;
static_assert(MW_W2 + (size_t)NEXP * 1024 * 512 * 2 <= 132 * MiB, "moe weights");
constexpr size_t WS_Z = 296 * MiB;
constexpr size_t MZ_XS = 0, MZ_HID = (size_t)XS_ROWS * 1024 * 2;
constexpr size_t WS_END = WS_Z + (size_t)MTOK * ZC * 2;
static_assert(MZ_HID + (size_t)XS_ROWS * 512 * 2 <= (size_t)MTOK * ZC * 2, "moe buffers");
constexpr int CW_BAR = 4096;
constexpr int CW_CNT = 16384;

__device__ __forceinline__ unsigned f2bf(float f) { unsigned u = __builtin_bit_cast(unsigned, f); return (u + 0x7fffu + ((u >> 16) & 1u)) >> 16; }
typedef __bf16 bf16x2_t __attribute__((ext_vector_type(2)));
__device__ __forceinline__ unsigned pk2(float lo, float hi) { const f32x2 v = {lo, hi}; return __builtin_bit_cast(unsigned, __builtin_convertvector(v, bf16x2_t)); }
__device__ __forceinline__ float bf2f(unsigned short b) { return __builtin_bit_cast(float, (unsigned)b << 16); }
__device__ __forceinline__ float bflo(unsigned w) { return __builtin_bit_cast(float, w << 16); }
__device__ __forceinline__ float bfhi(unsigned w) { return __builtin_bit_cast(float, w & 0xffff0000u); }
template <int CTRL> __device__ __forceinline__ float dppf(float v) { return __builtin_bit_cast(float, __builtin_amdgcn_update_dpp(0, __builtin_bit_cast(int, v), CTRL, 0xf, 0xf, true)); }
__device__ __forceinline__ float rlanef(float v, int l) { return __builtin_bit_cast(float, __builtin_amdgcn_readlane(__builtin_bit_cast(int, v), l)); }
__device__ __forceinline__ float wave_sum(float v) {
    v += dppf<0xB1>(v); v += dppf<0x4E>(v); v += dppf<0x141>(v); v += dppf<0x140>(v);
    return (rlanef(v, 0) + rlanef(v, 16)) + (rlanef(v, 32) + rlanef(v, 48));
}
__device__ __forceinline__ int shfl_i(int v, int src_lane) { return __builtin_amdgcn_ds_bpermute(src_lane << 2, v); }
__device__ __forceinline__ float shfl_f(float v, int src_lane) { return __builtin_bit_cast(float, __builtin_amdgcn_ds_bpermute(src_lane << 2, __builtin_bit_cast(int, v))); }
__device__ __forceinline__ float sigmoidf_(float x) { return __builtin_amdgcn_rcpf(1.f + __expf(-x)); }
__device__ __forceinline__ float siluf_(float x) { return x * __builtin_amdgcn_rcpf(1.f + __expf(-x)); }
__device__ __forceinline__ float gelu_tanh(float x) { const float t = 0.7978845608028654f * (x + 0.044715f * x * x * x); return x * __builtin_amdgcn_rcpf(1.f + __expf(-2.f * t)); }
__device__ __forceinline__ int tok_modrow(int row) { return row < NLAT ? (row >> 11) : 8; }

namespace pg8 {
constexpr int BM = 256, BK = 64, HALF = 128, HTB = HALF * BK * 2, STAGE_BYTES = 8 * HTB, NXCD = 8, WGM = 8;
__host__ __device__ __forceinline__ int lds_byte(int r, int c) { const int st = (r >> 4) * 2 + (c >> 5), rr = r & 15, cc = c & 31, ob = rr * 64 + cc * 2; return st * 1024 + (ob ^ (((ob >> 9) & 1) << 5)); }
__host__ __device__ __forceinline__ void stage_rc(int b, int& R, int& C) { const int st = b / 1024, sb = b % 1024, swz = sb ^ (((sb >> 9) & 1) << 5); R = (st >> 1) * 16 + swz / 64; C = (st & 1) * 32 + (swz % 64) / 2; }
__host__ __device__ __forceinline__ int perm32(int rho) { const int n = rho >> 4, i = rho & 15; return 8 * (i >> 2) + 4 * n + (i & 3); }
struct Unit { int pm, pn, h; };
struct Gemm { const bf16_t* A; const bf16_t* Bt; int K, lda, ldb; };
struct StaticOrder {
    int nM, nN, nwg, G, c;
    __device__ void init(int M, int N, int G_, int c_) { nM = M / BM; nN = N / BM; nwg = nM * nN; G = G_; c = c_; }
    __device__ bool next(int i, Unit& u) const {
        const long L = (long)i * G + c; if (L >= nwg) return false;
        int wgid = (int)L; { const int q = nwg / NXCD, r = nwg % NXCD, xcd = wgid % NXCD, off = wgid / NXCD; wgid = (xcd < r ? xcd * (q + 1) : r * (q + 1) + (xcd - r) * q) + off; }
        const int nig = WGM * nN, gid = wgid / nig, fm = gid * WGM, gsz = (nM - fm) < WGM ? (nM - fm) : WGM;
        u.pm = fm + ((wgid % nig) % gsz); u.pn = (wgid % nig) / gsz; u.h = -1; return true;
    }
};
template <class Epi, class Sched, bool GATHER = false, bool HALFS = false>
__device__ __forceinline__ void gemm_phase(LAS unsigned char* lds, int tid_in, const Gemm g, const Sched& S, const Epi& E) {
    int tid_ = tid_in; asm volatile("" : "+v"(tid_));
    const int tid = tid_, wid = __builtin_amdgcn_readfirstlane(tid >> 6), lane = tid & 63, wr = wid >> 2, wc = wid & 3, fr = lane & 15, fq = lane >> 4;
    const int K = g.K, nt = K / BK;
    unsigned voffB[2], vAc[2][2], vAx[2][2];
#pragma unroll
    for (int i = 0; i < 2; ++i) { int R, C; stage_rc(tid * 16 + i * 8192, R, C); const int Rb = (R & ~31) + perm32(R & 31);
        voffB[i] = (unsigned)(Rb * g.ldb + C) * 2u;
#pragma unroll
        for (int h = 0; h < 2; ++h) vAc[h][i] = vAx[h][i] = (unsigned)((R + 128 * h) * g.lda + C) * 2u; }
#define PG8_GROWS(dst, uidx) do { if constexpr (GATHER) { _Pragma("unroll") for (int i_ = 0; i_ < 2; ++i_) { int R_, C_; stage_rc(tid * 16 + i_ * 8192, R_, C_); \
        _Pragma("unroll") for (int h_ = 0; h_ < 2; ++h_) dst[h_][i_] = (unsigned)(S.a_row((uidx), R_ + 128 * h_) * g.lda + C_) * 2u; } } } while (0)
    const size_t kstep = (size_t)(BK * 2);
    const size_t hstepA = (size_t)HALF * g.lda * 2, hstepB = (size_t)HALF * g.ldb * 2;
    const size_t tstepA = 2 * hstepA, tstepB = 2 * hstepB;
    const unsigned ldsw = (unsigned)wid * 1024u;
    const int aoff = lds_byte(wr * 64 + fr, fq * 8), boff = lds_byte(wc * 32 + fr, fq * 8);
#define PG8_SA(b, h) (((b) * 2 + (h)) * HTB)
#define PG8_SB(b, h) ((4 + (b) * 2 + (h)) * HTB)
#define PG8_STAGE(bufoff, gbase, voff) do { _Pragma("unroll") for (int _i = 0; _i < 2; ++_i) \
        __builtin_amdgcn_global_load_lds((const unsigned*)((const char*)(gbase) + (voff)[_i]), (LAS unsigned*)(lds + (bufoff) + ldsw + _i * 8192), 16, 0, 0); } while (0)
#define PG8_LDA(dst, b, h) do { _Pragma("unroll") for (int m = 0; m < 4; ++m) _Pragma("unroll") for (int k = 0; k < 2; ++k) dst[m][k] = *(const LAS bf16x8*)(lds + PG8_SA(b, h) + aoff + m * 2048 + k * 1024); } while (0)
#define PG8_LDB(dst, b, h) do { _Pragma("unroll") for (int n = 0; n < 2; ++n) _Pragma("unroll") for (int k = 0; k < 2; ++k) dst[n][k] = *(const LAS bf16x8*)(lds + PG8_SB(b, h) + boff + n * 2048 + k * 1024); } while (0)
#define PG8_MMA(ai, bj, At, Bt) do { __builtin_amdgcn_s_setprio(1); _Pragma("unroll") for (int m = 0; m < 4; ++m) _Pragma("unroll") for (int n = 0; n < 2; ++n) _Pragma("unroll") for (int k = 0; k < 2; ++k) \
        acc[ai][bj][m][n] = __builtin_amdgcn_mfma_f32_16x16x32_bf16(Bt[n][k], At[m][k], acc[ai][bj][m][n], 0, 0, 0); __builtin_amdgcn_s_setprio(0); } while (0)
#define PG8_WAIT_V(n) asm volatile("s_waitcnt vmcnt(" #n ")" ::: "memory")
#define PG8_WAIT_L(n) asm volatile("s_waitcnt lgkmcnt(" #n ")" ::: "memory")
#define PG8_BAR __builtin_amdgcn_s_barrier()
#define PG8_SCHED __builtin_amdgcn_sched_barrier(0)
    Unit cur, nxt; int ui = 0;
    if (!S.next(0, cur)) return;
    f32x4 acc[2][2][4][2];
#pragma unroll
    for (int a = 0; a < 2; ++a)
#pragma unroll
        for (int b = 0; b < 2; ++b)
#pragma unroll
            for (int m = 0; m < 4; ++m)
#pragma unroll
                for (int n = 0; n < 2; ++n) acc[a][b][m][n] = (f32x4){0.f, 0.f, 0.f, 0.f};
    bf16x8 At[4][2], B0[2][2], B1[2][2];
    const char* cA = (const char*)g.A + (GATHER ? (size_t)0 : (size_t)cur.pm * tstepA); const char* cB = (const char*)g.Bt + (size_t)cur.pn * tstepB;
    PG8_GROWS(vAc, 0);
    PG8_STAGE(PG8_SB(0, 0), cB, voffB); PG8_STAGE(PG8_SB(0, 1), cB + hstepB, voffB); PG8_STAGE(PG8_SA(0, 0), cA, vAc[0]); PG8_STAGE(PG8_SA(0, 1), cA, vAc[1]);
    if (wr == 1) PG8_BAR;
    PG8_WAIT_V(2); PG8_BAR;
    PG8_STAGE(PG8_SB(1, 0), cB + kstep, voffB); PG8_STAGE(PG8_SA(1, 0), cA + kstep, vAc[0]); PG8_STAGE(PG8_SB(1, 1), cB + hstepB + kstep, voffB);
    PG8_WAIT_V(6); PG8_BAR;
    for (;;) {
        const bool has_next = S.next(ui + 1, nxt);
        const char* nA = (has_next && !GATHER) ? (const char*)g.A + (size_t)nxt.pm * tstepA : cA;
        if constexpr (GATHER) { if (has_next) PG8_GROWS(vAx, ui + 1); else {
#pragma unroll
            for (int h = 0; h < 2; ++h) { vAx[h][0] = vAc[h][0]; vAx[h][1] = vAc[h][1]; } } }
        const char* nB = has_next ? (const char*)g.Bt + (size_t)nxt.pn * tstepB : cB;
        asm volatile(".p2align 8" ::: "memory");
        for (int t = 0; t < nt; t += 2) {
            const bool last = (t == nt - 2);
            const char* a1 = cA + (size_t)(t + 1) * kstep;
            const char* a2 = last ? nA : cA + (size_t)(t + 2) * kstep; const char* b2 = last ? nB : cB + (size_t)(t + 2) * kstep;
            const char* a3 = a2 + kstep; const char* b3 = b2 + kstep;
            unsigned vS0[2], vS1[2];
            if constexpr (GATHER) { vS0[0] = last ? vAx[0][0] : vAc[0][0]; vS0[1] = last ? vAx[0][1] : vAc[0][1]; vS1[0] = last ? vAx[1][0] : vAc[1][0]; vS1[1] = last ? vAx[1][1] : vAc[1][1]; }
            else { vS0[0] = vAc[0][0]; vS0[1] = vAc[0][1]; vS1[0] = vAc[1][0]; vS1[1] = vAc[1][1]; }
            PG8_LDB(B0, 0, 0); PG8_LDB(B1, 0, 1); PG8_SCHED; PG8_LDA(At, 0, 0); PG8_STAGE(PG8_SA(1, 1), a1, vAc[1]);
            PG8_WAIT_V(8); PG8_WAIT_L(0); PG8_BAR; if (!HALFS || cur.h != 1) { PG8_MMA(0, 0, At, B0); PG8_MMA(0, 1, At, B1); } PG8_BAR; PG8_SCHED;
            PG8_LDA(At, 0, 1); PG8_STAGE(PG8_SB(0, 0), b2, voffB); PG8_STAGE(PG8_SB(0, 1), b2 + hstepB, voffB); PG8_STAGE(PG8_SA(0, 0), a2, vS0);
            PG8_WAIT_V(8); PG8_WAIT_L(0); PG8_BAR; if (!HALFS || cur.h != 0) { PG8_MMA(1, 0, At, B0); PG8_MMA(1, 1, At, B1); } PG8_BAR; PG8_SCHED;
            PG8_LDB(B0, 1, 0); PG8_LDB(B1, 1, 1); PG8_SCHED; PG8_LDA(At, 1, 0); PG8_STAGE(PG8_SA(0, 1), a2, vS1);
            PG8_WAIT_V(8); PG8_WAIT_L(0); PG8_BAR; if (!HALFS || cur.h != 1) { PG8_MMA(0, 0, At, B0); PG8_MMA(0, 1, At, B1); } PG8_BAR; PG8_SCHED;
            PG8_LDA(At, 1, 1); PG8_STAGE(PG8_SB(1, 0), b3, voffB); PG8_STAGE(PG8_SB(1, 1), b3 + hstepB, voffB); PG8_STAGE(PG8_SA(1, 0), a3, vS0);
            PG8_WAIT_V(8); PG8_WAIT_L(0); PG8_BAR; if (!HALFS || cur.h != 0) { PG8_MMA(1, 0, At, B0); PG8_MMA(1, 1, At, B1); } PG8_BAR; PG8_SCHED;
        }
        if (wr == 0) PG8_BAR;
        E(acc, cur, wr, wc, fr, fq);
        if (!has_next) break;
#pragma unroll
        for (int a = 0; a < 2; ++a)
#pragma unroll
            for (int b = 0; b < 2; ++b)
#pragma unroll
                for (int m = 0; m < 4; ++m)
#pragma unroll
                    for (int n = 0; n < 2; ++n) acc[a][b][m][n] = (f32x4){0.f, 0.f, 0.f, 0.f};
        cur = nxt; cA = nA; cB = nB; ++ui;
        if constexpr (GATHER) {
#pragma unroll
            for (int h = 0; h < 2; ++h) { vAc[h][0] = vAx[h][0]; vAc[h][1] = vAx[h][1]; } }
        if (wr == 1) PG8_BAR;
    }
    PG8_WAIT_V(0);
    PG8_BAR;
#undef PG8_SA
#undef PG8_SB
#undef PG8_STAGE
#undef PG8_GROWS
#undef PG8_LDA
#undef PG8_LDB
#undef PG8_MMA
#undef PG8_WAIT_V
#undef PG8_WAIT_L
#undef PG8_BAR
#undef PG8_SCHED
}
}

enum EpiMode { EM_Z = 0, EM_Q = 1, EM_KV = 2, EM_GLU = 3, EM_MERGE0 = 4, EM_MERGE1 = 5, EM_WOUT = 6, EM_MOEUP = 7, EM_MOEDN = 8, EM_S5 = 9 };
template <int mode> struct Epi {
    bf16_t* o0; bf16_t* o1; bf16_t* o2;
    const bf16_t* i0;
    const float* f0; const float* f1; const float* f2;
    float* fo;
    float* ssq;
    const float* rope;
    int layer;
    struct Side { u32x4 s[4]; };
    __device__ __forceinline__ Side load_side(const pg8::Unit& u, int ai, int m, int wr, int fr, int cl) const {
        Side S; const int row = u.pm * 256 + ai * 128 + wr * 64 + m * 16 + fr;
        if constexpr (mode == EM_Q) S.s[0] = *(const u32x4*)(ssq + (size_t)row * 4);
        else if constexpr (mode == EM_KV) S.s[0] = *(const u32x4*)(ssq + (size_t)MTOK * 4 + (size_t)row * 4);
        else if constexpr (mode == EM_GLU) { S.s[0] = *(const u32x4*)(i0 + (size_t)row * 256 + cl); S.s[1] = *(const u32x4*)(i0 + (size_t)row * 256 + 128 + cl); }
        else if constexpr (mode == EM_MERGE0 || mode == EM_MERGE1) { const int col = u.pn * 256 + cl;
            S.s[0] = *(const u32x4*)(i0 + (size_t)row * ZC + col); S.s[1] = *(const u32x4*)(i0 + (size_t)row * ZC + col + 128);
            if constexpr (mode == EM_MERGE1) { S.s[2] = __builtin_nontemporal_load((const u32x4*)(o0 + (size_t)row * 1024 + col)); S.s[3] = __builtin_nontemporal_load((const u32x4*)(o0 + (size_t)row * 1024 + col + 128)); } }
        else if constexpr (mode == EM_WOUT) { const float* xin = (layer == 0) ? (row < NLAT ? f1 + (size_t)row * D : f2 + (size_t)(row - NLAT) * D) : fo + (size_t)row * D; const int col = u.pn * 256 + cl;
            S.s[0] = *(const u32x4*)(xin + col); S.s[1] = *(const u32x4*)(xin + col + 4); S.s[2] = *(const u32x4*)(xin + col + 128); S.s[3] = *(const u32x4*)(xin + col + 132); }
        else if constexpr (mode == EM_S5) { S.s[0] = *(const u32x4*)(i0 + (size_t)row * 512 + cl); S.s[1] = *(const u32x4*)(i0 + (size_t)row * 512 + 128 + cl); }
        return S;
    }
    __device__ __forceinline__ void operator()(const f32x4 (&acc)[2][2][4][2], const pg8::Unit& u, int wr, int wc, int fr_in, int fq_in) const {
        int fr = fr_in, fq = fq_in; asm volatile("" : "+v"(fr), "+v"(fq));
        const int cl = wc * 32 + 8 * fq;
        f32x4 hc[4] = {};
        if constexpr (mode == EM_GLU) { hc[0] = *(const f32x4*)(f0 + cl); hc[1] = *(const f32x4*)(f0 + cl + 4); hc[2] = *(const f32x4*)(f0 + 128 + cl); hc[3] = *(const f32x4*)(f0 + 128 + cl + 4); }
        if constexpr (mode == EM_WOUT) { const float* gt = f0 + (size_t)tok_modrow(u.pm * 256) * 6144 + 2 * 1024 + u.pn * 256 + cl;
            hc[0] = *(const f32x4*)(gt); hc[1] = *(const f32x4*)(gt + 4); hc[2] = *(const f32x4*)(gt + 128); hc[3] = *(const f32x4*)(gt + 132); }
        if constexpr (mode == EM_S5) { const float* dk = f0 + u.pn * 16 + (cl & 15); hc[0] = *(const f32x4*)(dk); hc[1] = *(const f32x4*)(dk + 4); }
        Side cur = load_side(u, 0, 0, wr, fr, cl);
#pragma unroll
        for (int it = 0; it < 8; ++it) {
                const int ai = it >> 2, m = it & 3;
                if (u.h >= 0 && ai != u.h) { if (it < 7) cur = load_side(u, (it + 1) >> 2, (it + 1) & 3, wr, fr, cl); continue; }
                Side nxt = cur; if (it < 7) nxt = load_side(u, (it + 1) >> 2, (it + 1) & 3, wr, fr, cl);
                asm volatile("" ::: "memory");
                const int row = u.pm * 256 + ai * 128 + wr * 64 + m * 16 + fr;
                if constexpr (mode == EM_Z) {
                    float s0 = 0.f;
#pragma unroll
                    for (int bj = 0; bj < 2; ++bj) {
                        f32x4 v0 = acc[ai][bj][m][0], v1 = acc[ai][bj][m][1];
                        const int col = u.pn * 256 + bj * 128 + cl;
                        if (u.pn == 1 || (u.pn == 2 && bj == 0)) s0 += (v0[0] * v0[0] + v0[1] * v0[1]) + (v0[2] * v0[2] + v0[3] * v0[3]) + (v1[0] * v1[0] + v1[1] * v1[1]) + (v1[2] * v1[2] + v1[3] * v1[3]);
                        if (u.pn == 2 && bj == 1 && wc == 0) {
                            if (row < NLAT) {
                                const int t = row & 2047, pb = 4 * fq, axis = pb >> 3, pos = axis ? (t & 63) : (t >> 6);
                                const float* cs = rope + pos * 8 + (pb & 7); const float* sn = cs + 512;
                                float x1, x2;
                                x1 = v0[0]; x2 = v0[1]; v0[0] = x1 * cs[0] - x2 * sn[0]; v0[1] = x1 * sn[0] + x2 * cs[0];
                                x1 = v0[2]; x2 = v0[3]; v0[2] = x1 * cs[1] - x2 * sn[1]; v0[3] = x1 * sn[1] + x2 * cs[1];
                                x1 = v1[0]; x2 = v1[1]; v1[0] = x1 * cs[2] - x2 * sn[2]; v1[1] = x1 * sn[2] + x2 * cs[2];
                                x1 = v1[2]; x2 = v1[3]; v1[2] = x1 * cs[3] - x2 * sn[3]; v1[3] = x1 * sn[3] + x2 * cs[3];
                            }
                            u32x4 w; w.x = pk2(v0[0], v0[1]); w.y = pk2(v0[2], v0[3]); w.z = pk2(v1[0], v1[1]); w.w = pk2(v1[2], v1[3]);
                            *(u32x4*)(o1 + (size_t)row * 32 + 8 * fq) = w;
                        }
                        u32x4 w; w.x = pk2(v0[0], v0[1]); w.y = pk2(v0[2], v0[3]); w.z = pk2(v1[0], v1[1]); w.w = pk2(v1[2], v1[3]);
                        *(u32x4*)(o0 + (size_t)row * ZC + col) = w;
                        if (u.pn == 0) {
                            int b, s; if (row < NLAT) { b = row >> 11; s = 256 + (row & 2047); } else { b = (row - NLAT) >> 8; s = (row - NLAT) & 255; }
                            const int colu = bj * 128 + cl, g = colu >> 4, h0 = colu & 15;
                            *(u32x4*)(o2 + ((size_t)g * 1280 + b * 160 + (s >> 4)) * 512 + (s & 15) * 16 + h0) = w;
                        }
                    }
                    if (u.pn == 1 || u.pn == 2) {
                        { const int ln = fr + 16 * fq; s0 += shfl_f(s0, ln ^ 16); s0 += shfl_f(s0, ln ^ 32); }
                        if (fq == 0) ssq[(size_t)(u.pn - 1) * MTOK * 4 + (size_t)row * 4 + wc] = s0;
                    }
                } else if constexpr (mode == EM_Q || mode == EM_KV) {
                    const f32x4 sp = __builtin_bit_cast(f32x4, cur.s[0]);
                    const float rs = mode == EM_Q ? rsqrtf(((sp[0] + sp[1]) + (sp[2] + sp[3])) * (1.f / 256.f) + EPS) * QSCALE : rsqrtf(((sp[0] + sp[1]) + (sp[2] + sp[3])) * (1.f / 128.f) + EPS);
#pragma unroll
                    for (int bj = 0; bj < 2; ++bj) {
                        f32x4 v0 = acc[ai][bj][m][0] * rs, v1 = acc[ai][bj][m][1] * rs;
                        const int col = u.pn * 256 + bj * 128 + cl;
                        if constexpr (mode == EM_Q) { const int cc = col % 96;
                            if (cc >= 64 && row < NLAT) {
                                const int t = row & 2047, pb = (cc - 64) >> 1, axis = pb >> 3, pos = axis ? (t & 63) : (t >> 6);
                                const float* cs = rope + pos * 8 + (pb & 7); const float* sn = cs + 512;
                                float x1, x2;
                                x1 = v0[0]; x2 = v0[1]; v0[0] = x1 * cs[0] - x2 * sn[0]; v0[1] = x1 * sn[0] + x2 * cs[0];
                                x1 = v0[2]; x2 = v0[3]; v0[2] = x1 * cs[1] - x2 * sn[1]; v0[3] = x1 * sn[1] + x2 * cs[1];
                                x1 = v1[0]; x2 = v1[1]; v1[0] = x1 * cs[2] - x2 * sn[2]; v1[1] = x1 * sn[2] + x2 * cs[2];
                                x1 = v1[2]; x2 = v1[3]; v1[2] = x1 * cs[3] - x2 * sn[3]; v1[3] = x1 * sn[3] + x2 * cs[3];
                            } }
                        u32x4 w; w.x = pk2(v0[0], v0[1]); w.y = pk2(v0[2], v0[3]); w.z = pk2(v1[0], v1[1]); w.w = pk2(v1[2], v1[3]);
                        if constexpr (mode == EM_Q) *(u32x4*)(o0 + (size_t)row * 768 + col) = w;
                        else { bf16_t* dst = col < 512 ? o0 + (size_t)row * 512 + col : o1 + (size_t)row * 512 + (col - 512); *(u32x4*)dst = w; }
                    }
                } else if constexpr (mode == EM_GLU) {
#pragma unroll
                    for (int bj = 0; bj < 2; ++bj) {
                        const int col = bj * 128 + cl;
                        const f32x4 a0 = acc[ai][bj][m][0] + hc[2 * bj], a1 = acc[ai][bj][m][1] + hc[2 * bj + 1];
                        const u32x4 y = cur.s[bj];
                        u32x4 w;
                        w.x = pk2(bflo(y.x) * sigmoidf_(a0[0]), bfhi(y.x) * sigmoidf_(a0[1])); w.y = pk2(bflo(y.y) * sigmoidf_(a0[2]), bfhi(y.y) * sigmoidf_(a0[3]));
                        w.z = pk2(bflo(y.z) * sigmoidf_(a1[0]), bfhi(y.z) * sigmoidf_(a1[1])); w.w = pk2(bflo(y.w) * sigmoidf_(a1[2]), bfhi(y.w) * sigmoidf_(a1[3]));
                        *(u32x4*)(o0 + (size_t)row * 256 + col) = w;
                    }
                } else if constexpr (mode == EM_MERGE0 || mode == EM_MERGE1) {
#pragma unroll
                    for (int bj = 0; bj < 2; ++bj) {
                        const int col = u.pn * 256 + bj * 128 + cl;
                        const u32x4 gt = cur.s[bj];
                        const f32x4 a0 = acc[ai][bj][m][0], a1 = acc[ai][bj][m][1];
                        float r[8] = { a0[0] * sigmoidf_(bflo(gt.x)), a0[1] * sigmoidf_(bfhi(gt.x)), a0[2] * sigmoidf_(bflo(gt.y)), a0[3] * sigmoidf_(bfhi(gt.y)),
                                       a1[0] * sigmoidf_(bflo(gt.z)), a1[1] * sigmoidf_(bfhi(gt.z)), a1[2] * sigmoidf_(bflo(gt.w)), a1[3] * sigmoidf_(bfhi(gt.w)) };
                        if constexpr (mode == EM_MERGE1) { const u32x4 pv = cur.s[2 + bj];
                            r[0] += bflo(pv.x); r[1] += bfhi(pv.x); r[2] += bflo(pv.y); r[3] += bfhi(pv.y); r[4] += bflo(pv.z); r[5] += bfhi(pv.z); r[6] += bflo(pv.w); r[7] += bfhi(pv.w); }
                        u32x4 w; w.x = pk2(r[0], r[1]); w.y = pk2(r[2], r[3]); w.z = pk2(r[4], r[5]); w.w = pk2(r[6], r[7]);
                        *(u32x4*)(o0 + (size_t)row * 1024 + col) = w;
                    }
                } else if constexpr (mode == EM_WOUT) {
#pragma unroll
                    for (int bj = 0; bj < 2; ++bj) {
                        const int col = u.pn * 256 + bj * 128 + cl;
#pragma unroll
                        for (int n = 0; n < 2; ++n) *(f32x4*)(fo + (size_t)row * D + col + 4 * n) = __builtin_bit_cast(f32x4, cur.s[2 * bj + n]) + hc[2 * bj + n] * acc[ai][bj][m][n];
                    }
                } else if constexpr (mode == EM_MOEUP) {
                    const f32x4 a0 = acc[ai][0][m][0], a1 = acc[ai][0][m][1], b0 = acc[ai][1][m][0], b1 = acc[ai][1][m][1];
                    u32x4 w; w.x = pk2(siluf_(a0[0]) * b0[0], siluf_(a0[1]) * b0[1]); w.y = pk2(siluf_(a0[2]) * b0[2], siluf_(a0[3]) * b0[3]);
                    w.z = pk2(siluf_(a1[0]) * b1[0], siluf_(a1[1]) * b1[1]); w.w = pk2(siluf_(a1[2]) * b1[2], siluf_(a1[3]) * b1[3]);
                    *(u32x4*)(o0 + (size_t)row * HID + (u.pn & 3) * 128 + cl) = w;
                } else if constexpr (mode == EM_MOEDN) {
#pragma unroll
                    for (int bj = 0; bj < 2; ++bj) {
                        const f32x4 v0 = acc[ai][bj][m][0], v1 = acc[ai][bj][m][1];
                        u32x4 w; w.x = pk2(v0[0], v0[1]); w.y = pk2(v0[2], v0[3]); w.z = pk2(v1[0], v1[1]); w.w = pk2(v1[2], v1[3]);
                        *(u32x4*)(o0 + (size_t)row * 1024 + (u.pn & 3) * 256 + bj * 128 + cl) = w;
                    }
                } else if constexpr (mode == EM_S5) {
                    const int g = u.pn, rr = row - g * 1280, b = rr / 160, c = rr - b * 160;
                    if (c < 144) {
#pragma unroll
                        for (int bj = 0; bj < 2; ++bj) {
                            const int n = bj * 128 + cl, i = n >> 4, h0 = n & 15, s = 16 * c + i;
                            const int trow = s < 256 ? NLAT + b * 256 + s : b * 2048 + (s - 256);
                            const u32x4 uv = cur.s[bj];
                            const f32x4 a0 = acc[ai][bj][m][0], a1 = acc[ai][bj][m][1];
                            u32x4 w;
                            w.x = pk2(gelu_tanh(a0[0] + hc[0][0] * bflo(uv.x)), gelu_tanh(a0[1] + hc[0][1] * bfhi(uv.x))); w.y = pk2(gelu_tanh(a0[2] + hc[0][2] * bflo(uv.y)), gelu_tanh(a0[3] + hc[0][3] * bfhi(uv.y)));
                            w.z = pk2(gelu_tanh(a1[0] + hc[1][0] * bflo(uv.z)), gelu_tanh(a1[1] + hc[1][1] * bfhi(uv.z))); w.w = pk2(gelu_tanh(a1[2] + hc[1][2] * bflo(uv.w)), gelu_tanh(a1[3] + hc[1][3] * bfhi(uv.w)));
                            *(u32x4*)(o0 + (size_t)trow * 256 + g * 16 + h0) = w;
                        }
                    }
                }
                cur = nxt;
        }
    }
};

#define XB_TMO      128
#define XB_XCNT(j)  (256  + 64 * (j))
#define XB_XSUB(j)  (1280 + 64 * (j))
#define XB_XGEN(j)  (2304 + 64 * (j))
#define XB_TOP      3328
#define XB_TOPGEN   3392
#define XCD_BAR_WORDS 3456
#define XB_SPIN_CAP (1u << 22)
__device__ __forceinline__ unsigned xb_ld(unsigned* p)              { return __hip_atomic_load(p, __ATOMIC_RELAXED, __HIP_MEMORY_SCOPE_AGENT); }
__device__ __forceinline__ unsigned xb_add(unsigned* p, unsigned v) { return __hip_atomic_fetch_add(p, v, __ATOMIC_RELAXED, __HIP_MEMORY_SCOPE_AGENT); }
__device__ __forceinline__ unsigned xb_xcc_id() { return (unsigned)__builtin_amdgcn_s_getreg((3 << 11) | 20) & 0xFu; }
#define XB_SPIN(cond, bar) do { unsigned _sp = 0; while (cond) { __builtin_amdgcn_s_sleep(1); \
    if ((++_sp & 255u) == 0u) { if (xb_ld(&(bar)[XB_TMO])) break; if (_sp > XB_SPIN_CAP) { atomicAdd(&(bar)[XB_TMO], 1u); break; } } } } while (0)
struct XcdBarrier { unsigned* bar; unsigned x; volatile LAS unsigned* st; };
__device__ __forceinline__ XcdBarrier xcd_barrier_post(unsigned* bar, volatile LAS unsigned* st) {
    XcdBarrier b; b.bar = bar; b.x = xb_xcc_id(); b.st = st;
    if (threadIdx.x == 0) (void)xb_add(&bar[XB_XCNT(b.x)], 1u);
    return b;
}
__device__ __forceinline__ void xcd_barrier_complete(unsigned* bar, unsigned x, unsigned& nloc, unsigned& nx) {
    const unsigned G = gridDim.x * gridDim.y * gridDim.z;
    unsigned sum, cnt, mine, sp = 0u;
    for (;;) {
        sum = 0u; cnt = 0u; mine = 0u;
#pragma unroll
        for (unsigned j = 0; j < 16; ++j) { const unsigned c = xb_ld(&bar[XB_XCNT(j)]); sum += c; cnt += (c > 0u) ? 1u : 0u; mine = (j == x) ? c : mine; }
        if (sum == G) break;
        __builtin_amdgcn_s_sleep(1);
        if ((++sp & 255u) == 0u) { if (xb_ld(&bar[XB_TMO])) break; if (sp > XB_SPIN_CAP) { atomicAdd(&bar[XB_TMO], 1u); break; } }
    }
    nloc = mine > 0u ? mine : 1u; nx = cnt > 0u ? cnt : 1u;
}
__device__ __noinline__ void xcd_barrier_fn(unsigned* bar_in, unsigned bx, unsigned st_off, int tid) {
    XcdBarrier b; b.bar = bar_in; b.x = bx; b.st = (volatile LAS unsigned*)(uintptr_t)st_off;
    asm volatile("s_waitcnt vmcnt(0)" ::: "memory");
    __syncthreads();
    if (tid == 0) {
        unsigned* bar = b.bar;
        __builtin_amdgcn_s_waitcnt(0);
        unsigned nloc = b.st[0], nx = b.st[1];
        if (nloc == 0u) { xcd_barrier_complete(bar, b.x, nloc, nx); b.st[0] = nloc; b.st[1] = nx; }
        const unsigned old = xb_add(&bar[XB_XSUB(b.x)], 1u);
        const unsigned gen = old / nloc;
        if (old + 1u == (gen + 1u) * nloc) {
            __builtin_amdgcn_fence(__ATOMIC_RELEASE, "agent");
            asm volatile("s_waitcnt vmcnt(0)" ::: "memory");
            const unsigned og = xb_add(&bar[XB_TOP], 1u);
            const unsigned tg = og / nx;
            if (og + 1u == (tg + 1u) * nx) xb_add(&bar[XB_TOPGEN], 1u);
            else XB_SPIN(xb_ld(&bar[XB_TOPGEN]) == tg, bar);
            __builtin_amdgcn_fence(__ATOMIC_ACQUIRE, "agent");
            xb_add(&bar[XB_XGEN(b.x)], 1u);
            asm volatile("s_waitcnt vmcnt(0)" ::: "memory");
        } else {
            XB_SPIN(xb_ld(&bar[XB_XGEN(b.x)]) == gen, bar);
            __builtin_amdgcn_fence(__ATOMIC_ACQUIRE, "agent");
            asm volatile("s_waitcnt vmcnt(0)" ::: "memory");
        }
    }
    __syncthreads();
}

constexpr int NWAVES = 8;
constexpr int RING_BYTES = 131072, MISC_OFF = RING_BYTES + 320, TBL_OFF = RING_BYTES + 1024, LDS_BYTES = 147456;
struct Args { const float* in[38]; float* out; unsigned char* ws; int ph_lo, ph_hi; };
typedef const __attribute__((address_space(4))) Args* ArgsP;
struct Frame {
    LAS unsigned char* lds;
    int tid, lane, wave, vcu, G, gw, NGW;
    unsigned char* ws;
};

enum RowMap { RM_ID = 0, RM_WIN = 1, RM_UQ = 2, RM_W13 = 3 };
__device__ __forceinline__ int rope_perm(int o) { const int axis = o >> 4, half = (o >> 3) & 1, i = o & 7; return 2 * (axis * 8 + i) + half; }
__device__ __forceinline__ int map_row(int rm, int n, int row_off) {
    if (rm == RM_WIN) return (n >= ZKPE && n < ZKPE + 32) ? ZKPE + rope_perm(n - ZKPE) : n;
    if (rm == RM_UQ) { const int hd = n / 96, cc = n - hd * 96; return cc >= 64 ? hd * 96 + 64 + rope_perm(cc - 64) : n; }
    if (rm == RM_W13) return row_off + (n >> 7) * 256 + (n & 127);
    return row_off + n;
}
__device__ __forceinline__ void transpose_item(const float* W, int K, int N, bf16_t* WT, int rm, int row_off, const float* kscale, LAS float* scr, int item, int lane) {
    const int nblk = N / 32, kb = item / nblk, nb = item % nblk, k0 = 64 * kb, n0 = 32 * nb;
    float tv[32];
#pragma unroll
    for (int i = 0; i < 32; ++i) tv[i] = W[(size_t)(k0 + 2 * i + (lane >> 5)) * N + n0 + (lane & 31)];
#pragma unroll
    for (int i = 0; i < 32; ++i) { const int kk = 2 * i + (lane >> 5); float v = tv[i]; if (kscale) v *= kscale[k0 + kk]; scr[kk * 33 + (lane & 31)] = v; }
    asm volatile("s_waitcnt lgkmcnt(0)" ::: "memory");
    const int c = lane & 7;
#pragma unroll
    for (int j = 0; j < 4; ++j) { const int n = (lane >> 3) + 8 * j; const LAS float* s = scr + (8 * c) * 33 + n;
        u32x4 o; o.x = pk2(s[0 * 33], s[1 * 33]); o.y = pk2(s[2 * 33], s[3 * 33]); o.z = pk2(s[4 * 33], s[5 * 33]); o.w = pk2(s[6 * 33], s[7 * 33]);
        *(u32x4*)(WT + (size_t)map_row(rm, n0 + n, row_off) * K + k0 + 8 * c) = o; }
    asm volatile("s_waitcnt lgkmcnt(0)" ::: "memory");
}

#if !NAIVE_S5
__device__ __forceinline__ void s5_build(Frame& F, ArgsP a);
#endif
__device__ __forceinline__ void prologue_phase(Frame& F, ArgsP a) {
    LAS float* scr = (LAS float*)(F.lds + F.wave * 16384);
    REP(21) for (int l = 0; l < 2; ++l) {
        unsigned char* wl = F.ws + WS_WB + (size_t)l * WL_STRIDE;
#define CONV(Wp, K_, N_, WTp, rm_, ro_, ks_) do { const int items_ = ((K_) / 64) * ((N_) / 32); \
            for (int it = F.gw; it < items_; it += F.NGW) transpose_item((Wp), (K_), (N_), (bf16_t*)(WTp), (rm_), (ro_), (ks_), scr, it, F.lane); } while (0)
        CONV(a->in[8] + (size_t)l * D * INC, D, INC, wl + WL_WIN, RM_WIN, 0, nullptr);
        CONV(a->in[21] + (size_t)l * 256 * 768, 256, 768, wl + WL_UQ, RM_UQ, 0, a->in[19] + l * 256);
        CONV(a->in[22] + (size_t)l * 128 * 512, 128, 512, wl + WL_UKV, RM_ID, 0, a->in[20] + l * 128);
        CONV(a->in[23] + (size_t)l * 128 * 512, 128, 512, wl + WL_UKV, RM_ID, 512, a->in[20] + l * 128);
        CONV(a->in[17] + (size_t)l * 256 * 256, 256, 256, wl + WL_GLU, RM_ID, 0, nullptr);
        CONV(a->in[26] + (size_t)l * 256 * 1024, 256, 1024, wl + WL_PA, RM_ID, 0, nullptr);
        CONV(a->in[27] + (size_t)l * 512 * 1024, 512, 1024, wl + WL_PB, RM_ID, 0, nullptr);
        CONV(a->in[28] + (size_t)l * 256 * 1024, 256, 1024, wl + WL_PC, RM_ID, 0, nullptr);
        CONV(a->in[29] + (size_t)l * 1024 * 1024, 1024, 1024, wl + WL_OUT, RM_ID, 0, nullptr);
#undef CONV
        u32x4* padp = (u32x4*)(wl + WL_WIN + (size_t)INC * D * 2);
        for (int i = F.gw * 64 + F.lane; i < (ZC - INC) * D * 2 / 16; i += F.NGW * 64) padp[i] = (u32x4){0u, 0u, 0u, 0u};
    }
    if (blockIdx.x == 0) {
        float* rp = (float*)(F.ws + WS_ROPE);
        const int pos = F.tid >> 3, i = F.tid & 7;
        const float ang = (float)pos * exp2f(-(float)i * (13.287712379549449f / 8.f));
        rp[F.tid] = cosf(ang); rp[512 + F.tid] = sinf(ang);
    }
    __syncthreads();
    REP(22)
    {
        LAS float* sil = (LAS float*)F.lds;
        LAS float* red = (LAS float*)(F.lds + 40960);
        bool have = false;
        for (int it = (F.G == 256 ? (int)blockIdx.x - 128 : (int)blockIdx.x); it < 192; it += (F.G == 256 ? 128 : F.G)) { if (it < 0) break;
            if (!have) {
                for (int i = F.tid; i < 9 * 1024; i += 512) { const int r = i >> 10, k = i & 1023; const float cv = r < 8 ? a->in[1][r * 1024 + k] : a->in[3][k]; sil[i] = siluf_(cv); }
                have = true; __syncthreads();
            }
            const int l = it / 96, n = (it % 96) * 64 + F.lane;
            const float* wp = a->in[4] + (size_t)l * D * 6144 + (size_t)(F.wave * 128) * 6144 + n;
            float acc[9];
#pragma unroll
            for (int r = 0; r < 9; ++r) acc[r] = 0.f;
#pragma unroll 8
            for (int k = 0; k < 128; ++k) { const float wv = wp[(size_t)k * 6144];
#pragma unroll
                for (int r = 0; r < 9; ++r) acc[r] += sil[r * 1024 + F.wave * 128 + k] * wv; }
#pragma unroll
            for (int r = 0; r < 9; ++r) red[(F.wave * 9 + r) * 64 + F.lane] = acc[r];
            __syncthreads();
            for (int i = F.tid; i < 9 * 64; i += 512) { const int r = i >> 6, ln = i & 63; float s = 0.f;
#pragma unroll
                for (int w = 0; w < 8; ++w) s += red[(w * 9 + r) * 64 + ln];
                const int nn = (it % 96) * 64 + ln;
                ((float*)(F.ws + WS_MODV))[((size_t)l * 9 + r) * 6144 + nn] = s + a->in[5][l * 6144 + nn]; }
            __syncthreads();
        }
    }
#if !NAIVE_S5
    REP(23) s5_build(F, a);
#endif
}

__device__ __forceinline__ void moe_convert(Frame& F, ArgsP a, int l) {
    LAS float* scr = (LAS float*)(F.lds + F.wave * 16384);
    bf16_t* w13 = (bf16_t*)(F.ws + WS_MIX + MW_W13); bf16_t* w2 = (bf16_t*)(F.ws + WS_MIX + MW_W2);
    for (int it = F.gw; it < NEXP * 768; it += F.NGW) {
        const int e = it / 768, r = it % 768, which = r >> 8, sub = r & 255;
        const size_t eoff = ((size_t)l * NEXP + e) * 1024 * 512;
        if (which == 0) transpose_item(a->in[34] + eoff, 1024, 512, w13, RM_W13, e * 1024, nullptr, scr, sub, F.lane);
        else if (which == 1) transpose_item(a->in[35] + eoff, 1024, 512, w13, RM_W13, e * 1024 + 128, nullptr, scr, sub, F.lane);
        else transpose_item(a->in[36] + eoff, 512, 1024, w2, RM_ID, e * 1024, nullptr, scr, sub, F.lane);
    }
}

__device__ __forceinline__ const float* x_row_ptr(ArgsP a, const float* X, int layer, int row) {
    return layer == 0 ? (row < NLAT ? a->in[0] + (size_t)row * D : a->in[2] + (size_t)(row - NLAT) * D) : X + (size_t)row * D;
}
__device__ __forceinline__ void norm_mod_row(const f32x4 (&v)[4], f32x4 (&h)[4], const float* g, const float* shift, const float* scale, int lane) {
    float ss = 0.f;
#pragma unroll
    for (int j = 0; j < 4; ++j) ss += (v[j][0] * v[j][0] + v[j][1] * v[j][1]) + (v[j][2] * v[j][2] + v[j][3] * v[j][3]);
    const float rstd = rsqrtf(wave_sum(ss) * (1.f / D) + EPS);
#pragma unroll
    for (int j = 0; j < 4; ++j) { const int c = 4 * lane + 256 * j; const f32x4 gv = *(const f32x4*)(g + c), sh = *(const f32x4*)(shift + c), sc = *(const f32x4*)(scale + c);
        h[j] = v[j] * rstd * gv * (sc + 1.f) + sh; }
}
__device__ __forceinline__ void store_row_bf16(bf16_t* orow, const f32x4 (&h)[4], int lane) {
#pragma unroll
    for (int j = 0; j < 4; ++j) { u32x2 w; w.x = pk2(h[j][0], h[j][1]); w.y = pk2(h[j][2], h[j][3]); *(u32x2*)(orow + 4 * lane + 256 * j) = w; }
}
__device__ __forceinline__ void norm1_phase(Frame& F, ArgsP a, int layer, int nrows) {
    const float* X = (const float*)(F.ws + WS_X); bf16_t* H = (bf16_t*)(F.ws + WS_H);
    const float* modv = (const float*)(F.ws + WS_MODV) + (size_t)layer * 9 * 6144;
    for (int row = F.gw; row < nrows; row += F.NGW) {
        const float* xr = x_row_ptr(a, X, layer, row); f32x4 v[4], h[4];
#pragma unroll
        for (int j = 0; j < 4; ++j) v[j] = *(const f32x4*)(xr + 4 * F.lane + 256 * j);
        const float* mv = modv + (size_t)tok_modrow(row) * 6144;
        norm_mod_row(v, h, a->in[6] + layer * D, mv, mv + 1024, F.lane);
        store_row_bf16(H + (size_t)row * D, h, F.lane);
    }
}

__device__ __forceinline__ int seq_row(int b, int s, int d) {
    if (d == 0) return s < 256 ? NLAT + b * 256 + s : b * 2048 + (s - 256);
    return s < 256 ? NLAT + b * 256 + (255 - s) : b * 2048 + (2047 - (s - 256));
}
__device__ __forceinline__ float hg_lb(ArgsP a, int l) { return l == 0 ? 0.f : 1.f / (1.f + __expf(a->in[24][0] - a->in[24][1])); }

#if NAIVE_S5
__device__ __forceinline__ void s5_naive(Frame& F, ArgsP a, int l) {
    const bf16_t* Z = (const bf16_t*)(F.ws + WS_Z); float* Yacc = (float*)(F.ws + WS_MIX + MX_S5A);
    for (int unit = F.gw; unit < 128; unit += F.NGW) {
        const int b = unit >> 4, g = unit & 15, p = F.lane;
        for (int d = 0; d < 2; ++d) {
            const int idx = (l * 2 + d) * 16 + g;
            const float lre = a->in[9][idx * 64 + p], lim = a->in[10][idx * 64 + p], dt = expf(a->in[15][idx]);
            const float mag = expf(lre * dt), lbr = mag * cosf(lim * dt), lbi = mag * sinf(lim * dt), den = lre * lre + lim * lim;
            const float fr = ((lbr - 1.f) * lre + lbi * lim) / den, fi = (lbi * lre - (lbr - 1.f) * lim) / den;
            float bbr[16], bbi[16], cre[16], cim[16];
#pragma unroll
            for (int h = 0; h < 16; ++h) { const float br = a->in[11][(size_t)(idx * 64 + p) * 16 + h], bi = a->in[12][(size_t)(idx * 64 + p) * 16 + h];
                bbr[h] = fr * br - fi * bi; bbi[h] = fr * bi + fi * br;
                cre[h] = a->in[13][(size_t)(idx * 16 + h) * 64 + p]; cim[h] = a->in[14][(size_t)(idx * 16 + h) * 64 + p]; }
            float hr = 0.f, hi = 0.f;
            for (int s = 0; s < 2304; ++s) {
                const int row = seq_row(b, s, d);
                const u32x4 u0 = *(const u32x4*)(Z + (size_t)row * ZC + g * 16), u1 = *(const u32x4*)(Z + (size_t)row * ZC + g * 16 + 8);
                const float uu[16] = { bflo(u0.x), bfhi(u0.x), bflo(u0.y), bfhi(u0.y), bflo(u0.z), bfhi(u0.z), bflo(u0.w), bfhi(u0.w),
                                       bflo(u1.x), bfhi(u1.x), bflo(u1.y), bfhi(u1.y), bflo(u1.z), bfhi(u1.z), bflo(u1.w), bfhi(u1.w) };
                float bur = 0.f, bui = 0.f;
#pragma unroll
                for (int h = 0; h < 16; ++h) { bur += bbr[h] * uu[h]; bui += bbi[h] * uu[h]; }
                const float nhr = lbr * hr - lbi * hi + bur, nhi = lbr * hi + lbi * hr + bui; hr = nhr; hi = nhi;
                float mine = 0.f;
#pragma unroll
                for (int h = 0; h < 16; ++h) { const float y = wave_sum(cre[h] * hr - cim[h] * hi); if (F.lane == h) mine = y; }
                if (F.lane < 16) { float* ptr = Yacc + (size_t)row * 256 + g * 16 + F.lane; if (d == 0) *ptr = mine; else *ptr += mine; }
            }
        }
    }
}
__device__ __forceinline__ void s5_naive_finish(Frame& F, ArgsP a, int l, int nrows) {
    const bf16_t* Z = (const bf16_t*)(F.ws + WS_Z); const float* Yacc = (const float*)(F.ws + WS_MIX + MX_S5A); bf16_t* ysp = (bf16_t*)(F.ws + WS_MIX + MX_YS5P);
    for (int i = F.gw * 64 + F.lane; i < nrows * 256; i += F.NGW * 64) { const int row = i >> 8, n = i & 255;
        ysp[i] = (bf16_t)f2bf(gelu_tanh(Yacc[i] + a->in[16][l * 256 + n] * bf2f(Z[(size_t)row * ZC + n]))); }
}
#endif

#if NAIVE_HG
__device__ __forceinline__ void hg_naive(Frame& F, ArgsP a, int l) {
    const bf16_t* Z = (const bf16_t*)(F.ws + WS_Z); float* Ohg = (float*)(F.ws + WS_H);
    LAS float* red = (LAS float*)F.lds;
    const float lb = hg_lb(a, l);
    for (int unit = blockIdx.x; unit < 32; unit += F.G) {
        const int b = unit >> 2, hd = unit & 3, v = F.tid & 63, kg = F.wave;
        for (int d = 0; d < 2; ++d) {
            float S[16];
#pragma unroll
            for (int k = 0; k < 16; ++k) S[k] = 0.f;
            for (int s = 0; s < 2304; ++s) {
                const int row = seq_row(b, s, d);
                const bf16_t* zr = Z + (size_t)row * ZC;
                const u32x4 q0 = *(const u32x4*)(zr + ZHQ + hd * 128 + kg * 16), q1 = *(const u32x4*)(zr + ZHQ + hd * 128 + kg * 16 + 8);
                const int zf = d ? ZF1 : ZF0;
                const u32x4 z0 = *(const u32x4*)(zr + zf + hd * 128 + kg * 16), z1 = *(const u32x4*)(zr + zf + hd * 128 + kg * 16 + 8);
                const float vt = bf2f(zr[ZI + hd * 64 + v]);
                const float qq[16] = { bflo(q0.x), bfhi(q0.x), bflo(q0.y), bfhi(q0.y), bflo(q0.z), bfhi(q0.z), bflo(q0.w), bfhi(q0.w),
                                       bflo(q1.x), bfhi(q1.x), bflo(q1.y), bfhi(q1.y), bflo(q1.z), bfhi(q1.z), bflo(q1.w), bfhi(q1.w) };
                const float zz[16] = { bflo(z0.x), bfhi(z0.x), bflo(z0.y), bfhi(z0.y), bflo(z0.z), bfhi(z0.z), bflo(z0.w), bfhi(z0.w),
                                       bflo(z1.x), bfhi(z1.x), bflo(z1.y), bfhi(z1.y), bflo(z1.z), bfhi(z1.z), bflo(z1.w), bfhi(z1.w) };
                float part = 0.f;
#pragma unroll
                for (int k = 0; k < 16; ++k) { const float kin = (1.f - lb) / (1.f + __expf(zz[k])), f = 1.f - kin; S[k] = f * S[k] + kin * vt; part += qq[k] * S[k]; }
                red[((s & 1) * 8 + kg) * 64 + v] = part;
                __syncthreads();
                if (F.tid < 64) { float o = 0.f;
#pragma unroll
                    for (int w = 0; w < 8; ++w) o += red[((s & 1) * 8 + w) * 64 + F.tid];
                    float* ptr = Ohg + (size_t)row * 256 + hd * 64 + F.tid; if (d == 0) *ptr = o; else *ptr += o; }
            }
            __syncthreads();
        }
    }
}
__device__ __forceinline__ void hg_naive_finish(Frame& F, ArgsP a, int l, int nrows) {
    const bf16_t* Z = (const bf16_t*)(F.ws + WS_Z); const float* Ohg = (const float*)(F.ws + WS_H); bf16_t* yhg = (bf16_t*)(F.ws + WS_MIX + MX_YHG);
    for (int it = F.gw; it < nrows * 4; it += F.NGW) { const int row = it >> 2, hd = it & 3, c = hd * 64 + F.lane;
        float o = Ohg[(size_t)row * 256 + c]; const float ms = wave_sum(o * o) * (1.f / 64.f);
        o = o * rsqrtf(ms + EPS) * a->in[25][l * 256 + c] * siluf_(bf2f(Z[(size_t)row * ZC + ZG + c]));
        yhg[(size_t)row * 256 + c] = (bf16_t)f2bf(o); }
}
#endif

#if NAIVE_ATTN
__device__ __forceinline__ void attn_naive(Frame& F, bool need_ctx) {
    const bf16_t* Q = (const bf16_t*)(F.ws + WS_MIX + MX_Q); const bf16_t* KN = (const bf16_t*)(F.ws + WS_MIX + MX_KN); const bf16_t* V = (const bf16_t*)(F.ws + WS_MIX + MX_V);
    const bf16_t* KPE = (const bf16_t*)(F.ws + WS_MIX + MX_KPE); bf16_t* YM = (bf16_t*)(F.ws + WS_MIX + MX_YMLA);
    const int nunits = need_ctx ? 320 : 256;
    for (int unit = blockIdx.x; unit < nunits; unit += F.G) {
        int b, h, qrow, nk; bool active = true; const bool lat = unit < 256;
        if (lat) { b = unit >> 5; h = (unit >> 2) & 7; qrow = b * 2048 + (unit & 3) * 512 + F.tid; nk = 2304; }
        else { const int u2 = unit - 256; b = u2 >> 3; h = u2 & 7; active = F.tid < 256; qrow = NLAT + b * 256 + (F.tid & 255); nk = 256; }
        float q[96];
#pragma unroll
        for (int c = 0; c < 12; ++c) { const u32x4 w = *(const u32x4*)(Q + (size_t)qrow * 768 + h * 96 + c * 8);
            q[c * 8 + 0] = bflo(w.x); q[c * 8 + 1] = bfhi(w.x); q[c * 8 + 2] = bflo(w.y); q[c * 8 + 3] = bfhi(w.y); q[c * 8 + 4] = bflo(w.z); q[c * 8 + 5] = bfhi(w.z); q[c * 8 + 6] = bflo(w.w); q[c * 8 + 7] = bfhi(w.w); }
        float o[64], m = -1e30f, lsum = 0.f;
#pragma unroll
        for (int dd = 0; dd < 64; ++dd) o[dd] = 0.f;
        for (int j = 0; j < nk; ++j) {
            const int krow = lat ? (j < 2048 ? b * 2048 + j : NLAT + b * 256 + (j - 2048)) : NLAT + b * 256 + j;
            const bf16_t* kn = KN + (size_t)krow * 512 + h * 64; const bf16_t* kp = KPE + (size_t)krow * 32; const bf16_t* vv = V + (size_t)krow * 512 + h * 64;
            float s = 0.f;
#pragma unroll
            for (int c = 0; c < 12; ++c) { const u32x4 w = c < 8 ? *(const u32x4*)(kn + c * 8) : *(const u32x4*)(kp + (c - 8) * 8);
                s += q[c * 8 + 0] * bflo(w.x) + q[c * 8 + 1] * bfhi(w.x) + q[c * 8 + 2] * bflo(w.y) + q[c * 8 + 3] * bfhi(w.y) + q[c * 8 + 4] * bflo(w.z) + q[c * 8 + 5] * bfhi(w.z) + q[c * 8 + 6] * bflo(w.w) + q[c * 8 + 7] * bfhi(w.w); }
            const float mn = fmaxf(m, s), al = __builtin_amdgcn_exp2f(m - mn), pp = __builtin_amdgcn_exp2f(s - mn);
            lsum = lsum * al + pp; m = mn;
#pragma unroll
            for (int c = 0; c < 8; ++c) { const u32x4 w = *(const u32x4*)(vv + c * 8);
                o[c * 8 + 0] = o[c * 8 + 0] * al + pp * bflo(w.x); o[c * 8 + 1] = o[c * 8 + 1] * al + pp * bfhi(w.x); o[c * 8 + 2] = o[c * 8 + 2] * al + pp * bflo(w.y); o[c * 8 + 3] = o[c * 8 + 3] * al + pp * bfhi(w.y);
                o[c * 8 + 4] = o[c * 8 + 4] * al + pp * bflo(w.z); o[c * 8 + 5] = o[c * 8 + 5] * al + pp * bfhi(w.z); o[c * 8 + 6] = o[c * 8 + 6] * al + pp * bflo(w.w); o[c * 8 + 7] = o[c * 8 + 7] * al + pp * bfhi(w.w); }
        }
        if (active) { const float inv = 1.f / lsum;
#pragma unroll
            for (int c = 0; c < 8; ++c) { u32x4 w; w.x = pk2(o[c * 8] * inv, o[c * 8 + 1] * inv); w.y = pk2(o[c * 8 + 2] * inv, o[c * 8 + 3] * inv); w.z = pk2(o[c * 8 + 4] * inv, o[c * 8 + 5] * inv); w.w = pk2(o[c * 8 + 6] * inv, o[c * 8 + 7] * inv);
                *(u32x4*)(YM + (size_t)qrow * 512 + h * 64 + c * 8) = w; } }
    }
}
#endif

typedef short s16x4 __attribute__((ext_vector_type(4)));
__device__ __forceinline__ f32x4 mfma16(bf16x8 a, bf16x8 b, f32x4 c) { return __builtin_amdgcn_mfma_f32_16x16x32_bf16(a, b, c, 0, 0, 0); }
__device__ __forceinline__ s16x4 vtr16(const LAS unsigned char* p) { return __builtin_bit_cast(s16x4, __builtin_amdgcn_ds_read_tr16_b64_v4i16((LAS s16x4*)p)); }
__device__ __forceinline__ float max3f_(float a, float b, float c) { float r; asm("v_max3_f32 %0, %1, %2, %3" : "=v"(r) : "v"(a), "v"(b), "v"(c)); return r; }
__device__ __forceinline__ void glds16(const void* gsrc, unsigned lds_dst) { unsigned keep;
    asm volatile("s_mov_b32 %0, m0\n\ts_mov_b32 m0, %2\n\ts_nop 0\n\tglobal_load_lds_dwordx4 %1, off\n\ts_mov_b32 m0, %0" : "=&s"(keep) : "v"(gsrc), "s"(lds_dst) : "memory"); }
#if !NAIVE_ATTN
template <int VAR> __device__ __forceinline__ void attn_fast(Frame& F, bool need_ctx, bf16_t* YM) {
    const bf16_t* Q = (const bf16_t*)(F.ws + WS_MIX + MX_Q); const bf16_t* KN = (const bf16_t*)(F.ws + WS_MIX + MX_KN); const bf16_t* V = (const bf16_t*)(F.ws + WS_MIX + MX_V);
    const bf16_t* KPE = (const bf16_t*)(F.ws + WS_MIX + MX_KPE);
    const int lane = F.lane, wid = F.wave, r32 = lane & 31, hi = lane >> 5;
    constexpr int SLOT = 20480, VOFF = 12288, NSLOT = 5;
    const unsigned lds0 = (unsigned)(uintptr_t)F.lds;
    const int nunits = need_ctx ? 576 : 512;
    const unsigned kA = (unsigned)(hi * 1024 + r32 * 16);
    const unsigned vB = (unsigned)(VOFF + ((lane >> 4) & 1) * 32 + (lane & 3) * 8 + (4 * hi + ((lane & 15) >> 2)) * 64);
    for (int unit = F.vcu; unit < nunits; unit += F.G) {
        int b, h, qrow0, NT; const bool lat = unit < 512;
        if (lat) { b = unit >> 6; h = (unit >> 3) & 7; qrow0 = b * 2048 + (unit & 7) * 256; NT = 36; }
        else { const int u2 = unit - 512; b = u2 >> 3; h = u2 & 7; qrow0 = NLAT + b * 256; NT = 4; }
#define ATT_KROW(t) (lat ? ((t) < 32 ? b * 2048 + 64 * (t) : NLAT + b * 256 + 64 * ((t) - 32)) : NLAT + b * 256 + 64 * (t))
#define ATT_ISSUE(tt, sl) do { const int tc_ = (tt) < NT ? (tt) : NT - 1; const int kr_ = ATT_KROW(tc_); const unsigned sd_ = (unsigned)__builtin_amdgcn_readfirstlane((int)(lds0 + (sl) * SLOT + wid * 1024)); \
            glds16(KN + (size_t)(kr_ + lane) * 512 + h * 64 + wid * 8, sd_); \
            if (wid < 4) glds16(KPE + (size_t)(kr_ + lane) * 32 + wid * 8, sd_ + 8 * 1024); \
            glds16(V + (size_t)(kr_ + 16 * (wid & 3) + (lane >> 2)) * 512 + h * 64 + (wid >> 2) * 32 + (lane & 3) * 8, sd_ + VOFF); } while (0)
#define ATT_QK(P0, P1, slot) do { const LAS unsigned char* sq_ = F.lds + (slot) * SLOT; _Pragma("unroll") for (int d0 = 0; d0 < 6; ++d0) { \
            const bf16x8 k0_ = *(const LAS bf16x8*)(sq_ + kA + d0 * 2048), k1_ = *(const LAS bf16x8*)(sq_ + kA + d0 * 2048 + 512); \
            if (d0 == 0) { P0 = __builtin_amdgcn_mfma_f32_32x32x16_bf16(k0_, qf[0], negm, 0, 0, 0); P1 = __builtin_amdgcn_mfma_f32_32x32x16_bf16(k1_, qf[0], negm, 0, 0, 0); } \
            else { P0 = __builtin_amdgcn_mfma_f32_32x32x16_bf16(k0_, qf[d0], P0, 0, 0, 0); P1 = __builtin_amdgcn_mfma_f32_32x32x16_bf16(k1_, qf[d0], P1, 0, 0, 0); } } } while (0)
        asm volatile("s_waitcnt vmcnt(0)" ::: "memory");
        __syncthreads();
        ATT_ISSUE(0, 0); ATT_ISSUE(1, 1); ATT_ISSUE(2, 2); ATT_ISSUE(3, 3);
        bf16x8 qf[6];
        { const bf16_t* qp = Q + (size_t)(qrow0 + wid * 32 + r32) * 768 + h * 96 + hi * 8;
#pragma unroll
          for (int d0 = 0; d0 < 6; ++d0) qf[d0] = *(const bf16x8*)(qp + d0 * 16); }
        float mref = 0.f, lsum = 0.f, dpend = 0.f; f32x16 o0 = {}, o1 = {}, negm = {};
        asm volatile("s_waitcnt vmcnt(0)" ::: "memory");
        __syncthreads();
        f32x16 p0, p1;
        ATT_QK(p0, p1, 0);
        int s_cur = 0, s_nxt = 1, s_new = 4;
        for (int t = 0; t < NT; ++t) {
            ATT_ISSUE(t + 4, s_new);
            const LAS unsigned char* sb = F.lds + s_cur * SLOT;
            f32x16 n0, n1;
            if (t + 1 < NT) ATT_QK(n0, n1, s_nxt); else { n0 = p0; n1 = p1; }
            if (__builtin_expect(__any(dpend != 0.f), 0)) {
#pragma unroll
                for (int r = 0; r < 16; ++r) { p0[r] -= dpend; p1[r] -= dpend; } }
            float mxa = max3f_(p0[0], p0[1], p1[0]), mxb = max3f_(p0[2], p0[3], p1[1]); mxa = max3f_(mxa, p1[2], p1[3]);
#pragma unroll
            for (int r = 4; r < 16; r += 4) { mxa = max3f_(mxa, p0[r], p0[r + 1]); mxb = max3f_(mxb, p0[r + 2], p0[r + 3]); mxa = max3f_(mxa, p1[r], p1[r + 1]); mxb = max3f_(mxb, p1[r + 2], p1[r + 3]); }
            float mx = fmaxf(mxa, mxb);
            { auto rr = __builtin_amdgcn_permlane32_swap(__float_as_uint(mx), __float_as_uint(mx), false, false); mx = fmaxf(__uint_as_float(rr[0]), __uint_as_float(rr[1])); }
            dpend = 0.f;
            if (__builtin_expect(t == 0 || __any(mx > 8.f), 0)) {
                const float dl = t == 0 ? mx : fmaxf(mx, 0.f); mref += dl; dpend = dl;
#pragma unroll
                for (int r = 0; r < 16; ++r) { p0[r] -= dl; p1[r] -= dl; negm[r] = -mref; }
                const float fs = __builtin_amdgcn_exp2f(-dl); lsum *= fs;
#pragma unroll
                for (int r = 0; r < 16; ++r) { o0[r] *= fs; o1[r] *= fs; } }
            f32x2 ps2 = {0.f, 0.f};
#pragma unroll
            for (int r = 0; r < 16; r += 2) { p0[r] = __builtin_amdgcn_exp2f(p0[r]); p0[r + 1] = __builtin_amdgcn_exp2f(p0[r + 1]); p1[r] = __builtin_amdgcn_exp2f(p1[r]); p1[r + 1] = __builtin_amdgcn_exp2f(p1[r + 1]);
                ps2 += (f32x2){p0[r], p0[r + 1]}; ps2 += (f32x2){p1[r], p1[r + 1]}; }
            lsum += ps2.x + ps2.y;
            bf16x8 pb[4];
#pragma unroll
            for (int s = 0; s < 4; ++s) { u32x4 w;
                if (s < 2) { w.x = pk2(p0[8 * s], p0[8 * s + 1]); w.y = pk2(p0[8 * s + 2], p0[8 * s + 3]); w.z = pk2(p0[8 * s + 4], p0[8 * s + 5]); w.w = pk2(p0[8 * s + 6], p0[8 * s + 7]); }
                else { const int q = s - 2; w.x = pk2(p1[8 * q], p1[8 * q + 1]); w.y = pk2(p1[8 * q + 2], p1[8 * q + 3]); w.z = pk2(p1[8 * q + 4], p1[8 * q + 5]); w.w = pk2(p1[8 * q + 6], p1[8 * q + 7]); }
                pb[s] = __builtin_bit_cast(bf16x8, w); }
#pragma unroll
            for (int s = 0; s < 4; ++s) {
                const s16x4 a0l = vtr16(sb + vB + s * 1024), a0h = vtr16(sb + vB + s * 1024 + 512), a1l = vtr16(sb + vB + 4096 + s * 1024), a1h = vtr16(sb + vB + 4096 + s * 1024 + 512);
                const bf16x8 va0 = {a0l[0], a0l[1], a0l[2], a0l[3], a0h[0], a0h[1], a0h[2], a0h[3]}, va1 = {a1l[0], a1l[1], a1l[2], a1l[3], a1h[0], a1h[1], a1h[2], a1h[3]};
                o0 = __builtin_amdgcn_mfma_f32_32x32x16_bf16(va0, pb[s], o0, 0, 0, 0);
                o1 = __builtin_amdgcn_mfma_f32_32x32x16_bf16(va1, pb[s], o1, 0, 0, 0);
            }
            if (wid < 4) asm volatile("s_waitcnt vmcnt(6) lgkmcnt(0)" ::: "memory"); else asm volatile("s_waitcnt vmcnt(4) lgkmcnt(0)" ::: "memory");
            __builtin_amdgcn_s_barrier();
            p0 = n0; p1 = n1;
            s_cur = s_nxt; s_nxt = s_nxt + 1 == NSLOT ? 0 : s_nxt + 1; s_new = s_new + 1 == NSLOT ? 0 : s_new + 1;
        }
#undef ATT_QK
#undef ATT_ISSUE
#undef ATT_KROW
        lsum += shfl_f(lsum, lane ^ 32);
        const float inv = 1.f / lsum;
        bf16_t* op = YM + (size_t)(qrow0 + wid * 32 + r32) * 512 + h * 64 + 4 * hi;
#pragma unroll
        for (int g = 0; g < 4; ++g) {
            u32x2 w0, w1; w0.x = pk2(o0[4 * g] * inv, o0[4 * g + 1] * inv); w0.y = pk2(o0[4 * g + 2] * inv, o0[4 * g + 3] * inv);
            w1.x = pk2(o1[4 * g] * inv, o1[4 * g + 1] * inv); w1.y = pk2(o1[4 * g + 2] * inv, o1[4 * g + 3] * inv);
            *(u32x2*)(op + 8 * g) = w0; *(u32x2*)(op + 32 + 8 * g) = w1;
        }
    }
}
#endif

#if !NAIVE_HG
__device__ __forceinline__ bf16x8 trfrag(const LAS unsigned char* p, int rowstep4) {
    const s16x4 lo = vtr16(p), hi = vtr16(p + rowstep4); return (bf16x8){lo[0], lo[1], lo[2], lo[3], hi[0], hi[1], hi[2], hi[3]}; }
__device__ __forceinline__ void hg_gate16(const bf16_t* Z, int b, int s0, int d, int zcol, float lb, float (&kin)[16], float (&gl)[16]) {
#pragma unroll
    for (int i = 0; i < 16; ++i) { const int row = seq_row(b, s0 + i, d); const float z = bf2f(Z[(size_t)row * ZC + zcol]);
        const float e = __expf(-z), sg = 1.f / (1.f + e), f = lb + (1.f - lb) * sg; kin[i] = (1.f - lb) * e * sg; gl[i] = __logf(f); }
}
__device__ __forceinline__ void hg_local_load(u32x4 (&tz)[2], u32x4& tv, const bf16_t* Z, int unit, int tid) {
    const int c = unit % 36, r = unit / 36, d = r & 1, hd = (r >> 1) & 3, b = r >> 3;
#pragma unroll
    for (int j = 0; j < 2; ++j) { const int pc = tid + 512 * j, t = pc >> 4, c16 = pc & 15, row = seq_row(b, 64 * c + t, d);
        tz[j] = *(const u32x4*)(Z + (size_t)row * ZC + (d ? ZF1 : ZF0) + hd * 128 + c16 * 8); }
    { const int t = tid >> 3, cc = tid & 7, row = seq_row(b, 64 * c + t, d); tv = *(const u32x4*)(Z + (size_t)row * ZC + ZI + hd * 64 + cc * 8); }
}
__device__ __forceinline__ void hg_local_phase(Frame& F, ArgsP a, int l) {
    const bf16_t* Z = (const bf16_t*)(F.ws + WS_Z); bf16_t* HGS = (bf16_t*)(F.ws + WS_H); float* HGD = (float*)(F.ws + WS_MIX + MX_HGD);
    const float lb = hg_lb(a, l);
    LAS unsigned char* Vl = F.lds; LAS unsigned char* KdT = F.lds + 9216; LAS float* seg = (LAS float*)(F.lds + 27648); LAS unsigned char* Zr = F.lds + 32768;
    const int tid = F.tid, lane = F.lane, w = F.wave, k = tid & 127, tq = tid >> 7;
    u32x4 tz[2], tv;
    if (F.vcu < 2304) hg_local_load(tz, tv, Z, F.vcu, tid);
    for (int unit = F.vcu; unit < 2304; unit += F.G) {
        __syncthreads();
#pragma unroll
        for (int j = 0; j < 2; ++j) { const int pc = tid + 512 * j; *(LAS u32x4*)(Zr + (pc >> 4) * 272 + (pc & 15) * 16) = tz[j]; }
        *(LAS u32x4*)(Vl + (tid >> 3) * 144 + (tid & 7) * 16) = tv;
        if (unit + F.G < 2304) hg_local_load(tz, tv, Z, unit + F.G, tid);
        __syncthreads();
        float kin0[8], kin1[8], g0[8], g1[8];
#pragma unroll
        for (int i = 0; i < 8; ++i) { const unsigned zz = *(const LAS unsigned*)(Zr + ((8 * w + i) * 136 + 2 * lane) * 2);
            { const float e = __expf(-bflo(zz)), sg = __builtin_amdgcn_rcpf(1.f + e); kin0[i] = (1.f - lb) * e * sg; g0[i] = __logf(lb + (1.f - lb) * sg); }
            { const float e = __expf(-bfhi(zz)), sg = __builtin_amdgcn_rcpf(1.f + e); kin1[i] = (1.f - lb) * e * sg; g1[i] = __logf(lb + (1.f - lb) * sg); } }
        float run0 = 0.f, run1 = 0.f;
#pragma unroll
        for (int i = 7; i >= 0; --i) { const float a0 = g0[i], a1 = g1[i]; g0[i] = run0; g1[i] = run1; run0 += a0; run1 += a1; }
        *(LAS f32x2*)(seg + w * 128 + 2 * lane) = (f32x2){run0, run1};
        __syncthreads();
        float lat0 = 0.f, lat1 = 0.f, tot0 = 0.f, tot1 = 0.f;
#pragma unroll
        for (int q = 0; q < 8; ++q) { const f32x2 sv = *(const LAS f32x2*)(seg + q * 128 + 2 * lane); tot0 += sv.x; tot1 += sv.y; if (q > w) { lat0 += sv.x; lat1 += sv.y; } }
        { u32x4 w0, w1;
          w0.x = pk2(kin0[0] * __expf(g0[0] + lat0), kin0[1] * __expf(g0[1] + lat0)); w0.y = pk2(kin0[2] * __expf(g0[2] + lat0), kin0[3] * __expf(g0[3] + lat0));
          w0.z = pk2(kin0[4] * __expf(g0[4] + lat0), kin0[5] * __expf(g0[5] + lat0)); w0.w = pk2(kin0[6] * __expf(g0[6] + lat0), kin0[7] * __expf(g0[7] + lat0));
          w1.x = pk2(kin1[0] * __expf(g1[0] + lat1), kin1[1] * __expf(g1[1] + lat1)); w1.y = pk2(kin1[2] * __expf(g1[2] + lat1), kin1[3] * __expf(g1[3] + lat1));
          w1.z = pk2(kin1[4] * __expf(g1[4] + lat1), kin1[5] * __expf(g1[5] + lat1)); w1.w = pk2(kin1[6] * __expf(g1[6] + lat1), kin1[7] * __expf(g1[7] + lat1));
          *(LAS u32x4*)(KdT + (2 * lane) * 144 + w * 16) = w0; *(LAS u32x4*)(KdT + (2 * lane + 1) * 144 + w * 16) = w1; }
        if (w == 0) *(f32x2*)(HGD + (size_t)unit * 128 + 2 * lane) = (f32x2){__expf(tot0), __expf(tot1)};
        __syncthreads();
        f32x4 acc[4] = {};
#pragma unroll
        for (int ks = 0; ks < 2; ++ks) {
            const bf16x8 bf = *(const LAS bf16x8*)(KdT + (16 * w + (lane & 15)) * 144 + (32 * ks + 8 * (lane >> 4)) * 2);
#pragma unroll
            for (int mt = 0; mt < 4; ++mt) { const bf16x8 af = trfrag(Vl + (32 * ks + 8 * (lane >> 4) + ((lane & 15) >> 2)) * 144 + (mt * 16 + 4 * (lane & 3)) * 2, 4 * 144);
                acc[mt] = mfma16(af, bf, acc[mt]); }
        }
        bf16_t* dst = HGS + (size_t)unit * 8192 + 16 * w + (lane & 15);
#pragma unroll
        for (int mt = 0; mt < 4; ++mt)
#pragma unroll
            for (int rr = 0; rr < 4; ++rr) dst[(size_t)(16 * mt + 4 * (lane >> 4) + rr) * 128] = (bf16_t)f2bf(acc[mt][rr]);
    }
}
__device__ __forceinline__ void hg_scan_phase(Frame& F) {
    bf16_t* HGS = (bf16_t*)(F.ws + WS_H); const float* HGD = (const float*)(F.ws + WS_MIX + MX_HGD);
    if (F.G == 256 && F.vcu >= 64 && F.vcu < 144) return;
    const int sb = F.G == 256 ? (F.vcu < 64 ? F.vcu : F.vcu - 80) : F.vcu, snb = F.G == 256 ? 176 : F.G;
    for (int it = (sb * NWAVES + F.wave) * 64 + F.lane; it < 64 * 1024; it += snb * NWAVES * 64) {
        const int r = it >> 10, e8 = (it & 1023) * 8, k0 = e8 & 127;
        float S[8];
#pragma unroll
        for (int j = 0; j < 8; ++j) S[j] = 0.f;
#pragma unroll 12
        for (int c = 0; c < 36; ++c) {
            u32x4* p = (u32x4*)(HGS + (size_t)(r * 36 + c) * 8192 + e8); const u32x4 ds = *p;
            const f32x4 d0 = *(const f32x4*)(HGD + (size_t)(r * 36 + c) * 128 + k0), d1 = *(const f32x4*)(HGD + (size_t)(r * 36 + c) * 128 + k0 + 4);
            u32x4 o; o.x = pk2(S[0], S[1]); o.y = pk2(S[2], S[3]); o.z = pk2(S[4], S[5]); o.w = pk2(S[6], S[7]); *p = o;
            S[0] = d0[0] * S[0] + bflo(ds.x); S[1] = d0[1] * S[1] + bfhi(ds.x); S[2] = d0[2] * S[2] + bflo(ds.y); S[3] = d0[3] * S[3] + bfhi(ds.y);
            S[4] = d1[0] * S[4] + bflo(ds.z); S[5] = d1[1] * S[5] + bfhi(ds.z); S[6] = d1[2] * S[6] + bflo(ds.w); S[7] = d1[3] * S[7] + bfhi(ds.w);
        }
    }
}
struct HgTile { u32x4 z[2], q[2], s[2], v; };
__device__ __forceinline__ void hg_out_decode(int unit, bool need_ctx, int& b, int& hd, int& ct) {
    if (need_ctx) { ct = unit % 36; hd = (unit / 36) & 3; b = unit / 144; } else { ct = 4 + (unit & 31); hd = (unit >> 5) & 3; b = unit >> 7; }
}
__device__ __forceinline__ void hg_out_load(HgTile& T, const bf16_t* Z, const bf16_t* HGS, int b, int hd, int ct, int d, int tid) {
    const int cs = d == 0 ? ct : (ct < 4 ? 3 - ct : 39 - ct); const size_t su = (size_t)(((b * 4 + hd) * 2 + d) * 36 + cs);
#pragma unroll
    for (int j = 0; j < 2; ++j) { const int pc = tid + 512 * j, t = pc >> 4, c16 = pc & 15, row = seq_row(b, 64 * cs + t, d);
        T.z[j] = *(const u32x4*)(Z + (size_t)row * ZC + (d ? ZF1 : ZF0) + hd * 128 + c16 * 8); T.q[j] = *(const u32x4*)(Z + (size_t)row * ZC + ZHQ + hd * 128 + c16 * 8);
        T.s[j] = *(const u32x4*)(HGS + su * 8192 + (size_t)t * 128 + c16 * 8); }
    { const int t = tid >> 3, cc = tid & 7, row = seq_row(b, 64 * cs + t, d); T.v = *(const u32x4*)(Z + (size_t)row * ZC + ZI + hd * 64 + cc * 8); }
}
__device__ __forceinline__ void hg_out_phase(Frame& F, ArgsP a, int l, bool need_ctx) {
    const bf16_t* Z = (const bf16_t*)(F.ws + WS_Z); const bf16_t* HGS = (const bf16_t*)(F.ws + WS_H); bf16_t* YHG = (bf16_t*)(F.ws + WS_MIX + MX_YHG);
    const float lb = hg_lb(a, l);
    LAS unsigned char* HQD = F.lds; LAS unsigned char* HQ1 = F.lds + 17408; LAS unsigned char* HK1 = F.lds + 34816; LAS unsigned char* HST = F.lds + 52224;
    LAS unsigned char* HV = F.lds + 69632; LAS unsigned char* HP = F.lds + 78848; LAS float* HO = (LAS float*)(F.lds + 88064); LAS float* seg = (LAS float*)(F.lds + 105472);
    const int tid = F.tid, lane = F.lane, w = F.wave, k = tid & 127, tq = tid >> 7, mt = w >> 1, nh = w & 1;
    const int nunits = need_ctx ? 1152 : 1024;
    const int nmine = F.vcu < nunits ? (nunits - 1 - F.vcu) / F.G + 1 : 0, nit = 2 * nmine;
    HgTile T;
    if (nit > 0) { int b, hd, ct; hg_out_decode(F.vcu, need_ctx, b, hd, ct); hg_out_load(T, Z, HGS, b, hd, ct, 0, tid); }
    for (int it = 0; it < nit; ++it) {
        const int unit = F.vcu + (it >> 1) * F.G, d = it & 1; int b, hd, ct; hg_out_decode(unit, need_ctx, b, hd, ct);
        __syncthreads();
#pragma unroll
        for (int j = 0; j < 2; ++j) { const int pc = tid + 512 * j, t = pc >> 4, c16 = pc & 15;
            *(LAS u32x4*)(HQD + t * 272 + c16 * 16) = T.q[j]; *(LAS u32x4*)(HK1 + t * 272 + c16 * 16) = T.z[j]; *(LAS u32x4*)(HST + t * 272 + c16 * 16) = T.s[j]; }
        *(LAS u32x4*)(HV + (tid >> 3) * 144 + (tid & 7) * 16) = T.v;
        if (it + 1 < nit) { const int un = F.vcu + ((it + 1) >> 1) * F.G; int b2, hd2, ct2; hg_out_decode(un, need_ctx, b2, hd2, ct2); hg_out_load(T, Z, HGS, b2, hd2, ct2, (it + 1) & 1, tid); }
        __syncthreads();
        float kin0[8], kin1[8], g0[8], g1[8];
#pragma unroll
        for (int i = 0; i < 8; ++i) { const unsigned zz = *(const LAS unsigned*)(HK1 + ((8 * w + i) * 136 + 2 * lane) * 2);
            { const float e = __expf(-bflo(zz)), sg = __builtin_amdgcn_rcpf(1.f + e); kin0[i] = (1.f - lb) * e * sg; g0[i] = __logf(lb + (1.f - lb) * sg); }
            { const float e = __expf(-bfhi(zz)), sg = __builtin_amdgcn_rcpf(1.f + e); kin1[i] = (1.f - lb) * e * sg; g1[i] = __logf(lb + (1.f - lb) * sg); } }
        float run0 = 0.f, run1 = 0.f;
#pragma unroll
        for (int i = 0; i < 8; ++i) { run0 += g0[i]; g0[i] = run0; run1 += g1[i]; g1[i] = run1; }
        *(LAS f32x2*)(seg + w * 128 + 2 * lane) = (f32x2){run0, run1};
        __syncthreads();
        float bef0 = 0.f, bef1 = 0.f, br0 = 0.f, br1 = 0.f;
#pragma unroll
        for (int q = 0; q < 7; ++q) { const f32x2 sv = *(const LAS f32x2*)(seg + q * 128 + 2 * lane); if (q < w) { bef0 += sv.x; bef1 += sv.y; } if (q < 4) { br0 += sv.x; br1 += sv.y; } }
        const float er0 = __expf(br0), er1 = __expf(br1);
#pragma unroll
        for (int i = 0; i < 8; ++i) { const int t = 8 * w + i, off = (t * 136 + 2 * lane) * 2;
            const unsigned qq = *(const LAS unsigned*)(HQD + off);
            const float e0 = __expf(fminf(fmaxf(bef0 + g0[i] - br0, -80.f), 80.f)), e1 = __expf(fminf(fmaxf(bef1 + g1[i] - br1, -80.f), 80.f));
            const float q10 = bflo(qq) * e0, q11 = bfhi(qq) * e1;
            *(LAS unsigned*)(HQ1 + off) = pk2(q10, q11);
            *(LAS unsigned*)(HQD + off) = pk2(q10 * er0, q11 * er1);
            *(LAS unsigned*)(HK1 + off) = pk2(kin0[i] * __builtin_amdgcn_rcpf(e0), kin1[i] * __builtin_amdgcn_rcpf(e1)); }
        __syncthreads();
        f32x4 ao[2] = {}, as[2] = {};
#pragma unroll
        for (int ks = 0; ks < 4; ++ks) {
            const int ko = (32 * ks + 8 * (lane >> 4)) * 2;
            const bf16x8 aqd = *(const LAS bf16x8*)(HQD + (16 * mt + (lane & 15)) * 272 + ko), aq1 = *(const LAS bf16x8*)(HQ1 + (16 * mt + (lane & 15)) * 272 + ko);
#pragma unroll
            for (int j = 0; j < 2; ++j) { const int nt = 2 * nh + j;
                ao[j] = mfma16(aqd, *(const LAS bf16x8*)(HST + (16 * nt + (lane & 15)) * 272 + ko), ao[j]);
                as[j] = mfma16(aq1, *(const LAS bf16x8*)(HK1 + (16 * nt + (lane & 15)) * 272 + ko), as[j]); }
        }
#pragma unroll
        for (int j = 0; j < 2; ++j) { const int sc = 16 * (2 * nh + j) + (lane & 15);
#pragma unroll
            for (int rr = 0; rr < 4; ++rr) { const int t = 16 * mt + 4 * (lane >> 4) + rr; *(LAS bf16_t*)(HP + (t * 72 + sc) * 2) = (bf16_t)f2bf(sc <= t ? as[j][rr] : 0.f); } }
        __syncthreads();
#pragma unroll
        for (int ks = 0; ks < 2; ++ks) {
            const bf16x8 ap = *(const LAS bf16x8*)(HP + (16 * mt + (lane & 15)) * 144 + (32 * ks + 8 * (lane >> 4)) * 2);
#pragma unroll
            for (int j = 0; j < 2; ++j) { const int nt = 2 * nh + j;
                const bf16x8 bv = trfrag(HV + (32 * ks + 8 * (lane >> 4) + ((lane & 15) >> 2)) * 144 + (16 * nt + 4 * (lane & 3)) * 2, 4 * 144);
                ao[j] = mfma16(ap, bv, ao[j]); }
        }
#pragma unroll
        for (int j = 0; j < 2; ++j) { const int v = 16 * (2 * nh + j) + (lane & 15);
#pragma unroll
            for (int rr = 0; rr < 4; ++rr) { const int t = 16 * mt + 4 * (lane >> 4) + rr, tt = d == 0 ? t : 63 - t;
                if (d == 0) HO[tt * 68 + v] = ao[j][rr]; else HO[tt * 68 + v] += ao[j][rr]; } }
        if (d == 1) {
            __syncthreads();
#pragma unroll
            for (int i = 0; i < 8; ++i) { const int tt = 8 * w + i, row = ct < 4 ? NLAT + b * 256 + 64 * ct + tt : b * 2048 + 64 * (ct - 4) + tt, cidx = hd * 64 + lane;
                float o = HO[tt * 68 + lane]; const float ms = wave_sum(o * o) * (1.f / 64.f);
                o = o * rsqrtf(ms + EPS) * a->in[25][l * 256 + cidx] * siluf_(bf2f(Z[(size_t)row * ZC + ZG + cidx]));
                YHG[(size_t)row * 256 + cidx] = (bf16_t)f2bf(o); }
        }
    }
}
#endif

#if !NAIVE_S5
typedef f32x2 cf32;
__device__ __forceinline__ cf32 cmul(cf32 a, cf32 b) { return (cf32){a.x * b.x - a.y * b.y, a.x * b.y + a.y * b.x}; }
__device__ __forceinline__ void s5_build(Frame& F, ArgsP a) {
    LAS cf32* lamp = (LAS cf32*)F.lds;
    LAS cf32* Bb = lamp + 2 * 17 * 64;
    LAS cf32* Cc = Bb + 2 * 64 * 16;
    LAS float* Kd = (LAS float*)(Cc + 2 * 16 * 64);
    const int tid = F.tid;
    for (int unit = blockIdx.x; unit < 128; unit += F.G) {
        const int l = unit >> 6, g = (unit >> 2) & 15, q = unit & 3;
        bf16_t* Bs_t = (bf16_t*)(F.ws + WS_WB + (size_t)l * WL_STRIDE + WL_BS); bf16_t* B2_t = (bf16_t*)(F.ws + WS_WB + (size_t)l * WL_STRIDE + WL_B2);
        __syncthreads();
        if (tid < 128) { const int d = tid >> 6, p = tid & 63, idx = (l * 2 + d) * 16 + g;
            const float lre = a->in[9][idx * 64 + p], lim = a->in[10][idx * 64 + p], dt = expf(a->in[15][idx]);
            const float ar = lre * dt, ai = lim * dt;
            for (int tau = 0; tau <= 16; ++tau) { const float mag = expf(ar * (float)tau); float sn, cs; sincosf(ai * (float)tau, &sn, &cs); lamp[(d * 17 + tau) * 64 + p] = (cf32){mag * cs, mag * sn}; }
            const cf32 lb = lamp[(d * 17 + 1) * 64 + p]; const float den = lre * lre + lim * lim;
            const cf32 f = (cf32){((lb.x - 1.f) * lre + lb.y * lim) / den, (lb.y * lre - (lb.x - 1.f) * lim) / den};
            { const f32x4* br4 = (const f32x4*)(a->in[11] + (size_t)(idx * 64 + p) * 16); const f32x4* bi4 = (const f32x4*)(a->in[12] + (size_t)(idx * 64 + p) * 16);
              f32x4 br[4], bi[4];
#pragma unroll
              for (int q4 = 0; q4 < 4; ++q4) { br[q4] = br4[q4]; bi[q4] = bi4[q4]; }
#pragma unroll
              for (int h = 0; h < 16; ++h) Bb[(d * 64 + p) * 16 + h] = cmul(f, (cf32){br[h >> 2][h & 3], bi[h >> 2][h & 3]}); }
            if (q == 0) ((cf32*)(F.ws + WS_S5P))[idx * 64 + p] = lamp[(d * 17 + 16) * 64 + p];
        }
        for (int e = tid; e < 2048; e += 512) { const int d = e >> 10, h = (e >> 6) & 15, p = e & 63, idx = (l * 2 + d) * 16 + g;
            Cc[e] = (cf32){a->in[13][(size_t)(idx * 16 + h) * 64 + p], a->in[14][(size_t)(idx * 16 + h) * 64 + p]}; }
        __syncthreads();
        { const int d = tid >> 8, tau = (tid >> 4) & 15, h = tid & 15; float kacc[16];
#pragma unroll
          for (int hp = 0; hp < 16; ++hp) kacc[hp] = 0.f;
          for (int p = 0; p < 64; ++p) { const cf32 t1 = cmul(Cc[(d * 16 + h) * 64 + p], lamp[(d * 17 + tau) * 64 + p]);
#pragma unroll
              for (int hp = 0; hp < 16; ++hp) { const cf32 bb = Bb[(d * 64 + p) * 16 + hp]; kacc[hp] += t1.x * bb.x - t1.y * bb.y; } }
#pragma unroll
          for (int hp = 0; hp < 16; ++hp) Kd[tid * 16 + hp] = kacc[hp]; }
        __syncthreads();
        for (int e = tid; e < 64 * 512; e += 512) { const int n = 64 * q + (e >> 9), kk = e & 511, i = n >> 4, h = n & 15; float val;
            if (kk < 256) { const int j = kk >> 4, hp = kk & 15; val = 0.f;
                if (j <= i) val += Kd[((i - j) * 16 + h) * 16 + hp];
                if (j >= i) val += Kd[4096 + ((j - i) * 16 + h) * 16 + hp]; }
            else { const int dd = (kk - 256) >> 7, pp = (kk - 256) & 127, p = pp & 63, pw = dd == 0 ? i + 1 : 16 - i;
                const cf32 cl = cmul(Cc[(dd * 16 + h) * 64 + p], lamp[(dd * 17 + pw) * 64 + p]); val = pp < 64 ? cl.x : -cl.y; }
            B2_t[((size_t)g * 256 + n) * 512 + kk] = (bf16_t)f2bf(val); }
        { const int d = q & 1, half = q >> 1;
          for (int e = tid; e < 64 * 256; e += 512) { const int p = e >> 8, kk = e & 255, j = kk >> 4, hp = kk & 15, pw = d == 0 ? 15 - j : j;
              const cf32 v = cmul(lamp[(d * 17 + pw) * 64 + p], Bb[(d * 64 + p) * 16 + hp]);
              Bs_t[((size_t)(g * 2 + d) * 128 + half * 64 + p) * 256 + kk] = (bf16_t)f2bf(half ? v.y : v.x); } }
    }
    __syncthreads();
}
__device__ __forceinline__ void s5_state_phase(Frame& F, int l) {
    bf16_t* S5A = (bf16_t*)(F.ws + WS_MIX + MX_S5A); const bf16_t* Bs_t = (const bf16_t*)(F.ws + WS_WB + (size_t)l * WL_STRIDE + WL_BS);
    const cf32* lam16 = (const cf32*)(F.ws + WS_S5P);
    LAS float* hl = (LAS float*)F.lds;
    const int lane = F.lane, w = F.wave;
    for (int unit = F.vcu; unit < 256; unit += F.G) {
        const int b = unit & 7, d = (unit >> 3) & 1, g = unit >> 4;
        __syncthreads();
        f32x4 acc[10] = {};
        { u32x4 ta[10]; const bf16_t* Asrc = S5A + ((size_t)g * 1280 + b * 160) * 512;
#pragma unroll
          for (int j = 0; j < 10; ++j) { const int pc = F.tid + 512 * j; ta[j] = *(const u32x4*)(Asrc + (size_t)(pc >> 5) * 512 + (pc & 31) * 8); }
          const bf16_t* Bb = Bs_t + ((size_t)(g * 2 + d) * 128 + 16 * w + (lane & 15)) * 256 + 8 * (lane >> 4);
          bf16x8 bfr[8];
#pragma unroll
          for (int ks = 0; ks < 8; ++ks) bfr[ks] = *(const bf16x8*)(Bb + 32 * ks);
#pragma unroll
          for (int j = 0; j < 10; ++j) { const int pc = F.tid + 512 * j; *(LAS u32x4*)(F.lds + (pc >> 5) * 528 + (pc & 31) * 16) = ta[j]; }
          __syncthreads();
#pragma unroll
          for (int ks = 0; ks < 8; ++ks)
#pragma unroll
              for (int mt = 0; mt < 10; ++mt) acc[mt] = mfma16(*(const LAS bf16x8*)(F.lds + (16 * mt + (lane & 15)) * 528 + (32 * ks + 8 * (lane >> 4)) * 2), bfr[ks], acc[mt]);
          __syncthreads(); }
#pragma unroll
        for (int mt = 0; mt < 10; ++mt)
#pragma unroll
            for (int rr = 0; rr < 4; ++rr) hl[(16 * mt + 4 * (lane >> 4) + rr) * 132 + 16 * w + (lane & 15)] = acc[mt][rr];
        __syncthreads();
        if (w == 0) { const cf32 lm = lam16[((l * 2 + d) * 16 + g) * 64 + lane]; float hr = 0.f, hi = 0.f;
            bf16_t* dst = S5A + ((size_t)g * 1280 + b * 160) * 512 + 256 + d * 128 + lane;
            for (int s = 0; s < 144; ++s) { const int c = d == 0 ? s : (s < 16 ? 15 - s : 159 - s);
                dst[(size_t)c * 512] = (bf16_t)f2bf(hr); dst[(size_t)c * 512 + 64] = (bf16_t)f2bf(hi);
                const float lr = hl[c * 132 + lane], li = hl[c * 132 + 64 + lane];
                const float nr = lm.x * hr - lm.y * hi + lr, ni = lm.x * hi + lm.y * hr + li; hr = nr; hi = ni; }
        }
    }
}
struct WinOrderLast { pg8::StaticOrder S0; int G, c;
    __device__ bool next(int i, pg8::Unit& u) const { const int L = i * G + c; if (L < S0.nwg) return S0.next(i, u); const int e = L - S0.nwg; if (e >= 64) return false;
        const int t = e >> 3; u.pm = 64 + (e & 7); u.pn = t == 0 ? 0 : (t == 1 ? 2 : t + 2); u.h = -1; return true; } };
struct S5Order { int G, c; __device__ bool next(int i, pg8::Unit& u) const { const int L = i * G + c; if (L >= 80) return false; u.pm = L; u.pn = L / 5; u.h = -1; return true; } };
struct HalfTailOrder { pg8::StaticOrder S0; int G, c;
    __device__ bool next(int i, pg8::Unit& u) const { const int L = i * G + c; if (L < S0.nwg) return S0.next(i, u); const int e = L - S0.nwg; if (e >= 64) return false;
        u.pm = 64 + (e >> 3); u.pn = (e >> 1) & 3; u.h = e & 1; return true; } };
#endif

__device__ __forceinline__ bf16x8 pack8(const float (&v)[8]) { u32x4 w; w.x = pk2(v[0], v[1]); w.y = pk2(v[2], v[3]); w.z = pk2(v[4], v[5]); w.w = pk2(v[6], v[7]); return __builtin_bit_cast(bf16x8, w); }
__device__ __forceinline__ void norm2_router_phase(Frame& F, ArgsP a, int l, int nrows) {
    const float* X = (const float*)(F.ws + WS_X); bf16_t* H = (bf16_t*)(F.ws + WS_H);
    const float* modv = (const float*)(F.ws + WS_MODV) + (size_t)l * 9 * 6144;
    const float* Wg = a->in[30] + (size_t)l * D * 4; const float* bg = a->in[31] + l * 4; const float* We = a->in[32] + (size_t)l * D * 32; const float* be = a->in[33] + l * 32;
    int* ri = (int*)(F.ws + WS_ROUTE); float* rg = (float*)(F.ws + WS_ROUTE + (size_t)MTOK * 16);
    unsigned* cnt = (unsigned*)(F.ws + WS_CTL) + CW_CNT + l * 32 * 64;
    LAS unsigned char* hhi = F.lds; LAS unsigned char* hlo = F.lds + 33024; LAS float* part = (LAS float*)(F.lds + 66048); LAS float* lg = (LAS float*)(F.lds + 90624);
    const int w = F.wave, lane = F.lane, tid = F.tid;
    bf16x8 whi[4][3], wlo[4][3];
#pragma unroll
    for (int ks = 0; ks < 4; ++ks)
#pragma unroll
        for (int nt = 0; nt < 3; ++nt) { float hv[8], lv[8]; const int col = 16 * nt + (lane & 15);
#pragma unroll
            for (int i = 0; i < 8; ++i) { const int k = 128 * w + 32 * ks + 8 * (lane >> 4) + i;
                const float wv = col < 32 ? We[(size_t)k * 32 + col] : (col < 36 ? Wg[(size_t)k * 4 + (col - 32)] : 0.f);
                const float hi = bflo(pk2(wv, 0.f)); hv[i] = hi; lv[i] = wv - hi; }
            whi[ks][nt] = pack8(hv); wlo[ks][nt] = pack8(lv); }
    const int niter = nrows >> 4;
    for (int it = F.vcu; it < niter; it += F.G) {
        const int base = it * 16;
        __syncthreads();
#pragma unroll
        for (int rr = 0; rr < 2; ++rr) { const int lr = 2 * w + rr, row = base + lr; f32x4 v[4], h[4];
#pragma unroll
            for (int j = 0; j < 4; ++j) v[j] = *(const f32x4*)(X + (size_t)row * D + 4 * lane + 256 * j);
            const float* mv = modv + (size_t)tok_modrow(row) * 6144;
            norm_mod_row(v, h, a->in[7] + l * D, mv + 3 * 1024, mv + 4 * 1024, lane);
            store_row_bf16(H + (size_t)row * D, h, lane);
#pragma unroll
            for (int j = 0; j < 4; ++j) { u32x2 ph, pl; ph.x = pk2(h[j][0], h[j][1]); ph.y = pk2(h[j][2], h[j][3]);
                pl.x = pk2(h[j][0] - bflo(ph.x), h[j][1] - bfhi(ph.x)); pl.y = pk2(h[j][2] - bflo(ph.y), h[j][3] - bfhi(ph.y));
                *(LAS u32x2*)(hhi + (lr * 1032 + 4 * lane + 256 * j) * 2) = ph; *(LAS u32x2*)(hlo + (lr * 1032 + 4 * lane + 256 * j) * 2) = pl; } }
        __syncthreads();
        f32x4 acc[3] = {};
#pragma unroll
        for (int ks = 0; ks < 4; ++ks) { const int ao = ((lane & 15) * 1032 + 128 * w + 32 * ks + 8 * (lane >> 4)) * 2;
            const bf16x8 ahi = *(const LAS bf16x8*)(hhi + ao), alo = *(const LAS bf16x8*)(hlo + ao);
#pragma unroll
            for (int nt = 0; nt < 3; ++nt) { acc[nt] = mfma16(ahi, whi[ks][nt], acc[nt]); acc[nt] = mfma16(ahi, wlo[ks][nt], acc[nt]); acc[nt] = mfma16(alo, whi[ks][nt], acc[nt]); } }
#pragma unroll
        for (int nt = 0; nt < 3; ++nt)
#pragma unroll
            for (int r = 0; r < 4; ++r) part[(w * 16 + 4 * (lane >> 4) + r) * 48 + 16 * nt + (lane & 15)] = acc[nt][r];
        __syncthreads();
        for (int t = tid; t < 576; t += 512) { const int r = t / 36, c = t - r * 36; float sacc = 0.f;
#pragma unroll
            for (int q = 0; q < 8; ++q) sacc += part[(q * 16 + r) * 48 + c];
            lg[r * 40 + c] = sacc + (c < 32 ? be[c] : bg[c - 32]); }
        __syncthreads();
        if (tid < 16) { const int row = base + tid; const LAS float* lr = lg + tid * 40;
            int gi = 0; float gm = lr[32];
#pragma unroll
            for (int i = 1; i < 4; ++i) if (lr[32 + i] > gm) { gm = lr[32 + i]; gi = i; }
            float gs = 0.f;
#pragma unroll
            for (int i = 0; i < 4; ++i) gs += __expf(lr[32 + i] - gm);
            const float gw_ = 1.f / gs;
            const LAS float* el = lr + gi * 8;
            int i1 = 0; float v1 = el[0];
#pragma unroll
            for (int j = 1; j < 8; ++j) if (el[j] > v1) { v1 = el[j]; i1 = j; }
            int i2 = -1; float v2 = -3.0e38f;
#pragma unroll
            for (int j = 0; j < 8; ++j) if (j != i1 && el[j] > v2) { v2 = el[j]; i2 = j; }
            const float e2 = __expf(v2 - v1), g1 = gw_ / (1.f + e2), g2 = gw_ * e2 / (1.f + e2);
            const int e0 = gi * 8 + i1, e1 = gi * 8 + i2;
            const unsigned r0 = __hip_atomic_fetch_add(cnt + e0 * 64, 1u, __ATOMIC_RELAXED, __HIP_MEMORY_SCOPE_AGENT), r1 = __hip_atomic_fetch_add(cnt + e1 * 64, 1u, __ATOMIC_RELAXED, __HIP_MEMORY_SCOPE_AGENT);
            *(int4*)(ri + (size_t)row * 4) = make_int4(e0, e1, (int)r0, (int)r1);
            { int* lists = (int*)(F.ws + WS_LISTS); lists[(size_t)e0 * MTOK + r0] = row; lists[(size_t)e1 * MTOK + r1] = row; }
            rg[(size_t)row * 2 + 0] = g1; rg[(size_t)row * 2 + 1] = g2; }
    }
}
__device__ __forceinline__ int moe_starts(Frame& F, int l, int& total) {
    unsigned* cnt = (unsigned*)(F.ws + WS_CTL) + CW_CNT + l * 32 * 64;
    const int c = F.lane < 32 ? (int)__hip_atomic_load(cnt + (F.lane & 31) * 64, __ATOMIC_RELAXED, __HIP_MEMORY_SCOPE_AGENT) : 0;
    const int padded = (c + 255) & ~255; int incl = padded;
#pragma unroll
    for (int o = 1; o < 32; o <<= 1) { const int t = shfl_i(incl, F.lane - o); if (F.lane >= o) incl += t; }
    total = shfl_i(incl, 31);
    return incl - padded;
}
__device__ __forceinline__ void moe_gather_phase(Frame& F, int l, int nrows) {
    const bf16_t* H = (const bf16_t*)(F.ws + WS_H); bf16_t* XS = (bf16_t*)(F.ws + WS_Z + MZ_XS); const int* ri = (const int*)(F.ws + WS_ROUTE);
    int total; const int st = moe_starts(F, l, total);
    for (int row = F.gw; row < nrows; row += F.NGW) {
        const int e0 = ri[(size_t)row * 4], e1 = ri[(size_t)row * 4 + 1], r0 = ri[(size_t)row * 4 + 2], r1 = ri[(size_t)row * 4 + 3];
        const int d0 = shfl_i(st, e0) + r0, d1 = shfl_i(st, e1) + r1;
#pragma unroll
        for (int j = 0; j < 2; ++j) { const u32x4 w = *(const u32x4*)(H + (size_t)row * D + j * 512 + F.lane * 8);
            *(u32x4*)(XS + (size_t)d0 * D + j * 512 + F.lane * 8) = w; *(u32x4*)(XS + (size_t)d1 * D + j * 512 + F.lane * 8) = w; }
    }
}
__device__ __forceinline__ int moe_unit_wgid(int L, int nunits) { const int q = nunits / 8, r = nunits % 8, xcd = L % 8, off = L / 8; return (xcd < r ? xcd * (q + 1) : r * (q + 1) + (xcd - r) * q) + off; }
struct MoeOrder {
    int nunits, G, c; const LAS int* tile_e; const LAS int* rows;
    __device__ bool next(int i, pg8::Unit& u) const {
        const long L = (long)i * G + c; if (L >= nunits) return false;
        const int wgid = moe_unit_wgid((int)L, nunits), tile = wgid >> 2; const int te = tile_e[tile]; u.pm = tile; u.pn = (te & 255) * 4 + (wgid & 3); u.h = (te & 256) ? 0 : -1; return true;
    }
    __device__ unsigned a_row(int ui, int r) const { return (unsigned)rows[ui * 256 + r]; }
};
__device__ __forceinline__ int moe_build_tiles(Frame& F, int l, bool fill_rows) {
    LAS int* tbl = (LAS int*)(F.lds + TBL_OFF);
    __syncthreads();
    if (F.wave == 0) { int total; const int st = moe_starts(F, l, total); if (F.lane < 32) { tbl[F.lane] = st;
            tbl[256 + F.lane] = (int)__hip_atomic_load((unsigned*)(F.ws + WS_CTL) + CW_CNT + (l * 32 + F.lane) * 64, __ATOMIC_RELAXED, __HIP_MEMORY_SCOPE_AGENT); }
        if (F.lane == 0) tbl[32] = total; }
    __syncthreads();
    const int total = tbl[32], ntiles = total >> 8;
    for (int t = F.tid; t < ntiles; t += 512) { int e = 0;
#pragma unroll
        for (int j = 1; j < 32; ++j) if (tbl[j] <= t * 256) e = j;
        tbl[64 + t] = e | ((tbl[256 + e] - (t * 256 - tbl[e]) <= 128) ? 256 : 0); }
    __syncthreads();
    if (fill_rows) { const int* lists = (const int*)(F.ws + WS_LISTS); const int nunits = ntiles * 4;
        for (int x = F.tid; x < 768; x += 512) { const int ui = x >> 8, r = x & 255, L = ui * F.G + (int)blockIdx.x; int src = 0;
            if (L < nunits) { const int tile = moe_unit_wgid(L, nunits) >> 2, e = tbl[64 + tile] & 255, rank = tile * 256 - tbl[e] + r; if (rank < tbl[256 + e]) src = lists[(size_t)e * MTOK + rank]; }
            tbl[512 + x] = src; }
        __syncthreads(); }
    return ntiles;
}
__device__ __forceinline__ void moe_combine_phase(Frame& F, ArgsP a, int l, int nrows, bool dry = false) {
    float* X = (float*)(F.ws + WS_X); float* Xo = dry ? (float*)(F.ws + WS_Z + 132 * MiB) : X; float* outp = dry ? Xo : a->out; bf16_t* H = (bf16_t*)(F.ws + WS_H); const bf16_t* Y = (const bf16_t*)(F.ws + WS_Z + MZ_XS);
    const int* ri = (const int*)(F.ws + WS_ROUTE); const float* rg = (const float*)(F.ws + WS_ROUTE + (size_t)MTOK * 16);
    const float* modv = (const float*)(F.ws + WS_MODV);
    int total; const int st = moe_starts(F, l, total);
    for (int row = F.gw; row < nrows; row += F.NGW) {
        const int e0 = ri[(size_t)row * 4], e1 = ri[(size_t)row * 4 + 1], r0 = ri[(size_t)row * 4 + 2], r1 = ri[(size_t)row * 4 + 3];
        const int p0 = shfl_i(st, e0) + r0, p1 = shfl_i(st, e1) + r1; const float g0 = rg[(size_t)row * 2], g1 = rg[(size_t)row * 2 + 1];
        const float* mv = modv + ((size_t)l * 9 + tok_modrow(row)) * 6144;
        f32x4 v[4];
#pragma unroll
        for (int j = 0; j < 4; ++j) { const int c = 4 * F.lane + 256 * j;
            const u32x2 y0 = *(const u32x2*)(Y + (size_t)p0 * D + c), y1 = *(const u32x2*)(Y + (size_t)p1 * D + c);
            const f32x4 f = { g0 * bflo(y0.x) + g1 * bflo(y1.x), g0 * bfhi(y0.x) + g1 * bfhi(y1.x), g0 * bflo(y0.y) + g1 * bflo(y1.y), g0 * bfhi(y0.y) + g1 * bfhi(y1.y) };
            v[j] = *(const f32x4*)(X + (size_t)row * D + c) + *(const f32x4*)(mv + 5 * 1024 + c) * f; }
        if (l == 0) {
#pragma unroll
            for (int j = 0; j < 4; ++j) *(f32x4*)(Xo + (size_t)row * D + 4 * F.lane + 256 * j) = v[j];
            f32x4 h[4]; const float* mv1 = modv + ((size_t)9 + tok_modrow(row)) * 6144;
            norm_mod_row(v, h, a->in[6] + D, mv1, mv1 + 1024, F.lane);
            store_row_bf16(H + (size_t)row * D, h, F.lane);
        } else {
            float ss = 0.f;
#pragma unroll
            for (int j = 0; j < 4; ++j) ss += (v[j][0] * v[j][0] + v[j][1] * v[j][1]) + (v[j][2] * v[j][2] + v[j][3] * v[j][3]);
            const float rstd = rsqrtf(wave_sum(ss) * (1.f / D) + EPS);
#pragma unroll
            for (int j = 0; j < 4; ++j) { const int c = 4 * F.lane + 256 * j; *(f32x4*)(outp + (size_t)row * D + c) = v[j] * rstd * *(const f32x4*)(a->in[37] + c); }
        }
    }
}

#define REOPAQUE() { unsigned m1_ = ~0u; asm volatile("" : "+s"(m1_)); int ln_ = __builtin_amdgcn_mbcnt_hi(m1_, __builtin_amdgcn_mbcnt_lo(m1_, 0u)); asm volatile("" : "+v"(ln_)); F.lane = ln_; F.wave = wave_s; F.tid = wave_s * 64 + ln_; F.gw = F.vcu * NWAVES + F.wave; int z_ = 0; asm volatile("" : "+s"(z_)); args = (ArgsP)__builtin_amdgcn_kernarg_segment_ptr() + z_; F.ws = args->ws; }
#define PH_BEGIN if (ph >= lo && ph < hi) { REOPAQUE()
#define PH_END } if (ph >= lo && ph + 1 < hi) { if (!MK_PER_PHASE) REP(15) xcd_barrier_fn(bar.bar, bar.x, (unsigned)(uintptr_t)bar.st, F.tid); } ++ph;

#define pH ((bf16_t*)(F.ws + WS_H))
#define pZ ((bf16_t*)(F.ws + WS_Z))
#define pX ((float*)(F.ws + WS_X))
#define pMix (F.ws + WS_MIX)
#define pSsq ((float*)(F.ws + WS_SSQ))
#define pRope ((const float*)(F.ws + WS_ROPE))
#define pWl (F.ws + WS_WB + (size_t)l * WL_STRIDE)
#define pModv ((const float*)(F.ws + WS_MODV) + (size_t)l * 9 * 6144)


template <int l> __device__ __forceinline__ void layer_prog(Frame& F, ArgsP& args, int& ph, const int lo, const int hi, const XcdBarrier& bar, const int wave_s) {
        const bool need_ctx = (l == 0); const int nrows = need_ctx ? MTOK : NLAT;

        PH_BEGIN REP(1) { pg8::Gemm g{pH, (const bf16_t*)(pWl + WL_WIN), D, D, D};
            Epi<EM_Z> E{}; E.ssq = pSsq; E.rope = pRope; E.o0 = pZ; E.o1 = (bf16_t*)(pMix + MX_KPE); E.o2 = (bf16_t*)(pMix + MX_S5A);
            if constexpr (l == 0) { pg8::StaticOrder S; S.init(MTOK, ZC, F.G, (int)blockIdx.x); pg8::gemm_phase(F.lds, F.tid, g, S, E); }
            else { WinOrderLast S; S.S0.init(NLAT, ZC, F.G, (int)blockIdx.x); S.G = F.G; S.c = (int)blockIdx.x; pg8::gemm_phase(F.lds, F.tid, g, S, E); } } PH_END

        PH_BEGIN {
            REP(2) { pg8::Gemm g{pZ + ZCQ, (const bf16_t*)(pWl + WL_UQ), 256, ZC, 256}; pg8::StaticOrder S; S.init(nrows, 768, F.G, ((int)blockIdx.x + F.G - 32) % F.G);
              Epi<EM_Q> E{}; E.ssq = pSsq; E.rope = pRope; E.o0 = (bf16_t*)(pMix + MX_Q); pg8::gemm_phase(F.lds, F.tid, g, S, E); }
            REOPAQUE()
            REP(2) { pg8::Gemm g{pZ + ZCKV, (const bf16_t*)(pWl + WL_UKV), 128, ZC, 128}; pg8::StaticOrder S; S.init(MTOK, 1024, F.G, (int)blockIdx.x);
              Epi<EM_KV> E{}; E.ssq = pSsq; E.o0 = (bf16_t*)(pMix + MX_KN); E.o1 = (bf16_t*)(pMix + MX_V); pg8::gemm_phase(F.lds, F.tid, g, S, E); }
            REOPAQUE()
#if NAIVE_S5
            s5_naive(F, args, l);
#else
            REP(3) s5_state_phase(F, l);
#endif
            REOPAQUE()
#if NAIVE_HG
            hg_naive(F, args, l);
#else
            REP(4) hg_local_phase(F, args, l);
#endif
        } PH_END

        PH_BEGIN {
#if NAIVE_ATTN
            attn_naive(F, need_ctx);
#else
#if PROBE_PH >= 50 && PROBE_PH < 60
            attn_fast<PROBE_PH - 49>(F, need_ctx, (bf16_t*)args->out); REOPAQUE()
#endif
            attn_fast<0>(F, need_ctx, (bf16_t*)(pMix + MX_YMLA));
#endif
            REOPAQUE()
#if NAIVE_S5
            s5_naive_finish(F, args, l, nrows);
#else
            REP(6) { pg8::Gemm g{(const bf16_t*)(pMix + MX_S5A), (const bf16_t*)(pWl + WL_B2), 512, 512, 512}; S5Order S{F.G, (F.vcu + F.G - 64) % F.G};
              Epi<EM_S5> E{}; E.o0 = (bf16_t*)(pMix + MX_YS5P); E.i0 = (const bf16_t*)(pMix + MX_S5A); E.f0 = args->in[16] + l * 256; pg8::gemm_phase(F.lds, F.tid, g, S, E); }
#endif
            REOPAQUE()
#if NAIVE_HG
            hg_naive_finish(F, args, l, nrows);
#else
            hg_scan_phase(F);
#endif
        } PH_END

        PH_BEGIN {
#if !NAIVE_HG
            REP(7) hg_out_phase(F, args, l, need_ctx);
            REOPAQUE()
#endif
            REP(8) { pg8::Gemm g{(const bf16_t*)(pMix + MX_YS5P), (const bf16_t*)(pWl + WL_GLU), 256, 256, 256}; pg8::StaticOrder S; S.init(nrows, 256, F.G, (F.vcu + F.G - 128) % F.G);
            Epi<EM_GLU> E{}; E.o0 = (bf16_t*)(pMix + MX_YS5); E.i0 = (const bf16_t*)(pMix + MX_YS5P); E.f0 = args->in[18] + l * 256;
            pg8::gemm_phase(F.lds, F.tid, g, S, E); } } PH_END

        PH_BEGIN {
#define MERGE3(S, HS) do { \
            { pg8::Gemm g{(const bf16_t*)(pMix + MX_YS5), (const bf16_t*)(pWl + WL_PA), 256, 256, 256}; Epi<EM_MERGE0> E{}; E.o0 = pH; E.i0 = pZ + ZGA; pg8::gemm_phase<Epi<EM_MERGE0>, decltype(S), false, HS>(F.lds, F.tid, g, S, E); } \
            { pg8::Gemm g{(const bf16_t*)(pMix + MX_YMLA), (const bf16_t*)(pWl + WL_PB), 512, 512, 512}; Epi<EM_MERGE1> E{}; E.o0 = pH; E.i0 = pZ + ZGB; pg8::gemm_phase<Epi<EM_MERGE1>, decltype(S), false, HS>(F.lds, F.tid, g, S, E); } \
            { pg8::Gemm g{(const bf16_t*)(pMix + MX_YHG), (const bf16_t*)(pWl + WL_PC), 256, 256, 256}; Epi<EM_MERGE1> E{}; E.o0 = pH; E.i0 = pZ + ZGC; pg8::gemm_phase<Epi<EM_MERGE1>, decltype(S), false, HS>(F.lds, F.tid, g, S, E); } } while (0)
            if constexpr (l == 0) { HalfTailOrder S; S.S0.init(NLAT, 1024, F.G, (int)blockIdx.x); S.G = F.G; S.c = (int)blockIdx.x; MERGE3(S, true); }
            else { pg8::StaticOrder S; S.init(NLAT, 1024, F.G, (int)blockIdx.x); MERGE3(S, false); }
#undef MERGE3
        } PH_END

        PH_BEGIN { pg8::Gemm g{pH, (const bf16_t*)(pWl + WL_OUT), D, D, D};
            Epi<EM_WOUT> E{}; E.layer = l; E.f0 = pModv; E.f1 = args->in[0]; E.f2 = args->in[2]; E.fo = pX;
            if constexpr (l == 0) { HalfTailOrder S; S.S0.init(NLAT, 1024, F.G, (int)blockIdx.x); S.G = F.G; S.c = (int)blockIdx.x; pg8::gemm_phase<Epi<EM_WOUT>, HalfTailOrder, false, true>(F.lds, F.tid, g, S, E); }
            else { pg8::StaticOrder S; S.init(NLAT, 1024, F.G, (int)blockIdx.x); pg8::gemm_phase(F.lds, F.tid, g, S, E); } } PH_END

        PH_BEGIN { norm2_router_phase(F, args, l, nrows); REOPAQUE() REP(11) moe_convert(F, args, l); } PH_END
        PH_BEGIN REP(13) { const int nt = moe_build_tiles(F, l, true); MoeOrder S{nt * 4, F.G, (int)blockIdx.x, (const LAS int*)(F.lds + TBL_OFF) + 64, (const LAS int*)(F.lds + TBL_OFF) + 512};
            pg8::Gemm g{pH, (const bf16_t*)(pMix + MW_W13), D, D, D};
            Epi<EM_MOEUP> E{}; E.o0 = (bf16_t*)(F.ws + WS_Z + MZ_HID); pg8::gemm_phase<Epi<EM_MOEUP>, MoeOrder, true, true>(F.lds, F.tid, g, S, E); } PH_END
        PH_BEGIN REP(14) { const int nt = moe_build_tiles(F, l, false); MoeOrder S{nt * 4, F.G, (int)blockIdx.x, (const LAS int*)(F.lds + TBL_OFF) + 64, (const LAS int*)(F.lds + TBL_OFF) + 512};
            pg8::Gemm g{(const bf16_t*)(F.ws + WS_Z + MZ_HID), (const bf16_t*)(pMix + MW_W2), HID, HID, HID};
            Epi<EM_MOEDN> E{}; E.o0 = (bf16_t*)(F.ws + WS_Z + MZ_XS); pg8::gemm_phase<Epi<EM_MOEDN>, MoeOrder, false, true>(F.lds, F.tid, g, S, E); } PH_END
        PH_BEGIN { if (PROBE_PH == 19) { moe_combine_phase(F, args, l, nrows, true); REOPAQUE() } moe_combine_phase(F, args, l, nrows); } PH_END
    }

__global__ void __launch_bounds__(NWAVES * 64, 2) mega_fwd(Args args_by_value) {
    ArgsP args = (ArgsP)__builtin_amdgcn_kernarg_segment_ptr();
    extern __shared__ __attribute__((aligned(16))) unsigned char lds_raw[];
    Frame F;
    F.lds = (LAS unsigned char*)lds_raw;
    F.tid = threadIdx.x; F.lane = F.tid & 63; F.wave = __builtin_amdgcn_readfirstlane(F.tid >> 6);
    const int wave_s = F.wave;
    F.G = gridDim.x; { const int bx = blockIdx.x; F.vcu = (F.G % 8 == 0) ? (bx % 8) * (F.G / 8) + bx / 8 : bx; }
    F.gw = F.vcu * NWAVES + F.wave; F.NGW = F.G * NWAVES; F.ws = args->ws;
    volatile LAS unsigned* MISC = (volatile LAS unsigned*)(F.lds + MISC_OFF);
    for (int u = F.tid; u < (LDS_BYTES - RING_BYTES) / 4; u += NWAVES * 64) ((LAS unsigned*)(F.lds + RING_BYTES))[u] = 0u;
    __syncthreads();
    unsigned* ctl = (unsigned*)(F.ws + WS_CTL);
    XcdBarrier bar; bar.bar = ctl + CW_BAR; bar.x = 0; bar.st = nullptr;
    if (!MK_PER_PHASE) bar = xcd_barrier_post(ctl + CW_BAR, MISC + 8);
    const int lo = args->ph_lo, hi = args->ph_hi;
    int ph = 0;
    PH_BEGIN REP(17) prologue_phase(F, args); PH_END
    PH_BEGIN REP(16) norm1_phase(F, args, 0, MTOK); PH_END

    layer_prog<0>(F, args, ph, lo, hi, bar, wave_s);
    layer_prog<1>(F, args, ph, lo, hi, bar, wave_s);
#undef PH_BEGIN
#undef REOPAQUE
#undef PH_END
#undef pH
#undef pZ
#undef pX
#undef pMix
#undef pSsq
#undef pRope
#undef pWl
#undef pModv
}
constexpr int N_PHASES = 2 + 2 * 10;

extern "C" void kernel_launch(void* const* d_in, const int* in_sizes, int n_in, void* d_out, int out_size, void* d_ws, size_t ws_size, hipStream_t stream) {
    static int grid = 0;
    if (grid == 0) {
        if (n_in != 38 || out_size != NLAT * D || ws_size < WS_END) { fprintf(stderr, "kernel_launch: unexpected shapes (n_in %d out %d ws %zu need %zu)\n", n_in, out_size, ws_size, (size_t)WS_END); grid = -1; return; }
        int dev = 0, cus = 0, per_cu = 0;
        if (hipGetDevice(&dev) != hipSuccess || hipDeviceGetAttribute(&cus, hipDeviceAttributeMultiprocessorCount, dev) != hipSuccess) { grid = -1; return; }
        if (hipFuncSetAttribute((const void*)mega_fwd, hipFuncAttributeMaxDynamicSharedMemorySize, LDS_BYTES) != hipSuccess) { fprintf(stderr, "kernel_launch: hipFuncSetAttribute failed\n"); grid = -1; return; }
        if (hipOccupancyMaxActiveBlocksPerMultiprocessor(&per_cu, (const void*)mega_fwd, NWAVES * 64, LDS_BYTES) != hipSuccess || per_cu < 1) { fprintf(stderr, "kernel_launch: occupancy query says %d\n", per_cu); }
        (void)hipGetLastError();
        grid = cus;
    }
    if (grid < 0) return;
    (void)hipMemsetAsync((char*)d_ws + WS_CTL, 0, CTL_ZERO_BYTES, stream);
    Args a{};
    for (int i = 0; i < 38; ++i) a.in[i] = (const float*)d_in[i];
    a.out = (float*)d_out; a.ws = (unsigned char*)d_ws;
#if MK_PER_PHASE
    for (int p = 0; p < N_PHASES; ++p) { a.ph_lo = p; a.ph_hi = p + 1; hipLaunchKernelGGL(mega_fwd, dim3(grid), dim3(NWAVES * 64), LDS_BYTES, stream, a); }
#else
    a.ph_lo = 0; a.ph_hi = N_PHASES;
    hipLaunchKernelGGL(mega_fwd, dim3(grid), dim3(NWAVES * 64), LDS_BYTES, stream, a);
#endif
}
```

```cpp
#include <hip/hip_runtime.h>
#include <cstdio>
#include <cstdint>

#ifndef NAIVE_ATTN
#define NAIVE_ATTN 0
#endif
#ifndef NAIVE_S5
#define NAIVE_S5 0
#endif
#ifndef NAIVE_HG
#define NAIVE_HG 0
#endif
#ifndef PROBE_PH
#define PROBE_PH 0
#endif
#ifndef PROBE_N
#define PROBE_N 1
#endif
#define REP(id) for (int rep_ = 0; rep_ < ((PROBE_PH == (id)) ? PROBE_N : 1); ++rep_)
#ifndef MK_PER_PHASE
#define MK_PER_PHASE 0
#endif

#define GAS __attribute__((address_space(1)))
#define LAS __attribute__((address_space(3)))
typedef unsigned short bf16_t;
typedef short bf16x8 __attribute__((ext_vector_type(8)));
typedef float f32x4 __attribute__((ext_vector_type(4)));
typedef float f32x2 __attribute__((ext_vector_type(2)));
typedef float f32x16 __attribute__((ext_vector_type(16)));
typedef unsigned u32x4 __attribute__((ext_vector_type(4)));
typedef unsigned u32x2 __attribute__((ext_vector_type(2)));
typedef GAS unsigned gu32;

constexpr int D = 1024, NB = 8, SEQ = 2048, CTXL = 256, NLAT = NB * SEQ, NCTX = NB * CTXL, MTOK = NLAT + NCTX;
constexpr int ZC = 5888, INC = 5792;
constexpr int ZU = 0, ZCQ = 256, ZCKV = 512, ZKPE = 640, ZHQ = 672, ZF0 = 1184, ZF1 = 1696, ZI = 2208, ZG = 2464, ZGA = 2720, ZGB = 3744, ZGC = 4768;
constexpr float EPS = 1e-6f;
constexpr float QSCALE = 0.10206207261596577f * 1.4426950408889634f;
constexpr int NEXP = 32, HID = 512;
constexpr int XS_ROWS = 45056;

constexpr size_t MiB = 1u << 20;
constexpr size_t WS_CTL = 0, CTL_ZERO_BYTES = 96 * 1024;
constexpr size_t WS_MODV = 1 * MiB;
constexpr size_t WS_ROPE = 2 * MiB;
constexpr size_t WS_SSQ = 2 * MiB + 65536;
constexpr size_t WS_ROUTE = 3 * MiB;
constexpr size_t WS_S5P = 4 * MiB;
constexpr size_t WS_LISTS = 5 * MiB;
constexpr size_t WS_WB = 8 * MiB;
constexpr size_t WL_WIN = 0, WL_UQ = WL_WIN + (size_t)ZC * D * 2, WL_UKV = WL_UQ + 768 * 256 * 2, WL_GLU = WL_UKV + 1024 * 128 * 2,
                 WL_PA = WL_GLU + 256 * 256 * 2, WL_PB = WL_PA + 1024 * 256 * 2, WL_PC = WL_PB + 1024 * 512 * 2, WL_OUT = WL_PC + 1024 * 256 * 2,
                 WL_BS = WL_OUT + 1024 * 1024 * 2, WL_B2 = WL_BS + 32 * 128 * 256 * 2, WL_END = WL_B2 + 16 * 256 * 512 * 2;
constexpr size_t WL_STRIDE = 24 * MiB;
static_assert(WL_END <= WL_STRIDE, "weights per layer");
constexpr size_t WS_X = 56 * MiB;
constexpr size_t WS_H = 128 * MiB;
constexpr size_t WS_MIX = 164 * MiB;
constexpr size_t MX_Q = 0, MX_KN = MX_Q + (size_t)MTOK * 768 * 2, MX_V = MX_KN + (size_t)MTOK * 512 * 2, MX_KPE = MX_V + (size_t)MTOK * 512 * 2,
                 MX_YS5P = MX_KPE + (size_t)MTOK * 32 * 2, MX_YS5 = MX_YS5P + (size_t)MTOK * 256 * 2, MX_YHG = MX_YS5 + (size_t)MTOK * 256 * 2,
                 MX_YMLA = MX_YHG + (size_t)MTOK * 256 * 2, MX_S5A = MX_YMLA + (size_t)MTOK * 512 * 2, MX_HGD = MX_S5A + (size_t)16 * 1280 * 512 * 2,
                 MX_END = MX_HGD + (size_t)2304 * 128 * 4;
static_assert(MX_END <= 132 * MiB, "mixer region");
constexpr size_t MW_W13 = 0, MW_W2 = (size_t)NEXP * 1024 * 1024;
static_assert(MW_W2 + (size_t)NEXP * 1024 * 512 <= 132 * MiB, "moe weights");
constexpr size_t WS_Z = 296 * MiB;
constexpr size_t MZ_XS = 0, MZ_HID = (size_t)XS_ROWS * 1024 * 2;
constexpr size_t MZ_H8 = MZ_HID + (size_t)XS_ROWS * 512;
constexpr float W8_SCALE = 32.f, W8_INV = 1.f / 32.f;
constexpr size_t WS_END = WS_Z + (size_t)MTOK * ZC * 2;
static_assert(MZ_HID + (size_t)XS_ROWS * 512 * 2 <= (size_t)MTOK * ZC * 2, "moe buffers");
constexpr int CW_BAR = 4096;
constexpr int CW_CNT = 16384;

__device__ __forceinline__ unsigned f2bf(float f) { unsigned u = __builtin_bit_cast(unsigned, f); return (u + 0x7fffu + ((u >> 16) & 1u)) >> 16; }
typedef __bf16 bf16x2_t __attribute__((ext_vector_type(2)));
__device__ __forceinline__ unsigned pk2(float lo, float hi) { const f32x2 v = {lo, hi}; return __builtin_bit_cast(unsigned, __builtin_convertvector(v, bf16x2_t)); }
__device__ __forceinline__ unsigned pk4_fp8(float a, float b, float c, float d) { int w = 0; a = __builtin_amdgcn_fmed3f(a, 448.f, -448.f); b = __builtin_amdgcn_fmed3f(b, 448.f, -448.f); c = __builtin_amdgcn_fmed3f(c, 448.f, -448.f); d = __builtin_amdgcn_fmed3f(d, 448.f, -448.f); w = __builtin_amdgcn_cvt_pk_fp8_f32(a, b, w, false); w = __builtin_amdgcn_cvt_pk_fp8_f32(c, d, w, true); return (unsigned)w; }
__device__ __forceinline__ float bf2f(unsigned short b) { return __builtin_bit_cast(float, (unsigned)b << 16); }
__device__ __forceinline__ float bflo(unsigned w) { return __builtin_bit_cast(float, w << 16); }
__device__ __forceinline__ float bfhi(unsigned w) { return __builtin_bit_cast(float, w & 0xffff0000u); }
template <int CTRL> __device__ __forceinline__ float dppf(float v) { return __builtin_bit_cast(float, __builtin_amdgcn_update_dpp(0, __builtin_bit_cast(int, v), CTRL, 0xf, 0xf, true)); }
__device__ __forceinline__ float rlanef(float v, int l) { return __builtin_bit_cast(float, __builtin_amdgcn_readlane(__builtin_bit_cast(int, v), l)); }
__device__ __forceinline__ float wave_sum(float v) {
    v += dppf<0xB1>(v); v += dppf<0x4E>(v); v += dppf<0x141>(v); v += dppf<0x140>(v);
    return (rlanef(v, 0) + rlanef(v, 16)) + (rlanef(v, 32) + rlanef(v, 48));
}
__device__ __forceinline__ int shfl_i(int v, int src_lane) { return __builtin_amdgcn_ds_bpermute(src_lane << 2, v); }
__device__ __forceinline__ float shfl_f(float v, int src_lane) { return __builtin_bit_cast(float, __builtin_amdgcn_ds_bpermute(src_lane << 2, __builtin_bit_cast(int, v))); }
__device__ __forceinline__ float sigmoidf_(float x) { return __builtin_amdgcn_rcpf(1.f + __expf(-x)); }
__device__ __forceinline__ float siluf_(float x) { return x * __builtin_amdgcn_rcpf(1.f + __expf(-x)); }
__device__ __forceinline__ float gelu_tanh(float x) { const float t = 0.7978845608028654f * (x + 0.044715f * x * x * x); return x * __builtin_amdgcn_rcpf(1.f + __expf(-2.f * t)); }
__device__ __forceinline__ int tok_modrow(int row) { return row < NLAT ? (row >> 11) : 8; }

namespace pg8 {
constexpr int BM = 256, BK = 64, HALF = 128, HTB = HALF * BK * 2, STAGE_BYTES = 8 * HTB, NXCD = 8, WGM = 8;
__host__ __device__ __forceinline__ int lds_byte(int r, int c) { const int st = (r >> 4) * 2 + (c >> 5), rr = r & 15, cc = c & 31, ob = rr * 64 + cc * 2; return st * 1024 + (ob ^ (((ob >> 9) & 1) << 5)); }
__host__ __device__ __forceinline__ void stage_rc(int b, int& R, int& C) { const int st = b / 1024, sb = b % 1024, swz = sb ^ (((sb >> 9) & 1) << 5); R = (st >> 1) * 16 + swz / 64; C = (st & 1) * 32 + (swz % 64) / 2; }
__host__ __device__ __forceinline__ int perm32(int rho) { const int n = rho >> 4, i = rho & 15; return 8 * (i >> 2) + 4 * n + (i & 3); }
typedef int i32x8 __attribute__((ext_vector_type(8)));
typedef int i32x4_ __attribute__((ext_vector_type(4)));
__device__ __forceinline__ i32x8 cat8(bf16x8 lo, bf16x8 hi) { return __builtin_shufflevector(__builtin_bit_cast(i32x4_, lo), __builtin_bit_cast(i32x4_, hi), 0, 1, 2, 3, 4, 5, 6, 7); }
struct Unit { int pm, pn, h; };
struct Gemm { const bf16_t* A; const bf16_t* Bt; int K, lda, ldb; };
struct StaticOrder {
    int nM, nN, nwg, G, c;
    __device__ void init(int M, int N, int G_, int c_) { nM = M / BM; nN = N / BM; nwg = nM * nN; G = G_; c = c_; }
    __device__ bool next(int i, Unit& u) const {
        const long L = (long)i * G + c; if (L >= nwg) return false;
        int wgid = (int)L; { const int q = nwg / NXCD, r = nwg % NXCD, xcd = wgid % NXCD, off = wgid / NXCD; wgid = (xcd < r ? xcd * (q + 1) : r * (q + 1) + (xcd - r) * q) + off; }
        const int nig = WGM * nN, gid = wgid / nig, fm = gid * WGM, gsz = (nM - fm) < WGM ? (nM - fm) : WGM;
        u.pm = fm + ((wgid % nig) % gsz); u.pn = (wgid % nig) / gsz; u.h = -1; return true;
    }
};
template <class Epi, class Sched, bool GATHER = false, bool HALFS = false, bool FP8 = false>
__device__ __forceinline__ void gemm_phase(LAS unsigned char* lds, int tid_in, const Gemm g, const Sched& S, const Epi& E) {
    int tid_ = tid_in; asm volatile("" : "+v"(tid_));
    const int tid = tid_, wid = __builtin_amdgcn_readfirstlane(tid >> 6), lane = tid & 63, wr = wid >> 2, wc = wid & 3, fr = lane & 15, fq = lane >> 4;
    const int K = g.K, nt = K / BK;
    unsigned voffB[2], vAc[2][2], vAx[2][2];
#pragma unroll
    for (int i = 0; i < 2; ++i) { int R, C; stage_rc(tid * 16 + i * 8192, R, C); const int Rb = (R & ~31) + perm32(R & 31);
        voffB[i] = (unsigned)(Rb * g.ldb + C) * 2u;
#pragma unroll
        for (int h = 0; h < 2; ++h) vAc[h][i] = vAx[h][i] = (unsigned)((R + 128 * h) * g.lda + C) * 2u; }
#define PG8_GROWS(dst, uidx) do { if constexpr (GATHER) { _Pragma("unroll") for (int i_ = 0; i_ < 2; ++i_) { int R_, C_; stage_rc(tid * 16 + i_ * 8192, R_, C_); \
        _Pragma("unroll") for (int h_ = 0; h_ < 2; ++h_) dst[h_][i_] = (unsigned)(S.a_row((uidx), R_ + 128 * h_) * g.lda + C_) * 2u; } } } while (0)
    const size_t kstep = (size_t)(BK * 2);
    const size_t hstepA = (size_t)HALF * g.lda * 2, hstepB = (size_t)HALF * g.ldb * 2;
    const size_t tstepA = 2 * hstepA, tstepB = 2 * hstepB;
    const unsigned ldsw = (unsigned)wid * 1024u;
    const int aoff = lds_byte(wr * 64 + fr, fq * 8), boff = lds_byte(wc * 32 + fr, fq * 8);
#define PG8_SA(b, h) (((b) * 2 + (h)) * HTB)
#define PG8_SB(b, h) ((4 + (b) * 2 + (h)) * HTB)
#define PG8_STAGE(bufoff, gbase, voff) do { _Pragma("unroll") for (int _i = 0; _i < 2; ++_i) \
        __builtin_amdgcn_global_load_lds((const unsigned*)((const char*)(gbase) + (voff)[_i]), (LAS unsigned*)(lds + (bufoff) + ldsw + _i * 8192), 16, 0, 0); } while (0)
#define PG8_LDA(dst, b, h) do { _Pragma("unroll") for (int m = 0; m < 4; ++m) _Pragma("unroll") for (int k = 0; k < 2; ++k) dst[m][k] = *(const LAS bf16x8*)(lds + PG8_SA(b, h) + aoff + m * 2048 + k * 1024); } while (0)
#define PG8_LDB(dst, b, h) do { _Pragma("unroll") for (int n = 0; n < 2; ++n) _Pragma("unroll") for (int k = 0; k < 2; ++k) dst[n][k] = *(const LAS bf16x8*)(lds + PG8_SB(b, h) + boff + n * 2048 + k * 1024); } while (0)
#define PG8_MMA(ai, bj, At, Bt) do { __builtin_amdgcn_s_setprio(1); _Pragma("unroll") for (int m = 0; m < 4; ++m) _Pragma("unroll") for (int n = 0; n < 2; ++n) { \
        if constexpr (FP8) asm volatile("v_mfma_scale_f32_16x16x128_f8f6f4 %0, %1, %2, %0, %3, %3 op_sel_hi:[0,0,0]" : "+v"(acc[ai][bj][m][n]) : "v"(cat8(Bt[n][0], Bt[n][1])), "v"(cat8(At[m][0], At[m][1])), "v"(sc8)); \
        else { _Pragma("unroll") for (int k = 0; k < 2; ++k) acc[ai][bj][m][n] = __builtin_amdgcn_mfma_f32_16x16x32_bf16(Bt[n][k], At[m][k], acc[ai][bj][m][n], 0, 0, 0); } } __builtin_amdgcn_s_setprio(0); } while (0)
#define PG8_WAIT_V(n) asm volatile("s_waitcnt vmcnt(" #n ")" ::: "memory")
#define PG8_WAIT_L(n) asm volatile("s_waitcnt lgkmcnt(" #n ")" ::: "memory")
#define PG8_BAR __builtin_amdgcn_s_barrier()
#define PG8_SCHED __builtin_amdgcn_sched_barrier(0)
    Unit cur, nxt; int ui = 0;
    if (!S.next(0, cur)) return;
    f32x4 acc[2][2][4][2];
#pragma unroll
    for (int a = 0; a < 2; ++a)
#pragma unroll
        for (int b = 0; b < 2; ++b)
#pragma unroll
            for (int m = 0; m < 4; ++m)
#pragma unroll
                for (int n = 0; n < 2; ++n) acc[a][b][m][n] = (f32x4){0.f, 0.f, 0.f, 0.f};
    bf16x8 At[4][2], B0[2][2], B1[2][2];
    int sc8 = 0x7F7F7F7F; asm volatile("" : "+v"(sc8));
    const char* cA = (const char*)g.A + (GATHER ? (size_t)0 : (size_t)cur.pm * tstepA); const char* cB = (const char*)g.Bt + (size_t)cur.pn * tstepB;
    PG8_GROWS(vAc, 0);
    PG8_STAGE(PG8_SB(0, 0), cB, voffB); PG8_STAGE(PG8_SB(0, 1), cB + hstepB, voffB); PG8_STAGE(PG8_SA(0, 0), cA, vAc[0]); PG8_STAGE(PG8_SA(0, 1), cA, vAc[1]);
    if (wr == 1) PG8_BAR;
    PG8_WAIT_V(2); PG8_BAR;
    PG8_STAGE(PG8_SB(1, 0), cB + kstep, voffB); PG8_STAGE(PG8_SA(1, 0), cA + kstep, vAc[0]); PG8_STAGE(PG8_SB(1, 1), cB + hstepB + kstep, voffB);
    PG8_WAIT_V(6); PG8_BAR;
    for (;;) {
        const bool has_next = S.next(ui + 1, nxt);
        const char* nA = (has_next && !GATHER) ? (const char*)g.A + (size_t)nxt.pm * tstepA : cA;
        if constexpr (GATHER) { if (has_next) PG8_GROWS(vAx, ui + 1); else {
#pragma unroll
            for (int h = 0; h < 2; ++h) { vAx[h][0] = vAc[h][0]; vAx[h][1] = vAc[h][1]; } } }
        const char* nB = has_next ? (const char*)g.Bt + (size_t)nxt.pn * tstepB : cB;
        asm volatile(".p2align 8" ::: "memory");
        for (int t = 0; t < nt; t += 2) {
            const bool last = (t == nt - 2);
            const char* a1 = cA + (size_t)(t + 1) * kstep;
            const char* a2 = last ? nA : cA + (size_t)(t + 2) * kstep; const char* b2 = last ? nB : cB + (size_t)(t + 2) * kstep;
            const char* a3 = a2 + kstep; const char* b3 = b2 + kstep;
            unsigned vS0[2], vS1[2];
            if constexpr (GATHER) { vS0[0] = last ? vAx[0][0] : vAc[0][0]; vS0[1] = last ? vAx[0][1] : vAc[0][1]; vS1[0] = last ? vAx[1][0] : vAc[1][0]; vS1[1] = last ? vAx[1][1] : vAc[1][1]; }
            else { vS0[0] = vAc[0][0]; vS0[1] = vAc[0][1]; vS1[0] = vAc[1][0]; vS1[1] = vAc[1][1]; }
            PG8_LDB(B0, 0, 0); PG8_LDB(B1, 0, 1); PG8_SCHED; PG8_LDA(At, 0, 0); PG8_STAGE(PG8_SA(1, 1), a1, vAc[1]);
            PG8_WAIT_V(8); PG8_WAIT_L(0); PG8_BAR; if (!HALFS || cur.h != 1) { PG8_MMA(0, 0, At, B0); PG8_MMA(0, 1, At, B1); } PG8_BAR; PG8_SCHED;
            PG8_LDA(At, 0, 1); PG8_STAGE(PG8_SB(0, 0), b2, voffB); PG8_STAGE(PG8_SB(0, 1), b2 + hstepB, voffB); PG8_STAGE(PG8_SA(0, 0), a2, vS0);
            PG8_WAIT_V(8); PG8_WAIT_L(0); PG8_BAR; if (!HALFS || cur.h != 0) { PG8_MMA(1, 0, At, B0); PG8_MMA(1, 1, At, B1); } PG8_BAR; PG8_SCHED;
            PG8_LDB(B0, 1, 0); PG8_LDB(B1, 1, 1); PG8_SCHED; PG8_LDA(At, 1, 0); PG8_STAGE(PG8_SA(0, 1), a2, vS1);
            PG8_WAIT_V(8); PG8_WAIT_L(0); PG8_BAR; if (!HALFS || cur.h != 1) { PG8_MMA(0, 0, At, B0); PG8_MMA(0, 1, At, B1); } PG8_BAR; PG8_SCHED;
            PG8_LDA(At, 1, 1); PG8_STAGE(PG8_SB(1, 0), b3, voffB); PG8_STAGE(PG8_SB(1, 1), b3 + hstepB, voffB); PG8_STAGE(PG8_SA(1, 0), a3, vS0);
            PG8_WAIT_V(8); PG8_WAIT_L(0); PG8_BAR; if (!HALFS || cur.h != 0) { PG8_MMA(1, 0, At, B0); PG8_MMA(1, 1, At, B1); } PG8_BAR; PG8_SCHED;
        }
        if constexpr (FP8) asm volatile("s_nop 15\n\ts_nop 15" ::: "memory");
        if (wr == 0) PG8_BAR;
        E(acc, cur, wr, wc, fr, fq);
        if (!has_next) break;
#pragma unroll
        for (int a = 0; a < 2; ++a)
#pragma unroll
            for (int b = 0; b < 2; ++b)
#pragma unroll
                for (int m = 0; m < 4; ++m)
#pragma unroll
                    for (int n = 0; n < 2; ++n) acc[a][b][m][n] = (f32x4){0.f, 0.f, 0.f, 0.f};
        cur = nxt; cA = nA; cB = nB; ++ui;
        if constexpr (GATHER) {
#pragma unroll
            for (int h = 0; h < 2; ++h) { vAc[h][0] = vAx[h][0]; vAc[h][1] = vAx[h][1]; } }
        if (wr == 1) PG8_BAR;
    }
    PG8_WAIT_V(0);
    PG8_BAR;
#undef PG8_SA
#undef PG8_SB
#undef PG8_STAGE
#undef PG8_GROWS
#undef PG8_LDA
#undef PG8_LDB
#undef PG8_MMA
#undef PG8_WAIT_V
#undef PG8_WAIT_L
#undef PG8_BAR
#undef PG8_SCHED
}
}

enum EpiMode { EM_Z = 0, EM_Q = 1, EM_KV = 2, EM_GLU = 3, EM_MERGE0 = 4, EM_MERGE1 = 5, EM_WOUT = 6, EM_MOEUP = 7, EM_MOEDN = 8, EM_S5 = 9 };
template <int mode> struct Epi {
    bf16_t* o0; bf16_t* o1; bf16_t* o2;
    const bf16_t* i0;
    const float* f0; const float* f1; const float* f2;
    float* fo;
    float* ssq;
    const float* rope;
    int layer;
    struct Side { u32x4 s[4]; };
    __device__ __forceinline__ Side load_side(const pg8::Unit& u, int ai, int m, int wr, int fr, int cl) const {
        Side S; const int row = u.pm * 256 + ai * 128 + wr * 64 + m * 16 + fr;
        if constexpr (mode == EM_Q) S.s[0] = *(const u32x4*)(ssq + (size_t)row * 4);
        else if constexpr (mode == EM_KV) S.s[0] = *(const u32x4*)(ssq + (size_t)MTOK * 4 + (size_t)row * 4);
        else if constexpr (mode == EM_GLU) { S.s[0] = *(const u32x4*)(i0 + (size_t)row * 256 + cl); S.s[1] = *(const u32x4*)(i0 + (size_t)row * 256 + 128 + cl); }
        else if constexpr (mode == EM_MERGE0 || mode == EM_MERGE1) { const int col = u.pn * 256 + cl;
            S.s[0] = *(const u32x4*)(i0 + (size_t)row * ZC + col); S.s[1] = *(const u32x4*)(i0 + (size_t)row * ZC + col + 128);
            if constexpr (mode == EM_MERGE1) { S.s[2] = __builtin_nontemporal_load((const u32x4*)(o0 + (size_t)row * 1024 + col)); S.s[3] = __builtin_nontemporal_load((const u32x4*)(o0 + (size_t)row * 1024 + col + 128)); } }
        else if constexpr (mode == EM_WOUT) { const float* xin = (layer == 0) ? (row < NLAT ? f1 + (size_t)row * D : f2 + (size_t)(row - NLAT) * D) : fo + (size_t)row * D; const int col = u.pn * 256 + cl;
            S.s[0] = *(const u32x4*)(xin + col); S.s[1] = *(const u32x4*)(xin + col + 4); S.s[2] = *(const u32x4*)(xin + col + 128); S.s[3] = *(const u32x4*)(xin + col + 132); }
        else if constexpr (mode == EM_S5) { S.s[0] = *(const u32x4*)(i0 + (size_t)row * 512 + cl); S.s[1] = *(const u32x4*)(i0 + (size_t)row * 512 + 128 + cl); }
        return S;
    }
    __device__ __forceinline__ void operator()(const f32x4 (&acc)[2][2][4][2], const pg8::Unit& u, int wr, int wc, int fr_in, int fq_in) const {
        int fr = fr_in, fq = fq_in; asm volatile("" : "+v"(fr), "+v"(fq));
        const int cl = wc * 32 + 8 * fq;
        f32x4 hc[4] = {};
        if constexpr (mode == EM_GLU) { hc[0] = *(const f32x4*)(f0 + cl); hc[1] = *(const f32x4*)(f0 + cl + 4); hc[2] = *(const f32x4*)(f0 + 128 + cl); hc[3] = *(const f32x4*)(f0 + 128 + cl + 4); }
        if constexpr (mode == EM_WOUT) { const float* gt = f0 + (size_t)tok_modrow(u.pm * 256) * 6144 + 2 * 1024 + u.pn * 256 + cl;
            hc[0] = *(const f32x4*)(gt); hc[1] = *(const f32x4*)(gt + 4); hc[2] = *(const f32x4*)(gt + 128); hc[3] = *(const f32x4*)(gt + 132); }
        if constexpr (mode == EM_S5) { const float* dk = f0 + u.pn * 16 + (cl & 15); hc[0] = *(const f32x4*)(dk); hc[1] = *(const f32x4*)(dk + 4); }
        Side cur = load_side(u, 0, 0, wr, fr, cl);
#pragma unroll
        for (int it = 0; it < 8; ++it) {
                const int ai = it >> 2, m = it & 3;
                if (u.h >= 0 && ai != u.h) { if (it < 7) cur = load_side(u, (it + 1) >> 2, (it + 1) & 3, wr, fr, cl); continue; }
                Side nxt = cur; if (it < 7) nxt = load_side(u, (it + 1) >> 2, (it + 1) & 3, wr, fr, cl);
                asm volatile("" ::: "memory");
                const int row = u.pm * 256 + ai * 128 + wr * 64 + m * 16 + fr;
                if constexpr (mode == EM_Z) {
                    float s0 = 0.f;
#pragma unroll
                    for (int bj = 0; bj < 2; ++bj) {
                        f32x4 v0 = acc[ai][bj][m][0], v1 = acc[ai][bj][m][1];
                        const int col = u.pn * 256 + bj * 128 + cl;
                        if (u.pn == 1 || (u.pn == 2 && bj == 0)) s0 += (v0[0] * v0[0] + v0[1] * v0[1]) + (v0[2] * v0[2] + v0[3] * v0[3]) + (v1[0] * v1[0] + v1[1] * v1[1]) + (v1[2] * v1[2] + v1[3] * v1[3]);
                        if (u.pn == 2 && bj == 1 && wc == 0) {
                            if (row < NLAT) {
                                const int t = row & 2047, pb = 4 * fq, axis = pb >> 3, pos = axis ? (t & 63) : (t >> 6);
                                const float* cs = rope + pos * 8 + (pb & 7); const float* sn = cs + 512;
                                float x1, x2;
                                x1 = v0[0]; x2 = v0[1]; v0[0] = x1 * cs[0] - x2 * sn[0]; v0[1] = x1 * sn[0] + x2 * cs[0];
                                x1 = v0[2]; x2 = v0[3]; v0[2] = x1 * cs[1] - x2 * sn[1]; v0[3] = x1 * sn[1] + x2 * cs[1];
                                x1 = v1[0]; x2 = v1[1]; v1[0] = x1 * cs[2] - x2 * sn[2]; v1[1] = x1 * sn[2] + x2 * cs[2];
                                x1 = v1[2]; x2 = v1[3]; v1[2] = x1 * cs[3] - x2 * sn[3]; v1[3] = x1 * sn[3] + x2 * cs[3];
                            }
                            u32x4 w; w.x = pk2(v0[0], v0[1]); w.y = pk2(v0[2], v0[3]); w.z = pk2(v1[0], v1[1]); w.w = pk2(v1[2], v1[3]);
                            *(u32x4*)(o1 + (size_t)row * 32 + 8 * fq) = w;
                        }
                        u32x4 w; w.x = pk2(v0[0], v0[1]); w.y = pk2(v0[2], v0[3]); w.z = pk2(v1[0], v1[1]); w.w = pk2(v1[2], v1[3]);
                        *(u32x4*)(o0 + (size_t)row * ZC + col) = w;
                        if (u.pn == 0) {
                            int b, s; if (row < NLAT) { b = row >> 11; s = 256 + (row & 2047); } else { b = (row - NLAT) >> 8; s = (row - NLAT) & 255; }
                            const int colu = bj * 128 + cl, g = colu >> 4, h0 = colu & 15;
                            *(u32x4*)(o2 + ((size_t)g * 1280 + b * 160 + (s >> 4)) * 512 + (s & 15) * 16 + h0) = w;
                        }
                    }
                    if (u.pn == 1 || u.pn == 2) {
                        { const int ln = fr + 16 * fq; s0 += shfl_f(s0, ln ^ 16); s0 += shfl_f(s0, ln ^ 32); }
                        if (fq == 0) ssq[(size_t)(u.pn - 1) * MTOK * 4 + (size_t)row * 4 + wc] = s0;
                    }
                } else if constexpr (mode == EM_Q || mode == EM_KV) {
                    const f32x4 sp = __builtin_bit_cast(f32x4, cur.s[0]);
                    const float rs = mode == EM_Q ? rsqrtf(((sp[0] + sp[1]) + (sp[2] + sp[3])) * (1.f / 256.f) + EPS) * QSCALE : rsqrtf(((sp[0] + sp[1]) + (sp[2] + sp[3])) * (1.f / 128.f) + EPS);
#pragma unroll
                    for (int bj = 0; bj < 2; ++bj) {
                        f32x4 v0 = acc[ai][bj][m][0] * rs, v1 = acc[ai][bj][m][1] * rs;
                        const int col = u.pn * 256 + bj * 128 + cl;
                        if constexpr (mode == EM_Q) { const int cc = col % 96;
                            if (cc >= 64 && row < NLAT) {
                                const int t = row & 2047, pb = (cc - 64) >> 1, axis = pb >> 3, pos = axis ? (t & 63) : (t >> 6);
                                const float* cs = rope + pos * 8 + (pb & 7); const float* sn = cs + 512;
                                float x1, x2;
                                x1 = v0[0]; x2 = v0[1]; v0[0] = x1 * cs[0] - x2 * sn[0]; v0[1] = x1 * sn[0] + x2 * cs[0];
                                x1 = v0[2]; x2 = v0[3]; v0[2] = x1 * cs[1] - x2 * sn[1]; v0[3] = x1 * sn[1] + x2 * cs[1];
                                x1 = v1[0]; x2 = v1[1]; v1[0] = x1 * cs[2] - x2 * sn[2]; v1[1] = x1 * sn[2] + x2 * cs[2];
                                x1 = v1[2]; x2 = v1[3]; v1[2] = x1 * cs[3] - x2 * sn[3]; v1[3] = x1 * sn[3] + x2 * cs[3];
                            } }
                        u32x4 w; w.x = pk2(v0[0], v0[1]); w.y = pk2(v0[2], v0[3]); w.z = pk2(v1[0], v1[1]); w.w = pk2(v1[2], v1[3]);
                        if constexpr (mode == EM_Q) *(u32x4*)(o0 + (size_t)row * 768 + col) = w;
                        else { bf16_t* dst = col < 512 ? o0 + (size_t)row * 512 + col : o1 + (size_t)row * 512 + (col - 512); *(u32x4*)dst = w; }
                    }
                } else if constexpr (mode == EM_GLU) {
#pragma unroll
                    for (int bj = 0; bj < 2; ++bj) {
                        const int col = bj * 128 + cl;
                        const f32x4 a0 = acc[ai][bj][m][0] + hc[2 * bj], a1 = acc[ai][bj][m][1] + hc[2 * bj + 1];
                        const u32x4 y = cur.s[bj];
                        u32x4 w;
                        w.x = pk2(bflo(y.x) * sigmoidf_(a0[0]), bfhi(y.x) * sigmoidf_(a0[1])); w.y = pk2(bflo(y.y) * sigmoidf_(a0[2]), bfhi(y.y) * sigmoidf_(a0[3]));
                        w.z = pk2(bflo(y.z) * sigmoidf_(a1[0]), bfhi(y.z) * sigmoidf_(a1[1])); w.w = pk2(bflo(y.w) * sigmoidf_(a1[2]), bfhi(y.w) * sigmoidf_(a1[3]));
                        *(u32x4*)(o0 + (size_t)row * 256 + col) = w;
                    }
                } else if constexpr (mode == EM_MERGE0 || mode == EM_MERGE1) {
#pragma unroll
                    for (int bj = 0; bj < 2; ++bj) {
                        const int col = u.pn * 256 + bj * 128 + cl;
                        const u32x4 gt = cur.s[bj];
                        const f32x4 a0 = acc[ai][bj][m][0], a1 = acc[ai][bj][m][1];
                        float r[8] = { a0[0] * sigmoidf_(bflo(gt.x)), a0[1] * sigmoidf_(bfhi(gt.x)), a0[2] * sigmoidf_(bflo(gt.y)), a0[3] * sigmoidf_(bfhi(gt.y)),
                                       a1[0] * sigmoidf_(bflo(gt.z)), a1[1] * sigmoidf_(bfhi(gt.z)), a1[2] * sigmoidf_(bflo(gt.w)), a1[3] * sigmoidf_(bfhi(gt.w)) };
                        if constexpr (mode == EM_MERGE1) { const u32x4 pv = cur.s[2 + bj];
                            r[0] += bflo(pv.x); r[1] += bfhi(pv.x); r[2] += bflo(pv.y); r[3] += bfhi(pv.y); r[4] += bflo(pv.z); r[5] += bfhi(pv.z); r[6] += bflo(pv.w); r[7] += bfhi(pv.w); }
                        u32x4 w; w.x = pk2(r[0], r[1]); w.y = pk2(r[2], r[3]); w.z = pk2(r[4], r[5]); w.w = pk2(r[6], r[7]);
                        *(u32x4*)(o0 + (size_t)row * 1024 + col) = w;
                    }
                } else if constexpr (mode == EM_WOUT) {
#pragma unroll
                    for (int bj = 0; bj < 2; ++bj) {
                        const int col = u.pn * 256 + bj * 128 + cl;
#pragma unroll
                        for (int n = 0; n < 2; ++n) *(f32x4*)(fo + (size_t)row * D + col + 4 * n) = __builtin_bit_cast(f32x4, cur.s[2 * bj + n]) + hc[2 * bj + n] * acc[ai][bj][m][n];
                    }
                } else if constexpr (mode == EM_MOEUP) {
                    const f32x4 a0 = acc[ai][0][m][0], a1 = acc[ai][0][m][1], b0 = acc[ai][1][m][0], b1 = acc[ai][1][m][1];
                    u32x2 w; w.x = pk4_fp8(siluf_(a0[0] * W8_INV) * (b0[0] * W8_INV), siluf_(a0[1] * W8_INV) * (b0[1] * W8_INV), siluf_(a0[2] * W8_INV) * (b0[2] * W8_INV), siluf_(a0[3] * W8_INV) * (b0[3] * W8_INV));
                    w.y = pk4_fp8(siluf_(a1[0] * W8_INV) * (b1[0] * W8_INV), siluf_(a1[1] * W8_INV) * (b1[1] * W8_INV), siluf_(a1[2] * W8_INV) * (b1[2] * W8_INV), siluf_(a1[3] * W8_INV) * (b1[3] * W8_INV));
                    *(u32x2*)((unsigned char*)o0 + (size_t)row * HID + (u.pn & 3) * 128 + cl) = w;
                } else if constexpr (mode == EM_MOEDN) {
#pragma unroll
                    for (int bj = 0; bj < 2; ++bj) {
                        const f32x4 v0 = acc[ai][bj][m][0] * W8_INV, v1 = acc[ai][bj][m][1] * W8_INV;
                        u32x4 w; w.x = pk2(v0[0], v0[1]); w.y = pk2(v0[2], v0[3]); w.z = pk2(v1[0], v1[1]); w.w = pk2(v1[2], v1[3]);
                        *(u32x4*)(o0 + (size_t)row * 1024 + (u.pn & 3) * 256 + bj * 128 + cl) = w;
                    }
                } else if constexpr (mode == EM_S5) {
                    const int g = u.pn, rr = row - g * 1280, b = rr / 160, c = rr - b * 160;
                    if (c < 144) {
#pragma unroll
                        for (int bj = 0; bj < 2; ++bj) {
                            const int n = bj * 128 + cl, i = n >> 4, h0 = n & 15, s = 16 * c + i;
                            const int trow = s < 256 ? NLAT + b * 256 + s : b * 2048 + (s - 256);
                            const u32x4 uv = cur.s[bj];
                            const f32x4 a0 = acc[ai][bj][m][0], a1 = acc[ai][bj][m][1];
                            u32x4 w;
                            w.x = pk2(gelu_tanh(a0[0] + hc[0][0] * bflo(uv.x)), gelu_tanh(a0[1] + hc[0][1] * bfhi(uv.x))); w.y = pk2(gelu_tanh(a0[2] + hc[0][2] * bflo(uv.y)), gelu_tanh(a0[3] + hc[0][3] * bfhi(uv.y)));
                            w.z = pk2(gelu_tanh(a1[0] + hc[1][0] * bflo(uv.z)), gelu_tanh(a1[1] + hc[1][1] * bfhi(uv.z))); w.w = pk2(gelu_tanh(a1[2] + hc[1][2] * bflo(uv.w)), gelu_tanh(a1[3] + hc[1][3] * bfhi(uv.w)));
                            *(u32x4*)(o0 + (size_t)trow * 256 + g * 16 + h0) = w;
                        }
                    }
                }
                cur = nxt;
        }
    }
};

#define XB_TMO      128
#define XB_XCNT(j)  (256  + 64 * (j))
#define XB_XSUB(j)  (1280 + 64 * (j))
#define XB_XGEN(j)  (2304 + 64 * (j))
#define XB_TOP      3328
#define XB_TOPGEN   3392
#define XCD_BAR_WORDS 3456
#define XB_SPIN_CAP (1u << 22)
__device__ __forceinline__ unsigned xb_ld(unsigned* p)              { return __hip_atomic_load(p, __ATOMIC_RELAXED, __HIP_MEMORY_SCOPE_AGENT); }
__device__ __forceinline__ unsigned xb_add(unsigned* p, unsigned v) { return __hip_atomic_fetch_add(p, v, __ATOMIC_RELAXED, __HIP_MEMORY_SCOPE_AGENT); }
__device__ __forceinline__ unsigned xb_xcc_id() { return (unsigned)__builtin_amdgcn_s_getreg((3 << 11) | 20) & 0xFu; }
#define XB_SPIN(cond, bar) do { unsigned _sp = 0; while (cond) { __builtin_amdgcn_s_sleep(1); \
    if ((++_sp & 255u) == 0u) { if (xb_ld(&(bar)[XB_TMO])) break; if (_sp > XB_SPIN_CAP) { atomicAdd(&(bar)[XB_TMO], 1u); break; } } } } while (0)
struct XcdBarrier { unsigned* bar; unsigned x; volatile LAS unsigned* st; };
__device__ __forceinline__ XcdBarrier xcd_barrier_post(unsigned* bar, volatile LAS unsigned* st) {
    XcdBarrier b; b.bar = bar; b.x = xb_xcc_id(); b.st = st;
    if (threadIdx.x == 0) (void)xb_add(&bar[XB_XCNT(b.x)], 1u);
    return b;
}
__device__ __forceinline__ void xcd_barrier_complete(unsigned* bar, unsigned x, unsigned& nloc, unsigned& nx) {
    const unsigned G = gridDim.x * gridDim.y * gridDim.z;
    unsigned sum, cnt, mine, sp = 0u;
    for (;;) {
        sum = 0u; cnt = 0u; mine = 0u;
#pragma unroll
        for (unsigned j = 0; j < 16; ++j) { const unsigned c = xb_ld(&bar[XB_XCNT(j)]); sum += c; cnt += (c > 0u) ? 1u : 0u; mine = (j == x) ? c : mine; }
        if (sum == G) break;
        __builtin_amdgcn_s_sleep(1);
        if ((++sp & 255u) == 0u) { if (xb_ld(&bar[XB_TMO])) break; if (sp > XB_SPIN_CAP) { atomicAdd(&bar[XB_TMO], 1u); break; } }
    }
    nloc = mine > 0u ? mine : 1u; nx = cnt > 0u ? cnt : 1u;
}
__device__ __noinline__ void xcd_barrier_fn(unsigned* bar_in, unsigned bx, unsigned st_off, int tid) {
    XcdBarrier b; b.bar = bar_in; b.x = bx; b.st = (volatile LAS unsigned*)(uintptr_t)st_off;
    asm volatile("s_waitcnt vmcnt(0)" ::: "memory");
    __syncthreads();
    if (tid == 0) {
        unsigned* bar = b.bar;
        __builtin_amdgcn_s_waitcnt(0);
        unsigned nloc = b.st[0], nx = b.st[1];
        if (nloc == 0u) { xcd_barrier_complete(bar, b.x, nloc, nx); b.st[0] = nloc; b.st[1] = nx; }
        const unsigned old = xb_add(&bar[XB_XSUB(b.x)], 1u);
        const unsigned gen = old / nloc;
        if (old + 1u == (gen + 1u) * nloc) {
            __builtin_amdgcn_fence(__ATOMIC_RELEASE, "agent");
            asm volatile("s_waitcnt vmcnt(0)" ::: "memory");
            const unsigned og = xb_add(&bar[XB_TOP], 1u);
            const unsigned tg = og / nx;
            if (og + 1u == (tg + 1u) * nx) xb_add(&bar[XB_TOPGEN], 1u);
            else XB_SPIN(xb_ld(&bar[XB_TOPGEN]) == tg, bar);
            __builtin_amdgcn_fence(__ATOMIC_ACQUIRE, "agent");
            xb_add(&bar[XB_XGEN(b.x)], 1u);
            asm volatile("s_waitcnt vmcnt(0)" ::: "memory");
        } else {
            XB_SPIN(xb_ld(&bar[XB_XGEN(b.x)]) == gen, bar);
            __builtin_amdgcn_fence(__ATOMIC_ACQUIRE, "agent");
            asm volatile("s_waitcnt vmcnt(0)" ::: "memory");
        }
    }
    __syncthreads();
}

constexpr int NWAVES = 8;
constexpr int RING_BYTES = 131072, MISC_OFF = RING_BYTES + 320, TBL_OFF = RING_BYTES + 1024, LDS_BYTES = 147456;
struct Args { const float* in[38]; float* out; unsigned char* ws; int ph_lo, ph_hi; };
typedef const __attribute__((address_space(4))) Args* ArgsP;
struct Frame {
    LAS unsigned char* lds;
    int tid, lane, wave, vcu, G, gw, NGW;
    unsigned char* ws;
};

enum RowMap { RM_ID = 0, RM_WIN = 1, RM_UQ = 2, RM_W13 = 3 };
__device__ __forceinline__ int rope_perm(int o) { const int axis = o >> 4, half = (o >> 3) & 1, i = o & 7; return 2 * (axis * 8 + i) + half; }
__device__ __forceinline__ int map_row(int rm, int n, int row_off) {
    if (rm == RM_WIN) return (n >= ZKPE && n < ZKPE + 32) ? ZKPE + rope_perm(n - ZKPE) : n;
    if (rm == RM_UQ) { const int hd = n / 96, cc = n - hd * 96; return cc >= 64 ? hd * 96 + 64 + rope_perm(cc - 64) : n; }
    if (rm == RM_W13) return row_off + (n >> 7) * 256 + (n & 127);
    return row_off + n;
}
__device__ __forceinline__ void transpose_item(const float* W, int K, int N, bf16_t* WT, int rm, int row_off, const float* kscale, LAS float* scr, int item, int lane) {
    const int nblk = N / 32, kb = item / nblk, nb = item % nblk, k0 = 64 * kb, n0 = 32 * nb;
    float tv[32];
#pragma unroll
    for (int i = 0; i < 32; ++i) tv[i] = W[(size_t)(k0 + 2 * i + (lane >> 5)) * N + n0 + (lane & 31)];
#pragma unroll
    for (int i = 0; i < 32; ++i) { const int kk = 2 * i + (lane >> 5); float v = tv[i]; if (kscale) v *= kscale[k0 + kk]; scr[kk * 33 + (lane & 31)] = v; }
    asm volatile("s_waitcnt lgkmcnt(0)" ::: "memory");
    const int c = lane & 7;
#pragma unroll
    for (int j = 0; j < 4; ++j) { const int n = (lane >> 3) + 8 * j; const LAS float* s = scr + (8 * c) * 33 + n;
        u32x4 o; o.x = pk2(s[0 * 33], s[1 * 33]); o.y = pk2(s[2 * 33], s[3 * 33]); o.z = pk2(s[4 * 33], s[5 * 33]); o.w = pk2(s[6 * 33], s[7 * 33]);
        *(u32x4*)(WT + (size_t)map_row(rm, n0 + n, row_off) * K + k0 + 8 * c) = o; }
    asm volatile("s_waitcnt lgkmcnt(0)" ::: "memory");
}

#if !NAIVE_S5
__device__ __forceinline__ void s5_build(Frame& F, ArgsP a);
#endif
__device__ __forceinline__ void prologue_phase(Frame& F, ArgsP a) {
    LAS float* scr = (LAS float*)(F.lds + F.wave * 16384);
    REP(21) for (int l = 0; l < 2; ++l) {
        unsigned char* wl = F.ws + WS_WB + (size_t)l * WL_STRIDE;
#define CONV(Wp, K_, N_, WTp, rm_, ro_, ks_) do { const int items_ = ((K_) / 64) * ((N_) / 32); \
            for (int it = F.gw; it < items_; it += F.NGW) transpose_item((Wp), (K_), (N_), (bf16_t*)(WTp), (rm_), (ro_), (ks_), scr, it, F.lane); } while (0)
        CONV(a->in[8] + (size_t)l * D * INC, D, INC, wl + WL_WIN, RM_WIN, 0, nullptr);
        CONV(a->in[21] + (size_t)l * 256 * 768, 256, 768, wl + WL_UQ, RM_UQ, 0, a->in[19] + l * 256);
        CONV(a->in[22] + (size_t)l * 128 * 512, 128, 512, wl + WL_UKV, RM_ID, 0, a->in[20] + l * 128);
        CONV(a->in[23] + (size_t)l * 128 * 512, 128, 512, wl + WL_UKV, RM_ID, 512, a->in[20] + l * 128);
        CONV(a->in[17] + (size_t)l * 256 * 256, 256, 256, wl + WL_GLU, RM_ID, 0, nullptr);
        CONV(a->in[26] + (size_t)l * 256 * 1024, 256, 1024, wl + WL_PA, RM_ID, 0, nullptr);
        CONV(a->in[27] + (size_t)l * 512 * 1024, 512, 1024, wl + WL_PB, RM_ID, 0, nullptr);
        CONV(a->in[28] + (size_t)l * 256 * 1024, 256, 1024, wl + WL_PC, RM_ID, 0, nullptr);
        CONV(a->in[29] + (size_t)l * 1024 * 1024, 1024, 1024, wl + WL_OUT, RM_ID, 0, nullptr);
#undef CONV
        u32x4* padp = (u32x4*)(wl + WL_WIN + (size_t)INC * D * 2);
        for (int i = F.gw * 64 + F.lane; i < (ZC - INC) * D * 2 / 16; i += F.NGW * 64) padp[i] = (u32x4){0u, 0u, 0u, 0u};
    }
    if (blockIdx.x == 0) {
        float* rp = (float*)(F.ws + WS_ROPE);
        const int pos = F.tid >> 3, i = F.tid & 7;
        const float ang = (float)pos * exp2f(-(float)i * (13.287712379549449f / 8.f));
        rp[F.tid] = cosf(ang); rp[512 + F.tid] = sinf(ang);
    }
    __syncthreads();
    REP(22)
    {
        LAS float* sil = (LAS float*)F.lds;
        LAS float* red = (LAS float*)(F.lds + 40960);
        bool have = false;
        for (int it = (F.G == 256 ? (int)blockIdx.x - 128 : (int)blockIdx.x); it < 192; it += (F.G == 256 ? 128 : F.G)) { if (it < 0) break;
            if (!have) {
                for (int i = F.tid; i < 9 * 1024; i += 512) { const int r = i >> 10, k = i & 1023; const float cv = r < 8 ? a->in[1][r * 1024 + k] : a->in[3][k]; sil[i] = siluf_(cv); }
                have = true; __syncthreads();
            }
            const int l = it / 96, n = (it % 96) * 64 + F.lane;
            const float* wp = a->in[4] + (size_t)l * D * 6144 + (size_t)(F.wave * 128) * 6144 + n;
            float acc[9];
#pragma unroll
            for (int r = 0; r < 9; ++r) acc[r] = 0.f;
#pragma unroll 8
            for (int k = 0; k < 128; ++k) { const float wv = wp[(size_t)k * 6144];
#pragma unroll
                for (int r = 0; r < 9; ++r) acc[r] += sil[r * 1024 + F.wave * 128 + k] * wv; }
#pragma unroll
            for (int r = 0; r < 9; ++r) red[(F.wave * 9 + r) * 64 + F.lane] = acc[r];
            __syncthreads();
            for (int i = F.tid; i < 9 * 64; i += 512) { const int r = i >> 6, ln = i & 63; float s = 0.f;
#pragma unroll
                for (int w = 0; w < 8; ++w) s += red[(w * 9 + r) * 64 + ln];
                const int nn = (it % 96) * 64 + ln;
                ((float*)(F.ws + WS_MODV))[((size_t)l * 9 + r) * 6144 + nn] = s + a->in[5][l * 6144 + nn]; }
            __syncthreads();
        }
    }
#if !NAIVE_S5
    REP(23) s5_build(F, a);
#endif
}

__device__ __forceinline__ void transpose_item_fp8(const float* W, int K, int N, unsigned char* WT, int rm, int row_off, LAS float* scr, int item, int lane) {
    const int nblk = N / 32, kb = item / nblk, nb = item % nblk, k0 = 64 * kb, n0 = 32 * nb;
    float tv[32];
#pragma unroll
    for (int i = 0; i < 32; ++i) tv[i] = W[(size_t)(k0 + 2 * i + (lane >> 5)) * N + n0 + (lane & 31)];
#pragma unroll
    for (int i = 0; i < 32; ++i) scr[(2 * i + (lane >> 5)) * 33 + (lane & 31)] = tv[i] * W8_SCALE;
    asm volatile("s_waitcnt lgkmcnt(0)" ::: "memory");
    const int n = lane >> 1, kh = 32 * (lane & 1); const LAS float* sp = scr + kh * 33 + n;
    u32x4 o0, o1;
    o0.x = pk4_fp8(sp[0 * 33], sp[1 * 33], sp[2 * 33], sp[3 * 33]);     o0.y = pk4_fp8(sp[4 * 33], sp[5 * 33], sp[6 * 33], sp[7 * 33]);
    o0.z = pk4_fp8(sp[8 * 33], sp[9 * 33], sp[10 * 33], sp[11 * 33]);   o0.w = pk4_fp8(sp[12 * 33], sp[13 * 33], sp[14 * 33], sp[15 * 33]);
    o1.x = pk4_fp8(sp[16 * 33], sp[17 * 33], sp[18 * 33], sp[19 * 33]); o1.y = pk4_fp8(sp[20 * 33], sp[21 * 33], sp[22 * 33], sp[23 * 33]);
    o1.z = pk4_fp8(sp[24 * 33], sp[25 * 33], sp[26 * 33], sp[27 * 33]); o1.w = pk4_fp8(sp[28 * 33], sp[29 * 33], sp[30 * 33], sp[31 * 33]);
    unsigned char* dst = WT + (size_t)map_row(rm, n0 + n, row_off) * K + k0 + kh;
    *(u32x4*)dst = o0; *(u32x4*)(dst + 16) = o1;
    asm volatile("s_waitcnt lgkmcnt(0)" ::: "memory");
}
__device__ __forceinline__ void moe_convert(Frame& F, ArgsP a, int l) {
    LAS float* scr = (LAS float*)(F.lds + F.wave * 16384);
    unsigned char* w13 = F.ws + WS_MIX + MW_W13; unsigned char* w2 = F.ws + WS_MIX + MW_W2;
    for (int it = F.gw; it < NEXP * 768; it += F.NGW) {
        const int e = it / 768, r = it % 768, which = r >> 8, sub = r & 255;
        const size_t eoff = ((size_t)l * NEXP + e) * 1024 * 512;
        if (which == 0) transpose_item_fp8(a->in[34] + eoff, 1024, 512, w13, RM_W13, e * 1024, scr, sub, F.lane);
        else if (which == 1) transpose_item_fp8(a->in[35] + eoff, 1024, 512, w13, RM_W13, e * 1024 + 128, scr, sub, F.lane);
        else transpose_item_fp8(a->in[36] + eoff, 512, 1024, w2, RM_ID, e * 1024, scr, sub, F.lane);
    }
}

__device__ __forceinline__ const float* x_row_ptr(ArgsP a, const float* X, int layer, int row) {
    return layer == 0 ? (row < NLAT ? a->in[0] + (size_t)row * D : a->in[2] + (size_t)(row - NLAT) * D) : X + (size_t)row * D;
}
__device__ __forceinline__ void norm_mod_row(const f32x4 (&v)[4], f32x4 (&h)[4], const float* g, const float* shift, const float* scale, int lane) {
    float ss = 0.f;
#pragma unroll
    for (int j = 0; j < 4; ++j) ss += (v[j][0] * v[j][0] + v[j][1] * v[j][1]) + (v[j][2] * v[j][2] + v[j][3] * v[j][3]);
    const float rstd = rsqrtf(wave_sum(ss) * (1.f / D) + EPS);
#pragma unroll
    for (int j = 0; j < 4; ++j) { const int c = 4 * lane + 256 * j; const f32x4 gv = *(const f32x4*)(g + c), sh = *(const f32x4*)(shift + c), sc = *(const f32x4*)(scale + c);
        h[j] = v[j] * rstd * gv * (sc + 1.f) + sh; }
}
__device__ __forceinline__ void store_row_bf16(bf16_t* orow, const f32x4 (&h)[4], int lane) {
#pragma unroll
    for (int j = 0; j < 4; ++j) { u32x2 w; w.x = pk2(h[j][0], h[j][1]); w.y = pk2(h[j][2], h[j][3]); *(u32x2*)(orow + 4 * lane + 256 * j) = w; }
}
__device__ __forceinline__ void norm1_phase(Frame& F, ArgsP a, int layer, int nrows) {
    const float* X = (const float*)(F.ws + WS_X); bf16_t* H = (bf16_t*)(F.ws + WS_H);
    const float* modv = (const float*)(F.ws + WS_MODV) + (size_t)layer * 9 * 6144;
    for (int row = F.gw; row < nrows; row += F.NGW) {
        const float* xr = x_row_ptr(a, X, layer, row); f32x4 v[4], h[4];
#pragma unroll
        for (int j = 0; j < 4; ++j) v[j] = *(const f32x4*)(xr + 4 * F.lane + 256 * j);
        const float* mv = modv + (size_t)tok_modrow(row) * 6144;
        norm_mod_row(v, h, a->in[6] + layer * D, mv, mv + 1024, F.lane);
        store_row_bf16(H + (size_t)row * D, h, F.lane);
    }
}

__device__ __forceinline__ int seq_row(int b, int s, int d) {
    if (d == 0) return s < 256 ? NLAT + b * 256 + s : b * 2048 + (s - 256);
    return s < 256 ? NLAT + b * 256 + (255 - s) : b * 2048 + (2047 - (s - 256));
}
__device__ __forceinline__ float hg_lb(ArgsP a, int l) { return l == 0 ? 0.f : 1.f / (1.f + __expf(a->in[24][0] - a->in[24][1])); }

#if NAIVE_S5
__device__ __forceinline__ void s5_naive(Frame& F, ArgsP a, int l) {
    const bf16_t* Z = (const bf16_t*)(F.ws + WS_Z); float* Yacc = (float*)(F.ws + WS_MIX + MX_S5A);
    for (int unit = F.gw; unit < 128; unit += F.NGW) {
        const int b = unit >> 4, g = unit & 15, p = F.lane;
        for (int d = 0; d < 2; ++d) {
            const int idx = (l * 2 + d) * 16 + g;
            const float lre = a->in[9][idx * 64 + p], lim = a->in[10][idx * 64 + p], dt = expf(a->in[15][idx]);
            const float mag = expf(lre * dt), lbr = mag * cosf(lim * dt), lbi = mag * sinf(lim * dt), den = lre * lre + lim * lim;
            const float fr = ((lbr - 1.f) * lre + lbi * lim) / den, fi = (lbi * lre - (lbr - 1.f) * lim) / den;
            float bbr[16], bbi[16], cre[16], cim[16];
#pragma unroll
            for (int h = 0; h < 16; ++h) { const float br = a->in[11][(size_t)(idx * 64 + p) * 16 + h], bi = a->in[12][(size_t)(idx * 64 + p) * 16 + h];
                bbr[h] = fr * br - fi * bi; bbi[h] = fr * bi + fi * br;
                cre[h] = a->in[13][(size_t)(idx * 16 + h) * 64 + p]; cim[h] = a->in[14][(size_t)(idx * 16 + h) * 64 + p]; }
            float hr = 0.f, hi = 0.f;
            for (int s = 0; s < 2304; ++s) {
                const int row = seq_row(b, s, d);
                const u32x4 u0 = *(const u32x4*)(Z + (size_t)row * ZC + g * 16), u1 = *(const u32x4*)(Z + (size_t)row * ZC + g * 16 + 8);
                const float uu[16] = { bflo(u0.x), bfhi(u0.x), bflo(u0.y), bfhi(u0.y), bflo(u0.z), bfhi(u0.z), bflo(u0.w), bfhi(u0.w),
                                       bflo(u1.x), bfhi(u1.x), bflo(u1.y), bfhi(u1.y), bflo(u1.z), bfhi(u1.z), bflo(u1.w), bfhi(u1.w) };
                float bur = 0.f, bui = 0.f;
#pragma unroll
                for (int h = 0; h < 16; ++h) { bur += bbr[h] * uu[h]; bui += bbi[h] * uu[h]; }
                const float nhr = lbr * hr - lbi * hi + bur, nhi = lbr * hi + lbi * hr + bui; hr = nhr; hi = nhi;
                float mine = 0.f;
#pragma unroll
                for (int h = 0; h < 16; ++h) { const float y = wave_sum(cre[h] * hr - cim[h] * hi); if (F.lane == h) mine = y; }
                if (F.lane < 16) { float* ptr = Yacc + (size_t)row * 256 + g * 16 + F.lane; if (d == 0) *ptr = mine; else *ptr += mine; }
            }
        }
    }
}
__device__ __forceinline__ void s5_naive_finish(Frame& F, ArgsP a, int l, int nrows) {
    const bf16_t* Z = (const bf16_t*)(F.ws + WS_Z); const float* Yacc = (const float*)(F.ws + WS_MIX + MX_S5A); bf16_t* ysp = (bf16_t*)(F.ws + WS_MIX + MX_YS5P);
    for (int i = F.gw * 64 + F.lane; i < nrows * 256; i += F.NGW * 64) { const int row = i >> 8, n = i & 255;
        ysp[i] = (bf16_t)f2bf(gelu_tanh(Yacc[i] + a->in[16][l * 256 + n] * bf2f(Z[(size_t)row * ZC + n]))); }
}
#endif

#if NAIVE_HG
__device__ __forceinline__ void hg_naive(Frame& F, ArgsP a, int l) {
    const bf16_t* Z = (const bf16_t*)(F.ws + WS_Z); float* Ohg = (float*)(F.ws + WS_H);
    LAS float* red = (LAS float*)F.lds;
    const float lb = hg_lb(a, l);
    for (int unit = blockIdx.x; unit < 32; unit += F.G) {
        const int b = unit >> 2, hd = unit & 3, v = F.tid & 63, kg = F.wave;
        for (int d = 0; d < 2; ++d) {
            float S[16];
#pragma unroll
            for (int k = 0; k < 16; ++k) S[k] = 0.f;
            for (int s = 0; s < 2304; ++s) {
                const int row = seq_row(b, s, d);
                const bf16_t* zr = Z + (size_t)row * ZC;
                const u32x4 q0 = *(const u32x4*)(zr + ZHQ + hd * 128 + kg * 16), q1 = *(const u32x4*)(zr + ZHQ + hd * 128 + kg * 16 + 8);
                const int zf = d ? ZF1 : ZF0;
                const u32x4 z0 = *(const u32x4*)(zr + zf + hd * 128 + kg * 16), z1 = *(const u32x4*)(zr + zf + hd * 128 + kg * 16 + 8);
                const float vt = bf2f(zr[ZI + hd * 64 + v]);
                const float qq[16] = { bflo(q0.x), bfhi(q0.x), bflo(q0.y), bfhi(q0.y), bflo(q0.z), bfhi(q0.z), bflo(q0.w), bfhi(q0.w),
                                       bflo(q1.x), bfhi(q1.x), bflo(q1.y), bfhi(q1.y), bflo(q1.z), bfhi(q1.z), bflo(q1.w), bfhi(q1.w) };
                const float zz[16] = { bflo(z0.x), bfhi(z0.x), bflo(z0.y), bfhi(z0.y), bflo(z0.z), bfhi(z0.z), bflo(z0.w), bfhi(z0.w),
                                       bflo(z1.x), bfhi(z1.x), bflo(z1.y), bfhi(z1.y), bflo(z1.z), bfhi(z1.z), bflo(z1.w), bfhi(z1.w) };
                float part = 0.f;
#pragma unroll
                for (int k = 0; k < 16; ++k) { const float kin = (1.f - lb) / (1.f + __expf(zz[k])), f = 1.f - kin; S[k] = f * S[k] + kin * vt; part += qq[k] * S[k]; }
                red[((s & 1) * 8 + kg) * 64 + v] = part;
                __syncthreads();
                if (F.tid < 64) { float o = 0.f;
#pragma unroll
                    for (int w = 0; w < 8; ++w) o += red[((s & 1) * 8 + w) * 64 + F.tid];
                    float* ptr = Ohg + (size_t)row * 256 + hd * 64 + F.tid; if (d == 0) *ptr = o; else *ptr += o; }
            }
            __syncthreads();
        }
    }
}
__device__ __forceinline__ void hg_naive_finish(Frame& F, ArgsP a, int l, int nrows) {
    const bf16_t* Z = (const bf16_t*)(F.ws + WS_Z); const float* Ohg = (const float*)(F.ws + WS_H); bf16_t* yhg = (bf16_t*)(F.ws + WS_MIX + MX_YHG);
    for (int it = F.gw; it < nrows * 4; it += F.NGW) { const int row = it >> 2, hd = it & 3, c = hd * 64 + F.lane;
        float o = Ohg[(size_t)row * 256 + c]; const float ms = wave_sum(o * o) * (1.f / 64.f);
        o = o * rsqrtf(ms + EPS) * a->in[25][l * 256 + c] * siluf_(bf2f(Z[(size_t)row * ZC + ZG + c]));
        yhg[(size_t)row * 256 + c] = (bf16_t)f2bf(o); }
}
#endif

#if NAIVE_ATTN
__device__ __forceinline__ void attn_naive(Frame& F, bool need_ctx) {
    const bf16_t* Q = (const bf16_t*)(F.ws + WS_MIX + MX_Q); const bf16_t* KN = (const bf16_t*)(F.ws + WS_MIX + MX_KN); const bf16_t* V = (const bf16_t*)(F.ws + WS_MIX + MX_V);
    const bf16_t* KPE = (const bf16_t*)(F.ws + WS_MIX + MX_KPE); bf16_t* YM = (bf16_t*)(F.ws + WS_MIX + MX_YMLA);
    const int nunits = need_ctx ? 320 : 256;
    for (int unit = blockIdx.x; unit < nunits; unit += F.G) {
        int b, h, qrow, nk; bool active = true; const bool lat = unit < 256;
        if (lat) { b = unit >> 5; h = (unit >> 2) & 7; qrow = b * 2048 + (unit & 3) * 512 + F.tid; nk = 2304; }
        else { const int u2 = unit - 256; b = u2 >> 3; h = u2 & 7; active = F.tid < 256; qrow = NLAT + b * 256 + (F.tid & 255); nk = 256; }
        float q[96];
#pragma unroll
        for (int c = 0; c < 12; ++c) { const u32x4 w = *(const u32x4*)(Q + (size_t)qrow * 768 + h * 96 + c * 8);
            q[c * 8 + 0] = bflo(w.x); q[c * 8 + 1] = bfhi(w.x); q[c * 8 + 2] = bflo(w.y); q[c * 8 + 3] = bfhi(w.y); q[c * 8 + 4] = bflo(w.z); q[c * 8 + 5] = bfhi(w.z); q[c * 8 + 6] = bflo(w.w); q[c * 8 + 7] = bfhi(w.w); }
        float o[64], m = -1e30f, lsum = 0.f;
#pragma unroll
        for (int dd = 0; dd < 64; ++dd) o[dd] = 0.f;
        for (int j = 0; j < nk; ++j) {
            const int krow = lat ? (j < 2048 ? b * 2048 + j : NLAT + b * 256 + (j - 2048)) : NLAT + b * 256 + j;
            const bf16_t* kn = KN + (size_t)krow * 512 + h * 64; const bf16_t* kp = KPE + (size_t)krow * 32; const bf16_t* vv = V + (size_t)krow * 512 + h * 64;
            float s = 0.f;
#pragma unroll
            for (int c = 0; c < 12; ++c) { const u32x4 w = c < 8 ? *(const u32x4*)(kn + c * 8) : *(const u32x4*)(kp + (c - 8) * 8);
                s += q[c * 8 + 0] * bflo(w.x) + q[c * 8 + 1] * bfhi(w.x) + q[c * 8 + 2] * bflo(w.y) + q[c * 8 + 3] * bfhi(w.y) + q[c * 8 + 4] * bflo(w.z) + q[c * 8 + 5] * bfhi(w.z) + q[c * 8 + 6] * bflo(w.w) + q[c * 8 + 7] * bfhi(w.w); }
            const float mn = fmaxf(m, s), al = __builtin_amdgcn_exp2f(m - mn), pp = __builtin_amdgcn_exp2f(s - mn);
            lsum = lsum * al + pp; m = mn;
#pragma unroll
            for (int c = 0; c < 8; ++c) { const u32x4 w = *(const u32x4*)(vv + c * 8);
                o[c * 8 + 0] = o[c * 8 + 0] * al + pp * bflo(w.x); o[c * 8 + 1] = o[c * 8 + 1] * al + pp * bfhi(w.x); o[c * 8 + 2] = o[c * 8 + 2] * al + pp * bflo(w.y); o[c * 8 + 3] = o[c * 8 + 3] * al + pp * bfhi(w.y);
                o[c * 8 + 4] = o[c * 8 + 4] * al + pp * bflo(w.z); o[c * 8 + 5] = o[c * 8 + 5] * al + pp * bfhi(w.z); o[c * 8 + 6] = o[c * 8 + 6] * al + pp * bflo(w.w); o[c * 8 + 7] = o[c * 8 + 7] * al + pp * bfhi(w.w); }
        }
        if (active) { const float inv = 1.f / lsum;
#pragma unroll
            for (int c = 0; c < 8; ++c) { u32x4 w; w.x = pk2(o[c * 8] * inv, o[c * 8 + 1] * inv); w.y = pk2(o[c * 8 + 2] * inv, o[c * 8 + 3] * inv); w.z = pk2(o[c * 8 + 4] * inv, o[c * 8 + 5] * inv); w.w = pk2(o[c * 8 + 6] * inv, o[c * 8 + 7] * inv);
                *(u32x4*)(YM + (size_t)qrow * 512 + h * 64 + c * 8) = w; } }
    }
}
#endif

typedef short s16x4 __attribute__((ext_vector_type(4)));
__device__ __forceinline__ f32x4 mfma16(bf16x8 a, bf16x8 b, f32x4 c) { return __builtin_amdgcn_mfma_f32_16x16x32_bf16(a, b, c, 0, 0, 0); }
__device__ __forceinline__ s16x4 vtr16(const LAS unsigned char* p) { return __builtin_bit_cast(s16x4, __builtin_amdgcn_ds_read_tr16_b64_v4i16((LAS s16x4*)p)); }
__device__ __forceinline__ float max3f_(float a, float b, float c) { float r; asm("v_max3_f32 %0, %1, %2, %3" : "=v"(r) : "v"(a), "v"(b), "v"(c)); return r; }
__device__ __forceinline__ void glds16(const void* gsrc, unsigned lds_dst) { unsigned keep;
    asm volatile("s_mov_b32 %0, m0\n\ts_mov_b32 m0, %2\n\ts_nop 0\n\tglobal_load_lds_dwordx4 %1, off\n\ts_mov_b32 m0, %0" : "=&s"(keep) : "v"(gsrc), "s"(lds_dst) : "memory"); }
#if !NAIVE_ATTN
template <int VAR> __device__ __forceinline__ void attn_fast(Frame& F, bool need_ctx, bf16_t* YM) {
    const bf16_t* Q = (const bf16_t*)(F.ws + WS_MIX + MX_Q); const bf16_t* KN = (const bf16_t*)(F.ws + WS_MIX + MX_KN); const bf16_t* V = (const bf16_t*)(F.ws + WS_MIX + MX_V);
    const bf16_t* KPE = (const bf16_t*)(F.ws + WS_MIX + MX_KPE);
    const int lane = F.lane, wid = F.wave, r32 = lane & 31, hi = lane >> 5;
    constexpr int SLOT = 20480, VOFF = 12288, NSLOT = 5;
    const unsigned lds0 = (unsigned)(uintptr_t)F.lds;
    const int nunits = need_ctx ? 576 : 512;
    const unsigned kA = (unsigned)(hi * 1024 + r32 * 16);
    const unsigned vB = (unsigned)(VOFF + ((lane >> 4) & 1) * 32 + (lane & 3) * 8 + (4 * hi + ((lane & 15) >> 2)) * 64);
    for (int unit = F.vcu; unit < nunits; unit += F.G) {
        int b, h, qrow0, NT; const bool lat = unit < 512;
        if (lat) { b = unit >> 6; h = (unit >> 3) & 7; qrow0 = b * 2048 + (unit & 7) * 256; NT = 36; }
        else { const int u2 = unit - 512; b = u2 >> 3; h = u2 & 7; qrow0 = NLAT + b * 256; NT = 4; }
#define ATT_KROW(t) (lat ? ((t) < 32 ? b * 2048 + 64 * (t) : NLAT + b * 256 + 64 * ((t) - 32)) : NLAT + b * 256 + 64 * (t))
#define ATT_ISSUE(tt, sl) do { const int tc_ = (tt) < NT ? (tt) : NT - 1; const int kr_ = ATT_KROW(tc_); const unsigned sd_ = (unsigned)__builtin_amdgcn_readfirstlane((int)(lds0 + (sl) * SLOT + wid * 1024)); \
            glds16(KN + (size_t)(kr_ + lane) * 512 + h * 64 + wid * 8, sd_); \
            if (wid < 4) glds16(KPE + (size_t)(kr_ + lane) * 32 + wid * 8, sd_ + 8 * 1024); \
            glds16(V + (size_t)(kr_ + 16 * (wid & 3) + (lane >> 2)) * 512 + h * 64 + (wid >> 2) * 32 + (lane & 3) * 8, sd_ + VOFF); } while (0)
#define ATT_QK(P0, P1, slot) do { const LAS unsigned char* sq_ = F.lds + (slot) * SLOT; _Pragma("unroll") for (int d0 = 0; d0 < 6; ++d0) { \
            const bf16x8 k0_ = *(const LAS bf16x8*)(sq_ + kA + d0 * 2048), k1_ = *(const LAS bf16x8*)(sq_ + kA + d0 * 2048 + 512); \
            if (d0 == 0) { P0 = __builtin_amdgcn_mfma_f32_32x32x16_bf16(k0_, qf[0], negm, 0, 0, 0); P1 = __builtin_amdgcn_mfma_f32_32x32x16_bf16(k1_, qf[0], negm, 0, 0, 0); } \
            else { P0 = __builtin_amdgcn_mfma_f32_32x32x16_bf16(k0_, qf[d0], P0, 0, 0, 0); P1 = __builtin_amdgcn_mfma_f32_32x32x16_bf16(k1_, qf[d0], P1, 0, 0, 0); } } } while (0)
        asm volatile("s_waitcnt vmcnt(0)" ::: "memory");
        __syncthreads();
        ATT_ISSUE(0, 0); ATT_ISSUE(1, 1); ATT_ISSUE(2, 2); ATT_ISSUE(3, 3);
        bf16x8 qf[6];
        { const bf16_t* qp = Q + (size_t)(qrow0 + wid * 32 + r32) * 768 + h * 96 + hi * 8;
#pragma unroll
          for (int d0 = 0; d0 < 6; ++d0) qf[d0] = *(const bf16x8*)(qp + d0 * 16); }
        float mref = 0.f, lsum = 0.f, dpend = 0.f; f32x16 o0 = {}, o1 = {}, negm = {};
        asm volatile("s_waitcnt vmcnt(0)" ::: "memory");
        __syncthreads();
        f32x16 p0, p1;
        ATT_QK(p0, p1, 0);
        int s_cur = 0, s_nxt = 1, s_new = 4;
        for (int t = 0; t < NT; ++t) {
            ATT_ISSUE(t + 4, s_new);
            const LAS unsigned char* sb = F.lds + s_cur * SLOT;
            f32x16 n0, n1;
            if (t + 1 < NT) ATT_QK(n0, n1, s_nxt); else { n0 = p0; n1 = p1; }
            if (__builtin_expect(__any(dpend != 0.f), 0)) {
#pragma unroll
                for (int r = 0; r < 16; ++r) { p0[r] -= dpend; p1[r] -= dpend; } }
            float mxa = max3f_(p0[0], p0[1], p1[0]), mxb = max3f_(p0[2], p0[3], p1[1]); mxa = max3f_(mxa, p1[2], p1[3]);
#pragma unroll
            for (int r = 4; r < 16; r += 4) { mxa = max3f_(mxa, p0[r], p0[r + 1]); mxb = max3f_(mxb, p0[r + 2], p0[r + 3]); mxa = max3f_(mxa, p1[r], p1[r + 1]); mxb = max3f_(mxb, p1[r + 2], p1[r + 3]); }
            float mx = fmaxf(mxa, mxb);
            { auto rr = __builtin_amdgcn_permlane32_swap(__float_as_uint(mx), __float_as_uint(mx), false, false); mx = fmaxf(__uint_as_float(rr[0]), __uint_as_float(rr[1])); }
            dpend = 0.f;
            if (__builtin_expect(t == 0 || __any(mx > 8.f), 0)) {
                const float dl = t == 0 ? mx : fmaxf(mx, 0.f); mref += dl; dpend = dl;
#pragma unroll
                for (int r = 0; r < 16; ++r) { p0[r] -= dl; p1[r] -= dl; negm[r] = -mref; }
                const float fs = __builtin_amdgcn_exp2f(-dl); lsum *= fs;
#pragma unroll
                for (int r = 0; r < 16; ++r) { o0[r] *= fs; o1[r] *= fs; } }
            f32x2 ps2 = {0.f, 0.f};
#pragma unroll
            for (int r = 0; r < 16; r += 2) { p0[r] = __builtin_amdgcn_exp2f(p0[r]); p0[r + 1] = __builtin_amdgcn_exp2f(p0[r + 1]); p1[r] = __builtin_amdgcn_exp2f(p1[r]); p1[r + 1] = __builtin_amdgcn_exp2f(p1[r + 1]);
                ps2 += (f32x2){p0[r], p0[r + 1]}; ps2 += (f32x2){p1[r], p1[r + 1]}; }
            lsum += ps2.x + ps2.y;
            bf16x8 pb[4];
#pragma unroll
            for (int s = 0; s < 4; ++s) { u32x4 w;
                if (s < 2) { w.x = pk2(p0[8 * s], p0[8 * s + 1]); w.y = pk2(p0[8 * s + 2], p0[8 * s + 3]); w.z = pk2(p0[8 * s + 4], p0[8 * s + 5]); w.w = pk2(p0[8 * s + 6], p0[8 * s + 7]); }
                else { const int q = s - 2; w.x = pk2(p1[8 * q], p1[8 * q + 1]); w.y = pk2(p1[8 * q + 2], p1[8 * q + 3]); w.z = pk2(p1[8 * q + 4], p1[8 * q + 5]); w.w = pk2(p1[8 * q + 6], p1[8 * q + 7]); }
                pb[s] = __builtin_bit_cast(bf16x8, w); }
#pragma unroll
            for (int s = 0; s < 4; ++s) {
                const s16x4 a0l = vtr16(sb + vB + s * 1024), a0h = vtr16(sb + vB + s * 1024 + 512), a1l = vtr16(sb + vB + 4096 + s * 1024), a1h = vtr16(sb + vB + 4096 + s * 1024 + 512);
                const bf16x8 va0 = {a0l[0], a0l[1], a0l[2], a0l[3], a0h[0], a0h[1], a0h[2], a0h[3]}, va1 = {a1l[0], a1l[1], a1l[2], a1l[3], a1h[0], a1h[1], a1h[2], a1h[3]};
                o0 = __builtin_amdgcn_mfma_f32_32x32x16_bf16(va0, pb[s], o0, 0, 0, 0);
                o1 = __builtin_amdgcn_mfma_f32_32x32x16_bf16(va1, pb[s], o1, 0, 0, 0);
            }
            if (wid < 4) asm volatile("s_waitcnt vmcnt(6) lgkmcnt(0)" ::: "memory"); else asm volatile("s_waitcnt vmcnt(4) lgkmcnt(0)" ::: "memory");
            __builtin_amdgcn_s_barrier();
            p0 = n0; p1 = n1;
            s_cur = s_nxt; s_nxt = s_nxt + 1 == NSLOT ? 0 : s_nxt + 1; s_new = s_new + 1 == NSLOT ? 0 : s_new + 1;
        }
#undef ATT_QK
#undef ATT_ISSUE
#undef ATT_KROW
        lsum += shfl_f(lsum, lane ^ 32);
        const float inv = 1.f / lsum;
        bf16_t* op = YM + (size_t)(qrow0 + wid * 32 + r32) * 512 + h * 64 + 4 * hi;
#pragma unroll
        for (int g = 0; g < 4; ++g) {
            u32x2 w0, w1; w0.x = pk2(o0[4 * g] * inv, o0[4 * g + 1] * inv); w0.y = pk2(o0[4 * g + 2] * inv, o0[4 * g + 3] * inv);
            w1.x = pk2(o1[4 * g] * inv, o1[4 * g + 1] * inv); w1.y = pk2(o1[4 * g + 2] * inv, o1[4 * g + 3] * inv);
            *(u32x2*)(op + 8 * g) = w0; *(u32x2*)(op + 32 + 8 * g) = w1;
        }
    }
}
#endif

#if !NAIVE_HG
__device__ __forceinline__ bf16x8 trfrag(const LAS unsigned char* p, int rowstep4) {
    const s16x4 lo = vtr16(p), hi = vtr16(p + rowstep4); return (bf16x8){lo[0], lo[1], lo[2], lo[3], hi[0], hi[1], hi[2], hi[3]}; }
__device__ __forceinline__ void hg_gate16(const bf16_t* Z, int b, int s0, int d, int zcol, float lb, float (&kin)[16], float (&gl)[16]) {
#pragma unroll
    for (int i = 0; i < 16; ++i) { const int row = seq_row(b, s0 + i, d); const float z = bf2f(Z[(size_t)row * ZC + zcol]);
        const float e = __expf(-z), sg = 1.f / (1.f + e), f = lb + (1.f - lb) * sg; kin[i] = (1.f - lb) * e * sg; gl[i] = __logf(f); }
}
__device__ __forceinline__ void hg_local_load(u32x4 (&tz)[2], u32x4& tv, const bf16_t* Z, int unit, int tid) {
    const int c = unit % 36, r = unit / 36, d = r & 1, hd = (r >> 1) & 3, b = r >> 3;
#pragma unroll
    for (int j = 0; j < 2; ++j) { const int pc = tid + 512 * j, t = pc >> 4, c16 = pc & 15, row = seq_row(b, 64 * c + t, d);
        tz[j] = *(const u32x4*)(Z + (size_t)row * ZC + (d ? ZF1 : ZF0) + hd * 128 + c16 * 8); }
    { const int t = tid >> 3, cc = tid & 7, row = seq_row(b, 64 * c + t, d); tv = *(const u32x4*)(Z + (size_t)row * ZC + ZI + hd * 64 + cc * 8); }
}
__device__ __forceinline__ void hg_local_phase(Frame& F, ArgsP a, int l) {
    const bf16_t* Z = (const bf16_t*)(F.ws + WS_Z); bf16_t* HGS = (bf16_t*)(F.ws + WS_H); float* HGD = (float*)(F.ws + WS_MIX + MX_HGD);
    const float lb = hg_lb(a, l);
    LAS unsigned char* Vl = F.lds; LAS unsigned char* KdT = F.lds + 9216; LAS float* seg = (LAS float*)(F.lds + 27648); LAS unsigned char* Zr = F.lds + 32768;
    const int tid = F.tid, lane = F.lane, w = F.wave, k = tid & 127, tq = tid >> 7;
    u32x4 tz[2], tv;
    if (F.vcu < 2304) hg_local_load(tz, tv, Z, F.vcu, tid);
    for (int unit = F.vcu; unit < 2304; unit += F.G) {
        __syncthreads();
#pragma unroll
        for (int j = 0; j < 2; ++j) { const int pc = tid + 512 * j; *(LAS u32x4*)(Zr + (pc >> 4) * 272 + (pc & 15) * 16) = tz[j]; }
        *(LAS u32x4*)(Vl + (tid >> 3) * 144 + (tid & 7) * 16) = tv;
        if (unit + F.G < 2304) hg_local_load(tz, tv, Z, unit + F.G, tid);
        __syncthreads();
        float kin0[8], kin1[8], g0[8], g1[8];
#pragma unroll
        for (int i = 0; i < 8; ++i) { const unsigned zz = *(const LAS unsigned*)(Zr + ((8 * w + i) * 136 + 2 * lane) * 2);
            { const float e = __expf(-bflo(zz)), sg = __builtin_amdgcn_rcpf(1.f + e); kin0[i] = (1.f - lb) * e * sg; g0[i] = __logf(lb + (1.f - lb) * sg); }
            { const float e = __expf(-bfhi(zz)), sg = __builtin_amdgcn_rcpf(1.f + e); kin1[i] = (1.f - lb) * e * sg; g1[i] = __logf(lb + (1.f - lb) * sg); } }
        float run0 = 0.f, run1 = 0.f;
#pragma unroll
        for (int i = 7; i >= 0; --i) { const float a0 = g0[i], a1 = g1[i]; g0[i] = run0; g1[i] = run1; run0 += a0; run1 += a1; }
        *(LAS f32x2*)(seg + w * 128 + 2 * lane) = (f32x2){run0, run1};
        __syncthreads();
        float lat0 = 0.f, lat1 = 0.f, tot0 = 0.f, tot1 = 0.f;
#pragma unroll
        for (int q = 0; q < 8; ++q) { const f32x2 sv = *(const LAS f32x2*)(seg + q * 128 + 2 * lane); tot0 += sv.x; tot1 += sv.y; if (q > w) { lat0 += sv.x; lat1 += sv.y; } }
        { u32x4 w0, w1;
          w0.x = pk2(kin0[0] * __expf(g0[0] + lat0), kin0[1] * __expf(g0[1] + lat0)); w0.y = pk2(kin0[2] * __expf(g0[2] + lat0), kin0[3] * __expf(g0[3] + lat0));
          w0.z = pk2(kin0[4] * __expf(g0[4] + lat0), kin0[5] * __expf(g0[5] + lat0)); w0.w = pk2(kin0[6] * __expf(g0[6] + lat0), kin0[7] * __expf(g0[7] + lat0));
          w1.x = pk2(kin1[0] * __expf(g1[0] + lat1), kin1[1] * __expf(g1[1] + lat1)); w1.y = pk2(kin1[2] * __expf(g1[2] + lat1), kin1[3] * __expf(g1[3] + lat1));
          w1.z = pk2(kin1[4] * __expf(g1[4] + lat1), kin1[5] * __expf(g1[5] + lat1)); w1.w = pk2(kin1[6] * __expf(g1[6] + lat1), kin1[7] * __expf(g1[7] + lat1));
          *(LAS u32x4*)(KdT + (2 * lane) * 144 + w * 16) = w0; *(LAS u32x4*)(KdT + (2 * lane + 1) * 144 + w * 16) = w1; }
        if (w == 0) *(f32x2*)(HGD + (size_t)unit * 128 + 2 * lane) = (f32x2){__expf(tot0), __expf(tot1)};
        __syncthreads();
        f32x4 acc[4] = {};
#pragma unroll
        for (int ks = 0; ks < 2; ++ks) {
            const bf16x8 bf = *(const LAS bf16x8*)(KdT + (16 * w + (lane & 15)) * 144 + (32 * ks + 8 * (lane >> 4)) * 2);
#pragma unroll
            for (int mt = 0; mt < 4; ++mt) { const bf16x8 af = trfrag(Vl + (32 * ks + 8 * (lane >> 4) + ((lane & 15) >> 2)) * 144 + (mt * 16 + 4 * (lane & 3)) * 2, 4 * 144);
                acc[mt] = mfma16(af, bf, acc[mt]); }
        }
        bf16_t* dst = HGS + (size_t)unit * 8192 + 16 * w + (lane & 15);
#pragma unroll
        for (int mt = 0; mt < 4; ++mt)
#pragma unroll
            for (int rr = 0; rr < 4; ++rr) dst[(size_t)(16 * mt + 4 * (lane >> 4) + rr) * 128] = (bf16_t)f2bf(acc[mt][rr]);
    }
}
__device__ __forceinline__ void hg_scan_phase(Frame& F) {
    bf16_t* HGS = (bf16_t*)(F.ws + WS_H); const float* HGD = (const float*)(F.ws + WS_MIX + MX_HGD);
    if (F.G == 256 && F.vcu >= 64 && F.vcu < 144) return;
    const int sb = F.G == 256 ? (F.vcu < 64 ? F.vcu : F.vcu - 80) : F.vcu, snb = F.G == 256 ? 176 : F.G;
    for (int it = (sb * NWAVES + F.wave) * 64 + F.lane; it < 64 * 1024; it += snb * NWAVES * 64) {
        const int r = it >> 10, e8 = (it & 1023) * 8, k0 = e8 & 127;
        float S[8];
#pragma unroll
        for (int j = 0; j < 8; ++j) S[j] = 0.f;
#pragma unroll 12
        for (int c = 0; c < 36; ++c) {
            u32x4* p = (u32x4*)(HGS + (size_t)(r * 36 + c) * 8192 + e8); const u32x4 ds = *p;
            const f32x4 d0 = *(const f32x4*)(HGD + (size_t)(r * 36 + c) * 128 + k0), d1 = *(const f32x4*)(HGD + (size_t)(r * 36 + c) * 128 + k0 + 4);
            u32x4 o; o.x = pk2(S[0], S[1]); o.y = pk2(S[2], S[3]); o.z = pk2(S[4], S[5]); o.w = pk2(S[6], S[7]); *p = o;
            S[0] = d0[0] * S[0] + bflo(ds.x); S[1] = d0[1] * S[1] + bfhi(ds.x); S[2] = d0[2] * S[2] + bflo(ds.y); S[3] = d0[3] * S[3] + bfhi(ds.y);
            S[4] = d1[0] * S[4] + bflo(ds.z); S[5] = d1[1] * S[5] + bfhi(ds.z); S[6] = d1[2] * S[6] + bflo(ds.w); S[7] = d1[3] * S[7] + bfhi(ds.w);
        }
    }
}
struct HgTile { u32x4 z[2], q[2], s[2], v; };
__device__ __forceinline__ void hg_out_decode(int unit, bool need_ctx, int& b, int& hd, int& ct) {
    if (need_ctx) { ct = unit % 36; hd = (unit / 36) & 3; b = unit / 144; } else { ct = 4 + (unit & 31); hd = (unit >> 5) & 3; b = unit >> 7; }
}
__device__ __forceinline__ void hg_out_load(HgTile& T, const bf16_t* Z, const bf16_t* HGS, int b, int hd, int ct, int d, int tid) {
    const int cs = d == 0 ? ct : (ct < 4 ? 3 - ct : 39 - ct); const size_t su = (size_t)(((b * 4 + hd) * 2 + d) * 36 + cs);
#pragma unroll
    for (int j = 0; j < 2; ++j) { const int pc = tid + 512 * j, t = pc >> 4, c16 = pc & 15, row = seq_row(b, 64 * cs + t, d);
        T.z[j] = *(const u32x4*)(Z + (size_t)row * ZC + (d ? ZF1 : ZF0) + hd * 128 + c16 * 8); T.q[j] = *(const u32x4*)(Z + (size_t)row * ZC + ZHQ + hd * 128 + c16 * 8);
        T.s[j] = *(const u32x4*)(HGS + su * 8192 + (size_t)t * 128 + c16 * 8); }
    { const int t = tid >> 3, cc = tid & 7, row = seq_row(b, 64 * cs + t, d); T.v = *(const u32x4*)(Z + (size_t)row * ZC + ZI + hd * 64 + cc * 8); }
}
__device__ __forceinline__ void hg_out_phase(Frame& F, ArgsP a, int l, bool need_ctx) {
    const bf16_t* Z = (const bf16_t*)(F.ws + WS_Z); const bf16_t* HGS = (const bf16_t*)(F.ws + WS_H); bf16_t* YHG = (bf16_t*)(F.ws + WS_MIX + MX_YHG);
    const float lb = hg_lb(a, l);
    LAS unsigned char* HQD = F.lds; LAS unsigned char* HQ1 = F.lds + 17408; LAS unsigned char* HK1 = F.lds + 34816; LAS unsigned char* HST = F.lds + 52224;
    LAS unsigned char* HV = F.lds + 69632; LAS unsigned char* HP = F.lds + 78848; LAS float* HO = (LAS float*)(F.lds + 88064); LAS float* seg = (LAS float*)(F.lds + 105472);
    const int tid = F.tid, lane = F.lane, w = F.wave, k = tid & 127, tq = tid >> 7, mt = w >> 1, nh = w & 1;
    const int nunits = need_ctx ? 1152 : 1024;
    const int nmine = F.vcu < nunits ? (nunits - 1 - F.vcu) / F.G + 1 : 0, nit = 2 * nmine;
    HgTile T;
    if (nit > 0) { int b, hd, ct; hg_out_decode(F.vcu, need_ctx, b, hd, ct); hg_out_load(T, Z, HGS, b, hd, ct, 0, tid); }
    for (int it = 0; it < nit; ++it) {
        const int unit = F.vcu + (it >> 1) * F.G, d = it & 1; int b, hd, ct; hg_out_decode(unit, need_ctx, b, hd, ct);
        __syncthreads();
#pragma unroll
        for (int j = 0; j < 2; ++j) { const int pc = tid + 512 * j, t = pc >> 4, c16 = pc & 15;
            *(LAS u32x4*)(HQD + t * 272 + c16 * 16) = T.q[j]; *(LAS u32x4*)(HK1 + t * 272 + c16 * 16) = T.z[j]; *(LAS u32x4*)(HST + t * 272 + c16 * 16) = T.s[j]; }
        *(LAS u32x4*)(HV + (tid >> 3) * 144 + (tid & 7) * 16) = T.v;
        if (it + 1 < nit) { const int un = F.vcu + ((it + 1) >> 1) * F.G; int b2, hd2, ct2; hg_out_decode(un, need_ctx, b2, hd2, ct2); hg_out_load(T, Z, HGS, b2, hd2, ct2, (it + 1) & 1, tid); }
        __syncthreads();
        float kin0[8], kin1[8], g0[8], g1[8];
#pragma unroll
        for (int i = 0; i < 8; ++i) { const unsigned zz = *(const LAS unsigned*)(HK1 + ((8 * w + i) * 136 + 2 * lane) * 2);
            { const float e = __expf(-bflo(zz)), sg = __builtin_amdgcn_rcpf(1.f + e); kin0[i] = (1.f - lb) * e * sg; g0[i] = __logf(lb + (1.f - lb) * sg); }
            { const float e = __expf(-bfhi(zz)), sg = __builtin_amdgcn_rcpf(1.f + e); kin1[i] = (1.f - lb) * e * sg; g1[i] = __logf(lb + (1.f - lb) * sg); } }
        float run0 = 0.f, run1 = 0.f;
#pragma unroll
        for (int i = 0; i < 8; ++i) { run0 += g0[i]; g0[i] = run0; run1 += g1[i]; g1[i] = run1; }
        *(LAS f32x2*)(seg + w * 128 + 2 * lane) = (f32x2){run0, run1};
        __syncthreads();
        float bef0 = 0.f, bef1 = 0.f, br0 = 0.f, br1 = 0.f;
#pragma unroll
        for (int q = 0; q < 7; ++q) { const f32x2 sv = *(const LAS f32x2*)(seg + q * 128 + 2 * lane); if (q < w) { bef0 += sv.x; bef1 += sv.y; } if (q < 4) { br0 += sv.x; br1 += sv.y; } }
        const float er0 = __expf(br0), er1 = __expf(br1);
#pragma unroll
        for (int i = 0; i < 8; ++i) { const int t = 8 * w + i, off = (t * 136 + 2 * lane) * 2;
            const unsigned qq = *(const LAS unsigned*)(HQD + off);
            const float e0 = __expf(fminf(fmaxf(bef0 + g0[i] - br0, -80.f), 80.f)), e1 = __expf(fminf(fmaxf(bef1 + g1[i] - br1, -80.f), 80.f));
            const float q10 = bflo(qq) * e0, q11 = bfhi(qq) * e1;
            *(LAS unsigned*)(HQ1 + off) = pk2(q10, q11);
            *(LAS unsigned*)(HQD + off) = pk2(q10 * er0, q11 * er1);
            *(LAS unsigned*)(HK1 + off) = pk2(kin0[i] * __builtin_amdgcn_rcpf(e0), kin1[i] * __builtin_amdgcn_rcpf(e1)); }
        __syncthreads();
        f32x4 ao[2] = {}, as[2] = {};
#pragma unroll
        for (int ks = 0; ks < 4; ++ks) {
            const int ko = (32 * ks + 8 * (lane >> 4)) * 2;
            const bf16x8 aqd = *(const LAS bf16x8*)(HQD + (16 * mt + (lane & 15)) * 272 + ko), aq1 = *(const LAS bf16x8*)(HQ1 + (16 * mt + (lane & 15)) * 272 + ko);
#pragma unroll
            for (int j = 0; j < 2; ++j) { const int nt = 2 * nh + j;
                ao[j] = mfma16(aqd, *(const LAS bf16x8*)(HST + (16 * nt + (lane & 15)) * 272 + ko), ao[j]);
                as[j] = mfma16(aq1, *(const LAS bf16x8*)(HK1 + (16 * nt + (lane & 15)) * 272 + ko), as[j]); }
        }
#pragma unroll
        for (int j = 0; j < 2; ++j) { const int sc = 16 * (2 * nh + j) + (lane & 15);
#pragma unroll
            for (int rr = 0; rr < 4; ++rr) { const int t = 16 * mt + 4 * (lane >> 4) + rr; *(LAS bf16_t*)(HP + (t * 72 + sc) * 2) = (bf16_t)f2bf(sc <= t ? as[j][rr] : 0.f); } }
        __syncthreads();
#pragma unroll
        for (int ks = 0; ks < 2; ++ks) {
            const bf16x8 ap = *(const LAS bf16x8*)(HP + (16 * mt + (lane & 15)) * 144 + (32 * ks + 8 * (lane >> 4)) * 2);
#pragma unroll
            for (int j = 0; j < 2; ++j) { const int nt = 2 * nh + j;
                const bf16x8 bv = trfrag(HV + (32 * ks + 8 * (lane >> 4) + ((lane & 15) >> 2)) * 144 + (16 * nt + 4 * (lane & 3)) * 2, 4 * 144);
                ao[j] = mfma16(ap, bv, ao[j]); }
        }
#pragma unroll
        for (int j = 0; j < 2; ++j) { const int v = 16 * (2 * nh + j) + (lane & 15);
#pragma unroll
            for (int rr = 0; rr < 4; ++rr) { const int t = 16 * mt + 4 * (lane >> 4) + rr, tt = d == 0 ? t : 63 - t;
                if (d == 0) HO[tt * 68 + v] = ao[j][rr]; else HO[tt * 68 + v] += ao[j][rr]; } }
        if (d == 1) {
            __syncthreads();
#pragma unroll
            for (int i = 0; i < 8; ++i) { const int tt = 8 * w + i, row = ct < 4 ? NLAT + b * 256 + 64 * ct + tt : b * 2048 + 64 * (ct - 4) + tt, cidx = hd * 64 + lane;
                float o = HO[tt * 68 + lane]; const float ms = wave_sum(o * o) * (1.f / 64.f);
                o = o * rsqrtf(ms + EPS) * a->in[25][l * 256 + cidx] * siluf_(bf2f(Z[(size_t)row * ZC + ZG + cidx]));
                YHG[(size_t)row * 256 + cidx] = (bf16_t)f2bf(o); }
        }
    }
}
#endif

#if !NAIVE_S5
typedef f32x2 cf32;
__device__ __forceinline__ cf32 cmul(cf32 a, cf32 b) { return (cf32){a.x * b.x - a.y * b.y, a.x * b.y + a.y * b.x}; }
__device__ __forceinline__ void s5_build(Frame& F, ArgsP a) {
    LAS cf32* lamp = (LAS cf32*)F.lds;
    LAS cf32* Bb = lamp + 2 * 17 * 64;
    LAS cf32* Cc = Bb + 2 * 64 * 16;
    LAS float* Kd = (LAS float*)(Cc + 2 * 16 * 64);
    const int tid = F.tid;
    for (int unit = blockIdx.x; unit < 128; unit += F.G) {
        const int l = unit >> 6, g = (unit >> 2) & 15, q = unit & 3;
        bf16_t* Bs_t = (bf16_t*)(F.ws + WS_WB + (size_t)l * WL_STRIDE + WL_BS); bf16_t* B2_t = (bf16_t*)(F.ws + WS_WB + (size_t)l * WL_STRIDE + WL_B2);
        __syncthreads();
        if (tid < 128) { const int d = tid >> 6, p = tid & 63, idx = (l * 2 + d) * 16 + g;
            const float lre = a->in[9][idx * 64 + p], lim = a->in[10][idx * 64 + p], dt = expf(a->in[15][idx]);
            const float ar = lre * dt, ai = lim * dt;
            for (int tau = 0; tau <= 16; ++tau) { const float mag = expf(ar * (float)tau); float sn, cs; sincosf(ai * (float)tau, &sn, &cs); lamp[(d * 17 + tau) * 64 + p] = (cf32){mag * cs, mag * sn}; }
            const cf32 lb = lamp[(d * 17 + 1) * 64 + p]; const float den = lre * lre + lim * lim;
            const cf32 f = (cf32){((lb.x - 1.f) * lre + lb.y * lim) / den, (lb.y * lre - (lb.x - 1.f) * lim) / den};
            { const f32x4* br4 = (const f32x4*)(a->in[11] + (size_t)(idx * 64 + p) * 16); const f32x4* bi4 = (const f32x4*)(a->in[12] + (size_t)(idx * 64 + p) * 16);
              f32x4 br[4], bi[4];
#pragma unroll
              for (int q4 = 0; q4 < 4; ++q4) { br[q4] = br4[q4]; bi[q4] = bi4[q4]; }
#pragma unroll
              for (int h = 0; h < 16; ++h) Bb[(d * 64 + p) * 16 + h] = cmul(f, (cf32){br[h >> 2][h & 3], bi[h >> 2][h & 3]}); }
            if (q == 0) ((cf32*)(F.ws + WS_S5P))[idx * 64 + p] = lamp[(d * 17 + 16) * 64 + p];
        }
        for (int e = tid; e < 2048; e += 512) { const int d = e >> 10, h = (e >> 6) & 15, p = e & 63, idx = (l * 2 + d) * 16 + g;
            Cc[e] = (cf32){a->in[13][(size_t)(idx * 16 + h) * 64 + p], a->in[14][(size_t)(idx * 16 + h) * 64 + p]}; }
        __syncthreads();
        { const int d = tid >> 8, tau = (tid >> 4) & 15, h = tid & 15; float kacc[16];
#pragma unroll
          for (int hp = 0; hp < 16; ++hp) kacc[hp] = 0.f;
          for (int p = 0; p < 64; ++p) { const cf32 t1 = cmul(Cc[(d * 16 + h) * 64 + p], lamp[(d * 17 + tau) * 64 + p]);
#pragma unroll
              for (int hp = 0; hp < 16; ++hp) { const cf32 bb = Bb[(d * 64 + p) * 16 + hp]; kacc[hp] += t1.x * bb.x - t1.y * bb.y; } }
#pragma unroll
          for (int hp = 0; hp < 16; ++hp) Kd[tid * 16 + hp] = kacc[hp]; }
        __syncthreads();
        for (int e = tid; e < 64 * 512; e += 512) { const int n = 64 * q + (e >> 9), kk = e & 511, i = n >> 4, h = n & 15; float val;
            if (kk < 256) { const int j = kk >> 4, hp = kk & 15; val = 0.f;
                if (j <= i) val += Kd[((i - j) * 16 + h) * 16 + hp];
                if (j >= i) val += Kd[4096 + ((j - i) * 16 + h) * 16 + hp]; }
            else { const int dd = (kk - 256) >> 7, pp = (kk - 256) & 127, p = pp & 63, pw = dd == 0 ? i + 1 : 16 - i;
                const cf32 cl = cmul(Cc[(dd * 16 + h) * 64 + p], lamp[(dd * 17 + pw) * 64 + p]); val = pp < 64 ? cl.x : -cl.y; }
            B2_t[((size_t)g * 256 + n) * 512 + kk] = (bf16_t)f2bf(val); }
        { const int d = q & 1, half = q >> 1;
          for (int e = tid; e < 64 * 256; e += 512) { const int p = e >> 8, kk = e & 255, j = kk >> 4, hp = kk & 15, pw = d == 0 ? 15 - j : j;
              const cf32 v = cmul(lamp[(d * 17 + pw) * 64 + p], Bb[(d * 64 + p) * 16 + hp]);
              Bs_t[((size_t)(g * 2 + d) * 128 + half * 64 + p) * 256 + kk] = (bf16_t)f2bf(half ? v.y : v.x); } }
    }
    __syncthreads();
}
__device__ __forceinline__ void s5_state_phase(Frame& F, int l) {
    bf16_t* S5A = (bf16_t*)(F.ws + WS_MIX + MX_S5A); const bf16_t* Bs_t = (const bf16_t*)(F.ws + WS_WB + (size_t)l * WL_STRIDE + WL_BS);
    const cf32* lam16 = (const cf32*)(F.ws + WS_S5P);
    LAS float* hl = (LAS float*)F.lds;
    const int lane = F.lane, w = F.wave;
    for (int unit = F.vcu; unit < 256; unit += F.G) {
        const int b = unit & 7, d = (unit >> 3) & 1, g = unit >> 4;
        __syncthreads();
        f32x4 acc[10] = {};
        { u32x4 ta[10]; const bf16_t* Asrc = S5A + ((size_t)g * 1280 + b * 160) * 512;
#pragma unroll
          for (int j = 0; j < 10; ++j) { const int pc = F.tid + 512 * j; ta[j] = *(const u32x4*)(Asrc + (size_t)(pc >> 5) * 512 + (pc & 31) * 8); }
          const bf16_t* Bb = Bs_t + ((size_t)(g * 2 + d) * 128 + 16 * w + (lane & 15)) * 256 + 8 * (lane >> 4);
          bf16x8 bfr[8];
#pragma unroll
          for (int ks = 0; ks < 8; ++ks) bfr[ks] = *(const bf16x8*)(Bb + 32 * ks);
#pragma unroll
          for (int j = 0; j < 10; ++j) { const int pc = F.tid + 512 * j; *(LAS u32x4*)(F.lds + (pc >> 5) * 528 + (pc & 31) * 16) = ta[j]; }
          __syncthreads();
#pragma unroll
          for (int ks = 0; ks < 8; ++ks)
#pragma unroll
              for (int mt = 0; mt < 10; ++mt) acc[mt] = mfma16(*(const LAS bf16x8*)(F.lds + (16 * mt + (lane & 15)) * 528 + (32 * ks + 8 * (lane >> 4)) * 2), bfr[ks], acc[mt]);
          __syncthreads(); }
#pragma unroll
        for (int mt = 0; mt < 10; ++mt)
#pragma unroll
            for (int rr = 0; rr < 4; ++rr) hl[(16 * mt + 4 * (lane >> 4) + rr) * 132 + 16 * w + (lane & 15)] = acc[mt][rr];
        __syncthreads();
        if (w == 0) { const cf32 lm = lam16[((l * 2 + d) * 16 + g) * 64 + lane]; float hr = 0.f, hi = 0.f;
            bf16_t* dst = S5A + ((size_t)g * 1280 + b * 160) * 512 + 256 + d * 128 + lane;
            for (int s = 0; s < 144; ++s) { const int c = d == 0 ? s : (s < 16 ? 15 - s : 159 - s);
                dst[(size_t)c * 512] = (bf16_t)f2bf(hr); dst[(size_t)c * 512 + 64] = (bf16_t)f2bf(hi);
                const float lr = hl[c * 132 + lane], li = hl[c * 132 + 64 + lane];
                const float nr = lm.x * hr - lm.y * hi + lr, ni = lm.x * hi + lm.y * hr + li; hr = nr; hi = ni; }
        }
    }
}
struct WinOrderLast { pg8::StaticOrder S0; int G, c;
    __device__ bool next(int i, pg8::Unit& u) const { const int L = i * G + c; if (L < S0.nwg) return S0.next(i, u); const int e = L - S0.nwg; if (e >= 64) return false;
        const int t = e >> 3; u.pm = 64 + (e & 7); u.pn = t == 0 ? 0 : (t == 1 ? 2 : t + 2); u.h = -1; return true; } };
struct S5Order { int G, c; __device__ bool next(int i, pg8::Unit& u) const { const int L = i * G + c; if (L >= 80) return false; u.pm = L; u.pn = L / 5; u.h = -1; return true; } };
struct HalfTailOrder { pg8::StaticOrder S0; int G, c;
    __device__ bool next(int i, pg8::Unit& u) const { const int L = i * G + c; if (L < S0.nwg) return S0.next(i, u); const int e = L - S0.nwg; if (e >= 64) return false;
        u.pm = 64 + (e >> 3); u.pn = (e >> 1) & 3; u.h = e & 1; return true; } };
#endif

__device__ __forceinline__ bf16x8 pack8(const float (&v)[8]) { u32x4 w; w.x = pk2(v[0], v[1]); w.y = pk2(v[2], v[3]); w.z = pk2(v[4], v[5]); w.w = pk2(v[6], v[7]); return __builtin_bit_cast(bf16x8, w); }
__device__ __forceinline__ void norm2_router_phase(Frame& F, ArgsP a, int l, int nrows) {
    const float* X = (const float*)(F.ws + WS_X); bf16_t* H = (bf16_t*)(F.ws + WS_H);
    const float* modv = (const float*)(F.ws + WS_MODV) + (size_t)l * 9 * 6144;
    const float* Wg = a->in[30] + (size_t)l * D * 4; const float* bg = a->in[31] + l * 4; const float* We = a->in[32] + (size_t)l * D * 32; const float* be = a->in[33] + l * 32;
    int* ri = (int*)(F.ws + WS_ROUTE); float* rg = (float*)(F.ws + WS_ROUTE + (size_t)MTOK * 16);
    unsigned* cnt = (unsigned*)(F.ws + WS_CTL) + CW_CNT + l * 32 * 64;
    LAS unsigned char* hhi = F.lds; LAS unsigned char* hlo = F.lds + 33024; LAS float* part = (LAS float*)(F.lds + 66048); LAS float* lg = (LAS float*)(F.lds + 90624);
    const int w = F.wave, lane = F.lane, tid = F.tid;
    bf16x8 whi[4][3], wlo[4][3];
#pragma unroll
    for (int ks = 0; ks < 4; ++ks)
#pragma unroll
        for (int nt = 0; nt < 3; ++nt) { float hv[8], lv[8]; const int col = 16 * nt + (lane & 15);
#pragma unroll
            for (int i = 0; i < 8; ++i) { const int k = 128 * w + 32 * ks + 8 * (lane >> 4) + i;
                const float wv = col < 32 ? We[(size_t)k * 32 + col] : (col < 36 ? Wg[(size_t)k * 4 + (col - 32)] : 0.f);
                const float hi = bflo(pk2(wv, 0.f)); hv[i] = hi; lv[i] = wv - hi; }
            whi[ks][nt] = pack8(hv); wlo[ks][nt] = pack8(lv); }
    const int niter = nrows >> 4;
    for (int it = F.vcu; it < niter; it += F.G) {
        const int base = it * 16;
        __syncthreads();
#pragma unroll
        for (int rr = 0; rr < 2; ++rr) { const int lr = 2 * w + rr, row = base + lr; f32x4 v[4], h[4];
#pragma unroll
            for (int j = 0; j < 4; ++j) v[j] = *(const f32x4*)(X + (size_t)row * D + 4 * lane + 256 * j);
            const float* mv = modv + (size_t)tok_modrow(row) * 6144;
            norm_mod_row(v, h, a->in[7] + l * D, mv + 3 * 1024, mv + 4 * 1024, lane);
            store_row_bf16(H + (size_t)row * D, h, lane);
#pragma unroll
            for (int j = 0; j < 4; ++j) *(unsigned*)(F.ws + WS_Z + MZ_H8 + (size_t)row * D + 4 * lane + 256 * j) = pk4_fp8(h[j][0], h[j][1], h[j][2], h[j][3]);
#pragma unroll
            for (int j = 0; j < 4; ++j) { u32x2 ph, pl; ph.x = pk2(h[j][0], h[j][1]); ph.y = pk2(h[j][2], h[j][3]);
                pl.x = pk2(h[j][0] - bflo(ph.x), h[j][1] - bfhi(ph.x)); pl.y = pk2(h[j][2] - bflo(ph.y), h[j][3] - bfhi(ph.y));
                *(LAS u32x2*)(hhi + (lr * 1032 + 4 * lane + 256 * j) * 2) = ph; *(LAS u32x2*)(hlo + (lr * 1032 + 4 * lane + 256 * j) * 2) = pl; } }
        __syncthreads();
        f32x4 acc[3] = {};
#pragma unroll
        for (int ks = 0; ks < 4; ++ks) { const int ao = ((lane & 15) * 1032 + 128 * w + 32 * ks + 8 * (lane >> 4)) * 2;
            const bf16x8 ahi = *(const LAS bf16x8*)(hhi + ao), alo = *(const LAS bf16x8*)(hlo + ao);
#pragma unroll
            for (int nt = 0; nt < 3; ++nt) { acc[nt] = mfma16(ahi, whi[ks][nt], acc[nt]); acc[nt] = mfma16(ahi, wlo[ks][nt], acc[nt]); acc[nt] = mfma16(alo, whi[ks][nt], acc[nt]); } }
#pragma unroll
        for (int nt = 0; nt < 3; ++nt)
#pragma unroll
            for (int r = 0; r < 4; ++r) part[(w * 16 + 4 * (lane >> 4) + r) * 48 + 16 * nt + (lane & 15)] = acc[nt][r];
        __syncthreads();
        for (int t = tid; t < 576; t += 512) { const int r = t / 36, c = t - r * 36; float sacc = 0.f;
#pragma unroll
            for (int q = 0; q < 8; ++q) sacc += part[(q * 16 + r) * 48 + c];
            lg[r * 40 + c] = sacc + (c < 32 ? be[c] : bg[c - 32]); }
        __syncthreads();
        if (tid < 16) { const int row = base + tid; const LAS float* lr = lg + tid * 40;
            int gi = 0; float gm = lr[32];
#pragma unroll
            for (int i = 1; i < 4; ++i) if (lr[32 + i] > gm) { gm = lr[32 + i]; gi = i; }
            float gs = 0.f;
#pragma unroll
            for (int i = 0; i < 4; ++i) gs += __expf(lr[32 + i] - gm);
            const float gw_ = 1.f / gs;
            const LAS float* el = lr + gi * 8;
            int i1 = 0; float v1 = el[0];
#pragma unroll
            for (int j = 1; j < 8; ++j) if (el[j] > v1) { v1 = el[j]; i1 = j; }
            int i2 = -1; float v2 = -3.0e38f;
#pragma unroll
            for (int j = 0; j < 8; ++j) if (j != i1 && el[j] > v2) { v2 = el[j]; i2 = j; }
            const float e2 = __expf(v2 - v1), g1 = gw_ / (1.f + e2), g2 = gw_ * e2 / (1.f + e2);
            const int e0 = gi * 8 + i1, e1 = gi * 8 + i2;
            const unsigned r0 = __hip_atomic_fetch_add(cnt + e0 * 64, 1u, __ATOMIC_RELAXED, __HIP_MEMORY_SCOPE_AGENT), r1 = __hip_atomic_fetch_add(cnt + e1 * 64, 1u, __ATOMIC_RELAXED, __HIP_MEMORY_SCOPE_AGENT);
            *(int4*)(ri + (size_t)row * 4) = make_int4(e0, e1, (int)r0, (int)r1);
            { int* lists = (int*)(F.ws + WS_LISTS); lists[(size_t)e0 * MTOK + r0] = row; lists[(size_t)e1 * MTOK + r1] = row; }
            rg[(size_t)row * 2 + 0] = g1; rg[(size_t)row * 2 + 1] = g2; }
    }
}
__device__ __forceinline__ int moe_starts(Frame& F, int l, int& total) {
    unsigned* cnt = (unsigned*)(F.ws + WS_CTL) + CW_CNT + l * 32 * 64;
    const int c = F.lane < 32 ? (int)__hip_atomic_load(cnt + (F.lane & 31) * 64, __ATOMIC_RELAXED, __HIP_MEMORY_SCOPE_AGENT) : 0;
    const int padded = (c + 255) & ~255; int incl = padded;
#pragma unroll
    for (int o = 1; o < 32; o <<= 1) { const int t = shfl_i(incl, F.lane - o); if (F.lane >= o) incl += t; }
    total = shfl_i(incl, 31);
    return incl - padded;
}
__device__ __forceinline__ void moe_gather_phase(Frame& F, int l, int nrows) {
    const bf16_t* H = (const bf16_t*)(F.ws + WS_H); bf16_t* XS = (bf16_t*)(F.ws + WS_Z + MZ_XS); const int* ri = (const int*)(F.ws + WS_ROUTE);
    int total; const int st = moe_starts(F, l, total);
    for (int row = F.gw; row < nrows; row += F.NGW) {
        const int e0 = ri[(size_t)row * 4], e1 = ri[(size_t)row * 4 + 1], r0 = ri[(size_t)row * 4 + 2], r1 = ri[(size_t)row * 4 + 3];
        const int d0 = shfl_i(st, e0) + r0, d1 = shfl_i(st, e1) + r1;
#pragma unroll
        for (int j = 0; j < 2; ++j) { const u32x4 w = *(const u32x4*)(H + (size_t)row * D + j * 512 + F.lane * 8);
            *(u32x4*)(XS + (size_t)d0 * D + j * 512 + F.lane * 8) = w; *(u32x4*)(XS + (size_t)d1 * D + j * 512 + F.lane * 8) = w; }
    }
}
__device__ __forceinline__ int moe_unit_wgid(int L, int nunits) { const int q = nunits / 8, r = nunits % 8, xcd = L % 8, off = L / 8; return (xcd < r ? xcd * (q + 1) : r * (q + 1) + (xcd - r) * q) + off; }
struct MoeOrder {
    int nunits, G, c; const LAS int* tile_e; const LAS int* rows;
    __device__ bool next(int i, pg8::Unit& u) const {
        const long L = (long)i * G + c; if (L >= nunits) return false;
        const int wgid = moe_unit_wgid((int)L, nunits), tile = wgid >> 2; const int te = tile_e[tile]; u.pm = tile; u.pn = (te & 255) * 4 + (wgid & 3); u.h = (te & 256) ? 0 : -1; return true;
    }
    __device__ unsigned a_row(int ui, int r) const { return (unsigned)rows[ui * 256 + r]; }
};
__device__ __forceinline__ int moe_build_tiles(Frame& F, int l, bool fill_rows) {
    LAS int* tbl = (LAS int*)(F.lds + TBL_OFF);
    __syncthreads();
    if (F.wave == 0) { int total; const int st = moe_starts(F, l, total); if (F.lane < 32) { tbl[F.lane] = st;
            tbl[256 + F.lane] = (int)__hip_atomic_load((unsigned*)(F.ws + WS_CTL) + CW_CNT + (l * 32 + F.lane) * 64, __ATOMIC_RELAXED, __HIP_MEMORY_SCOPE_AGENT); }
        if (F.lane == 0) tbl[32] = total; }
    __syncthreads();
    const int total = tbl[32], ntiles = total >> 8;
    for (int t = F.tid; t < ntiles; t += 512) { int e = 0;
#pragma unroll
        for (int j = 1; j < 32; ++j) if (tbl[j] <= t * 256) e = j;
        tbl[64 + t] = e | ((tbl[256 + e] - (t * 256 - tbl[e]) <= 128) ? 256 : 0); }
    __syncthreads();
    if (fill_rows) { const int* lists = (const int*)(F.ws + WS_LISTS); const int nunits = ntiles * 4;
        for (int x = F.tid; x < 768; x += 512) { const int ui = x >> 8, r = x & 255, L = ui * F.G + (int)blockIdx.x; int src = 0;
            if (L < nunits) { const int tile = moe_unit_wgid(L, nunits) >> 2, e = tbl[64 + tile] & 255, rank = tile * 256 - tbl[e] + r; if (rank < tbl[256 + e]) src = lists[(size_t)e * MTOK + rank]; }
            tbl[512 + x] = src; }
        __syncthreads(); }
    return ntiles;
}
__device__ __forceinline__ void moe_combine_phase(Frame& F, ArgsP a, int l, int nrows, bool dry = false) {
    float* X = (float*)(F.ws + WS_X); float* Xo = dry ? (float*)(F.ws + WS_Z + 132 * MiB) : X; float* outp = dry ? Xo : a->out; bf16_t* H = (bf16_t*)(F.ws + WS_H); const bf16_t* Y = (const bf16_t*)(F.ws + WS_Z + MZ_XS);
    const int* ri = (const int*)(F.ws + WS_ROUTE); const float* rg = (const float*)(F.ws + WS_ROUTE + (size_t)MTOK * 16);
    const float* modv = (const float*)(F.ws + WS_MODV);
    int total; const int st = moe_starts(F, l, total);
    for (int row = F.gw; row < nrows; row += F.NGW) {
        const int e0 = ri[(size_t)row * 4], e1 = ri[(size_t)row * 4 + 1], r0 = ri[(size_t)row * 4 + 2], r1 = ri[(size_t)row * 4 + 3];
        const int p0 = shfl_i(st, e0) + r0, p1 = shfl_i(st, e1) + r1; const float g0 = rg[(size_t)row * 2], g1 = rg[(size_t)row * 2 + 1];
        const float* mv = modv + ((size_t)l * 9 + tok_modrow(row)) * 6144;
        f32x4 v[4];
#pragma unroll
        for (int j = 0; j < 4; ++j) { const int c = 4 * F.lane + 256 * j;
            const u32x2 y0 = *(const u32x2*)(Y + (size_t)p0 * D + c), y1 = *(const u32x2*)(Y + (size_t)p1 * D + c);
            const f32x4 f = { g0 * bflo(y0.x) + g1 * bflo(y1.x), g0 * bfhi(y0.x) + g1 * bfhi(y1.x), g0 * bflo(y0.y) + g1 * bflo(y1.y), g0 * bfhi(y0.y) + g1 * bfhi(y1.y) };
            v[j] = *(const f32x4*)(X + (size_t)row * D + c) + *(const f32x4*)(mv + 5 * 1024 + c) * f; }
        if (l == 0) {
#pragma unroll
            for (int j = 0; j < 4; ++j) *(f32x4*)(Xo + (size_t)row * D + 4 * F.lane + 256 * j) = v[j];
            f32x4 h[4]; const float* mv1 = modv + ((size_t)9 + tok_modrow(row)) * 6144;
            norm_mod_row(v, h, a->in[6] + D, mv1, mv1 + 1024, F.lane);
            store_row_bf16(H + (size_t)row * D, h, F.lane);
        } else {
            float ss = 0.f;
#pragma unroll
            for (int j = 0; j < 4; ++j) ss += (v[j][0] * v[j][0] + v[j][1] * v[j][1]) + (v[j][2] * v[j][2] + v[j][3] * v[j][3]);
            const float rstd = rsqrtf(wave_sum(ss) * (1.f / D) + EPS);
#pragma unroll
            for (int j = 0; j < 4; ++j) { const int c = 4 * F.lane + 256 * j; *(f32x4*)(outp + (size_t)row * D + c) = v[j] * rstd * *(const f32x4*)(a->in[37] + c); }
        }
    }
}

#define REOPAQUE() { unsigned m1_ = ~0u; asm volatile("" : "+s"(m1_)); int ln_ = __builtin_amdgcn_mbcnt_hi(m1_, __builtin_amdgcn_mbcnt_lo(m1_, 0u)); asm volatile("" : "+v"(ln_)); F.lane = ln_; F.wave = wave_s; F.tid = wave_s * 64 + ln_; F.gw = F.vcu * NWAVES + F.wave; int z_ = 0; asm volatile("" : "+s"(z_)); args = (ArgsP)__builtin_amdgcn_kernarg_segment_ptr() + z_; F.ws = args->ws; }
#define PH_BEGIN if (ph >= lo && ph < hi) { REOPAQUE()
#define PH_END } if (ph >= lo && ph + 1 < hi) { if (!MK_PER_PHASE) REP(15) xcd_barrier_fn(bar.bar, bar.x, (unsigned)(uintptr_t)bar.st, F.tid); } ++ph;

#define pH ((bf16_t*)(F.ws + WS_H))
#define pZ ((bf16_t*)(F.ws + WS_Z))
#define pX ((float*)(F.ws + WS_X))
#define pMix (F.ws + WS_MIX)
#define pSsq ((float*)(F.ws + WS_SSQ))
#define pRope ((const float*)(F.ws + WS_ROPE))
#define pWl (F.ws + WS_WB + (size_t)l * WL_STRIDE)
#define pModv ((const float*)(F.ws + WS_MODV) + (size_t)l * 9 * 6144)


template <int l> __device__ __forceinline__ void layer_prog(Frame& F, ArgsP& args, int& ph, const int lo, const int hi, const XcdBarrier& bar, const int wave_s) {
        const bool need_ctx = (l == 0); const int nrows = need_ctx ? MTOK : NLAT;

        PH_BEGIN REP(1) { pg8::Gemm g{pH, (const bf16_t*)(pWl + WL_WIN), D, D, D};
            Epi<EM_Z> E{}; E.ssq = pSsq; E.rope = pRope; E.o0 = pZ; E.o1 = (bf16_t*)(pMix + MX_KPE); E.o2 = (bf16_t*)(pMix + MX_S5A);
            if constexpr (l == 0) { pg8::StaticOrder S; S.init(MTOK, ZC, F.G, (int)blockIdx.x); pg8::gemm_phase(F.lds, F.tid, g, S, E); }
            else { WinOrderLast S; S.S0.init(NLAT, ZC, F.G, (int)blockIdx.x); S.G = F.G; S.c = (int)blockIdx.x; pg8::gemm_phase(F.lds, F.tid, g, S, E); } } PH_END

        PH_BEGIN {
            REP(2) { pg8::Gemm g{pZ + ZCQ, (const bf16_t*)(pWl + WL_UQ), 256, ZC, 256}; pg8::StaticOrder S; S.init(nrows, 768, F.G, ((int)blockIdx.x + F.G - 32) % F.G);
              Epi<EM_Q> E{}; E.ssq = pSsq; E.rope = pRope; E.o0 = (bf16_t*)(pMix + MX_Q); pg8::gemm_phase(F.lds, F.tid, g, S, E); }
            REOPAQUE()
            REP(2) { pg8::Gemm g{pZ + ZCKV, (const bf16_t*)(pWl + WL_UKV), 128, ZC, 128}; pg8::StaticOrder S; S.init(MTOK, 1024, F.G, (int)blockIdx.x);
              Epi<EM_KV> E{}; E.ssq = pSsq; E.o0 = (bf16_t*)(pMix + MX_KN); E.o1 = (bf16_t*)(pMix + MX_V); pg8::gemm_phase(F.lds, F.tid, g, S, E); }
            REOPAQUE()
#if NAIVE_S5
            s5_naive(F, args, l);
#else
            REP(3) s5_state_phase(F, l);
#endif
            REOPAQUE()
#if NAIVE_HG
            hg_naive(F, args, l);
#else
            REP(4) hg_local_phase(F, args, l);
#endif
        } PH_END

        PH_BEGIN {
#if NAIVE_ATTN
            attn_naive(F, need_ctx);
#else
#if PROBE_PH >= 50 && PROBE_PH < 60
            attn_fast<PROBE_PH - 49>(F, need_ctx, (bf16_t*)args->out); REOPAQUE()
#endif
            attn_fast<0>(F, need_ctx, (bf16_t*)(pMix + MX_YMLA));
#endif
            REOPAQUE()
#if NAIVE_S5
            s5_naive_finish(F, args, l, nrows);
#else
            REP(6) { pg8::Gemm g{(const bf16_t*)(pMix + MX_S5A), (const bf16_t*)(pWl + WL_B2), 512, 512, 512}; S5Order S{F.G, (F.vcu + F.G - 64) % F.G};
              Epi<EM_S5> E{}; E.o0 = (bf16_t*)(pMix + MX_YS5P); E.i0 = (const bf16_t*)(pMix + MX_S5A); E.f0 = args->in[16] + l * 256; pg8::gemm_phase(F.lds, F.tid, g, S, E); }
#endif
            REOPAQUE()
#if NAIVE_HG
            hg_naive_finish(F, args, l, nrows);
#else
            hg_scan_phase(F);
#endif
        } PH_END

        PH_BEGIN {
#if !NAIVE_HG
            REP(7) hg_out_phase(F, args, l, need_ctx);
            REOPAQUE()
#endif
            REP(8) { pg8::Gemm g{(const bf16_t*)(pMix + MX_YS5P), (const bf16_t*)(pWl + WL_GLU), 256, 256, 256}; pg8::StaticOrder S; S.init(nrows, 256, F.G, (F.vcu + F.G - 128) % F.G);
            Epi<EM_GLU> E{}; E.o0 = (bf16_t*)(pMix + MX_YS5); E.i0 = (const bf16_t*)(pMix + MX_YS5P); E.f0 = args->in[18] + l * 256;
            pg8::gemm_phase(F.lds, F.tid, g, S, E); } } PH_END

        PH_BEGIN {
#define MERGE3(S, HS) do { \
            { pg8::Gemm g{(const bf16_t*)(pMix + MX_YS5), (const bf16_t*)(pWl + WL_PA), 256, 256, 256}; Epi<EM_MERGE0> E{}; E.o0 = pH; E.i0 = pZ + ZGA; pg8::gemm_phase<Epi<EM_MERGE0>, decltype(S), false, HS>(F.lds, F.tid, g, S, E); } \
            { pg8::Gemm g{(const bf16_t*)(pMix + MX_YMLA), (const bf16_t*)(pWl + WL_PB), 512, 512, 512}; Epi<EM_MERGE1> E{}; E.o0 = pH; E.i0 = pZ + ZGB; pg8::gemm_phase<Epi<EM_MERGE1>, decltype(S), false, HS>(F.lds, F.tid, g, S, E); } \
            { pg8::Gemm g{(const bf16_t*)(pMix + MX_YHG), (const bf16_t*)(pWl + WL_PC), 256, 256, 256}; Epi<EM_MERGE1> E{}; E.o0 = pH; E.i0 = pZ + ZGC; pg8::gemm_phase<Epi<EM_MERGE1>, decltype(S), false, HS>(F.lds, F.tid, g, S, E); } } while (0)
            if constexpr (l == 0) { HalfTailOrder S; S.S0.init(NLAT, 1024, F.G, (int)blockIdx.x); S.G = F.G; S.c = (int)blockIdx.x; MERGE3(S, true); }
            else { pg8::StaticOrder S; S.init(NLAT, 1024, F.G, (int)blockIdx.x); MERGE3(S, false); }
#undef MERGE3
        } PH_END

        PH_BEGIN { pg8::Gemm g{pH, (const bf16_t*)(pWl + WL_OUT), D, D, D};
            Epi<EM_WOUT> E{}; E.layer = l; E.f0 = pModv; E.f1 = args->in[0]; E.f2 = args->in[2]; E.fo = pX;
            if constexpr (l == 0) { HalfTailOrder S; S.S0.init(NLAT, 1024, F.G, (int)blockIdx.x); S.G = F.G; S.c = (int)blockIdx.x; pg8::gemm_phase<Epi<EM_WOUT>, HalfTailOrder, false, true>(F.lds, F.tid, g, S, E); }
            else { pg8::StaticOrder S; S.init(NLAT, 1024, F.G, (int)blockIdx.x); pg8::gemm_phase(F.lds, F.tid, g, S, E); } } PH_END

        PH_BEGIN { norm2_router_phase(F, args, l, nrows); REOPAQUE() REP(11) moe_convert(F, args, l); } PH_END
        PH_BEGIN REP(13) { const int nt = moe_build_tiles(F, l, true); MoeOrder S{nt * 4, F.G, (int)blockIdx.x, (const LAS int*)(F.lds + TBL_OFF) + 64, (const LAS int*)(F.lds + TBL_OFF) + 512};
            pg8::Gemm g{(const bf16_t*)(F.ws + WS_Z + MZ_H8), (const bf16_t*)(pMix + MW_W13), D / 2, D / 2, D / 2};
            Epi<EM_MOEUP> E{}; E.o0 = (bf16_t*)(F.ws + WS_Z + MZ_HID); pg8::gemm_phase<Epi<EM_MOEUP>, MoeOrder, true, true, true>(F.lds, F.tid, g, S, E); } PH_END
        PH_BEGIN REP(14) { const int nt = moe_build_tiles(F, l, false); MoeOrder S{nt * 4, F.G, (int)blockIdx.x, (const LAS int*)(F.lds + TBL_OFF) + 64, (const LAS int*)(F.lds + TBL_OFF) + 512};
            pg8::Gemm g{(const bf16_t*)(F.ws + WS_Z + MZ_HID), (const bf16_t*)(pMix + MW_W2), HID / 2, HID / 2, HID / 2};
            Epi<EM_MOEDN> E{}; E.o0 = (bf16_t*)(F.ws + WS_Z + MZ_XS); pg8::gemm_phase<Epi<EM_MOEDN>, MoeOrder, false, true, true>(F.lds, F.tid, g, S, E); } PH_END
        PH_BEGIN { if (PROBE_PH == 19) { moe_combine_phase(F, args, l, nrows, true); REOPAQUE() } moe_combine_phase(F, args, l, nrows); } PH_END
    }

__global__ void __launch_bounds__(NWAVES * 64, 2) mega_fwd(Args args_by_value) {
    ArgsP args = (ArgsP)__builtin_amdgcn_kernarg_segment_ptr();
    extern __shared__ __attribute__((aligned(16))) unsigned char lds_raw[];
    Frame F;
    F.lds = (LAS unsigned char*)lds_raw;
    F.tid = threadIdx.x; F.lane = F.tid & 63; F.wave = __builtin_amdgcn_readfirstlane(F.tid >> 6);
    const int wave_s = F.wave;
    F.G = gridDim.x; { const int bx = blockIdx.x; F.vcu = (F.G % 8 == 0) ? (bx % 8) * (F.G / 8) + bx / 8 : bx; }
    F.gw = F.vcu * NWAVES + F.wave; F.NGW = F.G * NWAVES; F.ws = args->ws;
    volatile LAS unsigned* MISC = (volatile LAS unsigned*)(F.lds + MISC_OFF);
    for (int u = F.tid; u < (LDS_BYTES - RING_BYTES) / 4; u += NWAVES * 64) ((LAS unsigned*)(F.lds + RING_BYTES))[u] = 0u;
    __syncthreads();
    unsigned* ctl = (unsigned*)(F.ws + WS_CTL);
    XcdBarrier bar; bar.bar = ctl + CW_BAR; bar.x = 0; bar.st = nullptr;
    if (!MK_PER_PHASE) bar = xcd_barrier_post(ctl + CW_BAR, MISC + 8);
    const int lo = args->ph_lo, hi = args->ph_hi;
    int ph = 0;
    PH_BEGIN REP(17) prologue_phase(F, args); PH_END
    PH_BEGIN REP(16) norm1_phase(F, args, 0, MTOK); PH_END

    layer_prog<0>(F, args, ph, lo, hi, bar, wave_s);
    layer_prog<1>(F, args, ph, lo, hi, bar, wave_s);
#undef PH_BEGIN
#undef REOPAQUE
#undef PH_END
#undef pH
#undef pZ
#undef pX
#undef pMix
#undef pSsq
#undef pRope
#undef pWl
#undef pModv
}
constexpr int N_PHASES = 2 + 2 * 10;

extern "C" void kernel_launch(void* const* d_in, const int* in_sizes, int n_in, void* d_out, int out_size, void* d_ws, size_t ws_size, hipStream_t stream) {
    static int grid = 0;
    if (grid == 0) {
        if (n_in != 38 || out_size != NLAT * D || ws_size < WS_END) { fprintf(stderr, "kernel_launch: unexpected shapes (n_in %d out %d ws %zu need %zu)\n", n_in, out_size, ws_size, (size_t)WS_END); grid = -1; return; }
        int dev = 0, cus = 0, per_cu = 0;
        if (hipGetDevice(&dev) != hipSuccess || hipDeviceGetAttribute(&cus, hipDeviceAttributeMultiprocessorCount, dev) != hipSuccess) { grid = -1; return; }
        if (hipFuncSetAttribute((const void*)mega_fwd, hipFuncAttributeMaxDynamicSharedMemorySize, LDS_BYTES) != hipSuccess) { fprintf(stderr, "kernel_launch: hipFuncSetAttribute failed\n"); grid = -1; return; }
        if (hipOccupancyMaxActiveBlocksPerMultiprocessor(&per_cu, (const void*)mega_fwd, NWAVES * 64, LDS_BYTES) != hipSuccess || per_cu < 1) { fprintf(stderr, "kernel_launch: occupancy query says %d\n", per_cu); }
        (void)hipGetLastError();
        grid = cus;
    }
    if (grid < 0) return;
    (void)hipMemsetAsync((char*)d_ws + WS_CTL, 0, CTL_ZERO_BYTES, stream);
    Args a{};
    for (int i = 0; i < 38; ++i) a.in[i] = (const float*)d_in[i];
    a.out = (float*)d_out; a.ws = (unsigned char*)d_ws;
#if MK_PER_PHASE
    for (int p = 0; p < N_PHASES; ++p) { a.ph_lo = p; a.ph_hi = p + 1; hipLaunchKernelGGL(mega_fwd, dim3(grid), dim3(NWAVES * 64), LDS_BYTES, stream, a); }
#else
    a.ph_lo = 0; a.ph_hi = N_PHASES;
    hipLaunchKernelGGL(mega_fwd, dim3(grid), dim3(NWAVES * 64), LDS_BYTES, stream, a);
#endif
}
```

```cpp
#include <hip/hip_runtime.h>
#include <cstdio>
#include <cstdint>

#ifndef NAIVE_ATTN
#define NAIVE_ATTN 0
#endif
#ifndef NAIVE_S5
#define NAIVE_S5 0
#endif
#ifndef NAIVE_HG
#define NAIVE_HG 0
#endif
#ifndef PROBE_PH
#define PROBE_PH 0
#endif
#ifndef PROBE_N
#define PROBE_N 1
#endif
#define LBAR() do { asm volatile("s_waitcnt lgkmcnt(0)" ::: "memory"); __builtin_amdgcn_s_barrier(); asm volatile("" ::: "memory"); } while (0)
#define REP(id) for (int rep_ = 0; rep_ < ((PROBE_PH == (id)) ? PROBE_N : 1); ++rep_)
#ifndef MK_PER_PHASE
#define MK_PER_PHASE 0
#endif

#define GAS __attribute__((address_space(1)))
#define LAS __attribute__((address_space(3)))
typedef unsigned short bf16_t;
typedef short bf16x8 __attribute__((ext_vector_type(8)));
typedef float f32x4 __attribute__((ext_vector_type(4)));
typedef float f32x2 __attribute__((ext_vector_type(2)));
typedef float f32x16 __attribute__((ext_vector_type(16)));
typedef unsigned u32x4 __attribute__((ext_vector_type(4)));
typedef unsigned u32x2 __attribute__((ext_vector_type(2)));
typedef GAS unsigned gu32;

constexpr int D = 1024, NB = 8, SEQ = 2048, CTXL = 256, NLAT = NB * SEQ, NCTX = NB * CTXL, MTOK = NLAT + NCTX;
constexpr int ZC = 5888, INC = 5792;
constexpr int ZU = 0, ZCQ = 256, ZCKV = 512, ZKPE = 640, ZHQ = 672, ZF0 = 1184, ZF1 = 1696, ZI = 2208, ZG = 2464, ZGA = 2720, ZGB = 3744, ZGC = 4768;
constexpr float EPS = 1e-6f;
constexpr float QSCALE = 0.10206207261596577f * 1.4426950408889634f;
constexpr int NEXP = 32, HID = 512;
constexpr int XS_ROWS = 45056;

constexpr size_t MiB = 1u << 20;
constexpr size_t WS_CTL = 0, CTL_ZERO_BYTES = 96 * 1024;
constexpr size_t WS_MODV = 1 * MiB;
constexpr size_t WS_ROPE = 2 * MiB;
constexpr size_t WS_SSQ = 2 * MiB + 65536;
constexpr size_t WS_ROUTE = 3 * MiB;
constexpr size_t WS_S5P = 4 * MiB;
constexpr size_t WS_LISTS = 5 * MiB;
constexpr size_t WS_WB = 8 * MiB;
constexpr size_t WL_WIN = 0, WL_UQ = WL_WIN + (size_t)ZC * D * 2, WL_UKV = WL_UQ + 768 * 256 * 2, WL_GLU = WL_UKV + 1024 * 128 * 2,
                 WL_PA = WL_GLU + 256 * 256 * 2, WL_PB = WL_PA + 1024 * 256 * 2, WL_PC = WL_PB + 1024 * 512 * 2, WL_OUT = WL_PC + 1024 * 256 * 2,
                 WL_BS = WL_OUT + 1024 * 1024 * 2, WL_B2 = WL_BS + 32 * 128 * 256 * 2, WL_END = WL_B2 + 16 * 256 * 512 * 2;
constexpr size_t WL_STRIDE = 24 * MiB;
static_assert(WL_END <= WL_STRIDE, "weights per layer");
constexpr size_t WS_X = 56 * MiB;
constexpr size_t WS_H = 128 * MiB;
constexpr size_t WS_MIX = 164 * MiB;
constexpr size_t MX_Q = 0, MX_KN = MX_Q + (size_t)MTOK * 768 * 2, MX_V = MX_KN + (size_t)MTOK * 512 * 2, MX_KPE = MX_V + (size_t)MTOK * 512 * 2,
                 MX_YS5P = MX_KPE + (size_t)MTOK * 32 * 2, MX_YS5 = MX_YS5P + (size_t)MTOK * 256 * 2, MX_YHG = MX_YS5 + (size_t)MTOK * 256 * 2,
                 MX_YMLA = MX_YHG + (size_t)MTOK * 256 * 2, MX_S5A = MX_YMLA + (size_t)MTOK * 512 * 2, MX_HGD = MX_S5A + (size_t)16 * 1280 * 512 * 2,
                 MX_END = MX_HGD + (size_t)2304 * 128 * 4;
static_assert(MX_END <= 132 * MiB, "mixer region");
constexpr size_t MW_W13 = 0, MW_W2 = (size_t)NEXP * 1024 * 1024;
static_assert(MW_W2 + (size_t)NEXP * 1024 * 512 <= 48 * MiB, "moe weights");
constexpr size_t WS_Z = 296 * MiB;
constexpr size_t MZ_XS = 0, MZ_HID = (size_t)XS_ROWS * 1024 * 2;
constexpr size_t MZ_H8 = MZ_HID + (size_t)XS_ROWS * 512;
constexpr float Y8_SCALE = 16.f, Y8_INV = 1.f / 16.f;
constexpr float W8_SCALE = 32.f, W8_INV = 1.f / 32.f;
constexpr size_t WS_MW = WS_Z + (size_t)MTOK * ZC * 2;
constexpr size_t WS_END = WS_MW + 48 * MiB;
static_assert(MZ_HID + (size_t)XS_ROWS * 512 * 2 <= (size_t)MTOK * ZC * 2, "moe buffers");
constexpr int CW_BAR = 4096;
constexpr int CW_CNT = 16384;

__device__ __forceinline__ unsigned f2bf(float f) { unsigned u = __builtin_bit_cast(unsigned, f); return (u + 0x7fffu + ((u >> 16) & 1u)) >> 16; }
typedef __bf16 bf16x2_t __attribute__((ext_vector_type(2)));
__device__ __forceinline__ unsigned pk2(float lo, float hi) { const f32x2 v = {lo, hi}; return __builtin_bit_cast(unsigned, __builtin_convertvector(v, bf16x2_t)); }
__device__ __forceinline__ unsigned pk4_fp8(float a, float b, float c, float d) { int w = 0; a = __builtin_amdgcn_fmed3f(a, 448.f, -448.f); b = __builtin_amdgcn_fmed3f(b, 448.f, -448.f); c = __builtin_amdgcn_fmed3f(c, 448.f, -448.f); d = __builtin_amdgcn_fmed3f(d, 448.f, -448.f); w = __builtin_amdgcn_cvt_pk_fp8_f32(a, b, w, false); w = __builtin_amdgcn_cvt_pk_fp8_f32(c, d, w, true); return (unsigned)w; }
__device__ __forceinline__ float bf2f(unsigned short b) { return __builtin_bit_cast(float, (unsigned)b << 16); }
__device__ __forceinline__ float bflo(unsigned w) { return __builtin_bit_cast(float, w << 16); }
__device__ __forceinline__ float bfhi(unsigned w) { return __builtin_bit_cast(float, w & 0xffff0000u); }
template <int CTRL> __device__ __forceinline__ float dppf(float v) { return __builtin_bit_cast(float, __builtin_amdgcn_update_dpp(0, __builtin_bit_cast(int, v), CTRL, 0xf, 0xf, true)); }
__device__ __forceinline__ float rlanef(float v, int l) { return __builtin_bit_cast(float, __builtin_amdgcn_readlane(__builtin_bit_cast(int, v), l)); }
__device__ __forceinline__ float wave_sum(float v) {
    v += dppf<0xB1>(v); v += dppf<0x4E>(v); v += dppf<0x141>(v); v += dppf<0x140>(v);
    return (rlanef(v, 0) + rlanef(v, 16)) + (rlanef(v, 32) + rlanef(v, 48));
}
__device__ __forceinline__ int shfl_i(int v, int src_lane) { return __builtin_amdgcn_ds_bpermute(src_lane << 2, v); }
__device__ __forceinline__ float shfl_f(float v, int src_lane) { return __builtin_bit_cast(float, __builtin_amdgcn_ds_bpermute(src_lane << 2, __builtin_bit_cast(int, v))); }
__device__ __forceinline__ float sigmoidf_(float x) { return __builtin_amdgcn_rcpf(1.f + __expf(-x)); }
__device__ __forceinline__ float siluf_(float x) { return x * __builtin_amdgcn_rcpf(1.f + __expf(-x)); }
__device__ __forceinline__ float gelu_tanh(float x) { const float t = 0.7978845608028654f * (x + 0.044715f * x * x * x); return x * __builtin_amdgcn_rcpf(1.f + __expf(-2.f * t)); }
__device__ __forceinline__ int tok_modrow(int row) { return row < NLAT ? (row >> 11) : 8; }

namespace pg8 {
constexpr int BM = 256, BK = 64, HALF = 128, HTB = HALF * BK * 2, STAGE_BYTES = 8 * HTB, NXCD = 8, WGM = 8;
__host__ __device__ __forceinline__ int lds_byte(int r, int c) { const int st = (r >> 4) * 2 + (c >> 5), rr = r & 15, cc = c & 31, ob = rr * 64 + cc * 2; return st * 1024 + (ob ^ (((ob >> 9) & 1) << 5)); }
__host__ __device__ __forceinline__ void stage_rc(int b, int& R, int& C) { const int st = b / 1024, sb = b % 1024, swz = sb ^ (((sb >> 9) & 1) << 5); R = (st >> 1) * 16 + swz / 64; C = (st & 1) * 32 + (swz % 64) / 2; }
__host__ __device__ __forceinline__ int perm32(int rho) { const int n = rho >> 4, i = rho & 15; return 8 * (i >> 2) + 4 * n + (i & 3); }
typedef int i32x8 __attribute__((ext_vector_type(8)));
typedef int i32x4_ __attribute__((ext_vector_type(4)));
__device__ __forceinline__ i32x8 cat8(bf16x8 lo, bf16x8 hi) { return __builtin_shufflevector(__builtin_bit_cast(i32x4_, lo), __builtin_bit_cast(i32x4_, hi), 0, 1, 2, 3, 4, 5, 6, 7); }
struct Unit { int pm, pn, h; };
struct Gemm { const bf16_t* A; const bf16_t* Bt; int K, lda, ldb; };
struct StaticOrder {
    int nM, nN, nwg, G, c;
    __device__ void init(int M, int N, int G_, int c_) { nM = M / BM; nN = N / BM; nwg = nM * nN; G = G_; c = c_; }
    __device__ bool next(int i, Unit& u) const { const long L = (long)i * G + c; if (L >= nwg) return false; map((int)L, u); return true; }
    __device__ void map(int L, Unit& u) const {
        int wgid = L; { const int q = nwg / NXCD, r = nwg % NXCD, xcd = wgid % NXCD, off = wgid / NXCD; wgid = (xcd < r ? xcd * (q + 1) : r * (q + 1) + (xcd - r) * q) + off; }
        const int nig = WGM * nN, gid = wgid / nig, fm = gid * WGM, gsz = (nM - fm) < WGM ? (nM - fm) : WGM;
        u.pm = fm + ((wgid % nig) % gsz); u.pn = (wgid % nig) / gsz; u.h = -1;
    }
};
template <class Epi, class Sched, bool GATHER = false, bool HALFS = false, bool FP8 = false, bool MERGE3 = false>
__device__ __forceinline__ void gemm_phase(LAS unsigned char* lds, int tid_in, const Gemm g, const Sched& S, const Epi& E) {
    int tid_ = tid_in; asm volatile("" : "+v"(tid_));
    const int tid = tid_, wid = __builtin_amdgcn_readfirstlane(tid >> 6), lane = tid & 63, wr = wid >> 2, wc = wid & 3, fr = lane & 15, fq = lane >> 4;
    const int K = g.K, nt = K / BK;
    unsigned voffB[2], vAc[2][2], vAx[2][2];
#pragma unroll
    for (int i = 0; i < 2; ++i) { int R, C; stage_rc(tid * 16 + i * 8192, R, C); const int Rb = (R & ~31) + perm32(R & 31);
        voffB[i] = (unsigned)(Rb * g.ldb + C) * 2u;
#pragma unroll
        for (int h = 0; h < 2; ++h) vAc[h][i] = vAx[h][i] = (unsigned)((R + 128 * h) * g.lda + C) * 2u; }
#define PG8_GROWS(dst, uidx) do { if constexpr (GATHER) { _Pragma("unroll") for (int i_ = 0; i_ < 2; ++i_) { int R_, C_; stage_rc(tid * 16 + i_ * 8192, R_, C_); \
        _Pragma("unroll") for (int h_ = 0; h_ < 2; ++h_) dst[h_][i_] = (unsigned)(S.a_row((uidx), R_ + 128 * h_) * g.lda + C_) * 2u; } } } while (0)
    const size_t kstep = (size_t)(BK * 2);
    const size_t hstepA = (size_t)HALF * g.lda * 2, hstepB = (size_t)HALF * g.ldb * 2;
    const size_t tstepA = 2 * hstepA, tstepB = 2 * hstepB;
    const unsigned ldsw = (unsigned)wid * 1024u;
    const int aoff = lds_byte(wr * 64 + fr, fq * 8), boff = lds_byte(wc * 32 + fr, fq * 8);
#define PG8_SA(b, h) (((b) * 2 + (h)) * HTB)
#define PG8_SB(b, h) ((4 + (b) * 2 + (h)) * HTB)
#define PG8_STAGE(bufoff, gbase, voff) do { const char* gb_ = (const char*)(gbase); asm volatile("" : "+s"(gb_)); _Pragma("unroll") for (int _i = 0; _i < 2; ++_i) { unsigned vo_ = (voff)[_i]; asm volatile("" : "+v"(vo_)); \
        __builtin_amdgcn_global_load_lds((const unsigned*)(gb_ + vo_), (LAS unsigned*)(lds + (bufoff) + ldsw + _i * 8192), 16, 0, 0); } } while (0)
#define PG8_LDA(dst, b, h) do { _Pragma("unroll") for (int m = 0; m < 4; ++m) _Pragma("unroll") for (int k = 0; k < 2; ++k) dst[m][k] = *(const LAS bf16x8*)(lds + PG8_SA(b, h) + aoff + m * 2048 + k * 1024); } while (0)
#define PG8_LDB(dst, b, h) do { _Pragma("unroll") for (int n = 0; n < 2; ++n) _Pragma("unroll") for (int k = 0; k < 2; ++k) dst[n][k] = *(const LAS bf16x8*)(lds + PG8_SB(b, h) + boff + n * 2048 + k * 1024); } while (0)
#define PG8_MMA(ai, bj, At, Bt) do { __builtin_amdgcn_s_setprio(1); _Pragma("unroll") for (int m = 0; m < 4; ++m) _Pragma("unroll") for (int n = 0; n < 2; ++n) { \
        if constexpr (FP8) asm volatile("v_mfma_f32_16x16x128_f8f6f4 %0, %1, %2, %0" : "+v"(acc[ai][bj][m][n]) : "v"(cat8(Bt[n][0], Bt[n][1])), "v"(cat8(At[m][0], At[m][1]))); \
        else { _Pragma("unroll") for (int k = 0; k < 2; ++k) acc[ai][bj][m][n] = __builtin_amdgcn_mfma_f32_16x16x32_bf16(Bt[n][k], At[m][k], acc[ai][bj][m][n], 0, 0, 0); } } __builtin_amdgcn_s_setprio(0); } while (0)
#define PG8_WAIT_V(n) asm volatile("s_waitcnt vmcnt(" #n ")" ::: "memory")
#define PG8_WAIT_L(n) asm volatile("s_waitcnt lgkmcnt(" #n ")" ::: "memory")
#define PG8_BAR __builtin_amdgcn_s_barrier()
#define PG8_SCHED __builtin_amdgcn_sched_barrier(0)
    Unit cur, nxt; int ui = 0;
    if (!S.next(0, cur)) return;
    f32x4 acc[2][2][4][2];
#pragma unroll
    for (int a = 0; a < 2; ++a)
#pragma unroll
        for (int b = 0; b < 2; ++b)
#pragma unroll
            for (int m = 0; m < 4; ++m)
#pragma unroll
                for (int n = 0; n < 2; ++n) acc[a][b][m][n] = (f32x4){0.f, 0.f, 0.f, 0.f};
    bf16x8 At[4][2], B0[2][2], B1[2][2];
    const char* cA = (const char*)g.A + (GATHER ? (size_t)0 : (size_t)cur.pm * tstepA); const char* cB = (const char*)g.Bt + (size_t)cur.pn * tstepB;
    PG8_GROWS(vAc, 0);
    PG8_STAGE(PG8_SB(0, 0), cB, voffB); PG8_STAGE(PG8_SB(0, 1), cB + hstepB, voffB); PG8_STAGE(PG8_SA(0, 0), cA, vAc[0]); PG8_STAGE(PG8_SA(0, 1), cA, vAc[1]);
    if (wr == 1) PG8_BAR;
    PG8_WAIT_V(2); PG8_BAR;
    PG8_STAGE(PG8_SB(1, 0), cB + kstep, voffB); PG8_STAGE(PG8_SA(1, 0), cA + kstep, vAc[0]); PG8_STAGE(PG8_SB(1, 1), cB + hstepB + kstep, voffB);
    PG8_WAIT_V(6); PG8_BAR;
    for (;;) {
        const bool has_next = S.next(ui + 1, nxt);
        const char* nA = (has_next && !GATHER) ? (const char*)g.A + (size_t)nxt.pm * tstepA : cA;
        if constexpr (GATHER) { if (has_next) PG8_GROWS(vAx, ui + 1); else {
#pragma unroll
            for (int h = 0; h < 2; ++h) { vAx[h][0] = vAc[h][0]; vAx[h][1] = vAc[h][1]; } } }
        const char* nB = has_next ? (const char*)g.Bt + (size_t)nxt.pn * tstepB : cB;
        asm volatile(".p2align 8" ::: "memory");
        for (int seg = 0; seg < (MERGE3 ? 3 : 1); ++seg) {
        const int tb = MERGE3 ? (seg == 0 ? 0 : (seg == 1 ? 4 : 12)) : 0, te = MERGE3 ? (seg == 0 ? 4 : (seg == 1 ? 12 : 16)) : nt;
        for (int t = tb; t < te; t += 2) {
            const bool last = (t == nt - 2);
            const char* a1 = cA + (size_t)(t + 1) * kstep;
            const char* a2 = last ? nA : cA + (size_t)(t + 2) * kstep; const char* b2 = last ? nB : cB + (size_t)(t + 2) * kstep;
            const char* a3 = a2 + kstep; const char* b3 = b2 + kstep;
            asm volatile("" : "+s"(a1), "+s"(a2), "+s"(b2), "+s"(a3), "+s"(b3));
            unsigned vS0[2], vS1[2];
            if constexpr (GATHER) { vS0[0] = last ? vAx[0][0] : vAc[0][0]; vS0[1] = last ? vAx[0][1] : vAc[0][1]; vS1[0] = last ? vAx[1][0] : vAc[1][0]; vS1[1] = last ? vAx[1][1] : vAc[1][1]; }
            else { vS0[0] = vAc[0][0]; vS0[1] = vAc[0][1]; vS1[0] = vAc[1][0]; vS1[1] = vAc[1][1]; }
            PG8_LDB(B0, 0, 0); PG8_LDB(B1, 0, 1); PG8_SCHED; PG8_LDA(At, 0, 0); PG8_STAGE(PG8_SA(1, 1), a1, vAc[1]);
            PG8_WAIT_V(8); PG8_WAIT_L(0); PG8_BAR; if (!HALFS || cur.h != 1) { PG8_MMA(0, 0, At, B0); PG8_MMA(0, 1, At, B1); } PG8_BAR; PG8_SCHED;
            PG8_LDA(At, 0, 1); PG8_STAGE(PG8_SB(0, 0), b2, voffB); PG8_STAGE(PG8_SB(0, 1), b2 + hstepB, voffB); PG8_STAGE(PG8_SA(0, 0), a2, vS0);
            PG8_WAIT_V(8); PG8_WAIT_L(0); PG8_BAR; if (!HALFS || cur.h != 0) { PG8_MMA(1, 0, At, B0); PG8_MMA(1, 1, At, B1); } PG8_BAR; PG8_SCHED;
            PG8_LDB(B0, 1, 0); PG8_LDB(B1, 1, 1); PG8_SCHED; PG8_LDA(At, 1, 0); PG8_STAGE(PG8_SA(0, 1), a2, vS1);
            PG8_WAIT_V(8); PG8_WAIT_L(0); PG8_BAR; if (!HALFS || cur.h != 1) { PG8_MMA(0, 0, At, B0); PG8_MMA(0, 1, At, B1); } PG8_BAR; PG8_SCHED;
            PG8_LDA(At, 1, 1); PG8_STAGE(PG8_SB(1, 0), b3, voffB); PG8_STAGE(PG8_SB(1, 1), b3 + hstepB, voffB); PG8_STAGE(PG8_SA(1, 0), a3, vS0);
            PG8_WAIT_V(8); PG8_WAIT_L(0); PG8_BAR; if (!HALFS || cur.h != 0) { PG8_MMA(1, 0, At, B0); PG8_MMA(1, 1, At, B1); } PG8_BAR; PG8_SCHED;
        }
        if constexpr (MERGE3) E.rescale(acc, cur, wr, wc, fr, fq, seg);
        }
        if constexpr (FP8) asm volatile("s_nop 15\n\ts_nop 15" ::: "memory");
        if (wr == 0) PG8_BAR;
        E(acc, cur, wr, wc, fr, fq);
        if (!has_next) break;
#pragma unroll
        for (int a = 0; a < 2; ++a)
#pragma unroll
            for (int b = 0; b < 2; ++b)
#pragma unroll
                for (int m = 0; m < 4; ++m)
#pragma unroll
                    for (int n = 0; n < 2; ++n) acc[a][b][m][n] = (f32x4){0.f, 0.f, 0.f, 0.f};
        cur = nxt; cA = nA; cB = nB; ++ui;
        if constexpr (GATHER) {
#pragma unroll
            for (int h = 0; h < 2; ++h) { vAc[h][0] = vAx[h][0]; vAc[h][1] = vAx[h][1]; } }
        if (wr == 1) PG8_BAR;
    }
    PG8_WAIT_V(0);
    PG8_BAR;
#undef PG8_SA
#undef PG8_SB
#undef PG8_STAGE
#undef PG8_GROWS
#undef PG8_LDA
#undef PG8_LDB
#undef PG8_MMA
#undef PG8_WAIT_V
#undef PG8_WAIT_L
#undef PG8_BAR
#undef PG8_SCHED
}
}

enum EpiMode { EM_Z = 0, EM_Q = 1, EM_KV = 2, EM_GLU = 3, EM_MERGE0 = 4, EM_MERGE1 = 5, EM_WOUT = 6, EM_MOEUP = 7, EM_MOEDN = 8, EM_S5 = 9, EM_MERGEF = 10 };
template <int mode> struct Epi {
    bf16_t* o0; bf16_t* o1; bf16_t* o2;
    const bf16_t* i0;
    const float* f0; const float* f1; const float* f2;
    float* fo;
    float* ssq;
    const float* rope;
    int layer;
    struct Side { u32x4 s[4]; };
    __device__ __forceinline__ Side load_side(const pg8::Unit& u, int ai, int m, int wr, int fr, int cl) const {
        Side S; const int row = u.pm * 256 + ai * 128 + wr * 64 + m * 16 + fr;
        if constexpr (mode == EM_Q) S.s[0] = *(const u32x4*)(ssq + (size_t)row * 4);
        else if constexpr (mode == EM_KV) S.s[0] = *(const u32x4*)(ssq + (size_t)MTOK * 4 + (size_t)row * 4);
        else if constexpr (mode == EM_GLU) { S.s[0] = *(const u32x4*)(i0 + (size_t)row * 256 + cl); S.s[1] = *(const u32x4*)(i0 + (size_t)row * 256 + 128 + cl); }
        else if constexpr (mode == EM_MERGE0 || mode == EM_MERGE1) { const int col = u.pn * 256 + cl;
            S.s[0] = *(const u32x4*)(i0 + (size_t)row * ZC + col); S.s[1] = *(const u32x4*)(i0 + (size_t)row * ZC + col + 128);
            if constexpr (mode == EM_MERGE1) { S.s[2] = __builtin_nontemporal_load((const u32x4*)(o0 + (size_t)row * 1024 + col)); S.s[3] = __builtin_nontemporal_load((const u32x4*)(o0 + (size_t)row * 1024 + col + 128)); } }
        else if constexpr (mode == EM_WOUT) { const int col = u.pn * 256 + cl;
            if (layer == 0) { const float* xin = row < NLAT ? f1 + (size_t)row * D : f2 + (size_t)(row - NLAT) * D;
                S.s[0] = *(const u32x4*)(xin + col); S.s[1] = *(const u32x4*)(xin + col + 4); S.s[2] = *(const u32x4*)(xin + col + 128); S.s[3] = *(const u32x4*)(xin + col + 132); }
            else { const bf16_t* xb = (const bf16_t*)fo + (size_t)row * D + col; const u32x4 p0 = *(const u32x4*)xb, p1 = *(const u32x4*)(xb + 128);
                S.s[0] = __builtin_bit_cast(u32x4, (f32x4){bflo(p0.x), bfhi(p0.x), bflo(p0.y), bfhi(p0.y)}); S.s[1] = __builtin_bit_cast(u32x4, (f32x4){bflo(p0.z), bfhi(p0.z), bflo(p0.w), bfhi(p0.w)});
                S.s[2] = __builtin_bit_cast(u32x4, (f32x4){bflo(p1.x), bfhi(p1.x), bflo(p1.y), bfhi(p1.y)}); S.s[3] = __builtin_bit_cast(u32x4, (f32x4){bflo(p1.z), bfhi(p1.z), bflo(p1.w), bfhi(p1.w)}); } }
        else if constexpr (mode == EM_S5) { S.s[0] = *(const u32x4*)(i0 + (size_t)row * 512 + cl); S.s[1] = *(const u32x4*)(i0 + (size_t)row * 512 + 128 + cl); }
        return S;
    }
    __device__ __forceinline__ void rescale(f32x4 (&acc)[2][2][4][2], const pg8::Unit& u, int wr, int wc, int fr_in, int fq_in, int stage) const {
        int fr = fr_in, fq = fq_in; asm volatile("" : "+v"(fr), "+v"(fq));
        const int cl = wc * 32 + 8 * fq; const bf16_t* ga = i0 + (stage == 0 ? ZGA : (stage == 1 ? ZGB : ZGC)) + u.pn * 256 + cl; const bf16_t* gb = i0 + (stage == 0 ? ZGB : ZGC) + u.pn * 256 + cl;
        const float nb = stage < 2 ? 1.f : 0.f;
        const size_t rb = (size_t)(u.pm * 256 + wr * 64 + fr) * ZC;
        u32x4 g[3][4];
#define RS_LD(it_) do { const size_t ro = rb + (size_t)(((it_) >> 2) * 128 + ((it_) & 3) * 16) * ZC; g[(it_) % 3][0] = *(const u32x4*)(ga + ro); g[(it_) % 3][1] = *(const u32x4*)(ga + ro + 128); \
            g[(it_) % 3][2] = *(const u32x4*)(gb + ro); g[(it_) % 3][3] = *(const u32x4*)(gb + ro + 128); } while (0)
        RS_LD(0); RS_LD(1);
#pragma unroll
        for (int it = 0; it < 8; ++it) { const int ai = it >> 2, m = it & 3;
            if (it + 2 < 8) RS_LD(it + 2);
            asm volatile("" ::: "memory");
            const u32x4 a0 = g[it % 3][0], a1 = g[it % 3][1], b0 = g[it % 3][2], b1 = g[it % 3][3];
#define RS_(av, bv) ((1.f + nb * (bv)) * __builtin_amdgcn_rcpf(1.f + (av)))
            { f32x4& c0 = acc[ai][0][m][0]; f32x4& c1 = acc[ai][0][m][1];
              c0[0] *= RS_(bflo(a0.x), bflo(b0.x)); c0[1] *= RS_(bfhi(a0.x), bfhi(b0.x)); c0[2] *= RS_(bflo(a0.y), bflo(b0.y)); c0[3] *= RS_(bfhi(a0.y), bfhi(b0.y));
              c1[0] *= RS_(bflo(a0.z), bflo(b0.z)); c1[1] *= RS_(bfhi(a0.z), bfhi(b0.z)); c1[2] *= RS_(bflo(a0.w), bflo(b0.w)); c1[3] *= RS_(bfhi(a0.w), bfhi(b0.w)); }
            { f32x4& c0 = acc[ai][1][m][0]; f32x4& c1 = acc[ai][1][m][1];
              c0[0] *= RS_(bflo(a1.x), bflo(b1.x)); c0[1] *= RS_(bfhi(a1.x), bfhi(b1.x)); c0[2] *= RS_(bflo(a1.y), bflo(b1.y)); c0[3] *= RS_(bfhi(a1.y), bfhi(b1.y));
              c1[0] *= RS_(bflo(a1.z), bflo(b1.z)); c1[1] *= RS_(bfhi(a1.z), bfhi(b1.z)); c1[2] *= RS_(bflo(a1.w), bflo(b1.w)); c1[3] *= RS_(bfhi(a1.w), bfhi(b1.w)); }
#undef RS_
        }
#undef RS_LD
    }
    __device__ __forceinline__ void operator()(const f32x4 (&acc)[2][2][4][2], const pg8::Unit& u, int wr, int wc, int fr_in, int fq_in) const {
        int fr = fr_in, fq = fq_in; asm volatile("" : "+v"(fr), "+v"(fq));
        const int cl = wc * 32 + 8 * fq;
        f32x4 hc[4] = {};
        if constexpr (mode == EM_GLU) { hc[0] = *(const f32x4*)(f0 + cl); hc[1] = *(const f32x4*)(f0 + cl + 4); hc[2] = *(const f32x4*)(f0 + 128 + cl); hc[3] = *(const f32x4*)(f0 + 128 + cl + 4); }
        if constexpr (mode == EM_WOUT) { const float* gt = f0 + (size_t)tok_modrow(u.pm * 256) * 6144 + 2 * 1024 + u.pn * 256 + cl;
            hc[0] = *(const f32x4*)(gt); hc[1] = *(const f32x4*)(gt + 4); hc[2] = *(const f32x4*)(gt + 128); hc[3] = *(const f32x4*)(gt + 132); }
        if constexpr (mode == EM_S5) { const float* dk = f0 + u.pn * 16 + (cl & 15); hc[0] = *(const f32x4*)(dk); hc[1] = *(const f32x4*)(dk + 4); }
        Side cur = load_side(u, 0, 0, wr, fr, cl);
#pragma unroll
        for (int it = 0; it < 8; ++it) {
                const int ai = it >> 2, m = it & 3;
                if (u.h >= 0 && ai != u.h) { if (it < 7) cur = load_side(u, (it + 1) >> 2, (it + 1) & 3, wr, fr, cl); continue; }
                Side nxt = cur; if (it < 7) nxt = load_side(u, (it + 1) >> 2, (it + 1) & 3, wr, fr, cl);
                asm volatile("" ::: "memory");
                const int row = u.pm * 256 + ai * 128 + wr * 64 + m * 16 + fr;
                if constexpr (mode == EM_Z) {
                    float s0 = 0.f;
#pragma unroll
                    for (int bj = 0; bj < 2; ++bj) {
                        f32x4 v0 = acc[ai][bj][m][0], v1 = acc[ai][bj][m][1];
                        const int col = u.pn * 256 + bj * 128 + cl;
                        if (u.pn == 1 || (u.pn == 2 && bj == 0)) s0 += (v0[0] * v0[0] + v0[1] * v0[1]) + (v0[2] * v0[2] + v0[3] * v0[3]) + (v1[0] * v1[0] + v1[1] * v1[1]) + (v1[2] * v1[2] + v1[3] * v1[3]);
                        if (u.pn == 2 && bj == 1 && wc == 0) {
                            if (row < NLAT) {
                                const int t = row & 2047, pb = 4 * fq, axis = pb >> 3, pos = axis ? (t & 63) : (t >> 6);
                                const float* cs = rope + pos * 8 + (pb & 7); const float* sn = cs + 512;
                                float x1, x2;
                                x1 = v0[0]; x2 = v0[1]; v0[0] = x1 * cs[0] - x2 * sn[0]; v0[1] = x1 * sn[0] + x2 * cs[0];
                                x1 = v0[2]; x2 = v0[3]; v0[2] = x1 * cs[1] - x2 * sn[1]; v0[3] = x1 * sn[1] + x2 * cs[1];
                                x1 = v1[0]; x2 = v1[1]; v1[0] = x1 * cs[2] - x2 * sn[2]; v1[1] = x1 * sn[2] + x2 * cs[2];
                                x1 = v1[2]; x2 = v1[3]; v1[2] = x1 * cs[3] - x2 * sn[3]; v1[3] = x1 * sn[3] + x2 * cs[3];
                            }
                            u32x4 w; w.x = pk2(v0[0], v0[1]); w.y = pk2(v0[2], v0[3]); w.z = pk2(v1[0], v1[1]); w.w = pk2(v1[2], v1[3]);
                            *(u32x4*)(o1 + (size_t)row * 32 + 8 * fq) = w;
                        }
                        if (col >= ZGA) {
#pragma unroll
                            for (int i = 0; i < 4; ++i) { v0[i] = __expf(-__builtin_amdgcn_fmed3f(v0[i], -30.f, 30.f)); v1[i] = __expf(-__builtin_amdgcn_fmed3f(v1[i], -30.f, 30.f)); } }
                        u32x4 w; w.x = pk2(v0[0], v0[1]); w.y = pk2(v0[2], v0[3]); w.z = pk2(v1[0], v1[1]); w.w = pk2(v1[2], v1[3]);
                        *(u32x4*)(o0 + (size_t)row * ZC + col) = w;
                        if (u.pn == 0) {
                            int b, s; if (row < NLAT) { b = row >> 11; s = 256 + (row & 2047); } else { b = (row - NLAT) >> 8; s = (row - NLAT) & 255; }
                            const int colu = bj * 128 + cl, g = colu >> 4, h0 = colu & 15;
                            *(u32x4*)(o2 + ((size_t)g * 1280 + b * 160 + (s >> 4)) * 512 + (s & 15) * 16 + h0) = w;
                        }
                    }
                    if (u.pn == 1 || u.pn == 2) {
                        { const int ln = fr + 16 * fq; s0 += shfl_f(s0, ln ^ 16); s0 += shfl_f(s0, ln ^ 32); }
                        if (fq == 0) ssq[(size_t)(u.pn - 1) * MTOK * 4 + (size_t)row * 4 + wc] = s0;
                    }
                } else if constexpr (mode == EM_Q || mode == EM_KV) {
                    const f32x4 sp = __builtin_bit_cast(f32x4, cur.s[0]);
                    const float rs = mode == EM_Q ? rsqrtf(((sp[0] + sp[1]) + (sp[2] + sp[3])) * (1.f / 256.f) + EPS) * QSCALE : rsqrtf(((sp[0] + sp[1]) + (sp[2] + sp[3])) * (1.f / 128.f) + EPS);
#pragma unroll
                    for (int bj = 0; bj < 2; ++bj) {
                        f32x4 v0 = acc[ai][bj][m][0] * rs, v1 = acc[ai][bj][m][1] * rs;
                        const int col = u.pn * 256 + bj * 128 + cl;
                        if constexpr (mode == EM_Q) { const int cc = col % 96;
                            if (cc >= 64 && row < NLAT) {
                                const int t = row & 2047, pb = (cc - 64) >> 1, axis = pb >> 3, pos = axis ? (t & 63) : (t >> 6);
                                const float* cs = rope + pos * 8 + (pb & 7); const float* sn = cs + 512;
                                float x1, x2;
                                x1 = v0[0]; x2 = v0[1]; v0[0] = x1 * cs[0] - x2 * sn[0]; v0[1] = x1 * sn[0] + x2 * cs[0];
                                x1 = v0[2]; x2 = v0[3]; v0[2] = x1 * cs[1] - x2 * sn[1]; v0[3] = x1 * sn[1] + x2 * cs[1];
                                x1 = v1[0]; x2 = v1[1]; v1[0] = x1 * cs[2] - x2 * sn[2]; v1[1] = x1 * sn[2] + x2 * cs[2];
                                x1 = v1[2]; x2 = v1[3]; v1[2] = x1 * cs[3] - x2 * sn[3]; v1[3] = x1 * sn[3] + x2 * cs[3];
                            } }
                        u32x4 w; w.x = pk2(v0[0], v0[1]); w.y = pk2(v0[2], v0[3]); w.z = pk2(v1[0], v1[1]); w.w = pk2(v1[2], v1[3]);
                        if constexpr (mode == EM_Q) *(u32x4*)(o0 + (size_t)row * 768 + col) = w;
                        else { bf16_t* dst = col < 512 ? o0 + (size_t)row * 512 + col : o1 + (size_t)row * 512 + (col - 512); *(u32x4*)dst = w; }
                    }
                } else if constexpr (mode == EM_GLU) {
#pragma unroll
                    for (int bj = 0; bj < 2; ++bj) {
                        const int col = bj * 128 + cl;
                        const f32x4 a0 = acc[ai][bj][m][0] + hc[2 * bj], a1 = acc[ai][bj][m][1] + hc[2 * bj + 1];
                        const u32x4 y = cur.s[bj];
                        u32x4 w;
                        w.x = pk2(bflo(y.x) * sigmoidf_(a0[0]), bfhi(y.x) * sigmoidf_(a0[1])); w.y = pk2(bflo(y.y) * sigmoidf_(a0[2]), bfhi(y.y) * sigmoidf_(a0[3]));
                        w.z = pk2(bflo(y.z) * sigmoidf_(a1[0]), bfhi(y.z) * sigmoidf_(a1[1])); w.w = pk2(bflo(y.w) * sigmoidf_(a1[2]), bfhi(y.w) * sigmoidf_(a1[3]));
                        *(u32x4*)(o0 + (size_t)row * 1024 + col) = w;
                    }
                } else if constexpr (mode == EM_MERGEF) {
#pragma unroll
                    for (int bj = 0; bj < 2; ++bj) {
                        const int col = u.pn * 256 + bj * 128 + cl;
                        const f32x4 a0 = acc[ai][bj][m][0], a1 = acc[ai][bj][m][1];
                        u32x4 w; w.x = pk2(a0[0], a0[1]); w.y = pk2(a0[2], a0[3]); w.z = pk2(a1[0], a1[1]); w.w = pk2(a1[2], a1[3]);
                        *(u32x4*)(o0 + (size_t)row * 1024 + col) = w;
                    }
                } else if constexpr (mode == EM_MERGE0 || mode == EM_MERGE1) {
#pragma unroll
                    for (int bj = 0; bj < 2; ++bj) {
                        const int col = u.pn * 256 + bj * 128 + cl;
                        const u32x4 gt = cur.s[bj];
                        const f32x4 a0 = acc[ai][bj][m][0], a1 = acc[ai][bj][m][1];
                        float r[8] = { a0[0] * sigmoidf_(bflo(gt.x)), a0[1] * sigmoidf_(bfhi(gt.x)), a0[2] * sigmoidf_(bflo(gt.y)), a0[3] * sigmoidf_(bfhi(gt.y)),
                                       a1[0] * sigmoidf_(bflo(gt.z)), a1[1] * sigmoidf_(bfhi(gt.z)), a1[2] * sigmoidf_(bflo(gt.w)), a1[3] * sigmoidf_(bfhi(gt.w)) };
                        if constexpr (mode == EM_MERGE1) { const u32x4 pv = cur.s[2 + bj];
                            r[0] += bflo(pv.x); r[1] += bfhi(pv.x); r[2] += bflo(pv.y); r[3] += bfhi(pv.y); r[4] += bflo(pv.z); r[5] += bfhi(pv.z); r[6] += bflo(pv.w); r[7] += bfhi(pv.w); }
                        u32x4 w; w.x = pk2(r[0], r[1]); w.y = pk2(r[2], r[3]); w.z = pk2(r[4], r[5]); w.w = pk2(r[6], r[7]);
                        *(u32x4*)(o0 + (size_t)row * 1024 + col) = w;
                    }
                } else if constexpr (mode == EM_WOUT) {
#pragma unroll
                    for (int bj = 0; bj < 2; ++bj) {
                        const int col = u.pn * 256 + bj * 128 + cl;
                        const f32x4 x0 = __builtin_bit_cast(f32x4, cur.s[2 * bj]) + hc[2 * bj] * acc[ai][bj][m][0], x1 = __builtin_bit_cast(f32x4, cur.s[2 * bj + 1]) + hc[2 * bj + 1] * acc[ai][bj][m][1];
                        u32x4 w; w.x = pk2(x0[0], x0[1]); w.y = pk2(x0[2], x0[3]); w.z = pk2(x1[0], x1[1]); w.w = pk2(x1[2], x1[3]);
                        *(u32x4*)((bf16_t*)fo + (size_t)row * D + col) = w;
                    }
                } else if constexpr (mode == EM_MOEUP) {
                    const f32x4 a0 = acc[ai][0][m][0], a1 = acc[ai][0][m][1], b0 = acc[ai][1][m][0], b1 = acc[ai][1][m][1];
                    u32x2 w; w.x = pk4_fp8(siluf_(a0[0] * W8_INV) * (b0[0] * W8_INV), siluf_(a0[1] * W8_INV) * (b0[1] * W8_INV), siluf_(a0[2] * W8_INV) * (b0[2] * W8_INV), siluf_(a0[3] * W8_INV) * (b0[3] * W8_INV));
                    w.y = pk4_fp8(siluf_(a1[0] * W8_INV) * (b1[0] * W8_INV), siluf_(a1[1] * W8_INV) * (b1[1] * W8_INV), siluf_(a1[2] * W8_INV) * (b1[2] * W8_INV), siluf_(a1[3] * W8_INV) * (b1[3] * W8_INV));
                    *(u32x2*)((unsigned char*)o0 + (size_t)row * HID + (u.pn & 3) * 128 + cl) = w;
                } else if constexpr (mode == EM_MOEDN) {
#pragma unroll
                    for (int bj = 0; bj < 2; ++bj) {
                        const f32x4 v0 = acc[ai][bj][m][0] * (W8_INV * Y8_SCALE), v1 = acc[ai][bj][m][1] * (W8_INV * Y8_SCALE);
                        u32x2 w; w.x = pk4_fp8(v0[0], v0[1], v0[2], v0[3]); w.y = pk4_fp8(v1[0], v1[1], v1[2], v1[3]);
                        *(u32x2*)((unsigned char*)o0 + (size_t)row * 1024 + (u.pn & 3) * 256 + bj * 128 + cl) = w;
                    }
                } else if constexpr (mode == EM_S5) {
                    const int g = u.pn, rr = row - g * 1280, b = rr / 160, c = rr - b * 160;
                    if (c < 144) {
#pragma unroll
                        for (int bj = 0; bj < 2; ++bj) {
                            const int n = bj * 128 + cl, i = n >> 4, h0 = n & 15, s = 16 * c + i;
                            const int trow = s < 256 ? NLAT + b * 256 + s : b * 2048 + (s - 256);
                            const u32x4 uv = cur.s[bj];
                            const f32x4 a0 = acc[ai][bj][m][0], a1 = acc[ai][bj][m][1];
                            u32x4 w;
                            w.x = pk2(gelu_tanh(a0[0] + hc[0][0] * bflo(uv.x)), gelu_tanh(a0[1] + hc[0][1] * bfhi(uv.x))); w.y = pk2(gelu_tanh(a0[2] + hc[0][2] * bflo(uv.y)), gelu_tanh(a0[3] + hc[0][3] * bfhi(uv.y)));
                            w.z = pk2(gelu_tanh(a1[0] + hc[1][0] * bflo(uv.z)), gelu_tanh(a1[1] + hc[1][1] * bfhi(uv.z))); w.w = pk2(gelu_tanh(a1[2] + hc[1][2] * bflo(uv.w)), gelu_tanh(a1[3] + hc[1][3] * bfhi(uv.w)));
                            *(u32x4*)(o0 + (size_t)trow * 256 + g * 16 + h0) = w;
                        }
                    }
                }
                cur = nxt;
        }
    }
};

#define XB_TMO      128
#define XB_XCNT(j)  (256  + 64 * (j))
#define XB_XSUB(j)  (1280 + 64 * (j))
#define XB_XGEN(j)  (2304 + 64 * (j))
#define XB_TOP      3328
#define XB_TOPGEN   3392
#define XCD_BAR_WORDS 3456
#define XB_SPIN_CAP (1u << 22)
__device__ __forceinline__ unsigned xb_ld(unsigned* p)              { return __hip_atomic_load(p, __ATOMIC_RELAXED, __HIP_MEMORY_SCOPE_AGENT); }
__device__ __forceinline__ unsigned xb_add(unsigned* p, unsigned v) { return __hip_atomic_fetch_add(p, v, __ATOMIC_RELAXED, __HIP_MEMORY_SCOPE_AGENT); }
__device__ __forceinline__ unsigned xb_xcc_id() { return (unsigned)__builtin_amdgcn_s_getreg((3 << 11) | 20) & 0xFu; }
#define XB_SPIN(cond, bar) do { unsigned _sp = 0; while (cond) { __builtin_amdgcn_s_sleep(1); \
    if ((++_sp & 255u) == 0u) { if (xb_ld(&(bar)[XB_TMO])) break; if (_sp > XB_SPIN_CAP) { atomicAdd(&(bar)[XB_TMO], 1u); break; } } } } while (0)
struct XcdBarrier { unsigned* bar; unsigned x; volatile LAS unsigned* st; };
__device__ __forceinline__ XcdBarrier xcd_barrier_post(unsigned* bar, volatile LAS unsigned* st) {
    XcdBarrier b; b.bar = bar; b.x = xb_xcc_id(); b.st = st;
    if (threadIdx.x == 0) (void)xb_add(&bar[XB_XCNT(b.x)], 1u);
    return b;
}
__device__ __forceinline__ void xcd_barrier_complete(unsigned* bar, unsigned x, unsigned& nloc, unsigned& nx) {
    const unsigned G = gridDim.x * gridDim.y * gridDim.z;
    unsigned sum, cnt, mine, sp = 0u;
    for (;;) {
        sum = 0u; cnt = 0u; mine = 0u;
#pragma unroll
        for (unsigned j = 0; j < 16; ++j) { const unsigned c = xb_ld(&bar[XB_XCNT(j)]); sum += c; cnt += (c > 0u) ? 1u : 0u; mine = (j == x) ? c : mine; }
        if (sum == G) break;
        __builtin_amdgcn_s_sleep(1);
        if ((++sp & 255u) == 0u) { if (xb_ld(&bar[XB_TMO])) break; if (sp > XB_SPIN_CAP) { atomicAdd(&bar[XB_TMO], 1u); break; } }
    }
    nloc = mine > 0u ? mine : 1u; nx = cnt > 0u ? cnt : 1u;
}
__device__ __noinline__ void xcd_barrier_fn(unsigned* bar_in, unsigned bx, unsigned st_off, int tid) {
    XcdBarrier b; b.bar = bar_in; b.x = bx; b.st = (volatile LAS unsigned*)(uintptr_t)st_off;
    asm volatile("s_waitcnt vmcnt(0)" ::: "memory");
    __syncthreads();
    if (tid == 0) {
        unsigned* bar = b.bar;
        __builtin_amdgcn_s_waitcnt(0);
        unsigned nloc = b.st[0], nx = b.st[1];
        if (nloc == 0u) { xcd_barrier_complete(bar, b.x, nloc, nx); b.st[0] = nloc; b.st[1] = nx; }
        const unsigned old = xb_add(&bar[XB_XSUB(b.x)], 1u);
        const unsigned gen = old / nloc;
        if (old + 1u == (gen + 1u) * nloc) {
            __builtin_amdgcn_fence(__ATOMIC_RELEASE, "agent");
            asm volatile("s_waitcnt vmcnt(0)" ::: "memory");
            const unsigned og = xb_add(&bar[XB_TOP], 1u);
            const unsigned tg = og / nx;
            if (og + 1u == (tg + 1u) * nx) xb_add(&bar[XB_TOPGEN], 1u);
            else XB_SPIN(xb_ld(&bar[XB_TOPGEN]) == tg, bar);
            __builtin_amdgcn_fence(__ATOMIC_ACQUIRE, "agent");
            xb_add(&bar[XB_XGEN(b.x)], 1u);
            asm volatile("s_waitcnt vmcnt(0)" ::: "memory");
        } else {
            XB_SPIN(xb_ld(&bar[XB_XGEN(b.x)]) == gen, bar);
            __builtin_amdgcn_fence(__ATOMIC_ACQUIRE, "agent");
            asm volatile("s_waitcnt vmcnt(0)" ::: "memory");
        }
    }
    __syncthreads();
}

constexpr int NWAVES = 8;
constexpr int RING_BYTES = 131072, MISC_OFF = RING_BYTES + 320, TBL_OFF = RING_BYTES + 1024, LDS_BYTES = 147456;
struct Args { const float* in[38]; float* out; unsigned char* ws; int ph_lo, ph_hi; };
typedef const __attribute__((address_space(4))) Args* ArgsP;
struct Frame {
    LAS unsigned char* lds;
    int tid, lane, wave, vcu, G, gw, NGW;
    unsigned char* ws;
};

enum RowMap { RM_ID = 0, RM_WIN = 1, RM_UQ = 2, RM_W13 = 3 };
__device__ __forceinline__ int rope_perm(int o) { const int axis = o >> 4, half = (o >> 3) & 1, i = o & 7; return 2 * (axis * 8 + i) + half; }
__device__ __forceinline__ int map_row(int rm, int n, int row_off) {
    if (rm == RM_WIN) return (n >= ZKPE && n < ZKPE + 32) ? ZKPE + rope_perm(n - ZKPE) : n;
    if (rm == RM_UQ) { const int hd = n / 96, cc = n - hd * 96; return cc >= 64 ? hd * 96 + 64 + rope_perm(cc - 64) : n; }
    if (rm == RM_W13) return row_off + (n >> 7) * 256 + (n & 127);
    return row_off + n;
}
__device__ __forceinline__ void transpose_item(const float* W, int K, int N, bf16_t* WT, int rm, int row_off, const float* kscale, LAS float* scr, int item, int lane, int ldk = 0, int koff = 0) {
    if (ldk == 0) ldk = K;
    const int nblk = N / 32, kb = item / nblk, nb = item % nblk, k0 = 64 * kb, n0 = 32 * nb;
    float tv[32];
#pragma unroll
    for (int i = 0; i < 32; ++i) tv[i] = W[(size_t)(k0 + 2 * i + (lane >> 5)) * N + n0 + (lane & 31)];
#pragma unroll
    for (int i = 0; i < 32; ++i) { const int kk = 2 * i + (lane >> 5); float v = tv[i]; if (kscale) v *= kscale[k0 + kk]; scr[kk * 33 + (lane & 31)] = v; }
    asm volatile("s_waitcnt lgkmcnt(0)" ::: "memory");
    const int c = lane & 7;
#pragma unroll
    for (int j = 0; j < 4; ++j) { const int n = (lane >> 3) + 8 * j; const LAS float* s = scr + (8 * c) * 33 + n;
        u32x4 o; o.x = pk2(s[0 * 33], s[1 * 33]); o.y = pk2(s[2 * 33], s[3 * 33]); o.z = pk2(s[4 * 33], s[5 * 33]); o.w = pk2(s[6 * 33], s[7 * 33]);
        *(u32x4*)(WT + (size_t)map_row(rm, n0 + n, row_off) * ldk + koff + k0 + 8 * c) = o; }
    asm volatile("s_waitcnt lgkmcnt(0)" ::: "memory");
}

#if !NAIVE_S5
__device__ __forceinline__ void s5_build(Frame& F, ArgsP a);
#endif
__device__ __forceinline__ void prologue_phase(Frame& F, ArgsP a) {
    LAS float* scr = (LAS float*)(F.lds + F.wave * 16384);
    REP(21) {
        constexpr int PER_L = 2896 + 96 + 32 + 32 + 32 + 128 + 256 + 128 + 512, TOTAL = 2 * PER_L;
        const int bx = (int)blockIdx.x; int base, wv, nw, cnt;
        if (F.G == 256) { if (bx < 128) { base = 0; wv = bx * 8 + F.wave; nw = 1024; cnt = 2; } else if (bx < 192) { base = 2048; wv = (bx - 128) * 8 + F.wave; nw = 512; cnt = 4; } else { base = 4096; wv = (bx - 192) * 8 + F.wave; nw = 512; cnt = 8; } }
        else { base = 0; wv = F.gw; nw = F.NGW; cnt = (TOTAL + F.NGW - 1) / F.NGW; }
        for (int jj = 0; jj <= cnt; ++jj) {
            int L = base + wv + nw * jj;
            if (jj == cnt) { if (F.G != 256 || bx < 192 || wv >= TOTAL - 8192) break; L = 8192 + wv; }
            if (L >= TOTAL) break;
            const int l = L >= PER_L ? 1 : 0; int it = L - l * PER_L;
            unsigned char* wl = F.ws + WS_WB + (size_t)l * WL_STRIDE;
            if (it < 2896) { transpose_item(a->in[8] + (size_t)l * D * INC, D, INC, (bf16_t*)(wl + WL_WIN), RM_WIN, 0, nullptr, scr, it, F.lane); continue; } it -= 2896;
            if (it < 96) { transpose_item(a->in[21] + (size_t)l * 256 * 768, 256, 768, (bf16_t*)(wl + WL_UQ), RM_UQ, 0, a->in[19] + l * 256, scr, it, F.lane); continue; } it -= 96;
            if (it < 64) { const int hb = it >> 5; transpose_item(a->in[22 + hb] + (size_t)l * 128 * 512, 128, 512, (bf16_t*)(wl + WL_UKV), RM_ID, 512 * hb, a->in[20] + l * 128, scr, it & 31, F.lane); continue; } it -= 64;
            if (it < 32) { transpose_item(a->in[17] + (size_t)l * 256 * 256, 256, 256, (bf16_t*)(wl + WL_GLU), RM_ID, 0, nullptr, scr, it, F.lane); continue; } it -= 32;
            if (it < 128) { transpose_item(a->in[26] + (size_t)l * 256 * 1024, 256, 1024, (bf16_t*)(wl + WL_PA), RM_ID, 0, nullptr, scr, it, F.lane, 1024, 0); continue; } it -= 128;
            if (it < 256) { transpose_item(a->in[27] + (size_t)l * 512 * 1024, 512, 1024, (bf16_t*)(wl + WL_PA), RM_ID, 0, nullptr, scr, it, F.lane, 1024, 256); continue; } it -= 256;
            if (it < 128) { transpose_item(a->in[28] + (size_t)l * 256 * 1024, 256, 1024, (bf16_t*)(wl + WL_PA), RM_ID, 0, nullptr, scr, it, F.lane, 1024, 768); continue; } it -= 128;
            transpose_item(a->in[29] + (size_t)l * 1024 * 1024, 1024, 1024, (bf16_t*)(wl + WL_OUT), RM_ID, 0, nullptr, scr, it, F.lane);
        }
        for (int l = 0; l < 2; ++l) {
            u32x4* padp = (u32x4*)(F.ws + WS_WB + (size_t)l * WL_STRIDE + WL_WIN + (size_t)INC * D * 2);
            for (int i = F.gw * 64 + F.lane; i < (ZC - INC) * D * 2 / 16; i += F.NGW * 64) padp[i] = (u32x4){0u, 0u, 0u, 0u};
        }
    }
    if (blockIdx.x == 0) {
        float* rp = (float*)(F.ws + WS_ROPE);
        const int pos = F.tid >> 3, i = F.tid & 7;
        const float ang = (float)pos * exp2f(-(float)i * (13.287712379549449f / 8.f));
        rp[F.tid] = cosf(ang); rp[512 + F.tid] = sinf(ang);
    }
    __syncthreads();
    REP(22)
    {
        LAS float* sil = (LAS float*)F.lds;
        LAS float* red = (LAS float*)(F.lds + 40960);
        bool have = false;
        for (int it = (F.G == 256 ? (int)blockIdx.x - 128 : (int)blockIdx.x); it < 192; it += (F.G == 256 ? 128 : F.G)) { if (it < 0) break;
            if (!have) {
                for (int i = F.tid; i < 9 * 1024; i += 512) { const int r = i >> 10, k = i & 1023; const float cv = r < 8 ? a->in[1][r * 1024 + k] : a->in[3][k]; sil[i] = siluf_(cv); }
                have = true; __syncthreads();
            }
            const int l = it / 96, n = (it % 96) * 64 + F.lane;
            const float* wp = a->in[4] + (size_t)l * D * 6144 + (size_t)(F.wave * 128) * 6144 + n;
            float acc[9];
#pragma unroll
            for (int r = 0; r < 9; ++r) acc[r] = 0.f;
#pragma unroll 8
            for (int k = 0; k < 128; ++k) { const float wv = wp[(size_t)k * 6144];
#pragma unroll
                for (int r = 0; r < 9; ++r) acc[r] += sil[r * 1024 + F.wave * 128 + k] * wv; }
#pragma unroll
            for (int r = 0; r < 9; ++r) red[(F.wave * 9 + r) * 64 + F.lane] = acc[r];
            __syncthreads();
            for (int i = F.tid; i < 9 * 64; i += 512) { const int r = i >> 6, ln = i & 63; float s = 0.f;
#pragma unroll
                for (int w = 0; w < 8; ++w) s += red[(w * 9 + r) * 64 + ln];
                const int nn = (it % 96) * 64 + ln;
                ((float*)(F.ws + WS_MODV))[((size_t)l * 9 + r) * 6144 + nn] = s + a->in[5][l * 6144 + nn]; }
            __syncthreads();
        }
    }
#if !NAIVE_S5
    REP(23) s5_build(F, a);
#endif
}

__device__ __forceinline__ void transpose_item_fp8(const float* W, int K, int N, unsigned char* WT, int rm, int row_off, LAS float* scr, int item, int lane) {
    const int nblk = N / 32, kb = item / nblk, nb = item % nblk, k0 = 64 * kb, n0 = 32 * nb;
    float tv[32];
#pragma unroll
    for (int i = 0; i < 32; ++i) tv[i] = __builtin_nontemporal_load(W + (size_t)(k0 + 2 * i + (lane >> 5)) * N + n0 + (lane & 31));
#pragma unroll
    for (int i = 0; i < 32; ++i) scr[(2 * i + (lane >> 5)) * 33 + (lane & 31)] = tv[i] * W8_SCALE;
    asm volatile("s_waitcnt lgkmcnt(0)" ::: "memory");
    const int n = lane >> 1, kh = 32 * (lane & 1); const LAS float* sp = scr + kh * 33 + n;
    u32x4 o0, o1;
    o0.x = pk4_fp8(sp[0 * 33], sp[1 * 33], sp[2 * 33], sp[3 * 33]);     o0.y = pk4_fp8(sp[4 * 33], sp[5 * 33], sp[6 * 33], sp[7 * 33]);
    o0.z = pk4_fp8(sp[8 * 33], sp[9 * 33], sp[10 * 33], sp[11 * 33]);   o0.w = pk4_fp8(sp[12 * 33], sp[13 * 33], sp[14 * 33], sp[15 * 33]);
    o1.x = pk4_fp8(sp[16 * 33], sp[17 * 33], sp[18 * 33], sp[19 * 33]); o1.y = pk4_fp8(sp[20 * 33], sp[21 * 33], sp[22 * 33], sp[23 * 33]);
    o1.z = pk4_fp8(sp[24 * 33], sp[25 * 33], sp[26 * 33], sp[27 * 33]); o1.w = pk4_fp8(sp[28 * 33], sp[29 * 33], sp[30 * 33], sp[31 * 33]);
    unsigned char* dst = WT + (size_t)map_row(rm, n0 + n, row_off) * K + k0 + kh;
    *(u32x4*)dst = o0; *(u32x4*)(dst + 16) = o1;
    asm volatile("s_waitcnt lgkmcnt(0)" ::: "memory");
}
__device__ __forceinline__ unsigned char* moe_wbase(Frame& F, ArgsP a, int l) { return (l == 1 && F.G == 256) ? (unsigned char*)a->out : F.ws + WS_MW; }
__device__ __forceinline__ void moe_convert_items(Frame& F, ArgsP a, int l, int first, int wv, int nw, int cnt, int last) {
    LAS float* scr = (LAS float*)(F.lds + F.wave * 16384);
    unsigned char* wb = moe_wbase(F, a, l); unsigned char* w13 = wb + MW_W13; unsigned char* w2 = wb + MW_W2;
    for (int jj = 0; jj < cnt; ++jj) { const int it = first + wv + nw * jj; if (it >= last) break;
        const int e = it / 768, r = it % 768, which = r >> 8, sub = r & 255;
        const size_t eoff = ((size_t)l * NEXP + e) * 1024 * 512;
        if (which == 0) transpose_item_fp8(a->in[34] + eoff, 1024, 512, w13, RM_W13, e * 1024, scr, sub, F.lane);
        else if (which == 1) transpose_item_fp8(a->in[35] + eoff, 1024, 512, w13, RM_W13, e * 1024 + 128, scr, sub, F.lane);
        else transpose_item_fp8(a->in[36] + eoff, 512, 1024, w2, RM_ID, e * 1024, scr, sub, F.lane);
    }
}
constexpr int MC_ALL = NEXP * 768, MC_F = 18432, MC_G = 4096, MC1_F = 7 * 1536, MC1_G = 6 * 1536;
__device__ __forceinline__ void moe_convert(Frame& F, ArgsP a, int l) {
    const bool tails = (l == 0 && F.G == 256), early1 = (l == 1 && F.G == 256);
    moe_convert_items(F, a, l, tails ? MC_F + MC_G : (early1 ? MC1_F + MC1_G : 0), tails ? (F.vcu - 128) * 8 + F.wave : F.gw, tails ? 1024 : F.NGW,
                      tails ? (F.vcu >= 128 ? 2 : 0) : (early1 ? (MC_ALL - MC1_F - MC1_G + F.NGW - 1) / F.NGW : (MC_ALL + F.NGW - 1) / F.NGW), MC_ALL);
}

__device__ __forceinline__ const float* x_row_ptr(ArgsP a, const float* X, int layer, int row) {
    return layer == 0 ? (row < NLAT ? a->in[0] + (size_t)row * D : a->in[2] + (size_t)(row - NLAT) * D) : X + (size_t)row * D;
}
__device__ __forceinline__ void norm_mod_row(const f32x4 (&v)[4], f32x4 (&h)[4], const float* g, const float* shift, const float* scale, int lane) {
    float ss = 0.f;
#pragma unroll
    for (int j = 0; j < 4; ++j) ss += (v[j][0] * v[j][0] + v[j][1] * v[j][1]) + (v[j][2] * v[j][2] + v[j][3] * v[j][3]);
    const float rstd = rsqrtf(wave_sum(ss) * (1.f / D) + EPS);
#pragma unroll
    for (int j = 0; j < 4; ++j) { const int c = 4 * lane + 256 * j; const f32x4 gv = *(const f32x4*)(g + c), sh = *(const f32x4*)(shift + c), sc = *(const f32x4*)(scale + c);
        h[j] = v[j] * rstd * gv * (sc + 1.f) + sh; }
}
__device__ __forceinline__ void store_row_bf16(bf16_t* orow, const f32x4 (&h)[4], int lane) {
#pragma unroll
    for (int j = 0; j < 4; ++j) { u32x2 w; w.x = pk2(h[j][0], h[j][1]); w.y = pk2(h[j][2], h[j][3]); *(u32x2*)(orow + 4 * lane + 256 * j) = w; }
}
__device__ __forceinline__ void norm1_phase(Frame& F, ArgsP a, int layer, int nrows) {
    const float* X = (const float*)(F.ws + WS_X); bf16_t* H = (bf16_t*)(F.ws + WS_H);
    const float* modv = (const float*)(F.ws + WS_MODV) + (size_t)layer * 9 * 6144;
    for (int row = F.gw; row < nrows; row += F.NGW) {
        const float* xr = x_row_ptr(a, X, layer, row); f32x4 v[4], h[4];
#pragma unroll
        for (int j = 0; j < 4; ++j) v[j] = *(const f32x4*)(xr + 4 * F.lane + 256 * j);
        const float* mv = modv + (size_t)tok_modrow(row) * 6144;
        norm_mod_row(v, h, a->in[6] + layer * D, mv, mv + 1024, F.lane);
        store_row_bf16(H + (size_t)row * D, h, F.lane);
    }
}

__device__ __forceinline__ int seq_row(int b, int s, int d) {
    if (d == 0) return s < 256 ? NLAT + b * 256 + s : b * 2048 + (s - 256);
    return s < 256 ? NLAT + b * 256 + (255 - s) : b * 2048 + (2047 - (s - 256));
}
__device__ __forceinline__ float hg_lb(ArgsP a, int l) { return l == 0 ? 0.f : 1.f / (1.f + __expf(a->in[24][0] - a->in[24][1])); }

#if NAIVE_S5
__device__ __forceinline__ void s5_naive(Frame& F, ArgsP a, int l) {
    const bf16_t* Z = (const bf16_t*)(F.ws + WS_Z); float* Yacc = (float*)(F.ws + WS_MIX + MX_S5A);
    for (int unit = F.gw; unit < 128; unit += F.NGW) {
        const int b = unit >> 4, g = unit & 15, p = F.lane;
        for (int d = 0; d < 2; ++d) {
            const int idx = (l * 2 + d) * 16 + g;
            const float lre = a->in[9][idx * 64 + p], lim = a->in[10][idx * 64 + p], dt = expf(a->in[15][idx]);
            const float mag = expf(lre * dt), lbr = mag * cosf(lim * dt), lbi = mag * sinf(lim * dt), den = lre * lre + lim * lim;
            const float fr = ((lbr - 1.f) * lre + lbi * lim) / den, fi = (lbi * lre - (lbr - 1.f) * lim) / den;
            float bbr[16], bbi[16], cre[16], cim[16];
#pragma unroll
            for (int h = 0; h < 16; ++h) { const float br = a->in[11][(size_t)(idx * 64 + p) * 16 + h], bi = a->in[12][(size_t)(idx * 64 + p) * 16 + h];
                bbr[h] = fr * br - fi * bi; bbi[h] = fr * bi + fi * br;
                cre[h] = a->in[13][(size_t)(idx * 16 + h) * 64 + p]; cim[h] = a->in[14][(size_t)(idx * 16 + h) * 64 + p]; }
            float hr = 0.f, hi = 0.f;
            for (int s = 0; s < 2304; ++s) {
                const int row = seq_row(b, s, d);
                const u32x4 u0 = *(const u32x4*)(Z + (size_t)row * ZC + g * 16), u1 = *(const u32x4*)(Z + (size_t)row * ZC + g * 16 + 8);
                const float uu[16] = { bflo(u0.x), bfhi(u0.x), bflo(u0.y), bfhi(u0.y), bflo(u0.z), bfhi(u0.z), bflo(u0.w), bfhi(u0.w),
                                       bflo(u1.x), bfhi(u1.x), bflo(u1.y), bfhi(u1.y), bflo(u1.z), bfhi(u1.z), bflo(u1.w), bfhi(u1.w) };
                float bur = 0.f, bui = 0.f;
#pragma unroll
                for (int h = 0; h < 16; ++h) { bur += bbr[h] * uu[h]; bui += bbi[h] * uu[h]; }
                const float nhr = lbr * hr - lbi * hi + bur, nhi = lbr * hi + lbi * hr + bui; hr = nhr; hi = nhi;
                float mine = 0.f;
#pragma unroll
                for (int h = 0; h < 16; ++h) { const float y = wave_sum(cre[h] * hr - cim[h] * hi); if (F.lane == h) mine = y; }
                if (F.lane < 16) { float* ptr = Yacc + (size_t)row * 256 + g * 16 + F.lane; if (d == 0) *ptr = mine; else *ptr += mine; }
            }
        }
    }
}
__device__ __forceinline__ void s5_naive_finish(Frame& F, ArgsP a, int l, int nrows) {
    const bf16_t* Z = (const bf16_t*)(F.ws + WS_Z); const float* Yacc = (const float*)(F.ws + WS_MIX + MX_S5A); bf16_t* ysp = (bf16_t*)(F.ws + WS_MIX + MX_YS5P);
    for (int i = F.gw * 64 + F.lane; i < nrows * 256; i += F.NGW * 64) { const int row = i >> 8, n = i & 255;
        ysp[i] = (bf16_t)f2bf(gelu_tanh(Yacc[i] + a->in[16][l * 256 + n] * bf2f(Z[(size_t)row * ZC + n]))); }
}
#endif

#if NAIVE_HG
__device__ __forceinline__ void hg_naive(Frame& F, ArgsP a, int l) {
    const bf16_t* Z = (const bf16_t*)(F.ws + WS_Z); float* Ohg = (float*)(F.ws + WS_H);
    LAS float* red = (LAS float*)F.lds;
    const float lb = hg_lb(a, l);
    for (int unit = blockIdx.x; unit < 32; unit += F.G) {
        const int b = unit >> 2, hd = unit & 3, v = F.tid & 63, kg = F.wave;
        for (int d = 0; d < 2; ++d) {
            float S[16];
#pragma unroll
            for (int k = 0; k < 16; ++k) S[k] = 0.f;
            for (int s = 0; s < 2304; ++s) {
                const int row = seq_row(b, s, d);
                const bf16_t* zr = Z + (size_t)row * ZC;
                const u32x4 q0 = *(const u32x4*)(zr + ZHQ + hd * 128 + kg * 16), q1 = *(const u32x4*)(zr + ZHQ + hd * 128 + kg * 16 + 8);
                const int zf = d ? ZF1 : ZF0;
                const u32x4 z0 = *(const u32x4*)(zr + zf + hd * 128 + kg * 16), z1 = *(const u32x4*)(zr + zf + hd * 128 + kg * 16 + 8);
                const float vt = bf2f(zr[ZI + hd * 64 + v]);
                const float qq[16] = { bflo(q0.x), bfhi(q0.x), bflo(q0.y), bfhi(q0.y), bflo(q0.z), bfhi(q0.z), bflo(q0.w), bfhi(q0.w),
                                       bflo(q1.x), bfhi(q1.x), bflo(q1.y), bfhi(q1.y), bflo(q1.z), bfhi(q1.z), bflo(q1.w), bfhi(q1.w) };
                const float zz[16] = { bflo(z0.x), bfhi(z0.x), bflo(z0.y), bfhi(z0.y), bflo(z0.z), bfhi(z0.z), bflo(z0.w), bfhi(z0.w),
                                       bflo(z1.x), bfhi(z1.x), bflo(z1.y), bfhi(z1.y), bflo(z1.z), bfhi(z1.z), bflo(z1.w), bfhi(z1.w) };
                float part = 0.f;
#pragma unroll
                for (int k = 0; k < 16; ++k) { const float kin = (1.f - lb) / (1.f + __expf(zz[k])), f = 1.f - kin; S[k] = f * S[k] + kin * vt; part += qq[k] * S[k]; }
                red[((s & 1) * 8 + kg) * 64 + v] = part;
                __syncthreads();
                if (F.tid < 64) { float o = 0.f;
#pragma unroll
                    for (int w = 0; w < 8; ++w) o += red[((s & 1) * 8 + w) * 64 + F.tid];
                    float* ptr = Ohg + (size_t)row * 256 + hd * 64 + F.tid; if (d == 0) *ptr = o; else *ptr += o; }
            }
            __syncthreads();
        }
    }
}
__device__ __forceinline__ void hg_naive_finish(Frame& F, ArgsP a, int l, int nrows) {
    const bf16_t* Z = (const bf16_t*)(F.ws + WS_Z); const float* Ohg = (const float*)(F.ws + WS_H); bf16_t* yhg = (bf16_t*)(F.ws + WS_MIX + MX_YHG);
    for (int it = F.gw; it < nrows * 4; it += F.NGW) { const int row = it >> 2, hd = it & 3, c = hd * 64 + F.lane;
        float o = Ohg[(size_t)row * 256 + c]; const float ms = wave_sum(o * o) * (1.f / 64.f);
        o = o * rsqrtf(ms + EPS) * a->in[25][l * 256 + c] * siluf_(bf2f(Z[(size_t)row * ZC + ZG + c]));
        yhg[(size_t)row * 256 + c] = (bf16_t)f2bf(o); }
}
#endif

#if NAIVE_ATTN
__device__ __forceinline__ void attn_naive(Frame& F, bool need_ctx) {
    const bf16_t* Q = (const bf16_t*)(F.ws + WS_MIX + MX_Q); const bf16_t* KN = (const bf16_t*)(F.ws + WS_MIX + MX_KN); const bf16_t* V = (const bf16_t*)(F.ws + WS_MIX + MX_V);
    const bf16_t* KPE = (const bf16_t*)(F.ws + WS_MIX + MX_KPE); bf16_t* YM = (bf16_t*)(F.ws + WS_MIX + MX_YMLA);
    const int nunits = need_ctx ? 320 : 256;
    for (int unit = blockIdx.x; unit < nunits; unit += F.G) {
        int b, h, qrow, nk; bool active = true; const bool lat = unit < 256;
        if (lat) { b = unit >> 5; h = (unit >> 2) & 7; qrow = b * 2048 + (unit & 3) * 512 + F.tid; nk = 2304; }
        else { const int u2 = unit - 256; b = u2 >> 3; h = u2 & 7; active = F.tid < 256; qrow = NLAT + b * 256 + (F.tid & 255); nk = 256; }
        float q[96];
#pragma unroll
        for (int c = 0; c < 12; ++c) { const u32x4 w = *(const u32x4*)(Q + (size_t)qrow * 768 + h * 96 + c * 8);
            q[c * 8 + 0] = bflo(w.x); q[c * 8 + 1] = bfhi(w.x); q[c * 8 + 2] = bflo(w.y); q[c * 8 + 3] = bfhi(w.y); q[c * 8 + 4] = bflo(w.z); q[c * 8 + 5] = bfhi(w.z); q[c * 8 + 6] = bflo(w.w); q[c * 8 + 7] = bfhi(w.w); }
        float o[64], m = -1e30f, lsum = 0.f;
#pragma unroll
        for (int dd = 0; dd < 64; ++dd) o[dd] = 0.f;
        for (int j = 0; j < nk; ++j) {
            const int krow = lat ? (j < 2048 ? b * 2048 + j : NLAT + b * 256 + (j - 2048)) : NLAT + b * 256 + j;
            const bf16_t* kn = KN + (size_t)krow * 512 + h * 64; const bf16_t* kp = KPE + (size_t)krow * 32; const bf16_t* vv = V + (size_t)krow * 512 + h * 64;
            float s = 0.f;
#pragma unroll
            for (int c = 0; c < 12; ++c) { const u32x4 w = c < 8 ? *(const u32x4*)(kn + c * 8) : *(const u32x4*)(kp + (c - 8) * 8);
                s += q[c * 8 + 0] * bflo(w.x) + q[c * 8 + 1] * bfhi(w.x) + q[c * 8 + 2] * bflo(w.y) + q[c * 8 + 3] * bfhi(w.y) + q[c * 8 + 4] * bflo(w.z) + q[c * 8 + 5] * bfhi(w.z) + q[c * 8 + 6] * bflo(w.w) + q[c * 8 + 7] * bfhi(w.w); }
            const float mn = fmaxf(m, s), al = __builtin_amdgcn_exp2f(m - mn), pp = __builtin_amdgcn_exp2f(s - mn);
            lsum = lsum * al + pp; m = mn;
#pragma unroll
            for (int c = 0; c < 8; ++c) { const u32x4 w = *(const u32x4*)(vv + c * 8);
                o[c * 8 + 0] = o[c * 8 + 0] * al + pp * bflo(w.x); o[c * 8 + 1] = o[c * 8 + 1] * al + pp * bfhi(w.x); o[c * 8 + 2] = o[c * 8 + 2] * al + pp * bflo(w.y); o[c * 8 + 3] = o[c * 8 + 3] * al + pp * bfhi(w.y);
                o[c * 8 + 4] = o[c * 8 + 4] * al + pp * bflo(w.z); o[c * 8 + 5] = o[c * 8 + 5] * al + pp * bfhi(w.z); o[c * 8 + 6] = o[c * 8 + 6] * al + pp * bflo(w.w); o[c * 8 + 7] = o[c * 8 + 7] * al + pp * bfhi(w.w); }
        }
        if (active) { const float inv = 1.f / lsum;
#pragma unroll
            for (int c = 0; c < 8; ++c) { u32x4 w; w.x = pk2(o[c * 8] * inv, o[c * 8 + 1] * inv); w.y = pk2(o[c * 8 + 2] * inv, o[c * 8 + 3] * inv); w.z = pk2(o[c * 8 + 4] * inv, o[c * 8 + 5] * inv); w.w = pk2(o[c * 8 + 6] * inv, o[c * 8 + 7] * inv);
                *(u32x4*)(YM + (size_t)qrow * 512 + h * 64 + c * 8) = w; } }
    }
}
#endif

typedef short s16x4 __attribute__((ext_vector_type(4)));
__device__ __forceinline__ f32x4 mfma16(bf16x8 a, bf16x8 b, f32x4 c) { return __builtin_amdgcn_mfma_f32_16x16x32_bf16(a, b, c, 0, 0, 0); }
__device__ __forceinline__ s16x4 vtr16(const LAS unsigned char* p) { return __builtin_bit_cast(s16x4, __builtin_amdgcn_ds_read_tr16_b64_v4i16((LAS s16x4*)p)); }
__device__ __forceinline__ float max3f_(float a, float b, float c) { float r; asm("v_max3_f32 %0, %1, %2, %3" : "=v"(r) : "v"(a), "v"(b), "v"(c)); return r; }
__device__ __forceinline__ void glds16(const void* gsrc, unsigned lds_dst) { unsigned keep;
    asm volatile("s_mov_b32 %0, m0\n\ts_mov_b32 m0, %2\n\ts_nop 0\n\tglobal_load_lds_dwordx4 %1, off\n\ts_mov_b32 m0, %0" : "=&s"(keep) : "v"(gsrc), "s"(lds_dst) : "memory"); }
#if !NAIVE_ATTN
template <int VAR> __device__ __forceinline__ void attn_fast(Frame& F, bool need_ctx, bf16_t* YM) {
    const bf16_t* Q = (const bf16_t*)(F.ws + WS_MIX + MX_Q); const bf16_t* KN = (const bf16_t*)(F.ws + WS_MIX + MX_KN); const bf16_t* V = (const bf16_t*)(F.ws + WS_MIX + MX_V);
    const bf16_t* KPE = (const bf16_t*)(F.ws + WS_MIX + MX_KPE);
    const int lane = F.lane, wid = F.wave, r32 = lane & 31, hi = lane >> 5;
    constexpr int SLOT = 20480, VOFF = 12288, NSLOT = 5;
    const unsigned lds0 = (unsigned)(uintptr_t)F.lds;
    const int nunits = need_ctx ? 576 : 512;
    const unsigned kA = (unsigned)(hi * 1024 + r32 * 16);
    const unsigned vB = (unsigned)(VOFF + ((lane >> 4) & 1) * 32 + (lane & 3) * 8 + (4 * hi + ((lane & 15) >> 2)) * 64);
    for (int unit = F.vcu; unit < nunits; unit += F.G) {
        int b, h, qrow0, NT; const bool lat = unit < 512;
        if (lat) { b = unit >> 6; h = (unit >> 3) & 7; qrow0 = b * 2048 + (unit & 7) * 256; NT = 36; }
        else { const int u2 = unit - 512; b = u2 >> 3; h = u2 & 7; qrow0 = NLAT + b * 256; NT = 4; }
#define ATT_KROW(t) (lat ? ((t) < 32 ? b * 2048 + 64 * (t) : NLAT + b * 256 + 64 * ((t) - 32)) : NLAT + b * 256 + 64 * (t))
#define ATT_ISSUE(tt, sl) do { const int tc_ = (tt) < NT ? (tt) : NT - 1; const int kr_ = ATT_KROW(tc_); const unsigned sd_ = (unsigned)__builtin_amdgcn_readfirstlane((int)(lds0 + (sl) * SLOT + wid * 1024)); \
            glds16(KN + (size_t)(kr_ + lane) * 512 + h * 64 + wid * 8, sd_); \
            if (wid < 4) glds16(KPE + (size_t)(kr_ + lane) * 32 + wid * 8, sd_ + 8 * 1024); \
            glds16(V + (size_t)(kr_ + 16 * (wid & 3) + (lane >> 2)) * 512 + h * 64 + (wid >> 2) * 32 + (lane & 3) * 8, sd_ + VOFF); } while (0)
#define ATT_QK(P0, P1, slot) do { const LAS unsigned char* sq_ = F.lds + (slot) * SLOT; _Pragma("unroll") for (int d0 = 0; d0 < 6; ++d0) { \
            const bf16x8 k0_ = *(const LAS bf16x8*)(sq_ + kA + d0 * 2048), k1_ = *(const LAS bf16x8*)(sq_ + kA + d0 * 2048 + 512); \
            if (d0 == 0) { P0 = __builtin_amdgcn_mfma_f32_32x32x16_bf16(k0_, qf[0], negm, 0, 0, 0); P1 = __builtin_amdgcn_mfma_f32_32x32x16_bf16(k1_, qf[0], negm, 0, 0, 0); } \
            else { P0 = __builtin_amdgcn_mfma_f32_32x32x16_bf16(k0_, qf[d0], P0, 0, 0, 0); P1 = __builtin_amdgcn_mfma_f32_32x32x16_bf16(k1_, qf[d0], P1, 0, 0, 0); } } } while (0)
        asm volatile("s_waitcnt vmcnt(0)" ::: "memory");
        __syncthreads();
        ATT_ISSUE(0, 0); ATT_ISSUE(1, 1); ATT_ISSUE(2, 2); ATT_ISSUE(3, 3);
        bf16x8 qf[6];
        { const bf16_t* qp = Q + (size_t)(qrow0 + wid * 32 + r32) * 768 + h * 96 + hi * 8;
#pragma unroll
          for (int d0 = 0; d0 < 6; ++d0) qf[d0] = *(const bf16x8*)(qp + d0 * 16); }
        float mref = 0.f, lsum = 0.f, dpend = 0.f; f32x16 o0 = {}, o1 = {}, negm = {};
        asm volatile("s_waitcnt vmcnt(0)" ::: "memory");
        __syncthreads();
        f32x16 p0, p1;
        ATT_QK(p0, p1, 0);
        int s_cur = 0, s_nxt = 1, s_new = 4;
        for (int t = 0; t < NT; ++t) {
            ATT_ISSUE(t + 4, s_new);
            const LAS unsigned char* sb = F.lds + s_cur * SLOT;
            f32x16 n0, n1;
            if (t + 1 < NT) ATT_QK(n0, n1, s_nxt); else { n0 = p0; n1 = p1; }
            if (__builtin_expect(__any(dpend != 0.f), 0)) {
#pragma unroll
                for (int r = 0; r < 16; ++r) { p0[r] -= dpend; p1[r] -= dpend; } }
            float mxa = max3f_(p0[0], p0[1], p1[0]), mxb = max3f_(p0[2], p0[3], p1[1]); mxa = max3f_(mxa, p1[2], p1[3]);
#pragma unroll
            for (int r = 4; r < 16; r += 4) { mxa = max3f_(mxa, p0[r], p0[r + 1]); mxb = max3f_(mxb, p0[r + 2], p0[r + 3]); mxa = max3f_(mxa, p1[r], p1[r + 1]); mxb = max3f_(mxb, p1[r + 2], p1[r + 3]); }
            float mx = fmaxf(mxa, mxb);
            { auto rr = __builtin_amdgcn_permlane32_swap(__float_as_uint(mx), __float_as_uint(mx), false, false); mx = fmaxf(__uint_as_float(rr[0]), __uint_as_float(rr[1])); }
            dpend = 0.f;
            if (__builtin_expect(t == 0 || __any(mx > 8.f), 0)) {
                const float dl = t == 0 ? mx : fmaxf(mx, 0.f); mref += dl; dpend = dl;
#pragma unroll
                for (int r = 0; r < 16; ++r) { p0[r] -= dl; p1[r] -= dl; negm[r] = -mref; }
                const float fs = __builtin_amdgcn_exp2f(-dl); lsum *= fs;
#pragma unroll
                for (int r = 0; r < 16; ++r) { o0[r] *= fs; o1[r] *= fs; } }
            f32x2 ps2 = {0.f, 0.f};
#pragma unroll
            for (int r = 0; r < 16; r += 2) { p0[r] = __builtin_amdgcn_exp2f(p0[r]); p0[r + 1] = __builtin_amdgcn_exp2f(p0[r + 1]); p1[r] = __builtin_amdgcn_exp2f(p1[r]); p1[r + 1] = __builtin_amdgcn_exp2f(p1[r + 1]);
                ps2 += (f32x2){p0[r], p0[r + 1]}; ps2 += (f32x2){p1[r], p1[r + 1]}; }
            lsum += ps2.x + ps2.y;
            bf16x8 pb[4];
#pragma unroll
            for (int s = 0; s < 4; ++s) { u32x4 w;
                if (s < 2) { w.x = pk2(p0[8 * s], p0[8 * s + 1]); w.y = pk2(p0[8 * s + 2], p0[8 * s + 3]); w.z = pk2(p0[8 * s + 4], p0[8 * s + 5]); w.w = pk2(p0[8 * s + 6], p0[8 * s + 7]); }
                else { const int q = s - 2; w.x = pk2(p1[8 * q], p1[8 * q + 1]); w.y = pk2(p1[8 * q + 2], p1[8 * q + 3]); w.z = pk2(p1[8 * q + 4], p1[8 * q + 5]); w.w = pk2(p1[8 * q + 6], p1[8 * q + 7]); }
                pb[s] = __builtin_bit_cast(bf16x8, w); }
#pragma unroll
            for (int s = 0; s < 4; ++s) {
                const s16x4 a0l = vtr16(sb + vB + s * 1024), a0h = vtr16(sb + vB + s * 1024 + 512), a1l = vtr16(sb + vB + 4096 + s * 1024), a1h = vtr16(sb + vB + 4096 + s * 1024 + 512);
                const bf16x8 va0 = {a0l[0], a0l[1], a0l[2], a0l[3], a0h[0], a0h[1], a0h[2], a0h[3]}, va1 = {a1l[0], a1l[1], a1l[2], a1l[3], a1h[0], a1h[1], a1h[2], a1h[3]};
                o0 = __builtin_amdgcn_mfma_f32_32x32x16_bf16(va0, pb[s], o0, 0, 0, 0);
                o1 = __builtin_amdgcn_mfma_f32_32x32x16_bf16(va1, pb[s], o1, 0, 0, 0);
            }
            if (wid < 4) asm volatile("s_waitcnt vmcnt(6) lgkmcnt(0)" ::: "memory"); else asm volatile("s_waitcnt vmcnt(4) lgkmcnt(0)" ::: "memory");
            __builtin_amdgcn_s_barrier();
            p0 = n0; p1 = n1;
            s_cur = s_nxt; s_nxt = s_nxt + 1 == NSLOT ? 0 : s_nxt + 1; s_new = s_new + 1 == NSLOT ? 0 : s_new + 1;
        }
#undef ATT_QK
#undef ATT_ISSUE
#undef ATT_KROW
        lsum += shfl_f(lsum, lane ^ 32);
        const float inv = 1.f / lsum;
        bf16_t* op = YM + (size_t)(qrow0 + wid * 32 + r32) * 1024 + h * 64 + 4 * hi;
#pragma unroll
        for (int g = 0; g < 4; ++g) {
            u32x2 w0, w1; w0.x = pk2(o0[4 * g] * inv, o0[4 * g + 1] * inv); w0.y = pk2(o0[4 * g + 2] * inv, o0[4 * g + 3] * inv);
            w1.x = pk2(o1[4 * g] * inv, o1[4 * g + 1] * inv); w1.y = pk2(o1[4 * g + 2] * inv, o1[4 * g + 3] * inv);
            *(u32x2*)(op + 8 * g) = w0; *(u32x2*)(op + 32 + 8 * g) = w1;
        }
    }
}
#endif

#if !NAIVE_HG
__device__ __forceinline__ bf16x8 trfrag(const LAS unsigned char* p, int rowstep4) {
    const s16x4 lo = vtr16(p), hi = vtr16(p + rowstep4); return (bf16x8){lo[0], lo[1], lo[2], lo[3], hi[0], hi[1], hi[2], hi[3]}; }
__device__ __forceinline__ void hg_gate16(const bf16_t* Z, int b, int s0, int d, int zcol, float lb, float (&kin)[16], float (&gl)[16]) {
#pragma unroll
    for (int i = 0; i < 16; ++i) { const int row = seq_row(b, s0 + i, d); const float z = bf2f(Z[(size_t)row * ZC + zcol]);
        const float e = __expf(-z), sg = 1.f / (1.f + e), f = lb + (1.f - lb) * sg; kin[i] = (1.f - lb) * e * sg; gl[i] = __logf(f); }
}
__device__ __forceinline__ void hg_local_load(u32x4 (&tz)[2], u32x4& tv, const bf16_t* Z, int unit, int tid) {
    const int c = unit % 36, r = unit / 36, d = r & 1, hd = (r >> 1) & 3, b = r >> 3;
#pragma unroll
    for (int j = 0; j < 2; ++j) { const int pc = tid + 512 * j, t = pc >> 4, c16 = pc & 15, row = seq_row(b, 64 * c + t, d);
        tz[j] = *(const u32x4*)(Z + (size_t)row * ZC + (d ? ZF1 : ZF0) + hd * 128 + c16 * 8); }
    { const int t = tid >> 3, cc = tid & 7, row = seq_row(b, 64 * c + t, d); tv = *(const u32x4*)(Z + (size_t)row * ZC + ZI + hd * 64 + cc * 8); }
}
__device__ __forceinline__ void hg_local_phase(Frame& F, ArgsP a, int l) {
    const bf16_t* Z = (const bf16_t*)(F.ws + WS_Z); bf16_t* HGS = (bf16_t*)(F.ws + WS_H); float* HGD = (float*)(F.ws + WS_MIX + MX_HGD);
    const float lb = hg_lb(a, l);
    LAS unsigned char* Vl = F.lds; LAS unsigned char* KdT = F.lds + 9216; LAS float* seg = (LAS float*)(F.lds + 27648); LAS unsigned char* Zr = F.lds + 32768;
    const int tid = F.tid, lane = F.lane, w = F.wave, k = tid & 127, tq = tid >> 7;
    u32x4 tz[2], tv;
    if (F.vcu < 2304) hg_local_load(tz, tv, Z, F.vcu, tid);
    for (int unit = F.vcu; unit < 2304; unit += F.G) {
        __syncthreads();
#pragma unroll
        for (int j = 0; j < 2; ++j) { const int pc = tid + 512 * j; *(LAS u32x4*)(Zr + (pc >> 4) * 272 + (pc & 15) * 16) = tz[j]; }
        *(LAS u32x4*)(Vl + (tid >> 3) * 144 + (tid & 7) * 16) = tv;
        if (unit + F.G < 2304) hg_local_load(tz, tv, Z, unit + F.G, tid);
        __syncthreads();
        float kin0[8], kin1[8], g0[8], g1[8];
#pragma unroll
        for (int i = 0; i < 8; ++i) { const unsigned zz = *(const LAS unsigned*)(Zr + ((8 * w + i) * 136 + 2 * lane) * 2);
            { const float e = __expf(-bflo(zz)), sg = __builtin_amdgcn_rcpf(1.f + e); kin0[i] = (1.f - lb) * e * sg; g0[i] = __logf(lb + (1.f - lb) * sg); }
            { const float e = __expf(-bfhi(zz)), sg = __builtin_amdgcn_rcpf(1.f + e); kin1[i] = (1.f - lb) * e * sg; g1[i] = __logf(lb + (1.f - lb) * sg); } }
        float run0 = 0.f, run1 = 0.f;
#pragma unroll
        for (int i = 7; i >= 0; --i) { const float a0 = g0[i], a1 = g1[i]; g0[i] = run0; g1[i] = run1; run0 += a0; run1 += a1; }
        *(LAS f32x2*)(seg + w * 128 + 2 * lane) = (f32x2){run0, run1};
        __syncthreads();
        float lat0 = 0.f, lat1 = 0.f, tot0 = 0.f, tot1 = 0.f;
#pragma unroll
        for (int q = 0; q < 8; ++q) { const f32x2 sv = *(const LAS f32x2*)(seg + q * 128 + 2 * lane); tot0 += sv.x; tot1 += sv.y; if (q > w) { lat0 += sv.x; lat1 += sv.y; } }
        { u32x4 w0, w1;
          w0.x = pk2(kin0[0] * __expf(g0[0] + lat0), kin0[1] * __expf(g0[1] + lat0)); w0.y = pk2(kin0[2] * __expf(g0[2] + lat0), kin0[3] * __expf(g0[3] + lat0));
          w0.z = pk2(kin0[4] * __expf(g0[4] + lat0), kin0[5] * __expf(g0[5] + lat0)); w0.w = pk2(kin0[6] * __expf(g0[6] + lat0), kin0[7] * __expf(g0[7] + lat0));
          w1.x = pk2(kin1[0] * __expf(g1[0] + lat1), kin1[1] * __expf(g1[1] + lat1)); w1.y = pk2(kin1[2] * __expf(g1[2] + lat1), kin1[3] * __expf(g1[3] + lat1));
          w1.z = pk2(kin1[4] * __expf(g1[4] + lat1), kin1[5] * __expf(g1[5] + lat1)); w1.w = pk2(kin1[6] * __expf(g1[6] + lat1), kin1[7] * __expf(g1[7] + lat1));
          *(LAS u32x4*)(KdT + (2 * lane) * 144 + w * 16) = w0; *(LAS u32x4*)(KdT + (2 * lane + 1) * 144 + w * 16) = w1; }
        if (w == 0) *(f32x2*)(HGD + (size_t)unit * 128 + 2 * lane) = (f32x2){__expf(tot0), __expf(tot1)};
        __syncthreads();
        f32x4 acc[4] = {};
#pragma unroll
        for (int ks = 0; ks < 2; ++ks) {
            const bf16x8 bf = *(const LAS bf16x8*)(KdT + (16 * w + (lane & 15)) * 144 + (32 * ks + 8 * (lane >> 4)) * 2);
#pragma unroll
            for (int mt = 0; mt < 4; ++mt) { const bf16x8 af = trfrag(Vl + (32 * ks + 8 * (lane >> 4) + ((lane & 15) >> 2)) * 144 + (mt * 16 + 4 * (lane & 3)) * 2, 4 * 144);
                acc[mt] = mfma16(af, bf, acc[mt]); }
        }
        bf16_t* dst = HGS + (size_t)unit * 8192 + 16 * w + (lane & 15);
#pragma unroll
        for (int mt = 0; mt < 4; ++mt)
#pragma unroll
            for (int rr = 0; rr < 4; ++rr) dst[(size_t)(16 * mt + 4 * (lane >> 4) + rr) * 128] = (bf16_t)f2bf(acc[mt][rr]);
    }
}
__device__ __forceinline__ void hg_scan_phase(Frame& F) {
    bf16_t* HGS = (bf16_t*)(F.ws + WS_H); const float* HGD = (const float*)(F.ws + WS_MIX + MX_HGD);
    if (F.G == 256 && F.vcu >= 64 && F.vcu < 144) return;
    const int sb = F.G == 256 ? (F.vcu < 64 ? F.vcu : F.vcu - 80) : F.vcu, snb = F.G == 256 ? 176 : F.G;
    for (int it = (sb * NWAVES + F.wave) * 64 + F.lane; it < 64 * 1024; it += snb * NWAVES * 64) {
        const int r = it >> 10, e8 = (it & 1023) * 8, k0 = e8 & 127;
        float S[8];
#pragma unroll
        for (int j = 0; j < 8; ++j) S[j] = 0.f;
#pragma unroll 12
        for (int c = 0; c < 36; ++c) {
            u32x4* p = (u32x4*)(HGS + (size_t)(r * 36 + c) * 8192 + e8); const u32x4 ds = *p;
            const f32x4 d0 = *(const f32x4*)(HGD + (size_t)(r * 36 + c) * 128 + k0), d1 = *(const f32x4*)(HGD + (size_t)(r * 36 + c) * 128 + k0 + 4);
            u32x4 o; o.x = pk2(S[0], S[1]); o.y = pk2(S[2], S[3]); o.z = pk2(S[4], S[5]); o.w = pk2(S[6], S[7]); *p = o;
            S[0] = d0[0] * S[0] + bflo(ds.x); S[1] = d0[1] * S[1] + bfhi(ds.x); S[2] = d0[2] * S[2] + bflo(ds.y); S[3] = d0[3] * S[3] + bfhi(ds.y);
            S[4] = d1[0] * S[4] + bflo(ds.z); S[5] = d1[1] * S[5] + bfhi(ds.z); S[6] = d1[2] * S[6] + bflo(ds.w); S[7] = d1[3] * S[7] + bfhi(ds.w);
        }
    }
}
struct HgTile { u32x4 z[2], q[2], s[2], v; };
__device__ __forceinline__ void hg_out_decode(int unit, bool need_ctx, int& b, int& hd, int& ct) {
    if (need_ctx) { ct = unit % 36; hd = (unit / 36) & 3; b = unit / 144; } else { ct = 4 + (unit & 31); hd = (unit >> 5) & 3; b = unit >> 7; }
}
__device__ __forceinline__ void hg_out_load(HgTile& T, const bf16_t* Z, const bf16_t* HGS, int b, int hd, int ct, int d, int tid) {
    const int cs = d == 0 ? ct : (ct < 4 ? 3 - ct : 39 - ct); const size_t su = (size_t)(((b * 4 + hd) * 2 + d) * 36 + cs);
#pragma unroll
    for (int j = 0; j < 2; ++j) { const int pc = tid + 512 * j, t = pc >> 4, c16 = pc & 15, row = seq_row(b, 64 * cs + t, d);
        T.z[j] = *(const u32x4*)(Z + (size_t)row * ZC + (d ? ZF1 : ZF0) + hd * 128 + c16 * 8); T.q[j] = *(const u32x4*)(Z + (size_t)row * ZC + ZHQ + hd * 128 + c16 * 8);
        T.s[j] = *(const u32x4*)(HGS + su * 8192 + (size_t)t * 128 + c16 * 8); }
    { const int t = tid >> 3, cc = tid & 7, row = seq_row(b, 64 * cs + t, d); T.v = *(const u32x4*)(Z + (size_t)row * ZC + ZI + hd * 64 + cc * 8); }
}
__device__ __forceinline__ void hg_out_phase(Frame& F, ArgsP a, int l, bool need_ctx) {
    const bf16_t* Z = (const bf16_t*)(F.ws + WS_Z); const bf16_t* HGS = (const bf16_t*)(F.ws + WS_H); bf16_t* YHG = (bf16_t*)(F.ws + WS_MIX + MX_YS5) + 768;
    const float lb = hg_lb(a, l);
    LAS unsigned char* HQD = F.lds; LAS unsigned char* HQ1 = F.lds + 17408; LAS unsigned char* HK1 = F.lds + 34816; LAS unsigned char* HST = F.lds + 52224;
    LAS unsigned char* HV = F.lds + 69632; LAS unsigned char* HP = F.lds + 78848; LAS float* HO = (LAS float*)(F.lds + 88064); LAS float* seg = (LAS float*)(F.lds + 105472);
    const int tid = F.tid, lane = F.lane, w = F.wave, k = tid & 127, tq = tid >> 7, mt = w >> 1, nh = w & 1;
    const int nunits = need_ctx ? 1152 : 1024;
    const int nmine = F.vcu < nunits ? (nunits - 1 - F.vcu) / F.G + 1 : 0, nit = 2 * nmine;
    HgTile T;
    if (nit > 0) { int b, hd, ct; hg_out_decode(F.vcu, need_ctx, b, hd, ct); hg_out_load(T, Z, HGS, b, hd, ct, 0, tid); }
    for (int it = 0; it < nit; ++it) {
        const int unit = F.vcu + (it >> 1) * F.G, d = it & 1; int b, hd, ct; hg_out_decode(unit, need_ctx, b, hd, ct);
        __syncthreads();
#pragma unroll
        for (int j = 0; j < 2; ++j) { const int pc = tid + 512 * j, t = pc >> 4, c16 = pc & 15;
            *(LAS u32x4*)(HQD + t * 272 + c16 * 16) = T.q[j]; *(LAS u32x4*)(HK1 + t * 272 + c16 * 16) = T.z[j]; *(LAS u32x4*)(HST + t * 272 + c16 * 16) = T.s[j]; }
        *(LAS u32x4*)(HV + (tid >> 3) * 144 + (tid & 7) * 16) = T.v;
        if (it + 1 < nit) { const int un = F.vcu + ((it + 1) >> 1) * F.G; int b2, hd2, ct2; hg_out_decode(un, need_ctx, b2, hd2, ct2); hg_out_load(T, Z, HGS, b2, hd2, ct2, (it + 1) & 1, tid); }
        __syncthreads();
        float kin0[8], kin1[8], g0[8], g1[8];
#pragma unroll
        for (int i = 0; i < 8; ++i) { const unsigned zz = *(const LAS unsigned*)(HK1 + ((8 * w + i) * 136 + 2 * lane) * 2);
            { const float e = __expf(-bflo(zz)), sg = __builtin_amdgcn_rcpf(1.f + e); kin0[i] = (1.f - lb) * e * sg; g0[i] = __logf(lb + (1.f - lb) * sg); }
            { const float e = __expf(-bfhi(zz)), sg = __builtin_amdgcn_rcpf(1.f + e); kin1[i] = (1.f - lb) * e * sg; g1[i] = __logf(lb + (1.f - lb) * sg); } }
        float run0 = 0.f, run1 = 0.f;
#pragma unroll
        for (int i = 0; i < 8; ++i) { run0 += g0[i]; g0[i] = run0; run1 += g1[i]; g1[i] = run1; }
        *(LAS f32x2*)(seg + w * 128 + 2 * lane) = (f32x2){run0, run1};
        __syncthreads();
        float bef0 = 0.f, bef1 = 0.f, br0 = 0.f, br1 = 0.f;
#pragma unroll
        for (int q = 0; q < 7; ++q) { const f32x2 sv = *(const LAS f32x2*)(seg + q * 128 + 2 * lane); if (q < w) { bef0 += sv.x; bef1 += sv.y; } if (q < 4) { br0 += sv.x; br1 += sv.y; } }
        const float er0 = __expf(br0), er1 = __expf(br1);
#pragma unroll
        for (int i = 0; i < 8; ++i) { const int t = 8 * w + i, off = (t * 136 + 2 * lane) * 2;
            const unsigned qq = *(const LAS unsigned*)(HQD + off);
            const float e0 = __expf(fminf(fmaxf(bef0 + g0[i] - br0, -80.f), 80.f)), e1 = __expf(fminf(fmaxf(bef1 + g1[i] - br1, -80.f), 80.f));
            const float q10 = bflo(qq) * e0, q11 = bfhi(qq) * e1;
            *(LAS unsigned*)(HQ1 + off) = pk2(q10, q11);
            *(LAS unsigned*)(HQD + off) = pk2(q10 * er0, q11 * er1);
            *(LAS unsigned*)(HK1 + off) = pk2(kin0[i] * __builtin_amdgcn_rcpf(e0), kin1[i] * __builtin_amdgcn_rcpf(e1)); }
        __syncthreads();
        f32x4 ao[2] = {}, as[2] = {};
#pragma unroll
        for (int ks = 0; ks < 4; ++ks) {
            const int ko = (32 * ks + 8 * (lane >> 4)) * 2;
            const bf16x8 aqd = *(const LAS bf16x8*)(HQD + (16 * mt + (lane & 15)) * 272 + ko), aq1 = *(const LAS bf16x8*)(HQ1 + (16 * mt + (lane & 15)) * 272 + ko);
#pragma unroll
            for (int j = 0; j < 2; ++j) { const int nt = 2 * nh + j;
                ao[j] = mfma16(aqd, *(const LAS bf16x8*)(HST + (16 * nt + (lane & 15)) * 272 + ko), ao[j]);
                as[j] = mfma16(aq1, *(const LAS bf16x8*)(HK1 + (16 * nt + (lane & 15)) * 272 + ko), as[j]); }
        }
#pragma unroll
        for (int j = 0; j < 2; ++j) { const int sc = 16 * (2 * nh + j) + (lane & 15);
#pragma unroll
            for (int rr = 0; rr < 4; ++rr) { const int t = 16 * mt + 4 * (lane >> 4) + rr; *(LAS bf16_t*)(HP + (t * 72 + sc) * 2) = (bf16_t)f2bf(sc <= t ? as[j][rr] : 0.f); } }
        __syncthreads();
#pragma unroll
        for (int ks = 0; ks < 2; ++ks) {
            const bf16x8 ap = *(const LAS bf16x8*)(HP + (16 * mt + (lane & 15)) * 144 + (32 * ks + 8 * (lane >> 4)) * 2);
#pragma unroll
            for (int j = 0; j < 2; ++j) { const int nt = 2 * nh + j;
                const bf16x8 bv = trfrag(HV + (32 * ks + 8 * (lane >> 4) + ((lane & 15) >> 2)) * 144 + (16 * nt + 4 * (lane & 3)) * 2, 4 * 144);
                ao[j] = mfma16(ap, bv, ao[j]); }
        }
#pragma unroll
        for (int j = 0; j < 2; ++j) { const int v = 16 * (2 * nh + j) + (lane & 15);
#pragma unroll
            for (int rr = 0; rr < 4; ++rr) { const int t = 16 * mt + 4 * (lane >> 4) + rr, tt = d == 0 ? t : 63 - t;
                if (d == 0) HO[tt * 68 + v] = ao[j][rr]; else HO[tt * 68 + v] += ao[j][rr]; } }
        if (d == 1) {
            __syncthreads();
#pragma unroll
            for (int i = 0; i < 8; ++i) { const int tt = 8 * w + i, row = ct < 4 ? NLAT + b * 256 + 64 * ct + tt : b * 2048 + 64 * (ct - 4) + tt, cidx = hd * 64 + lane;
                float o = HO[tt * 68 + lane]; const float ms = wave_sum(o * o) * (1.f / 64.f);
                o = o * rsqrtf(ms + EPS) * a->in[25][l * 256 + cidx] * siluf_(bf2f(Z[(size_t)row * ZC + ZG + cidx]));
                YHG[(size_t)row * 1024 + cidx] = (bf16_t)f2bf(o); }
        }
    }
}
#endif

#if !NAIVE_S5
typedef f32x2 cf32;
__device__ __forceinline__ cf32 cmul(cf32 a, cf32 b) { return (cf32){a.x * b.x - a.y * b.y, a.x * b.y + a.y * b.x}; }
__device__ __forceinline__ void s5_build(Frame& F, ArgsP a) {
    LAS cf32* lamp = (LAS cf32*)F.lds;
    LAS cf32* Bb = lamp + 2 * 17 * 64;
    LAS cf32* Cc = Bb + 2 * 64 * 16;
    LAS float* Kd = (LAS float*)(Cc + 2 * 16 * 64);
    const int tid = F.tid;
    for (int unit = blockIdx.x; unit < 128; unit += F.G) {
        const int l = unit >> 6, g = (unit >> 2) & 15, q = unit & 3;
        bf16_t* Bs_t = (bf16_t*)(F.ws + WS_WB + (size_t)l * WL_STRIDE + WL_BS); bf16_t* B2_t = (bf16_t*)(F.ws + WS_WB + (size_t)l * WL_STRIDE + WL_B2);
        __syncthreads();
        if (tid < 128) { const int d = tid >> 6, p = tid & 63, idx = (l * 2 + d) * 16 + g;
            const float lre = a->in[9][idx * 64 + p], lim = a->in[10][idx * 64 + p], dt = expf(a->in[15][idx]);
            const float ar = lre * dt, ai = lim * dt;
            for (int tau = 0; tau <= 16; ++tau) { const float mag = expf(ar * (float)tau); float sn, cs; sincosf(ai * (float)tau, &sn, &cs); lamp[(d * 17 + tau) * 64 + p] = (cf32){mag * cs, mag * sn}; }
            const cf32 lb = lamp[(d * 17 + 1) * 64 + p]; const float den = lre * lre + lim * lim;
            const cf32 f = (cf32){((lb.x - 1.f) * lre + lb.y * lim) / den, (lb.y * lre - (lb.x - 1.f) * lim) / den};
            { const f32x4* br4 = (const f32x4*)(a->in[11] + (size_t)(idx * 64 + p) * 16); const f32x4* bi4 = (const f32x4*)(a->in[12] + (size_t)(idx * 64 + p) * 16);
              f32x4 br[4], bi[4];
#pragma unroll
              for (int q4 = 0; q4 < 4; ++q4) { br[q4] = br4[q4]; bi[q4] = bi4[q4]; }
#pragma unroll
              for (int h = 0; h < 16; ++h) Bb[(d * 64 + p) * 16 + h] = cmul(f, (cf32){br[h >> 2][h & 3], bi[h >> 2][h & 3]}); }
            if (q == 0) ((cf32*)(F.ws + WS_S5P))[idx * 64 + p] = lamp[(d * 17 + 16) * 64 + p];
        }
        for (int e = tid; e < 2048; e += 512) { const int d = e >> 10, h = (e >> 6) & 15, p = e & 63, idx = (l * 2 + d) * 16 + g;
            Cc[e] = (cf32){a->in[13][(size_t)(idx * 16 + h) * 64 + p], a->in[14][(size_t)(idx * 16 + h) * 64 + p]}; }
        __syncthreads();
        { const int d = tid >> 8, tau = (tid >> 4) & 15, h = tid & 15; float kacc[16];
#pragma unroll
          for (int hp = 0; hp < 16; ++hp) kacc[hp] = 0.f;
          for (int p = 0; p < 64; ++p) { const cf32 t1 = cmul(Cc[(d * 16 + h) * 64 + p], lamp[(d * 17 + tau) * 64 + p]);
#pragma unroll
              for (int hp = 0; hp < 16; ++hp) { const cf32 bb = Bb[(d * 64 + p) * 16 + hp]; kacc[hp] += t1.x * bb.x - t1.y * bb.y; } }
#pragma unroll
          for (int hp = 0; hp < 16; ++hp) Kd[tid * 16 + hp] = kacc[hp]; }
        __syncthreads();
        for (int e = tid; e < 64 * 512; e += 512) { const int n = 64 * q + (e >> 9), kk = e & 511, i = n >> 4, h = n & 15; float val;
            if (kk < 256) { const int j = kk >> 4, hp = kk & 15; val = 0.f;
                if (j <= i) val += Kd[((i - j) * 16 + h) * 16 + hp];
                if (j >= i) val += Kd[4096 + ((j - i) * 16 + h) * 16 + hp]; }
            else { const int dd = (kk - 256) >> 7, pp = (kk - 256) & 127, p = pp & 63, pw = dd == 0 ? i + 1 : 16 - i;
                const cf32 cl = cmul(Cc[(dd * 16 + h) * 64 + p], lamp[(dd * 17 + pw) * 64 + p]); val = pp < 64 ? cl.x : -cl.y; }
            B2_t[((size_t)g * 256 + n) * 512 + kk] = (bf16_t)f2bf(val); }
        { const int d = q & 1, half = q >> 1;
          for (int e = tid; e < 64 * 256; e += 512) { const int p = e >> 8, kk = e & 255, j = kk >> 4, hp = kk & 15, pw = d == 0 ? 15 - j : j;
              const cf32 v = cmul(lamp[(d * 17 + pw) * 64 + p], Bb[(d * 64 + p) * 16 + hp]);
              Bs_t[((size_t)(g * 2 + d) * 128 + half * 64 + p) * 256 + kk] = (bf16_t)f2bf(half ? v.y : v.x); } }
    }
    __syncthreads();
}
__device__ __forceinline__ void s5_state_phase(Frame& F, int l) {
    bf16_t* S5A = (bf16_t*)(F.ws + WS_MIX + MX_S5A); const bf16_t* Bs_t = (const bf16_t*)(F.ws + WS_WB + (size_t)l * WL_STRIDE + WL_BS);
    const cf32* lam16 = (const cf32*)(F.ws + WS_S5P);
    LAS float* hl = (LAS float*)F.lds;
    const int lane = F.lane, w = F.wave;
    for (int unit = F.vcu; unit < 256; unit += F.G) {
        const int b = unit & 7, d = (unit >> 3) & 1, g = unit >> 4;
        __syncthreads();
        f32x4 acc[10] = {};
        { u32x4 ta[10]; const bf16_t* Asrc = S5A + ((size_t)g * 1280 + b * 160) * 512;
#pragma unroll
          for (int j = 0; j < 10; ++j) { const int pc = F.tid + 512 * j; ta[j] = *(const u32x4*)(Asrc + (size_t)(pc >> 5) * 512 + (pc & 31) * 8); }
          const bf16_t* Bb = Bs_t + ((size_t)(g * 2 + d) * 128 + 16 * w + (lane & 15)) * 256 + 8 * (lane >> 4);
          bf16x8 bfr[8];
#pragma unroll
          for (int ks = 0; ks < 8; ++ks) bfr[ks] = *(const bf16x8*)(Bb + 32 * ks);
#pragma unroll
          for (int j = 0; j < 10; ++j) { const int pc = F.tid + 512 * j; *(LAS u32x4*)(F.lds + (pc >> 5) * 528 + (pc & 31) * 16) = ta[j]; }
          __syncthreads();
#pragma unroll
          for (int ks = 0; ks < 8; ++ks)
#pragma unroll
              for (int mt = 0; mt < 10; ++mt) acc[mt] = mfma16(*(const LAS bf16x8*)(F.lds + (16 * mt + (lane & 15)) * 528 + (32 * ks + 8 * (lane >> 4)) * 2), bfr[ks], acc[mt]);
          __syncthreads(); }
#pragma unroll
        for (int mt = 0; mt < 10; ++mt)
#pragma unroll
            for (int rr = 0; rr < 4; ++rr) hl[(16 * mt + 4 * (lane >> 4) + rr) * 132 + 16 * w + (lane & 15)] = acc[mt][rr];
        __syncthreads();
        if (w == 0) { const cf32 lm = lam16[((l * 2 + d) * 16 + g) * 64 + lane]; float hr = 0.f, hi = 0.f;
            bf16_t* dst = S5A + ((size_t)g * 1280 + b * 160) * 512 + 256 + d * 128 + lane;
            for (int s = 0; s < 144; ++s) { const int c = d == 0 ? s : (s < 16 ? 15 - s : 159 - s);
                dst[(size_t)c * 512] = (bf16_t)f2bf(hr); dst[(size_t)c * 512 + 64] = (bf16_t)f2bf(hi);
                const float lr = hl[c * 132 + lane], li = hl[c * 132 + 64 + lane];
                const float nr = lm.x * hr - lm.y * hi + lr, ni = lm.x * hi + lm.y * hr + li; hr = nr; hi = ni; }
        }
    }
}
struct WinOrderLast { pg8::StaticOrder S0; int G, c;
    __device__ bool next(int i, pg8::Unit& u) const { const int L = i * G + c; if (L < S0.nwg) return S0.next(i, u); const int e = L - S0.nwg; if (e >= 64) return false;
        const int t = e >> 3; u.pm = 64 + (e & 7); u.pn = t == 0 ? 0 : (t == 1 ? 2 : t + 2); u.h = -1; return true; } };
struct WinFullRounds { pg8::StaticOrder S0; int G, c; __device__ bool next(int i, pg8::Unit& u) const { const long L = (long)i * G + c; if (L >= (S0.nwg / G) * G) return false; S0.map((int)L, u); return true; } };
struct WinTailHalves { pg8::StaticOrder S0; int G, c; __device__ bool next(int i, pg8::Unit& u) const { const int full = (S0.nwg / G) * G, rest = S0.nwg - full; if (i > 0 || c >= 2 * rest) return false; S0.map(full + (c % rest), u); u.h = c / rest; return true; } };
struct S5Order { int G, c; __device__ bool next(int i, pg8::Unit& u) const { const int L = i * G + c; if (L >= 80) return false; u.pm = L; u.pn = L / 5; u.h = -1; return true; } };
struct HalfTailOrder { pg8::StaticOrder S0; int G, c;
    __device__ bool next(int i, pg8::Unit& u) const { const int L = i * G + c; if (L < S0.nwg) return S0.next(i, u); const int e = L - S0.nwg; if (e >= 64) return false;
        u.pm = 64 + (e >> 3); u.pn = (e >> 1) & 3; u.h = e & 1; return true; } };
#endif

__device__ __forceinline__ bf16x8 pack8(const float (&v)[8]) { u32x4 w; w.x = pk2(v[0], v[1]); w.y = pk2(v[2], v[3]); w.z = pk2(v[4], v[5]); w.w = pk2(v[6], v[7]); return __builtin_bit_cast(bf16x8, w); }
__device__ __forceinline__ void norm2_router_phase(Frame& F, ArgsP a, int l, int nrows) {
    const bf16_t* X = (const bf16_t*)(F.ws + WS_X);
    const float* modv = (const float*)(F.ws + WS_MODV) + (size_t)l * 9 * 6144;
    const float* Wg = a->in[30] + (size_t)l * D * 4; const float* bg = a->in[31] + l * 4; const float* We = a->in[32] + (size_t)l * D * 32; const float* be = a->in[33] + l * 32;
    int* ri = (int*)(F.ws + WS_ROUTE); float* rg = (float*)(F.ws + WS_ROUTE + (size_t)MTOK * 16);
    unsigned* cnt = (unsigned*)(F.ws + WS_CTL) + CW_CNT + l * 32 * 64;
    LAS unsigned char* hhi = F.lds; LAS unsigned char* hlo = F.lds + 33024; LAS float* part = (LAS float*)(F.lds + 66048); LAS float* lg = (LAS float*)(F.lds + 90624);
    const int w = F.wave, lane = F.lane, tid = F.tid;
    bf16x8 whi[4][3], wlo[4][3];
#pragma unroll
    for (int ks = 0; ks < 4; ++ks)
#pragma unroll
        for (int nt = 0; nt < 3; ++nt) { float hv[8], lv[8]; const int col = 16 * nt + (lane & 15);
#pragma unroll
            for (int i = 0; i < 8; ++i) { const int k = 128 * w + 32 * ks + 8 * (lane >> 4) + i;
                const float wv = col < 32 ? We[(size_t)k * 32 + col] : (col < 36 ? Wg[(size_t)k * 4 + (col - 32)] : 0.f);
                const float hi = bflo(pk2(wv, 0.f)); hv[i] = hi; lv[i] = wv - hi; }
            whi[ks][nt] = pack8(hv); wlo[ks][nt] = pack8(lv); }
    const int niter = nrows >> 4;
    LAS unsigned* lcnt = (LAS unsigned*)(F.lds + 94208); LAS unsigned* gbase = lcnt + 32; LAS int* ent = (LAS int*)(F.lds + 94208 + 512);
    if (tid < 32) lcnt[tid] = 0u;
    int kit = 0;
    f32x4 vn[2][4];
    if (F.vcu < niter) {
#pragma unroll
        for (int rr = 0; rr < 2; ++rr)
#pragma unroll
            for (int j = 0; j < 4; ++j) { const u32x2 p = *(const u32x2*)(X + (size_t)(F.vcu * 16 + 2 * w + rr) * D + 4 * lane + 256 * j); vn[rr][j] = (f32x4){bflo(p.x), bfhi(p.x), bflo(p.y), bfhi(p.y)}; } }
    __syncthreads();
    for (int it = F.vcu; it < niter; it += F.G) {
        const int base = it * 16;
        f32x4 mA[4], mB[4];
        { const float* mv = modv + (size_t)tok_modrow(base + 2 * w) * 6144; const float* gp = a->in[7] + l * D;
#pragma unroll
          for (int j = 0; j < 4; ++j) { const int c = 4 * lane + 256 * j; const f32x4 gv = *(const f32x4*)(gp + c), sh = *(const f32x4*)(mv + 3 * 1024 + c), sc = *(const f32x4*)(mv + 4 * 1024 + c); mA[j] = gv * (sc + 1.f); mB[j] = sh; } }
#pragma unroll
        for (int rr = 0; rr < 2; ++rr) { const int lr = 2 * w + rr, row = base + lr; f32x4 v[4], h[4];
#pragma unroll
            for (int j = 0; j < 4; ++j) v[j] = vn[rr][j];
            { float ss = 0.f;
#pragma unroll
              for (int j = 0; j < 4; ++j) ss += (v[j][0] * v[j][0] + v[j][1] * v[j][1]) + (v[j][2] * v[j][2] + v[j][3] * v[j][3]);
              const float rstd = rsqrtf(wave_sum(ss) * (1.f / D) + EPS);
#pragma unroll
              for (int j = 0; j < 4; ++j) h[j] = v[j] * rstd * mA[j] + mB[j]; }
#pragma unroll
            for (int j = 0; j < 4; ++j) *(unsigned*)(F.ws + WS_Z + MZ_H8 + (size_t)row * D + 4 * lane + 256 * j) = pk4_fp8(h[j][0], h[j][1], h[j][2], h[j][3]);
#pragma unroll
            for (int j = 0; j < 4; ++j) { u32x2 ph, pl; ph.x = pk2(h[j][0], h[j][1]); ph.y = pk2(h[j][2], h[j][3]);
                pl.x = pk2(h[j][0] - bflo(ph.x), h[j][1] - bfhi(ph.x)); pl.y = pk2(h[j][2] - bflo(ph.y), h[j][3] - bfhi(ph.y));
                *(LAS u32x2*)(hhi + (lr * 1032 + 4 * lane + 256 * j) * 2) = ph; *(LAS u32x2*)(hlo + (lr * 1032 + 4 * lane + 256 * j) * 2) = pl; } }
        LBAR();
        f32x4 acc[3] = {};
#pragma unroll
        for (int ks = 0; ks < 4; ++ks) { const int ao = ((lane & 15) * 1032 + 128 * w + 32 * ks + 8 * (lane >> 4)) * 2;
            const bf16x8 ahi = *(const LAS bf16x8*)(hhi + ao), alo = *(const LAS bf16x8*)(hlo + ao);
#pragma unroll
            for (int nt = 0; nt < 3; ++nt) { acc[nt] = mfma16(ahi, whi[ks][nt], acc[nt]); acc[nt] = mfma16(ahi, wlo[ks][nt], acc[nt]); acc[nt] = mfma16(alo, whi[ks][nt], acc[nt]); } }
#pragma unroll
        for (int nt = 0; nt < 3; ++nt)
#pragma unroll
            for (int r = 0; r < 4; ++r) part[(w * 16 + 4 * (lane >> 4) + r) * 48 + 16 * nt + (lane & 15)] = acc[nt][r];
        LBAR();
        for (int t = tid; t < 576; t += 512) { const int r = t / 36, c = t - r * 36; float sacc = 0.f;
#pragma unroll
            for (int q = 0; q < 8; ++q) sacc += part[(q * 16 + r) * 48 + c];
            lg[r * 40 + c] = sacc + (c < 32 ? be[c] : bg[c - 32]); }
        LBAR();
        if (it + F.G < niter) {
#pragma unroll
            for (int rr = 0; rr < 2; ++rr)
#pragma unroll
                for (int j = 0; j < 4; ++j) { const u32x2 p = *(const u32x2*)(X + (size_t)((it + F.G) * 16 + 2 * w + rr) * D + 4 * lane + 256 * j); vn[rr][j] = (f32x4){bflo(p.x), bfhi(p.x), bflo(p.y), bfhi(p.y)}; } }
        if (tid < 16) { const int row = base + tid; const LAS float* lr = lg + tid * 40;
            int gi = 0; float gm = lr[32];
#pragma unroll
            for (int i = 1; i < 4; ++i) if (lr[32 + i] > gm) { gm = lr[32 + i]; gi = i; }
            float gs = 0.f;
#pragma unroll
            for (int i = 0; i < 4; ++i) gs += __expf(lr[32 + i] - gm);
            const float gw_ = 1.f / gs;
            const LAS float* el = lr + gi * 8;
            int i1 = 0; float v1 = el[0];
#pragma unroll
            for (int j = 1; j < 8; ++j) if (el[j] > v1) { v1 = el[j]; i1 = j; }
            int i2 = -1; float v2 = -3.0e38f;
#pragma unroll
            for (int j = 0; j < 8; ++j) if (j != i1 && el[j] > v2) { v2 = el[j]; i2 = j; }
            const float e2 = __expf(v2 - v1), g1 = gw_ / (1.f + e2), g2 = gw_ * e2 / (1.f + e2);
            const int e0 = gi * 8 + i1, e1 = gi * 8 + i2;
            const unsigned lr0 = __hip_atomic_fetch_add(lcnt + e0, 1u, __ATOMIC_RELAXED, __HIP_MEMORY_SCOPE_WORKGROUP), lr1 = __hip_atomic_fetch_add(lcnt + e1, 1u, __ATOMIC_RELAXED, __HIP_MEMORY_SCOPE_WORKGROUP);
            *(LAS u32x4*)(ent + (kit * 16 + tid) * 4) = (u32x4){(unsigned)e0, (unsigned)e1, lr0, lr1};
            rg[(size_t)row * 2 + 0] = g1; rg[(size_t)row * 2 + 1] = g2; }
        ++kit;
    }
    __syncthreads();
    if (tid < 32) { const unsigned n = lcnt[tid]; gbase[tid] = n ? __hip_atomic_fetch_add(cnt + tid * 64, n, __ATOMIC_RELAXED, __HIP_MEMORY_SCOPE_AGENT) : 0u; }
    __syncthreads();
    if (tid < kit * 16) { const u32x4 eu = *(const LAS u32x4*)(ent + tid * 4); const int4 en = make_int4((int)eu.x, (int)eu.y, (int)eu.z, (int)eu.w); const int row = (F.vcu + (tid >> 4) * F.G) * 16 + (tid & 15);
        const int r0 = (int)gbase[en.x] + en.z, r1 = (int)gbase[en.y] + en.w;
        *(int4*)(ri + (size_t)row * 4) = make_int4(en.x, en.y, r0, r1);
        int* lists = (int*)(F.ws + WS_LISTS); lists[(size_t)en.x * MTOK + r0] = row; lists[(size_t)en.y * MTOK + r1] = row; }
}
__device__ __forceinline__ int moe_starts(Frame& F, int l, int& total) {
    unsigned* cnt = (unsigned*)(F.ws + WS_CTL) + CW_CNT + l * 32 * 64;
    const int c = F.lane < 32 ? (int)__hip_atomic_load(cnt + (F.lane & 31) * 64, __ATOMIC_RELAXED, __HIP_MEMORY_SCOPE_AGENT) : 0;
    const int padded = (c + 255) & ~255; int incl = padded;
#pragma unroll
    for (int o = 1; o < 32; o <<= 1) { const int t = shfl_i(incl, F.lane - o); if (F.lane >= o) incl += t; }
    total = shfl_i(incl, 31);
    return incl - padded;
}
__device__ __forceinline__ void moe_gather_phase(Frame& F, int l, int nrows) {
    const bf16_t* H = (const bf16_t*)(F.ws + WS_H); bf16_t* XS = (bf16_t*)(F.ws + WS_Z + MZ_XS); const int* ri = (const int*)(F.ws + WS_ROUTE);
    int total; const int st = moe_starts(F, l, total);
    for (int row = F.gw; row < nrows; row += F.NGW) {
        const int e0 = ri[(size_t)row * 4], e1 = ri[(size_t)row * 4 + 1], r0 = ri[(size_t)row * 4 + 2], r1 = ri[(size_t)row * 4 + 3];
        const int d0 = shfl_i(st, e0) + r0, d1 = shfl_i(st, e1) + r1;
#pragma unroll
        for (int j = 0; j < 2; ++j) { const u32x4 w = *(const u32x4*)(H + (size_t)row * D + j * 512 + F.lane * 8);
            *(u32x4*)(XS + (size_t)d0 * D + j * 512 + F.lane * 8) = w; *(u32x4*)(XS + (size_t)d1 * D + j * 512 + F.lane * 8) = w; }
    }
}
__device__ __forceinline__ int moe_unit_wgid(int L, int nunits) { const int q = nunits / 8, r = nunits % 8, xcd = L % 8, off = L / 8; return (xcd < r ? xcd * (q + 1) : r * (q + 1) + (xcd - r) * q) + off; }
struct MoeOrder {
    int nunits, G, c; const LAS int* tile_e; const LAS int* rows;
    __device__ bool next(int i, pg8::Unit& u) const {
        const long L = (long)i * G + c; if (L >= nunits) return false;
        const int wgid = moe_unit_wgid((int)L, nunits), tile = wgid >> 2; const int te = __builtin_amdgcn_readfirstlane(tile_e[tile]); u.pm = tile; u.pn = (te & 255) * 4 + (wgid & 3); u.h = (te & 256) ? 0 : -1; return true;
    }
    __device__ unsigned a_row(int ui, int r) const { return (unsigned)rows[ui * 256 + r]; }
};
__device__ __forceinline__ int moe_build_tiles(Frame& F, int l, bool fill_rows) {
    LAS int* tbl = (LAS int*)(F.lds + TBL_OFF);
    __syncthreads();
    if (F.wave == 0) { int total; const int st = moe_starts(F, l, total); if (F.lane < 32) { tbl[F.lane] = st;
            tbl[256 + F.lane] = (int)__hip_atomic_load((unsigned*)(F.ws + WS_CTL) + CW_CNT + (l * 32 + F.lane) * 64, __ATOMIC_RELAXED, __HIP_MEMORY_SCOPE_AGENT); }
        if (F.lane == 0) tbl[32] = total; }
    __syncthreads();
    const int total = tbl[32], ntiles = total >> 8;
    for (int t = F.tid; t < ntiles; t += 512) { int e = 0;
#pragma unroll
        for (int j = 1; j < 32; ++j) if (tbl[j] <= t * 256) e = j;
        tbl[64 + t] = e | ((tbl[256 + e] - (t * 256 - tbl[e]) <= 128) ? 256 : 0); }
    __syncthreads();
    if (fill_rows) { const int* lists = (const int*)(F.ws + WS_LISTS); const int nunits = ntiles * 4;
        for (int x = F.tid; x < 768; x += 512) { const int ui = x >> 8, r = x & 255, L = ui * F.G + (int)blockIdx.x; int src = 0;
            if (L < nunits) { const int tile = moe_unit_wgid(L, nunits) >> 2, e = tbl[64 + tile] & 255, rank = tile * 256 - tbl[e] + r; if (rank < tbl[256 + e]) src = lists[(size_t)e * MTOK + rank]; }
            tbl[512 + x] = src; }
        __syncthreads(); }
    return ntiles;
}
__device__ __forceinline__ void moe_combine_phase(Frame& F, ArgsP a, int l, int nrows, bool dry = false) {
    bf16_t* X = (bf16_t*)(F.ws + WS_X); bf16_t* Xo = dry ? (bf16_t*)(F.ws + WS_Z + 132 * MiB) : X; float* outp = dry ? (float*)Xo : a->out; bf16_t* H = (bf16_t*)(F.ws + WS_H); const unsigned char* Y = F.ws + WS_Z + MZ_XS;
    const int* ri = (const int*)(F.ws + WS_ROUTE); const float* rg = (const float*)(F.ws + WS_ROUTE + (size_t)MTOK * 16);
    const float* modv = (const float*)(F.ws + WS_MODV);
    int total; const int st = moe_starts(F, l, total);
    const int per = (nrows + F.NGW - 1) / F.NGW, rbeg = F.gw * per, rend = (rbeg + per < nrows) ? rbeg + per : nrows;
    if (rbeg >= rend) return;
    f32x4 vg[4], vA[4], vB[4]; int cur_mod = -1;
    int yq0[4], yq1[4]; u32x2 xq[4]; float g0n, g1n;
#define CMB_LOAD(row_) do { const int r_ = (row_); const int e0_ = ri[(size_t)r_ * 4], e1_ = ri[(size_t)r_ * 4 + 1], r0_ = ri[(size_t)r_ * 4 + 2], r1_ = ri[(size_t)r_ * 4 + 3]; \
        const int p0_ = shfl_i(st, e0_) + r0_, p1_ = shfl_i(st, e1_) + r1_; g0n = rg[(size_t)r_ * 2] * Y8_INV; g1n = rg[(size_t)r_ * 2 + 1] * Y8_INV; \
        _Pragma("unroll") for (int j = 0; j < 4; ++j) { const int c = 4 * F.lane + 256 * j; yq0[j] = *(const int*)(Y + (size_t)p0_ * D + c); yq1[j] = *(const int*)(Y + (size_t)p1_ * D + c); xq[j] = *(const u32x2*)(X + (size_t)r_ * D + c); } } while (0)
    CMB_LOAD(rbeg);
    for (int row = rbeg; row < rend; ++row) {
        const int mr = tok_modrow(row);
        if (mr != cur_mod) { cur_mod = mr; const float* mv = modv + ((size_t)l * 9 + mr) * 6144; const float* mv1 = modv + ((size_t)9 + mr) * 6144;
#pragma unroll
            for (int j = 0; j < 4; ++j) { const int c = 4 * F.lane + 256 * j; vg[j] = *(const f32x4*)(mv + 5 * 1024 + c);
                if (l == 0) { vA[j] = *(const f32x4*)(a->in[6] + D + c) * (*(const f32x4*)(mv1 + 1024 + c) + 1.f); vB[j] = *(const f32x4*)(mv1 + c); } else vA[j] = *(const f32x4*)(a->in[37] + c); } }
        f32x4 v[4]; const float g0 = g0n, g1 = g1n;
#pragma unroll
        for (int j = 0; j < 4; ++j) {
            const f32x2 a0 = __builtin_amdgcn_cvt_pk_f32_fp8(yq0[j], false), a1 = __builtin_amdgcn_cvt_pk_f32_fp8(yq0[j], true), b0 = __builtin_amdgcn_cvt_pk_f32_fp8(yq1[j], false), b1 = __builtin_amdgcn_cvt_pk_f32_fp8(yq1[j], true);
            const f32x4 f = { g0 * a0.x + g1 * b0.x, g0 * a0.y + g1 * b0.y, g0 * a1.x + g1 * b1.x, g0 * a1.y + g1 * b1.y };
            v[j] = (f32x4){bflo(xq[j].x), bfhi(xq[j].x), bflo(xq[j].y), bfhi(xq[j].y)} + vg[j] * f; }
        if (row + 1 < rend) CMB_LOAD(row + 1);
        float ss = 0.f;
#pragma unroll
        for (int j = 0; j < 4; ++j) ss += (v[j][0] * v[j][0] + v[j][1] * v[j][1]) + (v[j][2] * v[j][2] + v[j][3] * v[j][3]);
        const float rstd = rsqrtf(wave_sum(ss) * (1.f / D) + EPS);
        if (l == 0) {
#pragma unroll
            for (int j = 0; j < 4; ++j) { u32x2 xw; xw.x = pk2(v[j][0], v[j][1]); xw.y = pk2(v[j][2], v[j][3]); *(u32x2*)(Xo + (size_t)row * D + 4 * F.lane + 256 * j) = xw; }
            f32x4 h[4];
#pragma unroll
            for (int j = 0; j < 4; ++j) h[j] = v[j] * rstd * vA[j] + vB[j];
            store_row_bf16(H + (size_t)row * D, h, F.lane);
        } else {
#pragma unroll
            for (int j = 0; j < 4; ++j) { const int c = 4 * F.lane + 256 * j; *(f32x4*)(outp + (size_t)row * D + c) = v[j] * rstd * vA[j]; }
        }
    }
#undef CMB_LOAD
}

#define REOPAQUE() { unsigned m1_ = ~0u; asm volatile("" : "+s"(m1_)); int ln_ = __builtin_amdgcn_mbcnt_hi(m1_, __builtin_amdgcn_mbcnt_lo(m1_, 0u)); asm volatile("" : "+v"(ln_)); F.lane = ln_; F.wave = wave_s; F.tid = wave_s * 64 + ln_; F.gw = F.vcu * NWAVES + F.wave; int z_ = 0; asm volatile("" : "+s"(z_)); args = (ArgsP)__builtin_amdgcn_kernarg_segment_ptr() + z_; F.ws = args->ws; }
#define PH_BEGIN if (ph >= lo && ph < hi) { REOPAQUE()
#define PH_END } if (ph >= lo && ph + 1 < hi) { if (!MK_PER_PHASE) REP(15) xcd_barrier_fn(bar.bar, bar.x, (unsigned)(uintptr_t)bar.st, F.tid); } ++ph;

#define pH ((bf16_t*)(F.ws + WS_H))
#define pZ ((bf16_t*)(F.ws + WS_Z))
#define pX ((float*)(F.ws + WS_X))
#define pMix (F.ws + WS_MIX)
#define pSsq ((float*)(F.ws + WS_SSQ))
#define pRope ((const float*)(F.ws + WS_ROPE))
#define pWl (F.ws + WS_WB + (size_t)l * WL_STRIDE)
#define pModv ((const float*)(F.ws + WS_MODV) + (size_t)l * 9 * 6144)


template <int l> __device__ __forceinline__ void layer_prog(Frame& F, ArgsP& args, int& ph, const int lo, const int hi, const XcdBarrier& bar, const int wave_s) {
        const bool need_ctx = (l == 0); const int nrows = need_ctx ? MTOK : NLAT;

        PH_BEGIN REP(1) { pg8::Gemm g{pH, (const bf16_t*)(pWl + WL_WIN), D, D, D};
            Epi<EM_Z> E{}; E.ssq = pSsq; E.rope = pRope; E.o0 = pZ; E.o1 = (bf16_t*)(pMix + MX_KPE); E.o2 = (bf16_t*)(pMix + MX_S5A);
            if constexpr (l == 0) { if (F.G == 256) { { WinFullRounds S; S.S0.init(MTOK, ZC, F.G, (int)blockIdx.x); S.G = F.G; S.c = (int)blockIdx.x; pg8::gemm_phase(F.lds, F.tid, g, S, E); }
                    { WinTailHalves S; S.S0.init(MTOK, ZC, F.G, (int)blockIdx.x); S.G = F.G; S.c = (int)blockIdx.x; pg8::gemm_phase<Epi<EM_Z>, WinTailHalves, false, true>(F.lds, F.tid, g, S, E); } }
                else { pg8::StaticOrder S; S.init(MTOK, ZC, F.G, (int)blockIdx.x); pg8::gemm_phase(F.lds, F.tid, g, S, E); } }
            else { WinOrderLast S; S.S0.init(NLAT, ZC, F.G, (int)blockIdx.x); S.G = F.G; S.c = (int)blockIdx.x; pg8::gemm_phase(F.lds, F.tid, g, S, E); } } PH_END

        PH_BEGIN {
            REP(2) { pg8::Gemm g{pZ + ZCQ, (const bf16_t*)(pWl + WL_UQ), 256, ZC, 256}; pg8::StaticOrder S; S.init(nrows, 768, F.G, ((int)blockIdx.x + F.G - 32) % F.G);
              Epi<EM_Q> E{}; E.ssq = pSsq; E.rope = pRope; E.o0 = (bf16_t*)(pMix + MX_Q); pg8::gemm_phase(F.lds, F.tid, g, S, E); }
            REOPAQUE()
            REP(2) { pg8::Gemm g{pZ + ZCKV, (const bf16_t*)(pWl + WL_UKV), 128, ZC, 128}; pg8::StaticOrder S; S.init(MTOK, 1024, F.G, (int)blockIdx.x);
              Epi<EM_KV> E{}; E.ssq = pSsq; E.o0 = (bf16_t*)(pMix + MX_KN); E.o1 = (bf16_t*)(pMix + MX_V); pg8::gemm_phase(F.lds, F.tid, g, S, E); }
            REOPAQUE()
#if NAIVE_S5
            s5_naive(F, args, l);
#else
            REP(3) s5_state_phase(F, l);
#endif
            REOPAQUE()
#if NAIVE_HG
            hg_naive(F, args, l);
#else
            REP(4) hg_local_phase(F, args, l);
#endif
        } PH_END

        PH_BEGIN {
#if NAIVE_ATTN
            attn_naive(F, need_ctx);
#else
#if PROBE_PH >= 50 && PROBE_PH < 60
            attn_fast<PROBE_PH - 49>(F, need_ctx, (bf16_t*)args->out); REOPAQUE()
#endif
            attn_fast<0>(F, need_ctx, (bf16_t*)(pMix + MX_YS5) + 256);
#endif
            LBAR();
            REOPAQUE()
#if NAIVE_S5
            s5_naive_finish(F, args, l, nrows);
#else
            REP(6) { pg8::Gemm g{(const bf16_t*)(pMix + MX_S5A), (const bf16_t*)(pWl + WL_B2), 512, 512, 512}; S5Order S{F.G, (F.vcu + F.G - 64) % F.G};
              Epi<EM_S5> E{}; E.o0 = (bf16_t*)(pMix + MX_YS5P); E.i0 = (const bf16_t*)(pMix + MX_S5A); E.f0 = args->in[16] + l * 256; pg8::gemm_phase(F.lds, F.tid, g, S, E); }
#endif
            REOPAQUE()
#if NAIVE_HG
            hg_naive_finish(F, args, l, nrows);
#else
            hg_scan_phase(F);
#endif
        } PH_END

        PH_BEGIN {
#if !NAIVE_HG
            REP(7) hg_out_phase(F, args, l, need_ctx);
            LBAR();
            REOPAQUE()
#endif
            REP(8) { pg8::Gemm g{(const bf16_t*)(pMix + MX_YS5P), (const bf16_t*)(pWl + WL_GLU), 256, 256, 256}; pg8::StaticOrder S; S.init(nrows, 256, F.G, (F.vcu + F.G - 128) % F.G);
            Epi<EM_GLU> E{}; E.o0 = (bf16_t*)(pMix + MX_YS5); E.i0 = (const bf16_t*)(pMix + MX_YS5P); E.f0 = args->in[18] + l * 256;
            pg8::gemm_phase(F.lds, F.tid, g, S, E); } } PH_END

        PH_BEGIN {
            pg8::Gemm g{(const bf16_t*)(pMix + MX_YS5), (const bf16_t*)(pWl + WL_PA), D, D, D};
            Epi<EM_MERGEF> E{}; E.o0 = pH; E.i0 = pZ;
            if constexpr (l == 0) { HalfTailOrder S; S.S0.init(NLAT, 1024, F.G, (int)blockIdx.x); S.G = F.G; S.c = (int)blockIdx.x; pg8::gemm_phase<Epi<EM_MERGEF>, HalfTailOrder, false, true, false, true>(F.lds, F.tid, g, S, E);
                REOPAQUE() if (F.G == 256 && blockIdx.x >= 64) { moe_convert_items(F, args, 0, 0, ((int)blockIdx.x - 64) * 8 + F.wave, 1536, MC_F / 1536, MC_F); moe_convert_items(F, args, 1, 0, ((int)blockIdx.x - 64) * 8 + F.wave, 1536, MC1_F / 1536, MC1_F); } }
            else { pg8::StaticOrder S; S.init(NLAT, 1024, F.G, (int)blockIdx.x); pg8::gemm_phase<Epi<EM_MERGEF>, pg8::StaticOrder, false, false, false, true>(F.lds, F.tid, g, S, E); }
        } PH_END

        PH_BEGIN { pg8::Gemm g{pH, (const bf16_t*)(pWl + WL_OUT), D, D, D};
            Epi<EM_WOUT> E{}; E.layer = l; E.f0 = pModv; E.f1 = args->in[0]; E.f2 = args->in[2]; E.fo = pX;
            if constexpr (l == 0) { HalfTailOrder S; S.S0.init(NLAT, 1024, F.G, (int)blockIdx.x); S.G = F.G; S.c = (int)blockIdx.x; pg8::gemm_phase<Epi<EM_WOUT>, HalfTailOrder, false, true>(F.lds, F.tid, g, S, E);
                REOPAQUE() if (F.G == 256 && blockIdx.x >= 64) { moe_convert_items(F, args, 0, MC_F, ((int)blockIdx.x - 64) * 8 + F.wave, 1536, 3, MC_F + MC_G); moe_convert_items(F, args, 1, MC1_F, ((int)blockIdx.x - 64) * 8 + F.wave, 1536, MC1_G / 1536, MC1_F + MC1_G); } }
            else { pg8::StaticOrder S; S.init(NLAT, 1024, F.G, (int)blockIdx.x); pg8::gemm_phase(F.lds, F.tid, g, S, E); } } PH_END

        PH_BEGIN { norm2_router_phase(F, args, l, nrows); REOPAQUE() REP(11) moe_convert(F, args, l); } PH_END
        PH_BEGIN REP(13) { const int nt = moe_build_tiles(F, l, true); MoeOrder S{nt * 4, F.G, (int)blockIdx.x, (const LAS int*)(F.lds + TBL_OFF) + 64, (const LAS int*)(F.lds + TBL_OFF) + 512};
            pg8::Gemm g{(const bf16_t*)(F.ws + WS_Z + MZ_H8), (const bf16_t*)(moe_wbase(F, args, l) + MW_W13), D / 2, D / 2, D / 2};
            Epi<EM_MOEUP> E{}; E.o0 = (bf16_t*)(F.ws + WS_Z + MZ_HID); pg8::gemm_phase<Epi<EM_MOEUP>, MoeOrder, true, true, true>(F.lds, F.tid, g, S, E); } PH_END
        PH_BEGIN REP(14) { const int nt = MK_PER_PHASE ? moe_build_tiles(F, l, false) : ((const LAS int*)(F.lds + TBL_OFF))[32] >> 8;
            MoeOrder S{nt * 4, F.G, (int)blockIdx.x, (const LAS int*)(F.lds + TBL_OFF) + 64, (const LAS int*)(F.lds + TBL_OFF) + 512};
            pg8::Gemm g{(const bf16_t*)(F.ws + WS_Z + MZ_HID), (const bf16_t*)(moe_wbase(F, args, l) + MW_W2), HID / 2, HID / 2, HID / 2};
            Epi<EM_MOEDN> E{}; E.o0 = (bf16_t*)(F.ws + WS_Z + MZ_XS); pg8::gemm_phase<Epi<EM_MOEDN>, MoeOrder, false, true, true>(F.lds, F.tid, g, S, E); } PH_END
        PH_BEGIN { if (PROBE_PH == 19) { moe_combine_phase(F, args, l, nrows, true); REOPAQUE() } moe_combine_phase(F, args, l, nrows); } PH_END
    }

__global__ void __launch_bounds__(NWAVES * 64, 2) mega_fwd(Args args_by_value) {
    ArgsP args = (ArgsP)__builtin_amdgcn_kernarg_segment_ptr();
    extern __shared__ __attribute__((aligned(16))) unsigned char lds_raw[];
    Frame F;
    F.lds = (LAS unsigned char*)lds_raw;
    F.tid = threadIdx.x; F.lane = F.tid & 63; F.wave = __builtin_amdgcn_readfirstlane(F.tid >> 6);
    const int wave_s = F.wave;
    F.G = gridDim.x; { const int bx = blockIdx.x; F.vcu = (F.G % 8 == 0) ? (bx % 8) * (F.G / 8) + bx / 8 : bx; }
    F.gw = F.vcu * NWAVES + F.wave; F.NGW = F.G * NWAVES; F.ws = args->ws;
    volatile LAS unsigned* MISC = (volatile LAS unsigned*)(F.lds + MISC_OFF);
    for (int u = F.tid; u < (LDS_BYTES - RING_BYTES) / 4; u += NWAVES * 64) ((LAS unsigned*)(F.lds + RING_BYTES))[u] = 0u;
    __syncthreads();
    unsigned* ctl = (unsigned*)(F.ws + WS_CTL);
    XcdBarrier bar; bar.bar = ctl + CW_BAR; bar.x = 0; bar.st = nullptr;
    if (!MK_PER_PHASE) bar = xcd_barrier_post(ctl + CW_BAR, MISC + 8);
    const int lo = args->ph_lo, hi = args->ph_hi;
    int ph = 0;
    PH_BEGIN REP(17) prologue_phase(F, args); PH_END
    PH_BEGIN REP(16) norm1_phase(F, args, 0, MTOK); PH_END

    layer_prog<0>(F, args, ph, lo, hi, bar, wave_s);
    layer_prog<1>(F, args, ph, lo, hi, bar, wave_s);
#undef PH_BEGIN
#undef REOPAQUE
#undef PH_END
#undef pH
#undef pZ
#undef pX
#undef pMix
#undef pSsq
#undef pRope
#undef pWl
#undef pModv
}
constexpr int N_PHASES = 2 + 2 * 10;

extern "C" void kernel_launch(void* const* d_in, const int* in_sizes, int n_in, void* d_out, int out_size, void* d_ws, size_t ws_size, hipStream_t stream) {
    static int grid = 0;
    if (grid == 0) {
        if (n_in != 38 || out_size != NLAT * D || ws_size < WS_END) { fprintf(stderr, "kernel_launch: unexpected shapes (n_in %d out %d ws %zu need %zu)\n", n_in, out_size, ws_size, (size_t)WS_END); grid = -1; return; }
        int dev = 0, cus = 0, per_cu = 0;
        if (hipGetDevice(&dev) != hipSuccess || hipDeviceGetAttribute(&cus, hipDeviceAttributeMultiprocessorCount, dev) != hipSuccess) { grid = -1; return; }
        if (hipFuncSetAttribute((const void*)mega_fwd, hipFuncAttributeMaxDynamicSharedMemorySize, LDS_BYTES) != hipSuccess) { fprintf(stderr, "kernel_launch: hipFuncSetAttribute failed\n"); grid = -1; return; }
        if (hipOccupancyMaxActiveBlocksPerMultiprocessor(&per_cu, (const void*)mega_fwd, NWAVES * 64, LDS_BYTES) != hipSuccess || per_cu < 1) { fprintf(stderr, "kernel_launch: occupancy query says %d\n", per_cu); }
        (void)hipGetLastError();
        grid = cus;
    }
    if (grid < 0) return;
    (void)hipMemsetAsync((char*)d_ws + WS_CTL, 0, CTL_ZERO_BYTES, stream);
    Args a{};
    for (int i = 0; i < 38; ++i) a.in[i] = (const float*)d_in[i];
    a.out = (float*)d_out; a.ws = (unsigned char*)d_ws;
#if MK_PER_PHASE
    for (int p = 0; p < N_PHASES; ++p) { a.ph_lo = p; a.ph_hi = p + 1; hipLaunchKernelGGL(mega_fwd, dim3(grid), dim3(NWAVES * 64), LDS_BYTES, stream, a); }
#else
    a.ph_lo = 0; a.ph_hi = N_PHASES;
    hipLaunchKernelGGL(mega_fwd, dim3(grid), dim3(NWAVES * 64), LDS_BYTES, stream, a);
#endif
}
```
